# Optimizing an MI355X kernel written in HIP

```python
import jax, jax.numpy as jnp
from jax import lax
import numpy as np

D_MODEL = 1024
BATCH = 4
SEQ = 4096
DEPTH = 2
DEC_BATCH = 128
DEC_SEQ = 4
PAST_LEN = 8192
PAGE_SIZE = 128

N_A_LAYERS = DEPTH // 2
N_B_LAYERS = DEPTH - N_A_LAYERS
ML_HEADS = 4
ML_DV = D_MODEL // ML_HEADS
ML_DK = ML_DV // 2
ML_CHUNK = 64
GATE_SOFTCAP = 15.0
ML_Q_END = ML_HEADS * ML_DK
ML_K_END = 2 * ML_HEADS * ML_DK
ML_V_END = ML_K_END + ML_HEADS * ML_DV
ML_O_END = ML_V_END + ML_HEADS * ML_DV
ML_I_END = ML_O_END + ML_HEADS
ML_IN = ML_I_END + ML_HEADS
ATT_HD = 64
ATT_QH = D_MODEL // ATT_HD
ATT_KVH = 4
ATT_GROUP = ATT_QH // ATT_KVH
WINDOW = 128
ATT_BLOCK = 128
D_FF = 4 * D_MODEL
EPS = 1e-6

kernel_name = "yoco_mlstm_swa_sink_decoder_step"


def rmsnorm(x, g):
    xf = x.astype(jnp.float32)
    y = xf * lax.rsqrt(jnp.mean(xf * xf, axis=-1, keepdims=True) + EPS)
    return (y * g.astype(jnp.float32)).astype(x.dtype)


def softcap(x):
    return GATE_SOFTCAP * jnp.tanh(x / GATE_SOFTCAP)


def mlstm_chunkwise(q, k, v, log_i, log_f, C0, n0, m0, chunk):
    B, L, H, DK = q.shape
    DV = v.shape[-1]
    nc = L // chunk

    def split(a):
        return jnp.moveaxis(a.reshape((B, nc, chunk) + a.shape[2:]), 1, 0)

    xs = (split(q), split(k), split(v), split(log_i), split(log_f))
    causal = jnp.tril(jnp.ones((chunk, chunk), dtype=bool))[None, :, :, None]

    def step(carry, inp):
        C, n, m = carry
        qc, kc, vc, lic, lfc = inp
        b = jnp.cumsum(lfc, axis=1)
        dmat = b[:, :, None, :] - b[:, None, :, :] + lic[:, None, :, :]
        dmat = jnp.where(causal, dmat, -jnp.inf)
        inter = b + m[:, None, :]
        m_t = jnp.maximum(inter, jnp.max(dmat, axis=2))
        w = jnp.exp(dmat - m_t[:, :, None, :])
        a_inter = jnp.exp(inter - m_t)
        s = jnp.einsum('bthd,bshd->btsh', qc, kc) * w
        num = jnp.einsum('btsh,bshv->bthv', s, vc) + a_inter[..., None] * jnp.einsum('bthd,bhdv->bthv', qc, C)
        den = jnp.sum(s, axis=2) + a_inter * jnp.einsum('bthd,bhd->bth', qc, n)
        h = num / jnp.maximum(jnp.abs(den), jnp.exp(-m_t))[..., None]
        m_new = m_t[:, -1]
        b_last = b[:, -1]
        decay = jnp.exp(b_last + m - m_new)
        wk = jnp.exp(b_last[:, None, :] - b + lic - m_new[:, None, :])
        C_new = decay[..., None, None] * C + jnp.einsum('bsh,bshd,bshv->bhdv', wk, kc, vc)
        n_new = decay[..., None] * n + jnp.einsum('bsh,bshd->bhd', wk, kc)
        return (C_new, n_new, m_new), h

    (C, n, m), hs = lax.scan(step, (C0, n0, m0), xs)
    h = jnp.moveaxis(hs, 0, 1).reshape(B, L, H, DV)
    return h, C, n, m


def mlstm_mixer(x, norm_g, w_in, b_i, b_f, head_g, w_out, C0, n0, m0, chunk):
    B, L, _ = x.shape
    p = rmsnorm(x, norm_g) @ w_in
    q = p[..., :ML_Q_END].reshape(B, L, ML_HEADS, ML_DK).astype(jnp.float32)
    k = p[..., ML_Q_END:ML_K_END].reshape(B, L, ML_HEADS, ML_DK).astype(jnp.float32) * (ML_DK ** -0.5)
    v = p[..., ML_K_END:ML_V_END].reshape(B, L, ML_HEADS, ML_DV).astype(jnp.float32)
    o = jax.nn.sigmoid(p[..., ML_V_END:ML_O_END].astype(jnp.float32))
    log_i = softcap(p[..., ML_O_END:ML_I_END].astype(jnp.float32) + b_i.astype(jnp.float32))
    log_f = jax.nn.log_sigmoid(softcap(p[..., ML_I_END:].astype(jnp.float32) + b_f.astype(jnp.float32)))
    h, C, n, m = mlstm_chunkwise(q, k, v, log_i, log_f, C0.astype(jnp.float32),
                                 n0.astype(jnp.float32), m0.astype(jnp.float32), chunk)
    h = rmsnorm(h, head_g.reshape(ML_HEADS, ML_DV)).reshape(B, L, ML_HEADS * ML_DV)
    return x + (o * h).astype(x.dtype) @ w_out, C, n, m


def sqrelu_mlp(x, g, w1, w2):
    return x + jnp.square(jax.nn.relu(rmsnorm(x, g) @ w1)) @ w2


def shared_kv(x, g, w_kv, k_norm_g):
    B, L, _ = x.shape
    kv = rmsnorm(x, g) @ w_kv
    k = kv[..., :ATT_KVH * ATT_HD].reshape(B, L, ATT_KVH, ATT_HD)
    v = kv[..., ATT_KVH * ATT_HD:].reshape(B, L, ATT_KVH, ATT_HD)
    return rmsnorm(k, k_norm_g), v


def sink_attention(q, k, v, mask, sinks):
    s = jnp.einsum('...qhgd,...khd->...hgqk', q.astype(jnp.float32), k.astype(jnp.float32)) * (ATT_HD ** -0.5)
    s = jnp.where(mask, s, -jnp.inf)
    sink_col = jnp.broadcast_to(sinks.astype(jnp.float32)[:, :, None, None], s.shape[:-1] + (1,))
    p = jax.nn.softmax(jnp.concatenate([s, sink_col], axis=-1), axis=-1)[..., :-1]
    return jnp.einsum('...hgqk,...khd->...qhgd', p, v.astype(jnp.float32))


def banded_window_attention(q, k, v, sinks):
    B, L = q.shape[:2]
    nb = L // ATT_BLOCK
    qb = q.reshape(B, nb, ATT_BLOCK, ATT_KVH, ATT_GROUP, ATT_HD)

    def band(a):
        ap = jnp.concatenate([jnp.zeros_like(a[:, :ATT_BLOCK]), a], axis=1)
        ap = ap.reshape(B, nb + 1, ATT_BLOCK, ATT_KVH, ATT_HD)
        return jnp.concatenate([ap[:, :-1], ap[:, 1:]], axis=2)

    kb, vb = band(k), band(v)
    qi = jnp.arange(ATT_BLOCK)[:, None] + ATT_BLOCK
    ki = jnp.arange(2 * ATT_BLOCK)[None, :]
    rel = qi - ki
    blk = jnp.arange(nb)[:, None, None]
    mask = (rel >= 0) & (rel <= WINDOW) & (blk * ATT_BLOCK - ATT_BLOCK + ki >= 0)
    o = sink_attention(qb, kb, vb, mask[None, :, None, None], sinks)
    return o.reshape(B, L, ATT_KVH, ATT_GROUP, ATT_HD)


def cached_window_attention(q, k, v, win_k, win_v, sinks):
    L = q.shape[1]
    W = win_k.shape[1]
    kk = jnp.concatenate([win_k.astype(k.dtype), k], axis=1)
    vv = jnp.concatenate([win_v.astype(v.dtype), v], axis=1)
    rel = (jnp.arange(L)[:, None] + W) - jnp.arange(W + L)[None, :]
    mask = (rel >= 0) & (rel <= WINDOW)
    o = sink_attention(q, kk, vv, mask, sinks)
    return o, kk[:, -W:], vv[:, -W:]


def swa_mixer(x, k, v, win_k, win_v, norm_g, w_q, q_norm_g, sinks, w_o):
    B, L, _ = x.shape
    q = (rmsnorm(x, norm_g) @ w_q).reshape(B, L, ATT_KVH, ATT_GROUP, ATT_HD)
    q = rmsnorm(q, q_norm_g)
    sk = sinks.reshape(ATT_KVH, ATT_GROUP)
    if win_k is None:
        o = banded_window_attention(q, k, v, sk)
        new_k, new_v = k[:, -WINDOW:], v[:, -WINDOW:]
    else:
        o, new_k, new_v = cached_window_attention(q, k, v, win_k, win_v, sk)
    return x + o.reshape(B, L, ATT_QH * ATT_HD).astype(x.dtype) @ w_o, new_k, new_v


def run_trunk(x, C0, n0, m0, win_k, win_v, chunk,
              ml_norm_g, ml_w_in, ml_b_i, ml_b_f, ml_head_g, ml_w_out,
              kv_norm_g, w_kv, k_norm_g,
              att_norm_g, att_w_q, q_norm_g, att_sinks, att_w_o,
              mlp_norm_g, mlp_w1, mlp_w2):
    Cs, ns, ms = [], [], []
    kv_k = kv_v = new_k = new_v = None
    for layer in range(DEPTH):
        if layer < N_A_LAYERS:
            x, C, n, m = mlstm_mixer(x, ml_norm_g[layer], ml_w_in[layer], ml_b_i[layer], ml_b_f[layer],
                                     ml_head_g[layer], ml_w_out[layer], C0[layer], n0[layer], m0[layer], chunk)
            Cs.append(C); ns.append(n); ms.append(m)
        else:
            j = layer - N_A_LAYERS
            x, new_k, new_v = swa_mixer(x, kv_k, kv_v, win_k, win_v, att_norm_g[j], att_w_q[j],
                                        q_norm_g[j], att_sinks[j], att_w_o[j])
        x = sqrelu_mlp(x, mlp_norm_g[layer], mlp_w1[layer], mlp_w2[layer])
        if layer == N_A_LAYERS - 1:
            kv_k, kv_v = shared_kv(x, kv_norm_g, w_kv, k_norm_g)
    return x, jnp.stack(Cs), jnp.stack(ns), jnp.stack(ms), new_k, new_v


def setup_inputs(seed: int = 0) -> dict:
    key = jax.random.key(seed)
    ks = jax.random.split(key, 32)
    f32 = jnp.float32
    nrm = lambda k, shape, s=1.0: (jax.random.normal(k, shape, f32) * s)
    return {
        "x_prompt": nrm(ks[0], (BATCH, SEQ, D_MODEL)),
        "x_sample": nrm(ks[1], (DEC_BATCH, DEC_SEQ, D_MODEL)),
        "state_mlstm_C": nrm(ks[2], (N_A_LAYERS, DEC_BATCH, ML_HEADS, ML_DK, ML_DV), 0.5),
        "state_mlstm_n": nrm(ks[3], (N_A_LAYERS, DEC_BATCH, ML_HEADS, ML_DK), 0.5),
        "state_mlstm_m": nrm(ks[4], (N_A_LAYERS, DEC_BATCH, ML_HEADS)),
        "cache_win_k": nrm(ks[5], (DEC_BATCH, WINDOW, ATT_KVH, ATT_HD)),
        "cache_win_v": nrm(ks[6], (DEC_BATCH, WINDOW, ATT_KVH, ATT_HD)),
        "ml_norm_g": 1.0 + nrm(ks[7], (N_A_LAYERS, D_MODEL), 0.02),
        "ml_w_in": nrm(ks[8], (N_A_LAYERS, D_MODEL, ML_IN), D_MODEL ** -0.5),
        "ml_b_i": nrm(ks[9], (N_A_LAYERS, ML_HEADS), 0.1),
        "ml_b_f": 3.0 + nrm(ks[10], (N_A_LAYERS, ML_HEADS), 0.1),
        "ml_head_g": 1.0 + nrm(ks[11], (N_A_LAYERS, ML_HEADS * ML_DV), 0.02),
        "ml_w_out": nrm(ks[12], (N_A_LAYERS, ML_HEADS * ML_DV, D_MODEL), (ML_HEADS * ML_DV) ** -0.5),
        "kv_norm_g": 1.0 + nrm(ks[13], (D_MODEL,), 0.02),
        "w_kv": nrm(ks[14], (D_MODEL, 2 * ATT_KVH * ATT_HD), D_MODEL ** -0.5),
        "k_norm_g": 1.0 + nrm(ks[15], (ATT_HD,), 0.02),
        "att_norm_g": 1.0 + nrm(ks[16], (N_B_LAYERS, D_MODEL), 0.02),
        "att_w_q": nrm(ks[17], (N_B_LAYERS, D_MODEL, ATT_QH * ATT_HD), D_MODEL ** -0.5),
        "q_norm_g": 1.0 + nrm(ks[18], (N_B_LAYERS, ATT_HD), 0.02),
        "att_sinks": nrm(ks[19], (N_B_LAYERS, ATT_QH), 0.5),
        "att_w_o": nrm(ks[20], (N_B_LAYERS, ATT_QH * ATT_HD, D_MODEL), (ATT_QH * ATT_HD) ** -0.5),
        "mlp_norm_g": 1.0 + nrm(ks[21], (DEPTH, D_MODEL), 0.02),
        "mlp_w1": nrm(ks[22], (DEPTH, D_MODEL, D_FF), D_MODEL ** -0.5),
        "mlp_w2": nrm(ks[23], (DEPTH, D_FF, D_MODEL), D_FF ** -0.5),
    }


def reference(x_prompt, x_sample, state_mlstm_C, state_mlstm_n, state_mlstm_m, cache_win_k, cache_win_v,
              ml_norm_g, ml_w_in, ml_b_i, ml_b_f, ml_head_g, ml_w_out,
              kv_norm_g, w_kv, k_norm_g,
              att_norm_g, att_w_q, q_norm_g, att_sinks, att_w_o,
              mlp_norm_g, mlp_w1, mlp_w2):
    B, L, _ = x_prompt.shape
    C0 = jnp.zeros((N_A_LAYERS, B, ML_HEADS, ML_DK, ML_DV), jnp.float32)
    n0 = jnp.zeros((N_A_LAYERS, B, ML_HEADS, ML_DK), jnp.float32)
    m0 = jnp.zeros((N_A_LAYERS, B, ML_HEADS), jnp.float32)
    prompt_chunk = ML_CHUNK if L % ML_CHUNK == 0 else L
    y_prompt, p_C, p_n, p_m, p_wk, p_wv = run_trunk(
        x_prompt, C0, n0, m0, None, None, prompt_chunk,
        ml_norm_g, ml_w_in, ml_b_i, ml_b_f, ml_head_g, ml_w_out,
        kv_norm_g, w_kv, k_norm_g, att_norm_g, att_w_q, q_norm_g, att_sinks, att_w_o,
        mlp_norm_g, mlp_w1, mlp_w2)
    y_sample, s_C, s_n, s_m, s_wk, s_wv = run_trunk(
        x_sample, state_mlstm_C, state_mlstm_n, state_mlstm_m, cache_win_k, cache_win_v, x_sample.shape[1],
        ml_norm_g, ml_w_in, ml_b_i, ml_b_f, ml_head_g, ml_w_out,
        kv_norm_g, w_kv, k_norm_g, att_norm_g, att_w_q, q_norm_g, att_sinks, att_w_o,
        mlp_norm_g, mlp_w1, mlp_w2)
    return (y_prompt, y_sample, p_C, p_n, p_m, p_wk, p_wv, s_C, s_n, s_m, s_wk, s_wv)
```

```cpp
#include <hip/hip_runtime.h>
#include <hip/hip_cooperative_groups.h>
#include <cstdio>
#include <cstdint>
namespace cg = cooperative_groups;

typedef unsigned short bf16_t;
typedef short bf16x8 __attribute__((ext_vector_type(8)));
typedef short bf16x4 __attribute__((ext_vector_type(4)));
typedef float f32x4 __attribute__((ext_vector_type(4)));
typedef unsigned u32x4 __attribute__((ext_vector_type(4)));
typedef unsigned u32x2 __attribute__((ext_vector_type(2)));

constexpr int D = 1024, TP = 16384, TS = 512, T = TP + TS;
constexpr int NIN = 3072, LDW_IN = 3080, FF = 4096, NKVQ = 1536;
constexpr float EPS = 1e-6f;
constexpr int NTHREADS = 512;
constexpr int LDS_BYTES = 147456;
#ifndef REP_P0
#define REP_P0 1
#endif
#ifndef REP_2AL
#define REP_2AL 1
#endif
#ifndef REP_2AS
#define REP_2AS 1
#endif
#ifndef REP_2C
#define REP_2C 1
#endif
#ifndef REP_7P
#define REP_7P 1
#endif
#ifndef REP_7S
#define REP_7S 1
#endif
#ifndef REP_PG
#define REP_PG 1
#endif
#ifndef REP_SG
#define REP_SG 1
#endif
#ifndef MAX_PHASE
#define MAX_PHASE 13
#endif
#ifndef N_LAUNCH_MODE
#define N_LAUNCH_MODE 1
#endif

constexpr size_t MiB = 1u << 20;
constexpr size_t WS_SS = 0;
constexpr size_t WS_CHB = 256 * 1024, WS_CHM = WS_CHB + 4096, WS_MPREV = WS_CHM + 4096;
constexpr size_t WS_GATES = 1 * MiB;
constexpr size_t WS_GN = 2 * MiB;
constexpr size_t WS_BAR = 3 * MiB, BAR_BYTES = 16384;
constexpr size_t WS_WIN = 4 * MiB, WS_WOUT = 10 * MiB, WS_W1A = 12 * MiB, WS_W2A = 20 * MiB, WS_WKVQ = 28 * MiB, WS_WO = 31 * MiB, WS_W1B = 33 * MiB, WS_W2B = 41 * MiB;
constexpr size_t WS_XB = 49 * MiB;
constexpr size_t WS_P = 82 * MiB;
constexpr size_t WS_HG = 181 * MiB;
constexpr size_t WS_HID = 82 * MiB;
constexpr size_t WS_KVQ = 82 * MiB;
constexpr size_t WS_ATT = 132 * MiB;
constexpr size_t WS_END = 214 * MiB;

constexpr size_t O_Y = 0, O_PC = 17301504, O_PN = 17825792, O_PM = 17827840, O_PWK = 17827856, O_PWV = 17958928,
                 O_SC = 18090000, O_SN = 34867216, O_SM = 34932752, O_SWK = 34933264, O_SWV = 39127568, O_END = 43321872;

struct Params {
    const float *x_prompt, *x_sample, *st_C, *st_n, *st_m, *cache_k, *cache_v;
    const float *ml_norm_g, *ml_w_in, *ml_b_i, *ml_b_f, *ml_head_g, *ml_w_out;
    const float *kv_norm_g, *w_kv, *k_norm_g;
    const float *att_norm_g, *att_w_q, *q_norm_g, *att_sinks, *att_w_o;
    const float *mlp_norm_g, *mlp_w1, *mlp_w2;
    float* out; unsigned char* ws;
    int ph_lo, ph_hi;
};

typedef float f32x2 __attribute__((ext_vector_type(2)));
typedef __bf16 bf16x2n __attribute__((ext_vector_type(2)));
__device__ __forceinline__ unsigned cvt_pk_bf16(float lo, float hi) { const f32x2 v = {lo, hi}; const bf16x2n b = __builtin_convertvector(v, bf16x2n); return __builtin_bit_cast(unsigned, b); }
__device__ __forceinline__ bf16_t f2bf(float f) { return (bf16_t)(cvt_pk_bf16(f, 0.f) & 0xffffu); }
__device__ __forceinline__ float bf2f(bf16_t h) { return __uint_as_float(((unsigned)h) << 16); }
__device__ __forceinline__ float bflo(unsigned u) { return __uint_as_float(u << 16); }
__device__ __forceinline__ float bfhi(unsigned u) { return __uint_as_float(u & 0xffff0000u); }
__device__ __forceinline__ float wave_sum(float v) {
#pragma unroll
    for (int o = 1; o < 64; o <<= 1) v += __shfl_xor(v, o);
    return v;
}
__device__ __forceinline__ float wave_max(float v) {
#pragma unroll
    for (int o = 1; o < 64; o <<= 1) v = fmaxf(v, __shfl_xor(v, o));
    return v;
}
__device__ __forceinline__ float scan_sum(float x, int lane) {
#pragma unroll
    for (int o = 1; o < 64; o <<= 1) { float y = __shfl_up(x, o); if (lane >= o) x += y; }
    return x;
}
__device__ __forceinline__ float scan_max(float x, int lane) {
#pragma unroll
    for (int o = 1; o < 64; o <<= 1) { float y = __shfl_up(x, o); if (lane >= o) x = fmaxf(x, y); }
    return x;
}
__device__ __forceinline__ float softcap15(float x) { return 15.f * tanhf(x * (1.f / 15.f)); }
__device__ __forceinline__ float logsigmoid(float z) { return fminf(z, 0.f) - log1pf(__expf(-fabsf(z))); }
__device__ __forceinline__ float sigmoidf_(float z) { return 1.f / (1.f + __expf(-z)); }
#define LDS_WAIT() asm volatile("s_waitcnt lgkmcnt(0)" ::: "memory")
#define MFMA32(x, y, acc) __builtin_amdgcn_mfma_f32_16x16x32_bf16((x), (y), (acc), 0, 0, 0)
#define MFMA16(x, y, acc) __builtin_amdgcn_mfma_f32_16x16x16bf16_1k((x), (y), (acc), 0, 0, 0)

__device__ __forceinline__ void transpose_item(const float* __restrict__ W, int ldw, int K, const float* __restrict__ gk, float cs,
                                               bf16_t* WT, int row_off, int k0, int n0, float* scr, int lane) {
    {
        const int kr = lane >> 3, n4 = (lane & 7) * 4;
        f32x4 wv[8];
#pragma unroll
        for (int i = 0; i < 8; ++i) wv[i] = *(const f32x4*)(W + (size_t)(k0 + kr + 8 * i) * ldw + n0 + n4);
#pragma unroll
        for (int i = 0; i < 8; ++i) {
            const int kk = kr + 8 * i;
            const float g = gk ? gk[k0 + kk] * cs : cs;
            float* d = scr + kk * 33 + n4;
            d[0] = wv[i].x * g; d[1] = wv[i].y * g; d[2] = wv[i].z * g; d[3] = wv[i].w * g;
        }
    }
    LDS_WAIT();
    const int c = lane & 7;
#pragma unroll
    for (int j = 0; j < 4; ++j) {
        const int n = (lane >> 3) + 8 * j; const float* s = scr + (8 * c) * 33 + n;
        u32x4 o; o.x = cvt_pk_bf16(s[0 * 33], s[1 * 33]); o.y = cvt_pk_bf16(s[2 * 33], s[3 * 33]); o.z = cvt_pk_bf16(s[4 * 33], s[5 * 33]); o.w = cvt_pk_bf16(s[6 * 33], s[7 * 33]);
        *(u32x4*)(WT + (size_t)(row_off + n0 + n) * K + k0 + 8 * c) = o;
    }
    LDS_WAIT();
}

__device__ __forceinline__ void p0_prologue(const Params& p, unsigned char* lds, int bid, int G) {
    const int tid = threadIdx.x, lane = tid & 63, wid = tid >> 6;
    unsigned char* ws = p.ws;
    float* scr = (float*)(lds + wid * 8448);
    float* wif = (float*)(lds + 73728);
    for (int k = tid; k < 1024; k += NTHREADS) {
        const float g = p.ml_norm_g[k];
        const f32x4 a = *(const f32x4*)(p.ml_w_in + (size_t)k * LDW_IN + 3072), b = *(const f32x4*)(p.ml_w_in + (size_t)k * LDW_IN + 3076);
        wif[0 * 1024 + k] = a.x * g; wif[1 * 1024 + k] = a.y * g; wif[2 * 1024 + k] = a.z * g; wif[3 * 1024 + k] = a.w * g;
        wif[4 * 1024 + k] = b.x * g; wif[5 * 1024 + k] = b.y * g; wif[6 * 1024 + k] = b.z * g; wif[7 * 1024 + k] = b.w * g;
    }
    { float* ss = (float*)(ws + WS_SS); for (int i = bid * NTHREADS + tid; i < 3 * T; i += G * NTHREADS) ss[i] = 0.f; }
    __syncthreads();
    const int gw = bid * 8 + wid, NGW = G * 8;
    constexpr int I_IN = 16 * 96, I_SQ = 16 * 32, I_1 = 16 * 128, I_2 = 64 * 32, I_KV = 16 * 16;
    constexpr int NITEMS = I_IN + I_SQ + I_1 + I_2 + I_KV + I_SQ;
    for (int it = gw; it < NITEMS; it += NGW) {
        int r = it;
        if (r < I_IN) { const int kb = r / 96, nb = r % 96, n0 = nb * 32; const float cs = (n0 >= 512 && n0 < 1024) ? 0.08838834764831845f : 1.f;
            transpose_item(p.ml_w_in, LDW_IN, 1024, p.ml_norm_g, cs, (bf16_t*)(ws + WS_WIN), 0, kb * 64, n0, scr, lane); continue; } r -= I_IN;
        if (r < I_SQ) { transpose_item(p.ml_w_out, 1024, 1024, nullptr, 1.f, (bf16_t*)(ws + WS_WOUT), 0, (r / 32) * 64, (r % 32) * 32, scr, lane); continue; } r -= I_SQ;
        if (r < I_1) { transpose_item(p.mlp_w1, 4096, 1024, p.mlp_norm_g, 1.f, (bf16_t*)(ws + WS_W1A), 0, (r / 128) * 64, (r % 128) * 32, scr, lane); continue; } r -= I_1;
        if (r < I_2) { transpose_item(p.mlp_w2, 1024, 4096, nullptr, 1.f, (bf16_t*)(ws + WS_W2A), 0, (r / 32) * 64, (r % 32) * 32, scr, lane); continue; } r -= I_2;
        if (r < I_KV) { transpose_item(p.w_kv, 512, 1024, p.kv_norm_g, 1.f, (bf16_t*)(ws + WS_WKVQ), 0, (r / 16) * 64, (r % 16) * 32, scr, lane); continue; } r -= I_KV;
        transpose_item(p.att_w_q, 1024, 1024, p.att_norm_g, 1.f, (bf16_t*)(ws + WS_WKVQ), 512, (r / 32) * 64, (r % 32) * 32, scr, lane);
    }
    bf16_t* XB = (bf16_t*)(ws + WS_XB); float* gates = (float*)(ws + WS_GATES);
    for (int m = gw; m < T; m += NGW) {
        const float* xrow = m < TP ? p.x_prompt + (size_t)m * D : p.x_sample + (size_t)(m - TP) * D;
        f32x4 v[4]; float s = 0.f;
#pragma unroll
        for (int j = 0; j < 4; ++j) { v[j] = *(const f32x4*)(xrow + 4 * lane + 256 * j); s += (v[j].x * v[j].x + v[j].y * v[j].y) + (v[j].z * v[j].z + v[j].w * v[j].w); }
        const float rstd = rsqrtf(wave_sum(s) * (1.f / D) + EPS);
        if (m >= TP) {
#pragma unroll
            for (int j = 0; j < 4; ++j) *(f32x4*)(p.out + O_Y + (size_t)m * D + 4 * lane + 256 * j) = v[j];
        }
#pragma unroll
        for (int j = 0; j < 4; ++j) { u32x2 w; w.x = cvt_pk_bf16(v[j].x * rstd, v[j].y * rstd); w.y = cvt_pk_bf16(v[j].z * rstd, v[j].w * rstd); *(u32x2*)(XB + (size_t)m * D + 4 * lane + 256 * j) = w; }
        float mine = 0.f;
#pragma unroll
        for (int g = 0; g < 8; ++g) {
            float a = 0.f;
#pragma unroll
            for (int j = 0; j < 4; ++j) { const f32x4 w = *(const f32x4*)(wif + g * 1024 + 4 * lane + 256 * j); a += (v[j].x * w.x + v[j].y * w.y) + (v[j].z * w.z + v[j].w * w.w); }
            a = wave_sum(a) * rstd;
            if (lane == g) mine = a;
        }
        if (lane < 4) gates[(size_t)m * 8 + lane] = softcap15(mine + p.ml_b_i[lane]);
        else if (lane < 8) gates[(size_t)m * 8 + lane] = logsigmoid(softcap15(mine + p.ml_b_f[lane - 4]));
    }
}

__device__ __forceinline__ void late_weights(const Params& p, unsigned char* lds, int slot, int nslots) {
    const int tid = threadIdx.x, lane = tid & 63, wid = tid >> 6;
    unsigned char* ws = p.ws;
    float* scr = (float*)(lds + wid * 8448);
    constexpr int I_SQ = 16 * 32, I_1 = 16 * 128, I_2 = 64 * 32, NIT = I_SQ + I_1 + I_2;
    for (int it = slot * 8 + wid; it < NIT; it += nslots * 8) {
        int r = it;
        if (r < I_SQ) { transpose_item(p.att_w_o, 1024, 1024, nullptr, 1.f, (bf16_t*)(ws + WS_WO), 0, (r / 32) * 64, (r % 32) * 32, scr, lane); continue; } r -= I_SQ;
        if (r < I_1) { transpose_item(p.mlp_w1 + (size_t)1024 * 4096, 4096, 1024, p.mlp_norm_g + 1024, 1.f, (bf16_t*)(ws + WS_W1B), 0, (r / 128) * 64, (r % 128) * 32, scr, lane); continue; } r -= I_1;
        transpose_item(p.mlp_w2 + (size_t)4096 * 1024, 1024, 4096, nullptr, 1.f, (bf16_t*)(ws + WS_W2B), 0, (r / 32) * 64, (r % 32) * 32, scr, lane);
    }
}

struct EpiBf16 {
    bf16_t* out; int ld; const float* ss; int act;
    template <int NQ, bool PAIRED> __device__ __forceinline__ void row(int r, const int (&c)[NQ], const f32x4 (&v)[NQ], int fq, float rscale) const {
        float sc = rscale; if (ss) sc = rsqrtf(ss[r] * (1.f / 1024.f) + EPS);
        u32x2 w[NQ];
#pragma unroll
        for (int q = 0; q < NQ; ++q) {
            f32x4 x = v[q] * sc;
            if (act) { x.x = fmaxf(x.x, 0.f); x.y = fmaxf(x.y, 0.f); x.z = fmaxf(x.z, 0.f); x.w = fmaxf(x.w, 0.f); x = x * x; }
            w[q].x = cvt_pk_bf16(x.x, x.y); w[q].y = cvt_pk_bf16(x.z, x.w);
        }
        if (PAIRED) {
#pragma unroll
            for (int q = 0; q < NQ; q += 2) { u32x4 o; o.x = w[q].x; o.y = w[q].y; o.z = w[q + 1].x; o.w = w[q + 1].y; *(u32x4*)(out + (size_t)r * ld + c[q]) = o; }
        } else {
#pragma unroll
            for (int q = 0; q < NQ; ++q) *(u32x2*)(out + (size_t)r * ld + c[q]) = w[q];
        }
    }
};
struct EpiRes {
    const float* srcp; const float* srcs; float* dst; bf16_t* xb; float* ss;
    template <int NQ, bool PAIRED> __device__ __forceinline__ void row(int r, const int (&c)[NQ], const f32x4 (&v)[NQ], int fq, float rscale) const {
        const float* s = r < TP ? srcp + (size_t)r * D : srcs + (size_t)(r - TP) * D;
        float a2 = 0.f;
        u32x2 w[NQ];
#pragma unroll
        for (int q = 0; q < NQ; ++q) {
            const f32x4 o = *(const f32x4*)(s + c[q]) + v[q];
            *(f32x4*)(dst + (size_t)r * D + c[q]) = o;
            w[q].x = cvt_pk_bf16(o.x, o.y); w[q].y = cvt_pk_bf16(o.z, o.w);
            a2 += (o.x * o.x + o.y * o.y) + (o.z * o.z + o.w * o.w);
        }
        if (xb) {
            if (PAIRED) {
#pragma unroll
                for (int q = 0; q < NQ; q += 2) { u32x4 o; o.x = w[q].x; o.y = w[q].y; o.z = w[q + 1].x; o.w = w[q + 1].y; *(u32x4*)(xb + (size_t)r * D + c[q]) = o; }
            } else {
#pragma unroll
                for (int q = 0; q < NQ; ++q) *(u32x2*)(xb + (size_t)r * D + c[q]) = w[q];
            }
        }
        if (ss) { a2 += __shfl_xor(a2, 16); a2 += __shfl_xor(a2, 32); if (fq == 0) atomicAdd(ss + r, a2); }
    }
};

namespace pg8 {
#define PG8_LAS __attribute__((address_space(3)))
typedef unsigned short bf16_t;
typedef short bf16x8 __attribute__((ext_vector_type(8)));
typedef float f32x4 __attribute__((ext_vector_type(4)));
typedef unsigned u32x4 __attribute__((ext_vector_type(4)));
constexpr int BM = 256, BK = 64, HALF = 128, HTB = HALF * BK * 2  , STAGE_BYTES = 8 * HTB, NXCD = 8, WGM = 8;

__host__ __device__ __forceinline__ int lds_byte(int r, int c) { const int st = (r >> 4) * 2 + (c >> 5), rr = r & 15, cc = c & 31, ob = rr * 64 + cc * 2; return st * 1024 + (ob ^ (((ob >> 9) & 1) << 5)); }
__host__ __device__ __forceinline__ void stage_rc(int b, int& R, int& C) { const int st = b / 1024, sb = b % 1024, swz = sb ^ (((sb >> 9) & 1) << 5); R = (st >> 1) * 16 + swz / 64; C = (st & 1) * 32 + (swz % 64) / 2; }
__host__ __device__ __forceinline__ int perm32(int rho) { const int n = rho >> 4, i = rho & 15; return 8 * (i >> 2) + 4 * n + (i & 3); }

struct Unit { int pm, pn; };
struct Gemm { const bf16_t* A; const bf16_t* Bt; int M, N, K; int revk; };

struct StaticOrder {
    int nM, nN, nwg, G, c;
    __host__ __device__ void init(int M, int N, int G_, int c_) { nM = M / BM; nN = N / BM; nwg = nM * nN; G = G_; c = c_; }
    __host__ __device__ bool next(int i, Unit& u) const {
        const long L = (long)i * G + c; if (L >= nwg) return false;
        int wgid = (int)L; { const int q = nwg / NXCD, r = nwg % NXCD, xcd = wgid % NXCD, off = wgid / NXCD; wgid = (xcd < r ? xcd * (q + 1) : r * (q + 1) + (xcd - r) * q) + off; }
        const int nig = WGM * nN, gid = wgid / nig, fm = gid * WGM, gsz = (nM - fm) < WGM ? (nM - fm) : WGM;
        u.pm = fm + ((wgid % nig) % gsz); u.pn = (wgid % nig) / gsz; return true;
    }
    __device__ __forceinline__ void a_ready(const Unit&) const {}
    __device__ __forceinline__ void done(const Unit&) const {}
};


template <class Epi, class Sched, bool ALIGN_EPI = false, bool SP2 = false>
__device__ __forceinline__ void gemm_phase(PG8_LAS unsigned char* lds, const Gemm g, const Sched& S, const Epi& E) {
    const int tid = threadIdx.x, wid = __builtin_amdgcn_readfirstlane(tid >> 6), lane = tid & 63, wr = wid >> 2, wc = wid & 3, fr = lane & 15, fq = lane >> 4;
    const int K = g.K, nt = K / BK;
    unsigned voffA[2], voffB[2];
#pragma unroll
    for (int i = 0; i < 2; ++i) { int R, C; stage_rc(tid * 16 + i * 8192, R, C); const int Rb = Epi::PERM ? ((R & ~31) + perm32(R & 31)) : R;
        voffA[i] = (unsigned)(R * K + C) * 2u; voffB[i] = (unsigned)(Rb * K + C) * 2u; }
    const size_t kstep = g.revk ? (size_t)0 - (size_t)(BK * 2) : (size_t)(BK * 2);
    const size_t koff = g.revk ? (size_t)(K - BK) * 2 : (size_t)0;
    const size_t hstep = (size_t)HALF * K * 2;
    const size_t tstep = 2 * hstep;
    const unsigned ldsw = (unsigned)wid * 1024u;
    const int aoff = lds_byte(wr * 64 + fr, fq * 8), boff = lds_byte(wc * 32 + fr, fq * 8);
#define PG8_SA(b, h) (((b) * 2 + (h)) * HTB)
#define PG8_SB(b, h) ((4 + (b) * 2 + (h)) * HTB)
#define PG8_STAGE(bufoff, gbase, voff) do { _Pragma("unroll") for (int _i = 0; _i < 2; ++_i) \
        __builtin_amdgcn_global_load_lds((const unsigned*)((const char*)(gbase) + (voff)[_i]), (PG8_LAS unsigned*)(lds + (bufoff) + ldsw + _i * 8192), 16, 0, 0); } while (0)
#define PG8_LDA(dst, b, h) do { _Pragma("unroll") for (int m = 0; m < 4; ++m) _Pragma("unroll") for (int k = 0; k < 2; ++k) dst[m][k] = *(const PG8_LAS bf16x8*)(lds + PG8_SA(b, h) + aoff + m * 2048 + k * 1024); } while (0)
#define PG8_LDB(dst, b, h) do { _Pragma("unroll") for (int n = 0; n < 2; ++n) _Pragma("unroll") for (int k = 0; k < 2; ++k) dst[n][k] = *(const PG8_LAS bf16x8*)(lds + PG8_SB(b, h) + boff + n * 2048 + k * 1024); } while (0)
#define PG8_MMA(ai, bj, At, Bt) do { __builtin_amdgcn_s_setprio(1); _Pragma("unroll") for (int m = 0; m < 4; ++m) _Pragma("unroll") for (int n = 0; n < 2; ++n) _Pragma("unroll") for (int k = 0; k < 2; ++k) \
        acc[ai][bj][m][n] = __builtin_amdgcn_mfma_f32_16x16x32_bf16(Bt[n][k], At[m][k], acc[ai][bj][m][n], 0, 0, 0); __builtin_amdgcn_s_setprio(0); } while (0)
#define PG8_WAIT_V(n) asm volatile("s_waitcnt vmcnt(" #n ")" ::: "memory")
#define PG8_WAIT_L(n) asm volatile("s_waitcnt lgkmcnt(" #n ")" ::: "memory")
#define PG8_BAR __builtin_amdgcn_s_barrier()
#define PG8_SCHED __builtin_amdgcn_sched_barrier(0)
    Unit cur, nxt; int ui = 0;
    if (!S.next(0, cur)) return;
    f32x4 acc[2][2][4][2];
#pragma unroll
    for (int a = 0; a < 2; ++a)
#pragma unroll
        for (int b = 0; b < 2; ++b)
#pragma unroll
            for (int m = 0; m < 4; ++m)
#pragma unroll
                for (int n = 0; n < 2; ++n) acc[a][b][m][n] = (f32x4){0.f, 0.f, 0.f, 0.f};
    bf16x8 At[4][2], B0[2][2], B1[2][2];
    const char* cA = (const char*)g.A + (size_t)cur.pm * tstep + koff; const char* cB = (const char*)g.Bt + (size_t)cur.pn * tstep + koff;
    S.a_ready(cur);
    if constexpr (SP2) {
        PG8_STAGE(PG8_SB(0, 0), cB, voffB); PG8_STAGE(PG8_SB(0, 1), cB + hstep, voffB); PG8_STAGE(PG8_SA(0, 0), cA, voffA); PG8_STAGE(PG8_SA(0, 1), cA + hstep, voffA);
        if (wr == 1) PG8_BAR;
        PG8_WAIT_V(2); PG8_BAR;
        PG8_STAGE(PG8_SB(1, 0), cB + kstep, voffB); PG8_STAGE(PG8_SA(1, 0), cA + kstep, voffA); PG8_STAGE(PG8_SB(1, 1), cB + hstep + kstep, voffB);
        PG8_WAIT_V(6); PG8_BAR;
    } else {
        PG8_STAGE(PG8_SB(0, 0), cB, voffB); PG8_STAGE(PG8_SA(0, 0), cA, voffA); PG8_STAGE(PG8_SB(0, 1), cB + hstep, voffB); PG8_STAGE(PG8_SA(0, 1), cA + hstep, voffA);
        if (wr == 1) PG8_BAR;
        PG8_WAIT_V(4); PG8_BAR;
        PG8_STAGE(PG8_SB(1, 0), cB + kstep, voffB); PG8_STAGE(PG8_SA(1, 0), cA + kstep, voffA); PG8_STAGE(PG8_SB(1, 1), cB + hstep + kstep, voffB);
        PG8_WAIT_V(6); PG8_BAR;
    }
    for (;;) {
        const bool has_next = S.next(ui + 1, nxt);
        const char* nA = has_next ? (const char*)g.A + (size_t)nxt.pm * tstep + koff : cA; const char* nB = has_next ? (const char*)g.Bt + (size_t)nxt.pn * tstep + koff : cB;
        for (int t = 0; t < nt; t += 2) {
            const bool last = (t == nt - 2);
            const char* a1 = cA + (size_t)(t + 1) * kstep;
            const char* a2 = last ? nA : cA + (size_t)(t + 2) * kstep; const char* b2 = last ? nB : cB + (size_t)(t + 2) * kstep;
            const char* a3 = a2 + kstep; const char* b3 = b2 + kstep;
            if (last && has_next) S.a_ready(nxt);
            if constexpr (SP2) {
            PG8_LDB(B0, 0, 0); PG8_LDB(B1, 0, 1); PG8_SCHED; PG8_LDA(At, 0, 0); PG8_STAGE(PG8_SA(1, 1), a1 + hstep, voffA);
            PG8_WAIT_V(8); PG8_WAIT_L(0); PG8_BAR; PG8_MMA(0, 0, At, B0); PG8_MMA(0, 1, At, B1); PG8_BAR; PG8_SCHED;
            PG8_LDA(At, 0, 1); PG8_STAGE(PG8_SB(0, 0), b2, voffB); PG8_STAGE(PG8_SB(0, 1), b2 + hstep, voffB); PG8_STAGE(PG8_SA(0, 0), a2, voffA);
            PG8_WAIT_V(8); PG8_WAIT_L(0); PG8_BAR; PG8_MMA(1, 0, At, B0); PG8_MMA(1, 1, At, B1); PG8_BAR; PG8_SCHED;
            PG8_LDB(B0, 1, 0); PG8_LDB(B1, 1, 1); PG8_SCHED; PG8_LDA(At, 1, 0); PG8_STAGE(PG8_SA(0, 1), a2 + hstep, voffA);
            PG8_WAIT_V(8); PG8_WAIT_L(0); PG8_BAR; PG8_MMA(0, 0, At, B0); PG8_MMA(0, 1, At, B1); PG8_BAR; PG8_SCHED;
            PG8_LDA(At, 1, 1); PG8_STAGE(PG8_SB(1, 0), b3, voffB); PG8_STAGE(PG8_SB(1, 1), b3 + hstep, voffB); PG8_STAGE(PG8_SA(1, 0), a3, voffA);
            PG8_WAIT_V(8); PG8_WAIT_L(0); PG8_BAR; PG8_MMA(1, 0, At, B0); PG8_MMA(1, 1, At, B1); PG8_BAR; PG8_SCHED;
            } else {
            PG8_LDB(B0, 0, 0); PG8_SCHED; PG8_LDA(At, 0, 0); PG8_STAGE(PG8_SA(1, 1), a1 + hstep, voffA);
            PG8_WAIT_L(8); PG8_BAR; PG8_WAIT_L(0); PG8_MMA(0, 0, At, B0); PG8_BAR; PG8_SCHED;
            PG8_LDB(B1, 0, 1); PG8_STAGE(PG8_SB(0, 0), b2, voffB);
            PG8_BAR; PG8_WAIT_L(0); PG8_MMA(0, 1, At, B1); PG8_BAR;
            PG8_LDA(At, 0, 1); PG8_STAGE(PG8_SA(0, 0), a2, voffA);
            PG8_BAR; PG8_WAIT_L(0); PG8_MMA(1, 0, At, B0); PG8_BAR; PG8_SCHED;
            PG8_STAGE(PG8_SB(0, 1), b2 + hstep, voffB);
            PG8_WAIT_V(6); PG8_BAR; PG8_MMA(1, 1, At, B1); PG8_BAR;
            PG8_LDB(B0, 1, 0); PG8_SCHED; PG8_LDA(At, 1, 0); PG8_STAGE(PG8_SA(0, 1), a2 + hstep, voffA);
            PG8_WAIT_L(8); PG8_BAR; PG8_WAIT_L(0); PG8_MMA(0, 0, At, B0); PG8_BAR; PG8_SCHED;
            PG8_LDB(B1, 1, 1); PG8_STAGE(PG8_SB(1, 0), b3, voffB);
            PG8_BAR; PG8_WAIT_L(0); PG8_MMA(0, 1, At, B1); PG8_BAR;
            PG8_LDA(At, 1, 1); PG8_STAGE(PG8_SA(1, 0), a3, voffA);
            PG8_BAR; PG8_WAIT_L(0); PG8_MMA(1, 0, At, B0); PG8_BAR; PG8_SCHED;
            PG8_STAGE(PG8_SB(1, 1), b3 + hstep, voffB);
            PG8_WAIT_V(6); PG8_BAR; PG8_MMA(1, 1, At, B1); PG8_BAR;
            }
        }
        if constexpr (ALIGN_EPI) { if (wr == 0) PG8_BAR; }
        if constexpr (!Epi::AFTER_DRAIN) { E(acc, cur, wr, wc, fr, fq); S.done(cur); }
        if (!has_next) break;
#pragma unroll
        for (int a = 0; a < 2; ++a)
#pragma unroll
            for (int b = 0; b < 2; ++b)
#pragma unroll
                for (int m = 0; m < 4; ++m)
#pragma unroll
                    for (int n = 0; n < 2; ++n) acc[a][b][m][n] = (f32x4){0.f, 0.f, 0.f, 0.f};
        cur = nxt; cA = nA; cB = nB; ++ui;
        if constexpr (ALIGN_EPI) { if (wr == 1) PG8_BAR; }
    }
    PG8_WAIT_V(0);
    if constexpr (!ALIGN_EPI) { if (wr == 0) PG8_BAR; }
    PG8_BAR;
    if constexpr (Epi::AFTER_DRAIN) { E.fused(acc, cur, wr, wc, fr, fq, lds, wid, lane); S.done(cur); }
#undef PG8_SA
#undef PG8_SB
#undef PG8_STAGE
#undef PG8_LDA
#undef PG8_LDB
#undef PG8_MMA
#undef PG8_WAIT_V
#undef PG8_WAIT_L
#undef PG8_BAR
#undef PG8_SCHED
}
}


template <class Inner> struct Pg8Epi {
    static constexpr bool PERM = true, AFTER_DRAIN = false;
    Inner in;
    __device__ __forceinline__ void operator()(const f32x4 (&acc)[2][2][4][2], const pg8::Unit& u, int wr, int wc, int fr, int fq) const {
#pragma unroll
        for (int ai = 0; ai < 2; ++ai)
#pragma unroll
            for (int m = 0; m < 4; ++m) {
                const int r = u.pm * 256 + ai * 128 + wr * 64 + m * 16 + fr;
                const int c0 = u.pn * 256 + wc * 32 + 8 * fq;
                const int cols[4] = {c0, c0 + 4, c0 + 128, c0 + 132};
                const f32x4 vv[4] = {acc[ai][0][m][0], acc[ai][0][m][1], acc[ai][1][m][0], acc[ai][1][m][1]};
                in.template row<4, true>(r, cols, vv, fq, 1.f);
            }
    }
};
struct EpiResB {
    const float* srcf; bf16_t* xb; float* dstf; float* ss;
    template <int NQ, bool PAIRED> __device__ __forceinline__ void row(int r, const int (&c)[NQ], const f32x4 (&v)[NQ], int fq, float rscale) const {
        static_assert(PAIRED && NQ % 2 == 0, "EpiResB: paired quads only");
        float a2 = 0.f;
#pragma unroll
        for (int q = 0; q < NQ; q += 2) {
            f32x4 s0, s1;
            if (srcf) { s0 = *(const f32x4*)(srcf + (size_t)r * D + c[q]); s1 = *(const f32x4*)(srcf + (size_t)r * D + c[q] + 4); }
            else { const u32x4 xr = *(const u32x4*)(xb + (size_t)r * D + c[q]); s0 = (f32x4){bflo(xr.x), bfhi(xr.x), bflo(xr.y), bfhi(xr.y)}; s1 = (f32x4){bflo(xr.z), bfhi(xr.z), bflo(xr.w), bfhi(xr.w)}; }
            const f32x4 o0 = s0 + v[q], o1 = s1 + v[q + 1];
            if (dstf) { *(f32x4*)(dstf + (size_t)r * D + c[q]) = o0; *(f32x4*)(dstf + (size_t)r * D + c[q] + 4) = o1; }
            else {
                u32x4 w; w.x = cvt_pk_bf16(o0.x, o0.y); w.y = cvt_pk_bf16(o0.z, o0.w); w.z = cvt_pk_bf16(o1.x, o1.y); w.w = cvt_pk_bf16(o1.z, o1.w);
                *(u32x4*)(xb + (size_t)r * D + c[q]) = w;
                a2 += (o0.x * o0.x + o0.y * o0.y) + (o0.z * o0.z + o0.w * o0.w) + (o1.x * o1.x + o1.y * o1.y) + (o1.z * o1.z + o1.w * o1.w);
            }
        }
        if (ss) { a2 += __shfl_xor(a2, 16); a2 += __shfl_xor(a2, 32); if (fq == 0) atomicAdd(ss + r, a2); }
    }
};
struct EpiAtomic {
    float* dst;
    template <int NQ, bool PAIRED> __device__ __forceinline__ void row(int r, const int (&c)[NQ], const f32x4 (&v)[NQ], int fq, float rscale) const {
#pragma unroll
        for (int q = 0; q < NQ; ++q) { float* d = dst + (size_t)r * D + c[q]; atomicAdd(d, v[q].x); atomicAdd(d + 1, v[q].y); atomicAdd(d + 2, v[q].z); atomicAdd(d + 3, v[q].w); }
    }
};

template <int AF32, class Epi>
__device__ __forceinline__ void sgemm64(unsigned char* lds, const void* Av, int lda, const bf16_t* __restrict__ Bt, int row0, int nrows, int N, int K, int ksplit,
                                        const Epi& E, int bid, int G) {
    const int tid = threadIdx.x, lane = tid & 63, wid = tid >> 6, wr = wid >> 2, wc = wid & 3, fr = lane & 15, fq = lane >> 4;
    const int nN = N / 128, nT = (nrows / 64) * nN, nU = nT * ksplit, Ksl = K / ksplit, nk = Ksl / 128;
    constexpr int LS = 136;
    bf16_t* As = (bf16_t*)lds;
    bf16_t* Bs = As + 2 * 64 * LS;
    float* rs = (float*)(Bs + 2 * 128 * LS);
    const int arow = tid >> 3, ak = (tid & 7) * 8;
    for (int u = bid; u < nU; u += G) {
        const int ks = u / nT, t = u % nT, pm = t / nN, pn = t % nN, k0 = ks * Ksl;
        const bf16_t* Ab = (const bf16_t*)Av + (size_t)(row0 + pm * 64 + arow) * lda + k0 + ak;
        const float* Af = (const float*)Av + (size_t)(row0 + pm * 64 + arow) * lda + k0 + ak;
        const bf16_t* Bg = Bt + (size_t)(pn * 128 + arow) * K + k0 + ak;
        f32x4 acc[2][2];
#pragma unroll
        for (int m = 0; m < 2; ++m)
#pragma unroll
            for (int n = 0; n < 2; ++n) acc[m][n] = (f32x4){0.f, 0.f, 0.f, 0.f};
        float ssq = 0.f;
        u32x4 ra[2], rb[2][2];
        auto loadAB = [&](int kt) {
#pragma unroll
            for (int h = 0; h < 2; ++h) {
                if (AF32) { const f32x4 a = *(const f32x4*)(Af + kt * 128 + 64 * h), b = *(const f32x4*)(Af + kt * 128 + 64 * h + 4);
                    ssq += (a.x * a.x + a.y * a.y) + (a.z * a.z + a.w * a.w) + (b.x * b.x + b.y * b.y) + (b.z * b.z + b.w * b.w);
                    ra[h].x = cvt_pk_bf16(a.x, a.y); ra[h].y = cvt_pk_bf16(a.z, a.w); ra[h].z = cvt_pk_bf16(b.x, b.y); ra[h].w = cvt_pk_bf16(b.z, b.w); }
                else ra[h] = *(const u32x4*)(Ab + kt * 128 + 64 * h);
#pragma unroll
                for (int i = 0; i < 2; ++i) rb[i][h] = *(const u32x4*)(Bg + (size_t)(64 * i) * K + kt * 128 + 64 * h);
            }
        };
        auto storeAB = [&](int buf) {
#pragma unroll
            for (int h = 0; h < 2; ++h) {
                *(u32x4*)(As + buf * 64 * LS + arow * LS + ak + 64 * h) = ra[h];
#pragma unroll
                for (int i = 0; i < 2; ++i) *(u32x4*)(Bs + buf * 128 * LS + (arow + 64 * i) * LS + ak + 64 * h) = rb[i][h];
            }
        };
        loadAB(0);
        storeAB(0);
        __syncthreads();
        for (int kt = 0; kt < nk; ++kt) {
            const int buf = kt & 1;
            if (kt + 1 < nk) loadAB(kt + 1);
            const bf16_t* as = As + buf * 64 * LS; const bf16_t* bs = Bs + buf * 128 * LS;
#pragma unroll
            for (int kk = 0; kk < 4; ++kk) {
                bf16x8 af[2], bfr[2];
#pragma unroll
                for (int m = 0; m < 2; ++m) af[m] = *(const bf16x8*)(as + (32 * wr + 16 * m + fr) * LS + 32 * kk + 8 * fq);
#pragma unroll
                for (int n = 0; n < 2; ++n) bfr[n] = *(const bf16x8*)(bs + (32 * wc + 16 * n + fr) * LS + 32 * kk + 8 * fq);
#pragma unroll
                for (int m = 0; m < 2; ++m)
#pragma unroll
                    for (int n = 0; n < 2; ++n) acc[m][n] = MFMA32(bfr[n], af[m], acc[m][n]);
            }
            if (kt + 1 < nk) storeAB(buf ^ 1);
            __syncthreads();
        }
        if (AF32) {
            ssq += __shfl_xor(ssq, 1); ssq += __shfl_xor(ssq, 2); ssq += __shfl_xor(ssq, 4);
            if ((tid & 7) == 0) rs[arow] = rsqrtf(ssq * (1.f / 1024.f) + EPS);
            __syncthreads();
        }
#pragma unroll
        for (int m = 0; m < 2; ++m) {
            const int lr = 32 * wr + 16 * m + fr, r = row0 + pm * 64 + lr;
            const int cols[2] = {pn * 128 + 32 * wc + 4 * fq, pn * 128 + 32 * wc + 16 + 4 * fq};
            const f32x4 vv[2] = {acc[m][0], acc[m][1]};
            E.template row<2, false>(r, cols, vv, fq, AF32 ? rs[lr] : 1.f);
        }
    }
}

template <class Epi>
__device__ __forceinline__ void sgemm_phase(unsigned char* lds, const bf16_t* __restrict__ A, const bf16_t* __restrict__ Bt, int row0, int nrows, int N, int K,
                                            const Epi& E, int bid, int G) {
    const int tid = threadIdx.x, lane = tid & 63, wid = tid >> 6, wr = wid >> 2, wc = wid & 3, fr = lane & 15, fq = lane >> 4;
    const int nN = N / 128, nU = (nrows / 128) * nN, nk = K / 64;
    bf16_t* As = (bf16_t*)lds;
    bf16_t* Bs = As + 2 * 128 * 72;
    const int ldrow = tid >> 3, ldk = (tid & 7) * 8;
    for (int u = bid; u < nU; u += G) {
        const int pm = u / nN, pn = u % nN;
        const bf16_t* Ag = A + (size_t)(row0 + pm * 128 + ldrow) * K + ldk;
        const bf16_t* Bg = Bt + (size_t)(pn * 128 + ldrow) * K + ldk;
        f32x4 acc[4][2];
#pragma unroll
        for (int m = 0; m < 4; ++m)
#pragma unroll
            for (int n = 0; n < 2; ++n) acc[m][n] = (f32x4){0.f, 0.f, 0.f, 0.f};
        u32x4 ra[2], rb[2];
#pragma unroll
        for (int i = 0; i < 2; ++i) { ra[i] = *(const u32x4*)(Ag + (size_t)(64 * i) * K); rb[i] = *(const u32x4*)(Bg + (size_t)(64 * i) * K); }
#pragma unroll
        for (int i = 0; i < 2; ++i) { *(u32x4*)(As + (ldrow + 64 * i) * 72 + ldk) = ra[i]; *(u32x4*)(Bs + (ldrow + 64 * i) * 72 + ldk) = rb[i]; }
        __syncthreads();
        for (int kt = 0; kt < nk; ++kt) {
            const int buf = kt & 1;
            if (kt + 1 < nk) {
#pragma unroll
                for (int i = 0; i < 2; ++i) { ra[i] = *(const u32x4*)(Ag + (size_t)(64 * i) * K + (kt + 1) * 64); rb[i] = *(const u32x4*)(Bg + (size_t)(64 * i) * K + (kt + 1) * 64); }
            }
            const bf16_t* as = As + buf * 128 * 72; const bf16_t* bs = Bs + buf * 128 * 72;
#pragma unroll
            for (int kk = 0; kk < 2; ++kk) {
                bf16x8 af[4], bfr[2];
#pragma unroll
                for (int m = 0; m < 4; ++m) af[m] = *(const bf16x8*)(as + (64 * wr + 16 * m + fr) * 72 + 32 * kk + 8 * fq);
#pragma unroll
                for (int n = 0; n < 2; ++n) bfr[n] = *(const bf16x8*)(bs + (32 * wc + 16 * n + fr) * 72 + 32 * kk + 8 * fq);
#pragma unroll
                for (int m = 0; m < 4; ++m)
#pragma unroll
                    for (int n = 0; n < 2; ++n) acc[m][n] = MFMA32(bfr[n], af[m], acc[m][n]);
            }
            if (kt + 1 < nk) {
                bf16_t* an = As + (buf ^ 1) * 128 * 72; bf16_t* bn = Bs + (buf ^ 1) * 128 * 72;
#pragma unroll
                for (int i = 0; i < 2; ++i) { *(u32x4*)(an + (ldrow + 64 * i) * 72 + ldk) = ra[i]; *(u32x4*)(bn + (ldrow + 64 * i) * 72 + ldk) = rb[i]; }
            }
            __syncthreads();
        }
#pragma unroll
        for (int m = 0; m < 4; ++m) {
            const int r = row0 + pm * 128 + 64 * wr + 16 * m + fr;
            const int cols[2] = {pn * 128 + 32 * wc + 4 * fq, pn * 128 + 32 * wc + 16 + 4 * fq};
            const f32x4 vv[2] = {acc[m][0], acc[m][1]};
            E.template row<2, false>(r, cols, vv, fq, 1.f);
        }
    }
}

__device__ __forceinline__ void mlstm_local_unit(const Params& p, unsigned char* lds, int u) {
    const int tid = threadIdx.x, lane = tid & 63, wid = tid >> 6, fr = lane & 15, fq = lane >> 4;
    const int bh = u >> 6, c = u & 63, b = bh >> 2, h = bh & 3, base = b * 4096 + c * 64;
    unsigned char* ws = p.ws;
    const bf16_t* P = (const bf16_t*)(ws + WS_P); const float* gates = (const float*)(ws + WS_GATES);
    bf16_t* GS = (bf16_t*)p.out;
    bf16_t* kT = (bf16_t*)lds;
    bf16_t* vT = kT + 128 * 72;
    float* wk = (float*)(vT + 256 * 72);
    if (wid == 0) {
        const float lf = gates[(size_t)(base + lane) * 8 + 4 + h], li = gates[(size_t)(base + lane) * 8 + h];
        const float bc = scan_sum(lf, lane);
        const float B = __shfl(bc, 63);
        const float val = B - bc + li;
        const float ml = wave_max(val);
        wk[lane] = __expf(val - ml);
        if (lane == 0) { ((float*)(ws + WS_CHB))[u] = B; ((float*)(ws + WS_CHM))[u] = ml; }
    }
    __syncthreads();
    {
        const bf16_t* Pk = P + (size_t)(base + lane) * NIN + 512 + h * 128;
#pragma unroll
        for (int i = 0; i < 2; ++i) {
            const int dch = wid * 2 + i; const u32x4 r = *(const u32x4*)(Pk + dch * 8);
            bf16_t* dst = kT + (dch * 8) * 72 + lane;
            dst[0 * 72] = (bf16_t)(r.x & 0xffff); dst[1 * 72] = (bf16_t)(r.x >> 16); dst[2 * 72] = (bf16_t)(r.y & 0xffff); dst[3 * 72] = (bf16_t)(r.y >> 16);
            dst[4 * 72] = (bf16_t)(r.z & 0xffff); dst[5 * 72] = (bf16_t)(r.z >> 16); dst[6 * 72] = (bf16_t)(r.w & 0xffff); dst[7 * 72] = (bf16_t)(r.w >> 16);
        }
        const bf16_t* Pv = P + (size_t)(base + lane) * NIN + 1024 + h * 256;
        const float w = wk[lane];
#pragma unroll
        for (int i = 0; i < 4; ++i) {
            const int vch = wid * 4 + i; const u32x4 r = *(const u32x4*)(Pv + vch * 8);
            bf16_t* dst = vT + (vch * 8) * 72 + lane;
            dst[0 * 72] = f2bf(bflo(r.x) * w); dst[1 * 72] = f2bf(bfhi(r.x) * w); dst[2 * 72] = f2bf(bflo(r.y) * w); dst[3 * 72] = f2bf(bfhi(r.y) * w);
            dst[4 * 72] = f2bf(bflo(r.z) * w); dst[5 * 72] = f2bf(bfhi(r.z) * w); dst[6 * 72] = f2bf(bflo(r.w) * w); dst[7 * 72] = f2bf(bfhi(r.w) * w);
        }
    }
    __syncthreads();
    {
        f32x4 acc[2][8];
#pragma unroll
        for (int a = 0; a < 2; ++a)
#pragma unroll
            for (int d = 0; d < 8; ++d) acc[a][d] = (f32x4){0.f, 0.f, 0.f, 0.f};
#pragma unroll
        for (int ks = 0; ks < 2; ++ks) {
            bf16x8 yf[2];
#pragma unroll
            for (int vt = 0; vt < 2; ++vt) yf[vt] = *(const bf16x8*)(vT + (32 * wid + 16 * vt + fr) * 72 + 32 * ks + 8 * fq);
#pragma unroll
            for (int dt = 0; dt < 8; ++dt) {
                const bf16x8 xf = *(const bf16x8*)(kT + (16 * dt + fr) * 72 + 32 * ks + 8 * fq);
#pragma unroll
                for (int vt = 0; vt < 2; ++vt) acc[vt][dt] = MFMA32(xf, yf[vt], acc[vt][dt]);
            }
        }
        bf16_t* G = GS + (size_t)u * 32768;
#pragma unroll
        for (int vt = 0; vt < 2; ++vt)
#pragma unroll
            for (int dt = 0; dt < 8; ++dt) {
                u32x2 w; w.x = cvt_pk_bf16(acc[vt][dt].x, acc[vt][dt].y); w.y = cvt_pk_bf16(acc[vt][dt].z, acc[vt][dt].w);
                *(u32x2*)(G + (32 * wid + 16 * vt + fr) * 128 + 16 * dt + 4 * fq) = w;
            }
    }
    if (tid < 128) {
        float s = 0.f;
#pragma unroll 8
        for (int ss = 0; ss < 64; ++ss) s += bf2f(kT[tid * 72 + ss]) * wk[ss];
        ((float*)(ws + WS_GN))[(size_t)u * 128 + tid] = s;
    }
    __syncthreads();
}

__device__ __forceinline__ void mlstm_sample_unit(const Params& p, unsigned char* lds, int u) {
    const int tid = threadIdx.x, lane = tid & 63, wid = tid >> 6;
    const int b = u >> 2, h = u & 3, base = TP + b * 4;
    unsigned char* ws = p.ws;
    const bf16_t* P = (const bf16_t*)(ws + WS_P); const float* gates = (const float*)(ws + WS_GATES);
    float* q = (float*)lds;
    float* k = q + 512;
    float* v = k + 512;
    float* n0 = v + 1024;
    float* sc = n0 + 128;
    float* red = sc + 64;
    const float* C0 = p.st_C + (size_t)u * 32768;
    float* Cout = p.out + O_SC + (size_t)u * 32768;
    {
        const int t = tid >> 7, d = tid & 127;
        q[tid] = bf2f(P[(size_t)(base + t) * NIN + h * 128 + d]);
        k[tid] = bf2f(P[(size_t)(base + t) * NIN + 512 + h * 128 + d]);
        const int t2 = tid >> 8, vv = tid & 255;
        v[tid] = bf2f(P[(size_t)(base + t2) * NIN + 1024 + h * 256 + vv]);
        v[512 + tid] = bf2f(P[(size_t)(base + 2 + t2) * NIN + 1024 + h * 256 + vv]);
        if (tid < 128) n0[tid] = p.st_n[(size_t)u * 128 + tid];
    }
    if (tid == 0) {
        float li[4], bc[4]; float run = 0.f;
#pragma unroll
        for (int t = 0; t < 4; ++t) { li[t] = gates[(size_t)(base + t) * 8 + h]; run += gates[(size_t)(base + t) * 8 + 4 + h]; bc[t] = run; }
        const float m0 = p.st_m[u]; float mt[4];
#pragma unroll
        for (int t = 0; t < 4; ++t) {
            const float inter = bc[t] + m0; float mx = inter;
#pragma unroll
            for (int s = 0; s < 4; ++s) if (s <= t) mx = fmaxf(mx, bc[t] - bc[s] + li[s]);
            mt[t] = mx; sc[16 + t] = __expf(inter - mx); sc[28 + t] = __expf(-mx);
#pragma unroll
            for (int s = 0; s < 4; ++s) sc[t * 4 + s] = (s <= t) ? __expf(bc[t] - bc[s] + li[s] - mx) : 0.f;
        }
        const float mn = mt[3];
        sc[24] = __expf(bc[3] + m0 - mn);
#pragma unroll
        for (int s = 0; s < 4; ++s) sc[20 + s] = __expf(bc[3] - bc[s] + li[s] - mn);
        p.out[O_SM + u] = mn;
    }
    __syncthreads();
#pragma unroll
    for (int i = 0; i < 2; ++i) {
        const int pr = wid * 2 + i, t = pr >> 2, s = pr & 3;
        float a = q[t * 128 + lane] * k[s * 128 + lane] + q[t * 128 + 64 + lane] * k[s * 128 + 64 + lane];
        a = wave_sum(a);
        if (lane == 0) sc[32 + pr] = a * sc[pr];
    }
    if (wid < 4) { float a = q[wid * 128 + lane] * n0[lane] + q[wid * 128 + 64 + lane] * n0[64 + lane]; a = wave_sum(a); if (lane == 0) sc[48 + wid] = a; }
    if (tid < 8) sc[52 + tid] = 0.f;
    {
        const int vq = lane, dg = wid;
        f32x4 qc[4];
#pragma unroll
        for (int t = 0; t < 4; ++t) qc[t] = (f32x4){0.f, 0.f, 0.f, 0.f};
        const float decay = sc[24];
        f32x4 vs[4];
#pragma unroll
        for (int s = 0; s < 4; ++s) vs[s] = *(const f32x4*)(v + s * 256 + 4 * vq) * sc[20 + s];
#pragma unroll 4
        for (int dd = 0; dd < 16; ++dd) {
            const int d = dg * 16 + dd;
            const f32x4 c0 = *(const f32x4*)(C0 + (size_t)d * 256 + 4 * vq);
            f32x4 cn = c0 * decay;
#pragma unroll
            for (int s = 0; s < 4; ++s) cn += vs[s] * k[s * 128 + d];
            *(f32x4*)(Cout + (size_t)d * 256 + 4 * vq) = cn;
#pragma unroll
            for (int t = 0; t < 4; ++t) qc[t] += c0 * q[t * 128 + d];
        }
#pragma unroll
        for (int t = 0; t < 4; ++t) *(f32x4*)(red + (dg * 4 + t) * 256 + 4 * vq) = qc[t];
    }
    if (tid < 128) {
        float nn = sc[24] * n0[tid];
#pragma unroll
        for (int s = 0; s < 4; ++s) nn += sc[20 + s] * k[s * 128 + tid];
        p.out[O_SN + (size_t)u * 128 + tid] = nn;
    }
    __syncthreads();
    {
        const int t = tid >> 7, v0 = (tid & 127) * 2;
        float den = sc[16 + t] * sc[48 + t];
#pragma unroll
        for (int s = 0; s < 4; ++s) den += sc[32 + t * 4 + s];
        const float inv = 1.f / fmaxf(fabsf(den), sc[28 + t]);
        float hv[2]; float ssq = 0.f;
#pragma unroll
        for (int j = 0; j < 2; ++j) {
            float qC = 0.f;
#pragma unroll
            for (int g = 0; g < 8; ++g) qC += red[(g * 4 + t) * 256 + v0 + j];
            float num = sc[16 + t] * qC;
#pragma unroll
            for (int s = 0; s < 4; ++s) num += sc[32 + t * 4 + s] * v[s * 256 + v0 + j];
            hv[j] = num * inv; ssq += hv[j] * hv[j];
        }
        ssq = wave_sum(ssq);
        if (lane == 0) sc[52 + wid] = ssq;
        __syncthreads();
        const float tot = sc[52 + 2 * t] + sc[52 + 2 * t + 1];
        const float rstd = rsqrtf(tot * (1.f / 256.f) + EPS);
        const unsigned ob = *(const unsigned*)(P + (size_t)(base + t) * NIN + 2048 + h * 256 + v0);
        const float o0 = sigmoidf_(bflo(ob)), o1 = sigmoidf_(bfhi(ob));
        const float g0 = p.ml_head_g[h * 256 + v0], g1 = p.ml_head_g[h * 256 + v0 + 1];
        bf16_t* HG = (bf16_t*)(ws + WS_HG);
        *(unsigned*)(HG + (size_t)(base + t) * D + h * 256 + v0) = cvt_pk_bf16(hv[0] * rstd * g0 * o0, hv[1] * rstd * g1 * o1);
    }
    __syncthreads();
}

__device__ __forceinline__ void mlstm_scan(const Params& p, unsigned char* lds, int bid, int G) {
    unsigned char* ws = p.ws;
    bf16_t* GS = (bf16_t*)p.out;
    const float* CHB = (const float*)(ws + WS_CHB); const float* CHM = (const float*)(ws + WS_CHM);
    float* MPREV = (float*)(ws + WS_MPREV); float* GN = (float*)(ws + WS_GN);
    const int tid = threadIdx.x;
    float* decs = (float*)lds;
    float* scls = decs + 64;
    float* tile = scls + 64;
    for (int blk = bid; blk < 256; blk += G) {
        const int bh = blk >> 4;
        if (tid < 64) {
            const float B = CHB[bh * 64 + tid], ml = CHM[bh * 64 + tid];
            float a = B, b2 = ml;
#pragma unroll
            for (int o = 1; o < 64; o <<= 1) { const float ya = __shfl_up(a, o), yb = __shfl_up(b2, o); if (tid >= o) { b2 = fmaxf(yb + a, b2); a = ya + a; } }
            const float m = fmaxf(a, b2);
            float mp = __shfl_up(m, 1); if (tid == 0) mp = 0.f;
            decs[tid] = __expf(B + mp - m); scls[tid] = __expf(ml - m);
            if ((blk & 15) == 0) { MPREV[bh * 64 + tid] = mp; if (tid == 63) p.out[O_PM + bh] = m; }
        }
        float gnv[64]; float* gp = GN + (size_t)(bh * 64) * 128 + (blk & 15) * 8 + (tid & 7);
        if (tid < 8) {
#pragma unroll
            for (int c = 0; c < 64; ++c) gnv[c] = gp[(size_t)c * 128];
        }
        __syncthreads();
        const int e4 = blk * NTHREADS + tid;
        const int off = (e4 & 8191) * 4;
        bf16_t* ptr = GS + (size_t)bh * 64 * 32768 + off;
        float c0 = 0.f, c1 = 0.f, c2 = 0.f, c3 = 0.f;
#pragma unroll 1
        for (int cb = 0; cb < 64; cb += 16) {
            u32x2 g[16];
#pragma unroll
            for (int j = 0; j < 16; ++j) g[j] = *(const u32x2*)(ptr + (size_t)(cb + j) * 32768);
#pragma unroll
            for (int j = 0; j < 16; ++j) {
                const float dec = decs[cb + j], s = scls[cb + j];
                u32x2 w; w.x = cvt_pk_bf16(c0, c1); w.y = cvt_pk_bf16(c2, c3);
                *(u32x2*)(ptr + (size_t)(cb + j) * 32768) = w;
                c0 = dec * c0 + s * bflo(g[j].x); c1 = dec * c1 + s * bfhi(g[j].x); c2 = dec * c2 + s * bflo(g[j].y); c3 = dec * c3 + s * bfhi(g[j].y);
            }
        }
        {
            const int vl = (off >> 7) & 15, d = off & 127;
            tile[(d + 0) * 20 + vl] = c0; tile[(d + 1) * 20 + vl] = c1; tile[(d + 2) * 20 + vl] = c2; tile[(d + 3) * 20 + vl] = c3;
            __syncthreads();
            const int dd = tid >> 2, vq = tid & 3, v0 = (blk & 15) * 16;
            const f32x4 o = (f32x4){tile[dd * 20 + 4 * vq], tile[dd * 20 + 4 * vq + 1], tile[dd * 20 + 4 * vq + 2], tile[dd * 20 + 4 * vq + 3]};
            *(f32x4*)(p.out + O_PC + (size_t)bh * 32768 + (size_t)dd * 256 + v0 + 4 * vq) = o;
        }
        if (tid < 8) {
            float n = 0.f;
#pragma unroll
            for (int c = 0; c < 64; ++c) { gp[(size_t)c * 128] = n; n = decs[c] * n + scls[c] * gnv[c]; }
            p.out[O_PN + bh * 128 + (blk & 15) * 8 + tid] = n;
        }
        __syncthreads();
    }
}

__device__ __forceinline__ void mlstm_out_unit(const Params& p, unsigned char* lds, int u) {
    const int tid = threadIdx.x, lane = tid & 63, wid = tid >> 6, fr = lane & 15, fq = lane >> 4;
    const int bh = u >> 6, c = u & 63, b = bh >> 2, h = bh & 3, base = b * 4096 + c * 64;
    unsigned char* ws = p.ws;
    const bf16_t* P = (const bf16_t*)(ws + WS_P); const float* gates = (const float*)(ws + WS_GATES);
    const bf16_t* CT = (const bf16_t*)p.out + (size_t)u * 32768;
    bf16_t* Qs = (bf16_t*)lds;
    bf16_t* Ks = Qs + 64 * 136;
    bf16_t* Ac = Ks + 64 * 136;
    bf16_t* VT = Ac + 64 * 200;
    float* sm = (float*)(VT + 256 * 72);
    float *bt = sm, *lmb = sm + 64, *mt = sm + 128, *at = sm + 192, *den = sm + 256, *hss = sm + 320, *npv = sm + 384;
    bf16x8 cf[2][4];
#pragma unroll
    for (int vt = 0; vt < 2; ++vt)
#pragma unroll
        for (int kd = 0; kd < 4; ++kd) cf[vt][kd] = *(const bf16x8*)(CT + (32 * wid + 16 * vt + fr) * 128 + 32 * kd + 8 * fq);
    if (wid == 0) {
        const float lf = gates[(size_t)(base + lane) * 8 + 4 + h], li = gates[(size_t)(base + lane) * 8 + h];
        const float bc = scan_sum(lf, lane);
        const float lm = li - bc;
        const float pm = scan_max(lm, lane);
        const float mprev = ((const float*)(ws + WS_MPREV))[u];
        const float inter = bc + mprev;
        const float m_t = fmaxf(inter, bc + pm);
        bt[lane] = bc; lmb[lane] = lm; mt[lane] = m_t; at[lane] = __expf(inter - m_t); den[lane] = 0.f; hss[lane] = 0.f;
    }
    if (wid == 1) { const float* NP = (const float*)(ws + WS_GN) + (size_t)u * 128; npv[lane] = NP[lane]; npv[64 + lane] = NP[64 + lane]; }
    __syncthreads();
#pragma unroll
    for (int i = 0; i < 2; ++i) {
        const int ci = tid + 512 * i, t = ci >> 4, dch = ci & 15;
        const u32x4 qv = *(const u32x4*)(P + (size_t)(base + t) * NIN + h * 128 + dch * 8);
        const u32x4 kv = *(const u32x4*)(P + (size_t)(base + t) * NIN + 512 + h * 128 + dch * 8);
        *(u32x4*)(Qs + t * 136 + dch * 8) = qv;
        *(u32x4*)(Ks + t * 136 + dch * 8) = kv;
        const float a = at[t];
        u32x4 sq; sq.x = cvt_pk_bf16(bflo(qv.x) * a, bfhi(qv.x) * a); sq.y = cvt_pk_bf16(bflo(qv.y) * a, bfhi(qv.y) * a);
        sq.z = cvt_pk_bf16(bflo(qv.z) * a, bfhi(qv.z) * a); sq.w = cvt_pk_bf16(bflo(qv.w) * a, bfhi(qv.w) * a);
        *(u32x4*)(Ac + t * 200 + 64 + dch * 8) = sq;
    }
    {
        const bf16_t* Pv = P + (size_t)(base + lane) * NIN + 1024 + h * 256;
#pragma unroll
        for (int i = 0; i < 4; ++i) {
            const int vch = wid * 4 + i; const u32x4 r = *(const u32x4*)(Pv + vch * 8);
            bf16_t* dst = VT + (vch * 8) * 72 + lane;
            dst[0 * 72] = (bf16_t)(r.x & 0xffff); dst[1 * 72] = (bf16_t)(r.x >> 16); dst[2 * 72] = (bf16_t)(r.y & 0xffff); dst[3 * 72] = (bf16_t)(r.y >> 16);
            dst[4 * 72] = (bf16_t)(r.z & 0xffff); dst[5 * 72] = (bf16_t)(r.z >> 16); dst[6 * 72] = (bf16_t)(r.w & 0xffff); dst[7 * 72] = (bf16_t)(r.w >> 16);
        }
    }
    __syncthreads();
    {
        const int tt = wid >> 1;
#pragma unroll
        for (int j = 0; j < 2; ++j) {
            const int st = 2 * (wid & 1) + j;
            const int t = 16 * tt + fr, s0 = 16 * st + 4 * fq;
            u32x2 w; w.x = 0u; w.y = 0u;
            if (st <= tt) {
                f32x4 a = (f32x4){0.f, 0.f, 0.f, 0.f};
#pragma unroll
                for (int kd = 0; kd < 4; ++kd) {
                    const bf16x8 x = *(const bf16x8*)(Ks + (16 * st + fr) * 136 + 32 * kd + 8 * fq);
                    const bf16x8 y = *(const bf16x8*)(Qs + (16 * tt + fr) * 136 + 32 * kd + 8 * fq);
                    a = MFMA32(x, y, a);
                }
                const float e0 = bt[t] - mt[t];
                float vals[4];
#pragma unroll
                for (int i = 0; i < 4; ++i) { const int s = s0 + i; vals[i] = (s <= t) ? a[i] * __expf(e0 + lmb[s]) : 0.f; }
                float rs = (vals[0] + vals[1]) + (vals[2] + vals[3]);
                rs += __shfl_xor(rs, 16); rs += __shfl_xor(rs, 32);
                if (fq == 0) atomicAdd(&den[t], rs);
                w.x = cvt_pk_bf16(vals[0], vals[1]); w.y = cvt_pk_bf16(vals[2], vals[3]);
            }
            *(u32x2*)(Ac + t * 200 + s0) = w;
        }
#pragma unroll
        for (int i = 0; i < 8; ++i) {
            const int t = 8 * wid + i;
            float a = bf2f(Qs[t * 136 + lane]) * npv[lane] + bf2f(Qs[t * 136 + 64 + lane]) * npv[64 + lane];
            a = wave_sum(a);
            if (lane == 0) atomicAdd(&den[t], at[t] * a);
        }
    }
    __syncthreads();
    f32x4 acc[4][2];
#pragma unroll
    for (int a = 0; a < 4; ++a)
#pragma unroll
        for (int d = 0; d < 2; ++d) acc[a][d] = (f32x4){0.f, 0.f, 0.f, 0.f};
#pragma unroll
    for (int kk = 0; kk < 6; ++kk) {
        bf16x8 x[2];
#pragma unroll
        for (int vt = 0; vt < 2; ++vt) x[vt] = (kk < 2) ? *(const bf16x8*)(VT + (32 * wid + 16 * vt + fr) * 72 + 32 * kk + 8 * fq) : cf[vt][kk >= 2 ? kk - 2 : 0];
#pragma unroll
        for (int tt = 0; tt < 4; ++tt) {
            const bf16x8 y = *(const bf16x8*)(Ac + (16 * tt + fr) * 200 + 32 * kk + 8 * fq);
#pragma unroll
            for (int vt = 0; vt < 2; ++vt) acc[tt][vt] = MFMA32(x[vt], y, acc[tt][vt]);
        }
    }
#pragma unroll
    for (int tt = 0; tt < 4; ++tt) {
        const int t = 16 * tt + fr;
        const float inv = 1.f / fmaxf(fabsf(den[t]), __expf(-mt[t]));
        float ssq = 0.f;
#pragma unroll
        for (int vt = 0; vt < 2; ++vt) { acc[tt][vt] = acc[tt][vt] * inv; const f32x4 a = acc[tt][vt]; ssq += (a.x * a.x + a.y * a.y) + (a.z * a.z + a.w * a.w); }
        ssq += __shfl_xor(ssq, 16); ssq += __shfl_xor(ssq, 32);
        if (fq == 0) atomicAdd(&hss[t], ssq);
    }
    __syncthreads();
    {
        bf16_t* HG = (bf16_t*)(ws + WS_HG);
#pragma unroll
        for (int tt = 0; tt < 4; ++tt) {
            const int t = 16 * tt + fr;
            const float rstd = rsqrtf(hss[t] * (1.f / 256.f) + EPS);
#pragma unroll
            for (int vt = 0; vt < 2; ++vt) {
                const int v0 = 32 * wid + 16 * vt + 4 * fq;
                const u32x2 ob = *(const u32x2*)(P + (size_t)(base + t) * NIN + 2048 + h * 256 + v0);
                const f32x4 g = *(const f32x4*)(p.ml_head_g + h * 256 + v0);
                const f32x4 a = acc[tt][vt];
                u32x2 w;
                w.x = cvt_pk_bf16(a.x * rstd * g.x * sigmoidf_(bflo(ob.x)), a.y * rstd * g.y * sigmoidf_(bfhi(ob.x)));
                w.y = cvt_pk_bf16(a.z * rstd * g.z * sigmoidf_(bflo(ob.y)), a.w * rstd * g.w * sigmoidf_(bfhi(ob.y)));
                *(u32x2*)(HG + (size_t)(base + t) * D + h * 256 + v0) = w;
            }
        }
    }
    __syncthreads();
}

__device__ __forceinline__ void norm_frag(const u32x4 r0, const u32x4 r1, const float* __restrict__ g, float extra, int fq, bf16x8& o0, bf16x8& o1) {
    float f[16];
    f[0] = bflo(r0.x); f[1] = bfhi(r0.x); f[2] = bflo(r0.y); f[3] = bfhi(r0.y); f[4] = bflo(r0.z); f[5] = bfhi(r0.z); f[6] = bflo(r0.w); f[7] = bfhi(r0.w);
    f[8] = bflo(r1.x); f[9] = bfhi(r1.x); f[10] = bflo(r1.y); f[11] = bfhi(r1.y); f[12] = bflo(r1.z); f[13] = bfhi(r1.z); f[14] = bflo(r1.w); f[15] = bfhi(r1.w);
    float s = 0.f;
#pragma unroll
    for (int i = 0; i < 16; ++i) s += f[i] * f[i];
    s += __shfl_xor(s, 16); s += __shfl_xor(s, 32);
    const float rs = rsqrtf(s * (1.f / 64.f) + EPS) * extra;
    const f32x4 ga = *(const f32x4*)(g + 8 * fq), gb = *(const f32x4*)(g + 8 * fq + 4), gc = *(const f32x4*)(g + 32 + 8 * fq), gd = *(const f32x4*)(g + 32 + 8 * fq + 4);
    u32x4 a, b2;
    a.x = cvt_pk_bf16(f[0] * rs * ga.x, f[1] * rs * ga.y); a.y = cvt_pk_bf16(f[2] * rs * ga.z, f[3] * rs * ga.w);
    a.z = cvt_pk_bf16(f[4] * rs * gb.x, f[5] * rs * gb.y); a.w = cvt_pk_bf16(f[6] * rs * gb.z, f[7] * rs * gb.w);
    b2.x = cvt_pk_bf16(f[8] * rs * gc.x, f[9] * rs * gc.y); b2.y = cvt_pk_bf16(f[10] * rs * gc.z, f[11] * rs * gc.w);
    b2.z = cvt_pk_bf16(f[12] * rs * gd.x, f[13] * rs * gd.y); b2.w = cvt_pk_bf16(f[14] * rs * gd.z, f[15] * rs * gd.w);
    o0 = __builtin_bit_cast(bf16x8, a); o1 = __builtin_bit_cast(bf16x8, b2);
}

__device__ __forceinline__ void attn_prompt_unit(const Params& p, unsigned char* lds, int u) {
    const int tid = threadIdx.x, lane = tid & 63, wid = tid >> 6, fr = lane & 15, fq = lane >> 4;
    const int qb = u & 31, kvh = (u >> 5) & 3, b = u >> 7;
    unsigned char* ws = p.ws;
    const bf16_t* KVQ = (const bf16_t*)(ws + WS_KVQ);
    bf16_t* AO = (bf16_t*)(ws + WS_ATT);
    bf16_t* Ks = (bf16_t*)lds;
    bf16_t* VT = Ks + 256 * 72;
    const int pos0 = qb * 128 - 128;
    u32x4 qr[4][2];
    {
        const int g_ = wid >> 1, half_ = wid & 1, head_ = kvh * 4 + g_;
#pragma unroll
        for (int m = 0; m < 4; ++m) {
            const bf16_t* qp = KVQ + ((size_t)b * 4096 + qb * 128 + 64 * half_ + 16 * m + fr) * NKVQ + 512 + head_ * 64;
            qr[m][0] = *(const u32x4*)(qp + 8 * fq); qr[m][1] = *(const u32x4*)(qp + 32 + 8 * fq);
        }
    }
#pragma unroll
    for (int i = 0; i < 4; ++i) {
        const int ci = tid + 512 * i, j = ci >> 3, ch = ci & 7, pos = pos0 + j;
        u32x4 r = (u32x4){0u, 0u, 0u, 0u};
        if (pos >= 0) r = *(const u32x4*)(KVQ + (size_t)(b * 4096 + pos) * NKVQ + kvh * 64 + ch * 8);
        float f[8] = {bflo(r.x), bfhi(r.x), bflo(r.y), bfhi(r.y), bflo(r.z), bfhi(r.z), bflo(r.w), bfhi(r.w)};
        float s = 0.f;
#pragma unroll
        for (int e = 0; e < 8; ++e) s += f[e] * f[e];
        s += __shfl_xor(s, 1); s += __shfl_xor(s, 2); s += __shfl_xor(s, 4);
        const float rs = rsqrtf(s * (1.f / 64.f) + EPS);
        const f32x4 g0 = *(const f32x4*)(p.k_norm_g + ch * 8), g1 = *(const f32x4*)(p.k_norm_g + ch * 8 + 4);
        f[0] *= rs * g0.x; f[1] *= rs * g0.y; f[2] *= rs * g0.z; f[3] *= rs * g0.w; f[4] *= rs * g1.x; f[5] *= rs * g1.y; f[6] *= rs * g1.z; f[7] *= rs * g1.w;
        u32x4 w; w.x = cvt_pk_bf16(f[0], f[1]); w.y = cvt_pk_bf16(f[2], f[3]); w.z = cvt_pk_bf16(f[4], f[5]); w.w = cvt_pk_bf16(f[6], f[7]);
        *(u32x4*)(Ks + j * 72 + ch * 8) = w;
        if (qb == 31 && j >= 128) {
            float* o = p.out + O_PWK + ((size_t)(b * 128 + (j - 128)) * 4 + kvh) * 64 + ch * 8;
            *(f32x4*)o = (f32x4){f[0], f[1], f[2], f[3]}; *(f32x4*)(o + 4) = (f32x4){f[4], f[5], f[6], f[7]};
        }
    }
#pragma unroll
    for (int i = 0; i < 4; ++i) {
        const int ci = tid + 512 * i, j = ci & 255, ch = ci >> 8, pos = pos0 + j;
        u32x4 r = (u32x4){0u, 0u, 0u, 0u};
        if (pos >= 0) r = *(const u32x4*)(KVQ + (size_t)(b * 4096 + pos) * NKVQ + 256 + kvh * 64 + ch * 8);
        bf16_t* dst = VT + (ch * 8) * 264 + j;
        dst[0 * 264] = (bf16_t)(r.x & 0xffff); dst[1 * 264] = (bf16_t)(r.x >> 16); dst[2 * 264] = (bf16_t)(r.y & 0xffff); dst[3 * 264] = (bf16_t)(r.y >> 16);
        dst[4 * 264] = (bf16_t)(r.z & 0xffff); dst[5 * 264] = (bf16_t)(r.z >> 16); dst[6 * 264] = (bf16_t)(r.w & 0xffff); dst[7 * 264] = (bf16_t)(r.w >> 16);
        if (qb == 31 && j >= 128) {
            float* o = p.out + O_PWV + ((size_t)(b * 128 + (j - 128)) * 4 + kvh) * 64 + ch * 8;
            *(f32x4*)o = (f32x4){bflo(r.x), bfhi(r.x), bflo(r.y), bfhi(r.y)}; *(f32x4*)(o + 4) = (f32x4){bflo(r.z), bfhi(r.z), bflo(r.w), bfhi(r.w)};
        }
    }
    __syncthreads();
    const int g = wid >> 1, half = wid & 1, head = kvh * 4 + g;
    const float sink = p.att_sinks[head];
    const float* qg = p.q_norm_g;
#pragma unroll
    for (int m = 0; m < 4; ++m) {
        const int j0 = 64 * half + 16 * m;
        const size_t R = (size_t)b * 4096 + qb * 128 + j0 + fr;
        bf16x8 q0, q1; norm_frag(qr[m][0], qr[m][1], qg, 0.125f, fq, q0, q1);
        f32x4 s[9];
#pragma unroll
        for (int i = 0; i < 9; ++i) {
            s[i] = (f32x4){0.f, 0.f, 0.f, 0.f};
            const bf16_t* kr = Ks + (j0 + 16 * i + fr) * 72 + 8 * fq;
            s[i] = MFMA32(*(const bf16x8*)kr, q0, s[i]);
            s[i] = MFMA32(*(const bf16x8*)(kr + 32), q1, s[i]);
        }
        float mx = sink;
#pragma unroll
        for (int i = 0; i < 9; ++i)
#pragma unroll
            for (int e = 0; e < 4; ++e) {
                const int jr = 16 * i + 4 * fq + e;
                const bool ok = (jr >= fr) && (jr <= 128 + fr) && (pos0 + j0 + jr >= 0);
                s[i][e] = ok ? s[i][e] : -INFINITY;
                mx = fmaxf(mx, s[i][e]);
            }
        mx = fmaxf(mx, __shfl_xor(mx, 16)); mx = fmaxf(mx, __shfl_xor(mx, 32));
        float l = 0.f;
        bf16x4 pf[9];
#pragma unroll
        for (int i = 0; i < 9; ++i) {
            float e0 = __expf(s[i][0] - mx), e1 = __expf(s[i][1] - mx), e2 = __expf(s[i][2] - mx), e3 = __expf(s[i][3] - mx);
            l += (e0 + e1) + (e2 + e3);
            u32x2 w; w.x = cvt_pk_bf16(e0, e1); w.y = cvt_pk_bf16(e2, e3);
            pf[i] = __builtin_bit_cast(bf16x4, w);
        }
        l += __shfl_xor(l, 16); l += __shfl_xor(l, 32);
        l += __expf(sink - mx);
        const float inv = 1.f / l;
        f32x4 o[4];
#pragma unroll
        for (int dt = 0; dt < 4; ++dt) {
            o[dt] = (f32x4){0.f, 0.f, 0.f, 0.f};
#pragma unroll
            for (int i = 0; i < 9; ++i) {
                const bf16x4 vf = *(const bf16x4*)(VT + (16 * dt + fr) * 264 + j0 + 16 * i + 4 * fq);
                o[dt] = MFMA16(vf, pf[i], o[dt]);
            }
        }
#pragma unroll
        for (int dt = 0; dt < 4; ++dt) {
            u32x2 w; w.x = cvt_pk_bf16(o[dt].x * inv, o[dt].y * inv); w.y = cvt_pk_bf16(o[dt].z * inv, o[dt].w * inv);
            *(u32x2*)(AO + R * D + head * 64 + 16 * dt + 4 * fq) = w;
        }
    }
    __syncthreads();
}

__device__ __forceinline__ void attn_sample_unit(const Params& p, int u, int lane) {
    const int fr = lane & 15, fq = lane >> 4;
    const int b = u >> 2, kvh = u & 3;
    unsigned char* ws = p.ws;
    const bf16_t* KVQ = (const bf16_t*)(ws + WS_KVQ);
    bf16_t* AO = (bf16_t*)(ws + WS_ATT);
    const float* ck = p.cache_k + (size_t)b * 128 * 256 + kvh * 64;
    const float* cv = p.cache_v + (size_t)b * 128 * 256 + kvh * 64;
    float* owk = p.out + O_SWK + (size_t)b * 128 * 256 + kvh * 64;
    float* owv = p.out + O_SWV + (size_t)b * 128 * 256 + kvh * 64;
    const size_t rbase = (size_t)TP + b * 4;
    for (int i = lane; i < 124 * 16; i += 64) {
        const int j = i >> 4, d4 = (i & 15) * 4;
        *(f32x4*)(owk + (size_t)j * 256 + d4) = *(const f32x4*)(ck + (size_t)(j + 4) * 256 + d4);
        *(f32x4*)(owv + (size_t)j * 256 + d4) = *(const f32x4*)(cv + (size_t)(j + 4) * 256 + d4);
    }
    {
        const int t = lane >> 4, d4 = (lane & 15) * 4;
        const u32x2 kr = *(const u32x2*)(KVQ + (rbase + t) * NKVQ + kvh * 64 + d4);
        const u32x2 vr = *(const u32x2*)(KVQ + (rbase + t) * NKVQ + 256 + kvh * 64 + d4);
        float f0 = bflo(kr.x), f1 = bfhi(kr.x), f2 = bflo(kr.y), f3 = bfhi(kr.y);
        float s = (f0 * f0 + f1 * f1) + (f2 * f2 + f3 * f3);
        s += __shfl_xor(s, 1); s += __shfl_xor(s, 2); s += __shfl_xor(s, 4); s += __shfl_xor(s, 8);
        const float rs = rsqrtf(s * (1.f / 64.f) + EPS);
        const f32x4 g = *(const f32x4*)(p.k_norm_g + d4);
        *(f32x4*)(owk + (size_t)(124 + t) * 256 + d4) = (f32x4){f0 * rs * g.x, f1 * rs * g.y, f2 * rs * g.z, f3 * rs * g.w};
        *(f32x4*)(owv + (size_t)(124 + t) * 256 + d4) = (f32x4){bflo(vr.x), bfhi(vr.x), bflo(vr.y), bfhi(vr.y)};
    }
    const int g = fr >> 2, t = fr & 3, head = kvh * 4 + g;
    const bf16_t* qp = KVQ + (rbase + t) * NKVQ + 512 + head * 64;
    const u32x4 r0 = *(const u32x4*)(qp + 8 * fq), r1 = *(const u32x4*)(qp + 32 + 8 * fq);
    bf16x8 q0, q1; norm_frag(r0, r1, p.q_norm_g, 0.125f, fq, q0, q1);
    const float sink = p.att_sinks[head];
    bf16x8 nk0, nk1;
    {
        const bf16_t* kp = KVQ + (rbase + (fr & 3)) * NKVQ + kvh * 64;
        const u32x4 a0 = *(const u32x4*)(kp + 8 * fq), a1 = *(const u32x4*)(kp + 32 + 8 * fq);
        norm_frag(a0, a1, p.k_norm_g, 1.f, fq, nk0, nk1);
        if (fr >= 4) { nk0 = (bf16x8){0, 0, 0, 0, 0, 0, 0, 0}; nk1 = nk0; }
    }
    f32x4 s[9];
#pragma unroll
    for (int i = 0; i < 8; ++i) {
        const float* kr = ck + (size_t)(16 * i + fr) * 256 + 8 * fq;
        const f32x4 a = *(const f32x4*)kr, b2 = *(const f32x4*)(kr + 4), c = *(const f32x4*)(kr + 32), d = *(const f32x4*)(kr + 36);
        u32x4 x0, x1;
        x0.x = cvt_pk_bf16(a.x, a.y); x0.y = cvt_pk_bf16(a.z, a.w); x0.z = cvt_pk_bf16(b2.x, b2.y); x0.w = cvt_pk_bf16(b2.z, b2.w);
        x1.x = cvt_pk_bf16(c.x, c.y); x1.y = cvt_pk_bf16(c.z, c.w); x1.z = cvt_pk_bf16(d.x, d.y); x1.w = cvt_pk_bf16(d.z, d.w);
        s[i] = (f32x4){0.f, 0.f, 0.f, 0.f};
        s[i] = MFMA32(__builtin_bit_cast(bf16x8, x0), q0, s[i]);
        s[i] = MFMA32(__builtin_bit_cast(bf16x8, x1), q1, s[i]);
    }
    s[8] = (f32x4){0.f, 0.f, 0.f, 0.f};
    s[8] = MFMA32(nk0, q0, s[8]); s[8] = MFMA32(nk1, q1, s[8]);
    float mx = sink;
#pragma unroll
    for (int i = 0; i < 9; ++i)
#pragma unroll
        for (int e = 0; e < 4; ++e) {
            const int j = 16 * i + 4 * fq + e;
            const bool ok = (j >= t) && (j <= t + 128);
            s[i][e] = ok ? s[i][e] : -INFINITY;
            mx = fmaxf(mx, s[i][e]);
        }
    mx = fmaxf(mx, __shfl_xor(mx, 16)); mx = fmaxf(mx, __shfl_xor(mx, 32));
    float l = 0.f; bf16x4 pf[9];
#pragma unroll
    for (int i = 0; i < 9; ++i) {
        float e0 = __expf(s[i][0] - mx), e1 = __expf(s[i][1] - mx), e2 = __expf(s[i][2] - mx), e3 = __expf(s[i][3] - mx);
        l += (e0 + e1) + (e2 + e3);
        u32x2 w; w.x = cvt_pk_bf16(e0, e1); w.y = cvt_pk_bf16(e2, e3);
        pf[i] = __builtin_bit_cast(bf16x4, w);
    }
    l += __shfl_xor(l, 16); l += __shfl_xor(l, 32);
    l += __expf(sink - mx);
    const float inv = 1.f / l;
#pragma unroll
    for (int dt = 0; dt < 4; ++dt) {
        f32x4 o = (f32x4){0.f, 0.f, 0.f, 0.f};
#pragma unroll
        for (int i = 0; i < 8; ++i) {
            const float* vr = cv + (size_t)(16 * i + 4 * fq) * 256 + 16 * dt + fr;
            u32x2 w; w.x = cvt_pk_bf16(vr[0], vr[256]); w.y = cvt_pk_bf16(vr[512], vr[768]);
            o = MFMA16(__builtin_bit_cast(bf16x4, w), pf[i], o);
        }
        {
            u32x2 w; w.x = 0u; w.y = 0u;
            const bf16_t* vp = KVQ + rbase * NKVQ + 256 + kvh * 64 + 16 * dt + fr;
            const unsigned v0 = vp[0], v1 = vp[NKVQ], v2 = vp[2 * NKVQ], v3 = vp[3 * NKVQ];
            if (fq == 0) { w.x = v0 | (v1 << 16); w.y = v2 | (v3 << 16); }
            o = MFMA16(__builtin_bit_cast(bf16x4, w), pf[8], o);
        }
        u32x2 w; w.x = cvt_pk_bf16(o.x * inv, o.y * inv); w.y = cvt_pk_bf16(o.z * inv, o.w * inv);
        *(u32x2*)(AO + (rbase + t) * D + head * 64 + 16 * dt + 4 * fq) = w;
    }
}


__device__ __forceinline__ void attn_sample_block(const Params& p, unsigned char* lds, int u) {
    const int tid = threadIdx.x, lane = tid & 63, wid = tid >> 6, fr = lane & 15, fq = lane >> 4;
    const int b = u >> 2, kvh = u & 3;
    unsigned char* ws = p.ws;
    const bf16_t* KVQ = (const bf16_t*)(ws + WS_KVQ);
    bf16_t* AO = (bf16_t*)(ws + WS_ATT);
    const float* ck = p.cache_k + (size_t)b * 128 * 256 + kvh * 64;
    const float* cv = p.cache_v + (size_t)b * 128 * 256 + kvh * 64;
    float* owk = p.out + O_SWK + (size_t)b * 128 * 256 + kvh * 64;
    float* owv = p.out + O_SWV + (size_t)b * 128 * 256 + kvh * 64;
    const size_t rbase = (size_t)TP + b * 4;
    bf16_t* Ks = (bf16_t*)lds;
    bf16_t* VT = Ks + 144 * 72;
    f32x4 kf[4], vf[4];
#pragma unroll
    for (int i = 0; i < 4; ++i) { const int idx = tid + 512 * i, j = idx >> 4, c4 = (idx & 15) * 4; kf[i] = *(const f32x4*)(ck + (size_t)j * 256 + c4); vf[i] = *(const f32x4*)(cv + (size_t)j * 256 + c4); }
#pragma unroll
    for (int i = 0; i < 4; ++i) {
        const int idx = tid + 512 * i, j = idx >> 4, c4 = (idx & 15) * 4;
        if (j >= 4) { *(f32x4*)(owk + (size_t)(j - 4) * 256 + c4) = kf[i]; *(f32x4*)(owv + (size_t)(j - 4) * 256 + c4) = vf[i]; }
        u32x2 w; w.x = cvt_pk_bf16(kf[i].x, kf[i].y); w.y = cvt_pk_bf16(kf[i].z, kf[i].w);
        *(u32x2*)(Ks + j * 72 + c4) = w;
        VT[(c4 + 0) * 152 + j] = f2bf(vf[i].x); VT[(c4 + 1) * 152 + j] = f2bf(vf[i].y); VT[(c4 + 2) * 152 + j] = f2bf(vf[i].z); VT[(c4 + 3) * 152 + j] = f2bf(vf[i].w);
    }
    if (tid < 64) {
        const int t = tid >> 4, d4 = (tid & 15) * 4;
        const u32x2 kr = *(const u32x2*)(KVQ + (rbase + t) * NKVQ + kvh * 64 + d4);
        const u32x2 vr = *(const u32x2*)(KVQ + (rbase + t) * NKVQ + 256 + kvh * 64 + d4);
        float f0 = bflo(kr.x), f1 = bfhi(kr.x), f2 = bflo(kr.y), f3 = bfhi(kr.y);
        float s = (f0 * f0 + f1 * f1) + (f2 * f2 + f3 * f3);
        s += __shfl_xor(s, 1); s += __shfl_xor(s, 2); s += __shfl_xor(s, 4); s += __shfl_xor(s, 8);
        const float rs = rsqrtf(s * (1.f / 64.f) + EPS);
        const f32x4 g = *(const f32x4*)(p.k_norm_g + d4);
        f0 *= rs * g.x; f1 *= rs * g.y; f2 *= rs * g.z; f3 *= rs * g.w;
        *(f32x4*)(owk + (size_t)(124 + t) * 256 + d4) = (f32x4){f0, f1, f2, f3};
        *(f32x4*)(owv + (size_t)(124 + t) * 256 + d4) = (f32x4){bflo(vr.x), bfhi(vr.x), bflo(vr.y), bfhi(vr.y)};
        u32x2 w; w.x = cvt_pk_bf16(f0, f1); w.y = cvt_pk_bf16(f2, f3);
        *(u32x2*)(Ks + (128 + t) * 72 + d4) = w;
        VT[(d4 + 0) * 152 + 128 + t] = (bf16_t)(vr.x & 0xffff); VT[(d4 + 1) * 152 + 128 + t] = (bf16_t)(vr.x >> 16);
        VT[(d4 + 2) * 152 + 128 + t] = (bf16_t)(vr.y & 0xffff); VT[(d4 + 3) * 152 + 128 + t] = (bf16_t)(vr.y >> 16);
    } else if (tid < 64 + 192) {
        const int i = tid - 64;
        if (i < 96) { const int r = 132 + (i >> 3), c8 = (i & 7) * 8; *(u32x4*)(Ks + r * 72 + c8) = (u32x4){0u, 0u, 0u, 0u}; }
        else { const int d = i - 96; if (d < 64) { bf16_t* z = VT + d * 152 + 132; for (int e = 0; e < 12; ++e) z[e] = 0; } }
    }
    __syncthreads();
    if (wid < 4) {
        const int dt = wid;
        const int g = fr >> 2, t = fr & 3, head = kvh * 4 + g;
        const bf16_t* qp = KVQ + (rbase + t) * NKVQ + 512 + head * 64;
        const u32x4 r0 = *(const u32x4*)(qp + 8 * fq), r1 = *(const u32x4*)(qp + 32 + 8 * fq);
        bf16x8 q0, q1; norm_frag(r0, r1, p.q_norm_g, 0.125f, fq, q0, q1);
        const float sink = p.att_sinks[head];
        f32x4 s[9];
#pragma unroll
        for (int i = 0; i < 9; ++i) {
            s[i] = (f32x4){0.f, 0.f, 0.f, 0.f};
            const bf16_t* kr = Ks + (16 * i + fr) * 72 + 8 * fq;
            s[i] = MFMA32(*(const bf16x8*)kr, q0, s[i]);
            s[i] = MFMA32(*(const bf16x8*)(kr + 32), q1, s[i]);
        }
        float mx = sink;
#pragma unroll
        for (int i = 0; i < 9; ++i)
#pragma unroll
            for (int e = 0; e < 4; ++e) {
                const int j = 16 * i + 4 * fq + e;
                const bool ok = (j >= t) && (j <= t + 128);
                s[i][e] = ok ? s[i][e] : -INFINITY;
                mx = fmaxf(mx, s[i][e]);
            }
        mx = fmaxf(mx, __shfl_xor(mx, 16)); mx = fmaxf(mx, __shfl_xor(mx, 32));
        float l = 0.f;
        f32x4 o = (f32x4){0.f, 0.f, 0.f, 0.f};
#pragma unroll
        for (int i = 0; i < 9; ++i) {
            const float e0 = __expf(s[i][0] - mx), e1 = __expf(s[i][1] - mx), e2 = __expf(s[i][2] - mx), e3 = __expf(s[i][3] - mx);
            l += (e0 + e1) + (e2 + e3);
            u32x2 w; w.x = cvt_pk_bf16(e0, e1); w.y = cvt_pk_bf16(e2, e3);
            const bf16x4 vfr = *(const bf16x4*)(VT + (16 * dt + fr) * 152 + 16 * i + 4 * fq);
            o = MFMA16(vfr, __builtin_bit_cast(bf16x4, w), o);
        }
        l += __shfl_xor(l, 16); l += __shfl_xor(l, 32);
        l += __expf(sink - mx);
        const float inv = 1.f / l;
        u32x2 w; w.x = cvt_pk_bf16(o.x * inv, o.y * inv); w.y = cvt_pk_bf16(o.z * inv, o.w * inv);
        *(u32x2*)(AO + (rbase + t) * D + head * 64 + 16 * dt + 4 * fq) = w;
    }
    __syncthreads();
}

#define LAS __attribute__((address_space(3)))
#define XB_TMO      128
#define XB_XCNT(j)  (256  + 64 * (j))
#define XB_XSUB(j)  (1280 + 64 * (j))
#define XB_XGEN(j)  (2304 + 64 * (j))
#define XB_TOP      3328
#define XB_TOPGEN   3392
#define XCD_BAR_WORDS 3456
#define XB_SPIN_CAP (1u << 18)

__device__ __forceinline__ unsigned xb_ld(unsigned* p)              { return __hip_atomic_load(p, __ATOMIC_RELAXED, __HIP_MEMORY_SCOPE_AGENT); }
__device__ __forceinline__ unsigned xb_add(unsigned* p, unsigned v) { return __hip_atomic_fetch_add(p, v, __ATOMIC_RELAXED, __HIP_MEMORY_SCOPE_AGENT); }
__device__ __forceinline__ unsigned xb_xcc_id() { return (unsigned)__builtin_amdgcn_s_getreg((3 << 11) | 20) & 0xFu; }
#define XB_SPIN(cond, bar) do { unsigned _sp = 0; while (cond) { __builtin_amdgcn_s_sleep(1); \
    if ((++_sp & 255u) == 0u) { if (xb_ld(&(bar)[XB_TMO])) break; if (_sp > XB_SPIN_CAP) { atomicAdd(&(bar)[XB_TMO], 1u); break; } } } } while (0)

struct XcdBarrier {
    unsigned* bar; unsigned x;
    volatile LAS unsigned* st;
};

__device__ __forceinline__ XcdBarrier xcd_barrier_post(unsigned* bar, volatile LAS unsigned* st) {
    XcdBarrier b; b.bar = bar; b.x = xb_xcc_id(); b.st = st;
    if (threadIdx.x == 0) (void)xb_add(&bar[XB_XCNT(b.x)], 1u);
    return b;
}
__device__ __forceinline__ void xcd_barrier_complete(unsigned* bar, unsigned x, unsigned& nloc, unsigned& nx) {
    const unsigned G = gridDim.x * gridDim.y * gridDim.z;
    unsigned sum, cnt, mine, sp = 0u;
    for (;;) {
        sum = 0u; cnt = 0u; mine = 0u;
#pragma unroll
        for (unsigned j = 0; j < 16; ++j) { const unsigned c = xb_ld(&bar[XB_XCNT(j)]); sum += c; cnt += (c > 0u) ? 1u : 0u; mine = (j == x) ? c : mine; }
        if (sum == G) break;
        __builtin_amdgcn_s_sleep(1);
        if ((++sp & 255u) == 0u) { if (xb_ld(&bar[XB_TMO])) break; if (sp > XB_SPIN_CAP) { atomicAdd(&bar[XB_TMO], 1u); break; } }
    }
    nloc = mine > 0u ? mine : 1u; nx = cnt > 0u ? cnt : 1u;
}

__device__ __forceinline__ void xcd_barrier(const XcdBarrier& b) {
    asm volatile("s_waitcnt vmcnt(0)" ::: "memory");
    __syncthreads();
    if (threadIdx.x == 0) {
        unsigned* bar = b.bar;
        __builtin_amdgcn_s_waitcnt(0);
        unsigned nloc = b.st[0], nx = b.st[1];
        if (nloc == 0u) { xcd_barrier_complete(bar, b.x, nloc, nx); b.st[0] = nloc; b.st[1] = nx; }
        const unsigned old = xb_add(&bar[XB_XSUB(b.x)], 1u);
        const unsigned gen = old / nloc;
        if (old + 1u == (gen + 1u) * nloc) {
            __builtin_amdgcn_fence(__ATOMIC_RELEASE, "agent");
            asm volatile("s_waitcnt vmcnt(0)" ::: "memory");
            const unsigned og = xb_add(&bar[XB_TOP], 1u);
            const unsigned tg = og / nx;
            if (og + 1u == (tg + 1u) * nx) xb_add(&bar[XB_TOPGEN], 1u);
            else XB_SPIN(xb_ld(&bar[XB_TOPGEN]) == tg, bar);
            __builtin_amdgcn_fence(__ATOMIC_ACQUIRE, "agent");
            xb_add(&bar[XB_XGEN(b.x)], 1u);
            asm volatile("s_waitcnt vmcnt(0)" ::: "memory");
        } else {
            XB_SPIN(xb_ld(&bar[XB_XGEN(b.x)]) == gen, bar);
            __builtin_amdgcn_fence(__ATOMIC_ACQUIRE, "agent");
            asm volatile("s_waitcnt vmcnt(0)" ::: "memory");
        }
    }
    __syncthreads();
}

__global__ void __launch_bounds__(NTHREADS) yoco_fwd(Params p) {
    extern __shared__ __attribute__((aligned(16))) unsigned char lds[];
    const int bid = blockIdx.x, G = gridDim.x;
    unsigned char* ws = p.ws;
    float* SS = (float*)(ws + WS_SS);
    float* Y = p.out + O_Y;
    bf16_t* XB = (bf16_t*)(ws + WS_XB);

#define IN(k) (p.ph_lo <= (k) && (k) < p.ph_hi)
    volatile LAS unsigned* bst = (volatile LAS unsigned*)((LAS unsigned char*)lds + 131072 + 64);
    XcdBarrier xbar; xbar.bar = (unsigned*)(ws + WS_BAR); xbar.x = 0; xbar.st = bst;
    if (p.ph_hi - p.ph_lo > 1) {
        if (threadIdx.x < 2) bst[threadIdx.x] = 0u;
        __syncthreads();
        xbar = xcd_barrier_post((unsigned*)(ws + WS_BAR), bst);
    }
#define SEAM(k) do { if (IN(k) && IN((k) + 1)) xcd_barrier(xbar); } while (0)
    if (IN(0)) { for (int rep = 0; rep < REP_P0; ++rep) p0_prologue(p, lds, bid, G); }
    SEAM(0);
    PG8_LAS unsigned char* l3 = (PG8_LAS unsigned char*)lds;
    float* YS = Y;
#define PGEMM(Aptr, Bptr, Nn, Kk, EpiT, ...) do { pg8::Gemm g_{(const bf16_t*)(Aptr), (const bf16_t*)(Bptr), TP, (Nn), (Kk), ((Kk) == FF) ? 1 : 0}; pg8::StaticOrder S_; S_.init(TP, (Nn), G, bid); \
        Pg8Epi<EpiT> E_{EpiT{__VA_ARGS__}}; pg8::gemm_phase<Pg8Epi<EpiT>, pg8::StaticOrder, true, true>(l3, g_, S_, E_); } while (0)
    if (IN(1)) {
        for (int rep = 0; rep < REP_PG; ++rep) { PGEMM(XB, ws + WS_WIN, NIN, 1024, EpiBf16, (bf16_t*)(ws + WS_P), NIN, nullptr, 0); }
        { EpiBf16 E{(bf16_t*)(ws + WS_P), NIN, nullptr, 0}; for (int rep = 0; rep < REP_SG; ++rep) sgemm64<0>(lds, XB, 1024, (const bf16_t*)(ws + WS_WIN), TP, TS, NIN, 1024, 1, E, bid, G); }
    }
    SEAM(1);
    if (IN(2)) {
        for (int rep = 0; rep < REP_2AL; ++rep) for (int u = bid; u < 1024; u += G) mlstm_local_unit(p, lds, u);
        for (int rep = 0; rep < REP_2AS; ++rep) for (int u = bid; u < 512; u += G) mlstm_sample_unit(p, lds, u);
    }
    SEAM(2);
    if (IN(3)) mlstm_scan(p, lds, bid, G);
    SEAM(3);
    if (IN(4)) { for (int rep = 0; rep < REP_2C; ++rep) for (int u = bid; u < 1024; u += G) mlstm_out_unit(p, lds, u); }
    SEAM(4);
    if (IN(5)) {
        PGEMM(ws + WS_HG, ws + WS_WOUT, 1024, 1024, EpiResB, p.x_prompt, XB, nullptr, SS);
        { EpiAtomic E{YS}; sgemm64<0>(lds, ws + WS_HG, 1024, (const bf16_t*)(ws + WS_WOUT), TP, TS, 1024, 1024, 4, E, bid, G); }
    }
    SEAM(5);
    if (IN(6)) {
        for (int rep = 0; rep < REP_PG; ++rep) { PGEMM(XB, ws + WS_W1A, FF, 1024, EpiBf16, (bf16_t*)(ws + WS_HID), FF, SS, 1); }
        { EpiBf16 E{(bf16_t*)(ws + WS_HID), FF, nullptr, 1}; for (int rep = 0; rep < REP_SG; ++rep) sgemm64<1>(lds, Y, 1024, (const bf16_t*)(ws + WS_W1A), TP, TS, FF, 1024, 1, E, bid, G); }
    }
    SEAM(6);
    if (IN(7)) {
        PGEMM(ws + WS_HID, ws + WS_W2A, 1024, FF, EpiResB, nullptr, XB, nullptr, SS + T);
        { EpiAtomic E{YS}; sgemm64<0>(lds, ws + WS_HID, FF, (const bf16_t*)(ws + WS_W2A), TP, TS, 1024, FF, 4, E, bid, G); }
    }
    SEAM(7);
    if (IN(8)) {
        for (int rep = 0; rep < REP_PG; ++rep) { PGEMM(XB, ws + WS_WKVQ, NKVQ, 1024, EpiBf16, (bf16_t*)(ws + WS_KVQ), NKVQ, SS + T, 0); }
        { EpiBf16 E{(bf16_t*)(ws + WS_KVQ), NKVQ, nullptr, 0}; for (int rep = 0; rep < REP_SG; ++rep) sgemm64<1>(lds, Y, 1024, (const bf16_t*)(ws + WS_WKVQ), TP, TS, NKVQ, 1024, 1, E, (bid + G / 2) % G, G); }
        __syncthreads();
        if (bid >= G / 2) late_weights(p, lds, bid - G / 2, G - G / 2);
    }
    SEAM(8);
    if (IN(9)) {
        for (int rep = 0; rep < REP_7P; ++rep) for (int u = bid; u < 512; u += G) attn_prompt_unit(p, lds, u);
        for (int rep = 0; rep < REP_7S; ++rep) for (int u = bid; u < 512; u += G) attn_sample_block(p, lds, u);
    }
    SEAM(9);
    if (IN(10)) {
        PGEMM(ws + WS_ATT, ws + WS_WO, 1024, 1024, EpiResB, nullptr, XB, nullptr, SS + 2 * T);
        { EpiAtomic E{YS}; sgemm64<0>(lds, ws + WS_ATT, 1024, (const bf16_t*)(ws + WS_WO), TP, TS, 1024, 1024, 4, E, bid, G); }
    }
    SEAM(10);
    if (IN(11)) {
        for (int rep = 0; rep < REP_PG; ++rep) { PGEMM(XB, ws + WS_W1B, FF, 1024, EpiBf16, (bf16_t*)(ws + WS_HID), FF, SS + 2 * T, 1); }
        { EpiBf16 E{(bf16_t*)(ws + WS_HID), FF, nullptr, 1}; for (int rep = 0; rep < REP_SG; ++rep) sgemm64<1>(lds, Y, 1024, (const bf16_t*)(ws + WS_W1B), TP, TS, FF, 1024, 1, E, bid, G); }
    }
    SEAM(11);
    if (IN(12)) {
        PGEMM(ws + WS_HID, ws + WS_W2B, 1024, FF, EpiResB, nullptr, XB, Y, nullptr);
        { EpiAtomic E{YS}; sgemm64<0>(lds, ws + WS_HID, FF, (const bf16_t*)(ws + WS_W2B), TP, TS, 1024, FF, 4, E, bid, G); }
    }
#undef PGEMM
#undef IN
#undef SEAM
}

extern "C" void kernel_launch(void* const* d_in, const int* in_sizes, int n_in, void* d_out, int out_size, void* d_ws, size_t ws_size, hipStream_t stream) {
    static int grid_blocks = 0;
    if (!grid_blocks) {
        if (n_in != 24 || (size_t)out_size != O_END || ws_size < WS_END) { fprintf(stderr, "kernel_launch: unexpected shapes n_in=%d out=%d ws=%zu\n", n_in, out_size, ws_size); grid_blocks = -1; return; }
        int dev = 0, cus = 0, per_cu = 0;
        hipGetDevice(&dev);
        hipDeviceGetAttribute(&cus, hipDeviceAttributeMultiprocessorCount, dev);
        hipFuncSetAttribute((const void*)yoco_fwd, hipFuncAttributeMaxDynamicSharedMemorySize, LDS_BYTES);
        hipOccupancyMaxActiveBlocksPerMultiprocessor(&per_cu, (const void*)yoco_fwd, NTHREADS, LDS_BYTES);
        if (per_cu < 1) per_cu = 1;
        grid_blocks = cus * per_cu;
        (void)hipGetLastError();
    }
    if (grid_blocks < 0) return;
    Params p{};
    const float** pp = (const float**)&p;
    for (int i = 0; i < 24; ++i) pp[i] = (const float*)d_in[i];
    p.out = (float*)d_out; p.ws = (unsigned char*)d_ws;
#if N_LAUNCH_MODE == 1
    p.ph_lo = 0; p.ph_hi = 13;
    (void)hipMemsetAsync((char*)d_ws + WS_BAR, 0, BAR_BYTES, stream);
    void* args[] = {&p};
    hipError_t e = hipLaunchCooperativeKernel((const void*)yoco_fwd, dim3(grid_blocks), dim3(NTHREADS), args, LDS_BYTES, stream);
    if (e != hipSuccess) fprintf(stderr, "cooperative launch failed: %s (grid %d)\n", hipGetErrorString(e), grid_blocks);
#else
    for (int k = 0; k < MAX_PHASE; ++k) { p.ph_lo = k; p.ph_hi = k + 1; hipLaunchKernelGGL(yoco_fwd, dim3(grid_blocks), dim3(NTHREADS), LDS_BYTES, stream, p); }
#endif
}
```

```cpp
#include <hip/hip_runtime.h>
#include <hip/hip_cooperative_groups.h>
#include <cstdio>
#include <cstdint>
namespace cg = cooperative_groups;

typedef unsigned short bf16_t;
typedef short bf16x8 __attribute__((ext_vector_type(8)));
typedef short bf16x4 __attribute__((ext_vector_type(4)));
typedef float f32x4 __attribute__((ext_vector_type(4)));
typedef unsigned u32x4 __attribute__((ext_vector_type(4)));
typedef unsigned u32x2 __attribute__((ext_vector_type(2)));

constexpr int D = 1024, TP = 16384, TS = 512, T = TP + TS;
constexpr int NIN = 3072, LDW_IN = 3080, FF = 4096, NKVQ = 1536;
constexpr float EPS = 1e-6f;
constexpr int NTHREADS = 512;
constexpr int LDS_BYTES = 147456;
#ifndef REP_P0
#define REP_P0 1
#endif
#ifndef REP_2AL
#define REP_2AL 1
#endif
#ifndef REP_2AS
#define REP_2AS 1
#endif
#ifndef REP_2C
#define REP_2C 1
#endif
#ifndef REP_7P
#define REP_7P 1
#endif
#ifndef REP_7S
#define REP_7S 1
#endif
#ifndef REP_PG
#define REP_PG 1
#endif
#ifndef REP_SG
#define REP_SG 1
#endif
#ifndef MAX_PHASE
#define MAX_PHASE 13
#endif
#ifndef N_LAUNCH_MODE
#define N_LAUNCH_MODE 1
#endif

constexpr size_t MiB = 1u << 20;
constexpr size_t WS_SS = 0;
constexpr size_t WS_CHB = 256 * 1024, WS_CHM = WS_CHB + 4096, WS_MPREV = WS_CHM + 4096;
constexpr size_t WS_GATES = 1 * MiB;
constexpr size_t WS_GN = 2 * MiB;
constexpr size_t WS_BAR = 3 * MiB, BAR_BYTES = 16384;
constexpr size_t WS_WIN = 4 * MiB, WS_WOUT = 10 * MiB, WS_W1A = 12 * MiB, WS_W2A = 20 * MiB, WS_WKVQ = 28 * MiB, WS_WO = 31 * MiB, WS_W1B = 33 * MiB, WS_W2B = 41 * MiB;
constexpr size_t WS_XB = 49 * MiB;
constexpr size_t WS_P = 82 * MiB;
constexpr size_t WS_HG = 181 * MiB;
constexpr size_t WS_HID = 82 * MiB;
constexpr size_t WS_KVQ = 82 * MiB;
constexpr size_t WS_ATT = 132 * MiB;
constexpr size_t WS_END = 214 * MiB;

constexpr size_t O_Y = 0, O_PC = 17301504, O_PN = 17825792, O_PM = 17827840, O_PWK = 17827856, O_PWV = 17958928,
                 O_SC = 18090000, O_SN = 34867216, O_SM = 34932752, O_SWK = 34933264, O_SWV = 39127568, O_END = 43321872;

struct Params {
    const float *x_prompt, *x_sample, *st_C, *st_n, *st_m, *cache_k, *cache_v;
    const float *ml_norm_g, *ml_w_in, *ml_b_i, *ml_b_f, *ml_head_g, *ml_w_out;
    const float *kv_norm_g, *w_kv, *k_norm_g;
    const float *att_norm_g, *att_w_q, *q_norm_g, *att_sinks, *att_w_o;
    const float *mlp_norm_g, *mlp_w1, *mlp_w2;
    float* out; unsigned char* ws;
    int ph_lo, ph_hi;
};

typedef float f32x2 __attribute__((ext_vector_type(2)));
typedef __bf16 bf16x2n __attribute__((ext_vector_type(2)));
__device__ __forceinline__ unsigned cvt_pk_bf16(float lo, float hi) { const f32x2 v = {lo, hi}; const bf16x2n b = __builtin_convertvector(v, bf16x2n); return __builtin_bit_cast(unsigned, b); }
__device__ __forceinline__ bf16_t f2bf(float f) { return (bf16_t)(cvt_pk_bf16(f, 0.f) & 0xffffu); }
__device__ __forceinline__ float bf2f(bf16_t h) { return __uint_as_float(((unsigned)h) << 16); }
__device__ __forceinline__ float bflo(unsigned u) { return __uint_as_float(u << 16); }
__device__ __forceinline__ float bfhi(unsigned u) { return __uint_as_float(u & 0xffff0000u); }
__device__ __forceinline__ float wave_sum(float v) {
#pragma unroll
    for (int o = 1; o < 64; o <<= 1) v += __shfl_xor(v, o);
    return v;
}
__device__ __forceinline__ float wave_max(float v) {
#pragma unroll
    for (int o = 1; o < 64; o <<= 1) v = fmaxf(v, __shfl_xor(v, o));
    return v;
}
__device__ __forceinline__ float scan_sum(float x, int lane) {
#pragma unroll
    for (int o = 1; o < 64; o <<= 1) { float y = __shfl_up(x, o); if (lane >= o) x += y; }
    return x;
}
__device__ __forceinline__ float scan_max(float x, int lane) {
#pragma unroll
    for (int o = 1; o < 64; o <<= 1) { float y = __shfl_up(x, o); if (lane >= o) x = fmaxf(x, y); }
    return x;
}
__device__ __forceinline__ float softcap15(float x) { return 15.f * tanhf(x * (1.f / 15.f)); }
__device__ __forceinline__ float logsigmoid(float z) { return fminf(z, 0.f) - log1pf(__expf(-fabsf(z))); }
__device__ __forceinline__ float sigmoidf_(float z) { return 1.f / (1.f + __expf(-z)); }
#define LDS_WAIT() asm volatile("s_waitcnt lgkmcnt(0)" ::: "memory")
#define MFMA32(x, y, acc) __builtin_amdgcn_mfma_f32_16x16x32_bf16((x), (y), (acc), 0, 0, 0)
#define MFMA16(x, y, acc) __builtin_amdgcn_mfma_f32_16x16x16bf16_1k((x), (y), (acc), 0, 0, 0)

__device__ __forceinline__ void transpose_item(const float* __restrict__ W, int ldw, int K, const float* __restrict__ gk, float cs,
                                               bf16_t* WT, int row_off, int k0, int n0, float* scr, int lane) {
    {
        const int kr = lane >> 3, n4 = (lane & 7) * 4;
        f32x4 wv[8];
#pragma unroll
        for (int i = 0; i < 8; ++i) wv[i] = *(const f32x4*)(W + (size_t)(k0 + kr + 8 * i) * ldw + n0 + n4);
#pragma unroll
        for (int i = 0; i < 8; ++i) {
            const int kk = kr + 8 * i;
            const float g = gk ? gk[k0 + kk] * cs : cs;
            float* d = scr + kk * 33 + n4;
            d[0] = wv[i].x * g; d[1] = wv[i].y * g; d[2] = wv[i].z * g; d[3] = wv[i].w * g;
        }
    }
    LDS_WAIT();
    const int c = lane & 7;
#pragma unroll
    for (int j = 0; j < 4; ++j) {
        const int n = (lane >> 3) + 8 * j; const float* s = scr + (8 * c) * 33 + n;
        u32x4 o; o.x = cvt_pk_bf16(s[0 * 33], s[1 * 33]); o.y = cvt_pk_bf16(s[2 * 33], s[3 * 33]); o.z = cvt_pk_bf16(s[4 * 33], s[5 * 33]); o.w = cvt_pk_bf16(s[6 * 33], s[7 * 33]);
        *(u32x4*)(WT + (size_t)(row_off + n0 + n) * K + k0 + 8 * c) = o;
    }
    LDS_WAIT();
}

__device__ __forceinline__ void p0_prologue(const Params& p, unsigned char* lds, int bid, int G) {
    const int tid = threadIdx.x, lane = tid & 63, wid = tid >> 6;
    unsigned char* ws = p.ws;
    float* scr = (float*)(lds + wid * 8448);
    float* wif = (float*)(lds + 73728);
    for (int k = tid; k < 1024; k += NTHREADS) {
        const float g = p.ml_norm_g[k];
        const f32x4 a = *(const f32x4*)(p.ml_w_in + (size_t)k * LDW_IN + 3072), b = *(const f32x4*)(p.ml_w_in + (size_t)k * LDW_IN + 3076);
        wif[0 * 1024 + k] = a.x * g; wif[1 * 1024 + k] = a.y * g; wif[2 * 1024 + k] = a.z * g; wif[3 * 1024 + k] = a.w * g;
        wif[4 * 1024 + k] = b.x * g; wif[5 * 1024 + k] = b.y * g; wif[6 * 1024 + k] = b.z * g; wif[7 * 1024 + k] = b.w * g;
    }
    { float* ss = (float*)(ws + WS_SS); for (int i = bid * NTHREADS + tid; i < 3 * T; i += G * NTHREADS) ss[i] = 0.f; }
    __syncthreads();
    const int gw = bid * 8 + wid, NGW = G * 8;
    constexpr int I_IN = 16 * 96, I_SQ = 16 * 32, I_1 = 16 * 128, I_2 = 64 * 32, I_KV = 16 * 16;
    constexpr int NITEMS = I_IN + I_SQ + I_1 + I_2 + I_KV + I_SQ;
    for (int it = gw; it < NITEMS; it += NGW) {
        int r = it;
        if (r < I_IN) { const int kb = r / 96, nb = r % 96, n0 = nb * 32; const float cs = (n0 >= 512 && n0 < 1024) ? 0.08838834764831845f : 1.f;
            transpose_item(p.ml_w_in, LDW_IN, 1024, p.ml_norm_g, cs, (bf16_t*)(ws + WS_WIN), 0, kb * 64, n0, scr, lane); continue; } r -= I_IN;
        if (r < I_SQ) { transpose_item(p.ml_w_out, 1024, 1024, nullptr, 1.f, (bf16_t*)(ws + WS_WOUT), 0, (r / 32) * 64, (r % 32) * 32, scr, lane); continue; } r -= I_SQ;
        if (r < I_1) { transpose_item(p.mlp_w1, 4096, 1024, p.mlp_norm_g, 1.f, (bf16_t*)(ws + WS_W1A), 0, (r / 128) * 64, (r % 128) * 32, scr, lane); continue; } r -= I_1;
        if (r < I_2) { transpose_item(p.mlp_w2, 1024, 4096, nullptr, 1.f, (bf16_t*)(ws + WS_W2A), 0, (r / 32) * 64, (r % 32) * 32, scr, lane); continue; } r -= I_2;
        if (r < I_KV) { transpose_item(p.w_kv, 512, 1024, p.kv_norm_g, 1.f, (bf16_t*)(ws + WS_WKVQ), 0, (r / 16) * 64, (r % 16) * 32, scr, lane); continue; } r -= I_KV;
        transpose_item(p.att_w_q, 1024, 1024, p.att_norm_g, 1.f, (bf16_t*)(ws + WS_WKVQ), 512, (r / 32) * 64, (r % 32) * 32, scr, lane);
    }
    bf16_t* XB = (bf16_t*)(ws + WS_XB); float* gates = (float*)(ws + WS_GATES);
    for (int m = gw; m < T; m += NGW) {
        const float* xrow = m < TP ? p.x_prompt + (size_t)m * D : p.x_sample + (size_t)(m - TP) * D;
        f32x4 v[4]; float s = 0.f;
#pragma unroll
        for (int j = 0; j < 4; ++j) { v[j] = *(const f32x4*)(xrow + 4 * lane + 256 * j); s += (v[j].x * v[j].x + v[j].y * v[j].y) + (v[j].z * v[j].z + v[j].w * v[j].w); }
        const float rstd = rsqrtf(wave_sum(s) * (1.f / D) + EPS);
        if (m >= TP) {
#pragma unroll
            for (int j = 0; j < 4; ++j) *(f32x4*)(p.out + O_Y + (size_t)m * D + 4 * lane + 256 * j) = v[j];
        }
#pragma unroll
        for (int j = 0; j < 4; ++j) { u32x2 w; w.x = cvt_pk_bf16(v[j].x * rstd, v[j].y * rstd); w.y = cvt_pk_bf16(v[j].z * rstd, v[j].w * rstd); *(u32x2*)(XB + (size_t)m * D + 4 * lane + 256 * j) = w; }
        float mine = 0.f;
#pragma unroll
        for (int g = 0; g < 8; ++g) {
            float a = 0.f;
#pragma unroll
            for (int j = 0; j < 4; ++j) { const f32x4 w = *(const f32x4*)(wif + g * 1024 + 4 * lane + 256 * j); a += (v[j].x * w.x + v[j].y * w.y) + (v[j].z * w.z + v[j].w * w.w); }
            a = wave_sum(a) * rstd;
            if (lane == g) mine = a;
        }
        if (lane < 4) gates[(size_t)m * 8 + lane] = softcap15(mine + p.ml_b_i[lane]);
        else if (lane < 8) gates[(size_t)m * 8 + lane] = logsigmoid(softcap15(mine + p.ml_b_f[lane - 4]));
    }
}

__device__ __forceinline__ void late_weights(const Params& p, unsigned char* lds, int slot, int nslots) {
    const int tid = threadIdx.x, lane = tid & 63, wid = tid >> 6;
    unsigned char* ws = p.ws;
    float* scr = (float*)(lds + wid * 8448);
    constexpr int I_SQ = 16 * 32, I_1 = 16 * 128, I_2 = 64 * 32, NIT = I_SQ + I_1 + I_2;
    for (int it = slot * 8 + wid; it < NIT; it += nslots * 8) {
        int r = it;
        if (r < I_SQ) { transpose_item(p.att_w_o, 1024, 1024, nullptr, 1.f, (bf16_t*)(ws + WS_WO), 0, (r / 32) * 64, (r % 32) * 32, scr, lane); continue; } r -= I_SQ;
        if (r < I_1) { transpose_item(p.mlp_w1 + (size_t)1024 * 4096, 4096, 1024, p.mlp_norm_g + 1024, 1.f, (bf16_t*)(ws + WS_W1B), 0, (r / 128) * 64, (r % 128) * 32, scr, lane); continue; } r -= I_1;
        transpose_item(p.mlp_w2 + (size_t)4096 * 1024, 1024, 4096, nullptr, 1.f, (bf16_t*)(ws + WS_W2B), 0, (r / 32) * 64, (r % 32) * 32, scr, lane);
    }
}

struct EpiBf16 {
    bf16_t* out; int ld; const float* ss; int act;
    template <int NQ, bool PAIRED> __device__ __forceinline__ void row(int r, const int (&c)[NQ], const f32x4 (&v)[NQ], int fq, float rscale) const {
        float sc = rscale; if (ss) sc = rsqrtf(ss[r] * (1.f / 1024.f) + EPS);
        u32x2 w[NQ];
#pragma unroll
        for (int q = 0; q < NQ; ++q) {
            f32x4 x = v[q] * sc;
            if (act) { x.x = fmaxf(x.x, 0.f); x.y = fmaxf(x.y, 0.f); x.z = fmaxf(x.z, 0.f); x.w = fmaxf(x.w, 0.f); x = x * x; }
            w[q].x = cvt_pk_bf16(x.x, x.y); w[q].y = cvt_pk_bf16(x.z, x.w);
        }
        if (PAIRED) {
#pragma unroll
            for (int q = 0; q < NQ; q += 2) { u32x4 o; o.x = w[q].x; o.y = w[q].y; o.z = w[q + 1].x; o.w = w[q + 1].y; *(u32x4*)(out + (size_t)r * ld + c[q]) = o; }
        } else {
#pragma unroll
            for (int q = 0; q < NQ; ++q) *(u32x2*)(out + (size_t)r * ld + c[q]) = w[q];
        }
    }
};
struct EpiRes {
    const float* srcp; const float* srcs; float* dst; bf16_t* xb; float* ss;
    template <int NQ, bool PAIRED> __device__ __forceinline__ void row(int r, const int (&c)[NQ], const f32x4 (&v)[NQ], int fq, float rscale) const {
        const float* s = r < TP ? srcp + (size_t)r * D : srcs + (size_t)(r - TP) * D;
        float a2 = 0.f;
        u32x2 w[NQ];
#pragma unroll
        for (int q = 0; q < NQ; ++q) {
            const f32x4 o = *(const f32x4*)(s + c[q]) + v[q];
            *(f32x4*)(dst + (size_t)r * D + c[q]) = o;
            w[q].x = cvt_pk_bf16(o.x, o.y); w[q].y = cvt_pk_bf16(o.z, o.w);
            a2 += (o.x * o.x + o.y * o.y) + (o.z * o.z + o.w * o.w);
        }
        if (xb) {
            if (PAIRED) {
#pragma unroll
                for (int q = 0; q < NQ; q += 2) { u32x4 o; o.x = w[q].x; o.y = w[q].y; o.z = w[q + 1].x; o.w = w[q + 1].y; *(u32x4*)(xb + (size_t)r * D + c[q]) = o; }
            } else {
#pragma unroll
                for (int q = 0; q < NQ; ++q) *(u32x2*)(xb + (size_t)r * D + c[q]) = w[q];
            }
        }
        if (ss) { a2 += __shfl_xor(a2, 16); a2 += __shfl_xor(a2, 32); if (fq == 0) atomicAdd(ss + r, a2); }
    }
};

namespace pg8 {
#define PG8_LAS __attribute__((address_space(3)))
typedef unsigned short bf16_t;
typedef short bf16x8 __attribute__((ext_vector_type(8)));
typedef float f32x4 __attribute__((ext_vector_type(4)));
typedef unsigned u32x4 __attribute__((ext_vector_type(4)));
constexpr int BM = 256, BK = 64, HALF = 128, HTB = HALF * BK * 2  , STAGE_BYTES = 8 * HTB, NXCD = 8, WGM = 8;

__host__ __device__ __forceinline__ int lds_byte(int r, int c) { const int st = (r >> 4) * 2 + (c >> 5), rr = r & 15, cc = c & 31, ob = rr * 64 + cc * 2; return st * 1024 + (ob ^ (((ob >> 9) & 1) << 5)); }
__host__ __device__ __forceinline__ void stage_rc(int b, int& R, int& C) { const int st = b / 1024, sb = b % 1024, swz = sb ^ (((sb >> 9) & 1) << 5); R = (st >> 1) * 16 + swz / 64; C = (st & 1) * 32 + (swz % 64) / 2; }
__host__ __device__ __forceinline__ int perm32(int rho) { const int n = rho >> 4, i = rho & 15; return 8 * (i >> 2) + 4 * n + (i & 3); }

struct Unit { int pm, pn; };
struct Gemm { const bf16_t* A; const bf16_t* Bt; int M, N, K; int revk; };

struct StaticOrder {
    int nM, nN, nwg, G, c;
    __host__ __device__ void init(int M, int N, int G_, int c_) { nM = M / BM; nN = N / BM; nwg = nM * nN; G = G_; c = c_; }
    __host__ __device__ bool next(int i, Unit& u) const {
        const long L = (long)i * G + c; if (L >= nwg) return false;
        int wgid = (int)L; { const int q = nwg / NXCD, r = nwg % NXCD, xcd = wgid % NXCD, off = wgid / NXCD; wgid = (xcd < r ? xcd * (q + 1) : r * (q + 1) + (xcd - r) * q) + off; }
        const int nig = WGM * nN, gid = wgid / nig, fm = gid * WGM, gsz = (nM - fm) < WGM ? (nM - fm) : WGM;
        u.pm = fm + ((wgid % nig) % gsz); u.pn = (wgid % nig) / gsz; return true;
    }
    __device__ __forceinline__ void a_ready(const Unit&) const {}
    __device__ __forceinline__ void done(const Unit&) const {}
};


template <class Epi, class Sched, bool ALIGN_EPI = false, bool SP2 = false>
__device__ __forceinline__ void gemm_phase(PG8_LAS unsigned char* lds, const Gemm g, const Sched& S, const Epi& E) {
    const int tid = threadIdx.x, wid = __builtin_amdgcn_readfirstlane(tid >> 6), lane = tid & 63, wr = wid >> 2, wc = wid & 3, fr = lane & 15, fq = lane >> 4;
    const int K = g.K, nt = K / BK;
    unsigned voffA[2], voffB[2];
#pragma unroll
    for (int i = 0; i < 2; ++i) { int R, C; stage_rc(tid * 16 + i * 8192, R, C); const int Rb = Epi::PERM ? ((R & ~31) + perm32(R & 31)) : R;
        voffA[i] = (unsigned)(R * K + C) * 2u; voffB[i] = (unsigned)(Rb * K + C) * 2u; }
    const size_t kstep = g.revk ? (size_t)0 - (size_t)(BK * 2) : (size_t)(BK * 2);
    const size_t koff = g.revk ? (size_t)(K - BK) * 2 : (size_t)0;
    const size_t hstep = (size_t)HALF * K * 2;
    const size_t tstep = 2 * hstep;
    const unsigned ldsw = (unsigned)wid * 1024u;
    const int aoff = lds_byte(wr * 64 + fr, fq * 8), boff = lds_byte(wc * 32 + fr, fq * 8);
#define PG8_SA(b, h) (((b) * 2 + (h)) * HTB)
#define PG8_SB(b, h) ((4 + (b) * 2 + (h)) * HTB)
#define PG8_STAGE(bufoff, gbase, voff) do { _Pragma("unroll") for (int _i = 0; _i < 2; ++_i) \
        __builtin_amdgcn_global_load_lds((const unsigned*)((const char*)(gbase) + (voff)[_i]), (PG8_LAS unsigned*)(lds + (bufoff) + ldsw + _i * 8192), 16, 0, 0); } while (0)
#define PG8_LDA(dst, b, h) do { _Pragma("unroll") for (int m = 0; m < 4; ++m) _Pragma("unroll") for (int k = 0; k < 2; ++k) dst[m][k] = *(const PG8_LAS bf16x8*)(lds + PG8_SA(b, h) + aoff + m * 2048 + k * 1024); } while (0)
#define PG8_LDB(dst, b, h) do { _Pragma("unroll") for (int n = 0; n < 2; ++n) _Pragma("unroll") for (int k = 0; k < 2; ++k) dst[n][k] = *(const PG8_LAS bf16x8*)(lds + PG8_SB(b, h) + boff + n * 2048 + k * 1024); } while (0)
#define PG8_MMA(ai, bj, At, Bt) do { __builtin_amdgcn_s_setprio(1); _Pragma("unroll") for (int m = 0; m < 4; ++m) _Pragma("unroll") for (int n = 0; n < 2; ++n) _Pragma("unroll") for (int k = 0; k < 2; ++k) \
        acc[ai][bj][m][n] = __builtin_amdgcn_mfma_f32_16x16x32_bf16(Bt[n][k], At[m][k], acc[ai][bj][m][n], 0, 0, 0); __builtin_amdgcn_s_setprio(0); } while (0)
#define PG8_WAIT_V(n) asm volatile("s_waitcnt vmcnt(" #n ")" ::: "memory")
#define PG8_WAIT_L(n) asm volatile("s_waitcnt lgkmcnt(" #n ")" ::: "memory")
#define PG8_BAR __builtin_amdgcn_s_barrier()
#define PG8_SCHED __builtin_amdgcn_sched_barrier(0)
    Unit cur, nxt; int ui = 0;
    if (!S.next(0, cur)) return;
    f32x4 acc[2][2][4][2];
#pragma unroll
    for (int a = 0; a < 2; ++a)
#pragma unroll
        for (int b = 0; b < 2; ++b)
#pragma unroll
            for (int m = 0; m < 4; ++m)
#pragma unroll
                for (int n = 0; n < 2; ++n) acc[a][b][m][n] = (f32x4){0.f, 0.f, 0.f, 0.f};
    bf16x8 At[4][2], B0[2][2], B1[2][2];
    const char* cA = (const char*)g.A + (size_t)cur.pm * tstep + koff; const char* cB = (const char*)g.Bt + (size_t)cur.pn * tstep + koff;
    S.a_ready(cur);
    if constexpr (SP2) {
        PG8_STAGE(PG8_SB(0, 0), cB, voffB); PG8_STAGE(PG8_SB(0, 1), cB + hstep, voffB); PG8_STAGE(PG8_SA(0, 0), cA, voffA); PG8_STAGE(PG8_SA(0, 1), cA + hstep, voffA);
        if (wr == 1) PG8_BAR;
        PG8_WAIT_V(2); PG8_BAR;
        PG8_STAGE(PG8_SB(1, 0), cB + kstep, voffB); PG8_STAGE(PG8_SA(1, 0), cA + kstep, voffA); PG8_STAGE(PG8_SB(1, 1), cB + hstep + kstep, voffB);
        PG8_WAIT_V(6); PG8_BAR;
    } else {
        PG8_STAGE(PG8_SB(0, 0), cB, voffB); PG8_STAGE(PG8_SA(0, 0), cA, voffA); PG8_STAGE(PG8_SB(0, 1), cB + hstep, voffB); PG8_STAGE(PG8_SA(0, 1), cA + hstep, voffA);
        if (wr == 1) PG8_BAR;
        PG8_WAIT_V(4); PG8_BAR;
        PG8_STAGE(PG8_SB(1, 0), cB + kstep, voffB); PG8_STAGE(PG8_SA(1, 0), cA + kstep, voffA); PG8_STAGE(PG8_SB(1, 1), cB + hstep + kstep, voffB);
        PG8_WAIT_V(6); PG8_BAR;
    }
    for (;;) {
        const bool has_next = S.next(ui + 1, nxt);
        const char* nA = has_next ? (const char*)g.A + (size_t)nxt.pm * tstep + koff : cA; const char* nB = has_next ? (const char*)g.Bt + (size_t)nxt.pn * tstep + koff : cB;
        for (int t = 0; t < nt; t += 2) {
            const bool last = (t == nt - 2);
            const char* a1 = cA + (size_t)(t + 1) * kstep;
            const char* a2 = last ? nA : cA + (size_t)(t + 2) * kstep; const char* b2 = last ? nB : cB + (size_t)(t + 2) * kstep;
            const char* a3 = a2 + kstep; const char* b3 = b2 + kstep;
            if (last && has_next) S.a_ready(nxt);
            if constexpr (SP2) {
            PG8_LDB(B0, 0, 0); PG8_LDB(B1, 0, 1); PG8_SCHED; PG8_LDA(At, 0, 0); PG8_STAGE(PG8_SA(1, 1), a1 + hstep, voffA);
            PG8_WAIT_V(8); PG8_WAIT_L(0); PG8_BAR; PG8_MMA(0, 0, At, B0); PG8_MMA(0, 1, At, B1); PG8_BAR; PG8_SCHED;
            PG8_LDA(At, 0, 1); PG8_STAGE(PG8_SB(0, 0), b2, voffB); PG8_STAGE(PG8_SB(0, 1), b2 + hstep, voffB); PG8_STAGE(PG8_SA(0, 0), a2, voffA);
            PG8_WAIT_V(8); PG8_WAIT_L(0); PG8_BAR; PG8_MMA(1, 0, At, B0); PG8_MMA(1, 1, At, B1); PG8_BAR; PG8_SCHED;
            PG8_LDB(B0, 1, 0); PG8_LDB(B1, 1, 1); PG8_SCHED; PG8_LDA(At, 1, 0); PG8_STAGE(PG8_SA(0, 1), a2 + hstep, voffA);
            PG8_WAIT_V(8); PG8_WAIT_L(0); PG8_BAR; PG8_MMA(0, 0, At, B0); PG8_MMA(0, 1, At, B1); PG8_BAR; PG8_SCHED;
            PG8_LDA(At, 1, 1); PG8_STAGE(PG8_SB(1, 0), b3, voffB); PG8_STAGE(PG8_SB(1, 1), b3 + hstep, voffB); PG8_STAGE(PG8_SA(1, 0), a3, voffA);
            PG8_WAIT_V(8); PG8_WAIT_L(0); PG8_BAR; PG8_MMA(1, 0, At, B0); PG8_MMA(1, 1, At, B1); PG8_BAR; PG8_SCHED;
            } else {
            PG8_LDB(B0, 0, 0); PG8_SCHED; PG8_LDA(At, 0, 0); PG8_STAGE(PG8_SA(1, 1), a1 + hstep, voffA);
            PG8_WAIT_L(8); PG8_BAR; PG8_WAIT_L(0); PG8_MMA(0, 0, At, B0); PG8_BAR; PG8_SCHED;
            PG8_LDB(B1, 0, 1); PG8_STAGE(PG8_SB(0, 0), b2, voffB);
            PG8_BAR; PG8_WAIT_L(0); PG8_MMA(0, 1, At, B1); PG8_BAR;
            PG8_LDA(At, 0, 1); PG8_STAGE(PG8_SA(0, 0), a2, voffA);
            PG8_BAR; PG8_WAIT_L(0); PG8_MMA(1, 0, At, B0); PG8_BAR; PG8_SCHED;
            PG8_STAGE(PG8_SB(0, 1), b2 + hstep, voffB);
            PG8_WAIT_V(6); PG8_BAR; PG8_MMA(1, 1, At, B1); PG8_BAR;
            PG8_LDB(B0, 1, 0); PG8_SCHED; PG8_LDA(At, 1, 0); PG8_STAGE(PG8_SA(0, 1), a2 + hstep, voffA);
            PG8_WAIT_L(8); PG8_BAR; PG8_WAIT_L(0); PG8_MMA(0, 0, At, B0); PG8_BAR; PG8_SCHED;
            PG8_LDB(B1, 1, 1); PG8_STAGE(PG8_SB(1, 0), b3, voffB);
            PG8_BAR; PG8_WAIT_L(0); PG8_MMA(0, 1, At, B1); PG8_BAR;
            PG8_LDA(At, 1, 1); PG8_STAGE(PG8_SA(1, 0), a3, voffA);
            PG8_BAR; PG8_WAIT_L(0); PG8_MMA(1, 0, At, B0); PG8_BAR; PG8_SCHED;
            PG8_STAGE(PG8_SB(1, 1), b3 + hstep, voffB);
            PG8_WAIT_V(6); PG8_BAR; PG8_MMA(1, 1, At, B1); PG8_BAR;
            }
        }
        if constexpr (ALIGN_EPI) { if (wr == 0) PG8_BAR; }
        if constexpr (!Epi::AFTER_DRAIN) { E(acc, cur, wr, wc, fr, fq); S.done(cur); }
        if (!has_next) break;
#pragma unroll
        for (int a = 0; a < 2; ++a)
#pragma unroll
            for (int b = 0; b < 2; ++b)
#pragma unroll
                for (int m = 0; m < 4; ++m)
#pragma unroll
                    for (int n = 0; n < 2; ++n) acc[a][b][m][n] = (f32x4){0.f, 0.f, 0.f, 0.f};
        cur = nxt; cA = nA; cB = nB; ++ui;
        if constexpr (ALIGN_EPI) { if (wr == 1) PG8_BAR; }
    }
    PG8_WAIT_V(0);
    if constexpr (!ALIGN_EPI) { if (wr == 0) PG8_BAR; }
    PG8_BAR;
    if constexpr (Epi::AFTER_DRAIN) { E.fused(acc, cur, wr, wc, fr, fq, lds, wid, lane); S.done(cur); }
#undef PG8_SA
#undef PG8_SB
#undef PG8_STAGE
#undef PG8_LDA
#undef PG8_LDB
#undef PG8_MMA
#undef PG8_WAIT_V
#undef PG8_WAIT_L
#undef PG8_BAR
#undef PG8_SCHED
}
}


template <class Inner> struct Pg8Epi {
    static constexpr bool PERM = true, AFTER_DRAIN = false;
    Inner in;
    __device__ __forceinline__ void operator()(const f32x4 (&acc)[2][2][4][2], const pg8::Unit& u, int wr, int wc, int fr, int fq) const {
#pragma unroll
        for (int ai = 0; ai < 2; ++ai)
#pragma unroll
            for (int m = 0; m < 4; ++m) {
                const int r = u.pm * 256 + ai * 128 + wr * 64 + m * 16 + fr;
                const int c0 = u.pn * 256 + wc * 32 + 8 * fq;
                const int cols[4] = {c0, c0 + 4, c0 + 128, c0 + 132};
                const f32x4 vv[4] = {acc[ai][0][m][0], acc[ai][0][m][1], acc[ai][1][m][0], acc[ai][1][m][1]};
                in.template row<4, true>(r, cols, vv, fq, 1.f);
            }
    }
};
struct EpiResB {
    const float* srcf; bf16_t* xb; float* dstf; float* ss;
    template <int NQ, bool PAIRED> __device__ __forceinline__ void row(int r, const int (&c)[NQ], const f32x4 (&v)[NQ], int fq, float rscale) const {
        static_assert(PAIRED && NQ % 2 == 0, "EpiResB: paired quads only");
        float a2 = 0.f;
#pragma unroll
        for (int q = 0; q < NQ; q += 2) {
            f32x4 s0, s1;
            if (srcf) { s0 = *(const f32x4*)(srcf + (size_t)r * D + c[q]); s1 = *(const f32x4*)(srcf + (size_t)r * D + c[q] + 4); }
            else { const u32x4 xr = *(const u32x4*)(xb + (size_t)r * D + c[q]); s0 = (f32x4){bflo(xr.x), bfhi(xr.x), bflo(xr.y), bfhi(xr.y)}; s1 = (f32x4){bflo(xr.z), bfhi(xr.z), bflo(xr.w), bfhi(xr.w)}; }
            const f32x4 o0 = s0 + v[q], o1 = s1 + v[q + 1];
            if (dstf) { *(f32x4*)(dstf + (size_t)r * D + c[q]) = o0; *(f32x4*)(dstf + (size_t)r * D + c[q] + 4) = o1; }
            else {
                u32x4 w; w.x = cvt_pk_bf16(o0.x, o0.y); w.y = cvt_pk_bf16(o0.z, o0.w); w.z = cvt_pk_bf16(o1.x, o1.y); w.w = cvt_pk_bf16(o1.z, o1.w);
                *(u32x4*)(xb + (size_t)r * D + c[q]) = w;
                a2 += (o0.x * o0.x + o0.y * o0.y) + (o0.z * o0.z + o0.w * o0.w) + (o1.x * o1.x + o1.y * o1.y) + (o1.z * o1.z + o1.w * o1.w);
            }
        }
        if (ss) { a2 += __shfl_xor(a2, 16); a2 += __shfl_xor(a2, 32); if (fq == 0) atomicAdd(ss + r, a2); }
    }
};
struct EpiAtomic {
    float* dst;
    template <int NQ, bool PAIRED> __device__ __forceinline__ void row(int r, const int (&c)[NQ], const f32x4 (&v)[NQ], int fq, float rscale) const {
#pragma unroll
        for (int q = 0; q < NQ; ++q) { float* d = dst + (size_t)r * D + c[q]; atomicAdd(d, v[q].x); atomicAdd(d + 1, v[q].y); atomicAdd(d + 2, v[q].z); atomicAdd(d + 3, v[q].w); }
    }
};

template <int AF32, class Epi>
__device__ __forceinline__ void sgemm64(unsigned char* lds, const void* Av, int lda, const bf16_t* __restrict__ Bt, int row0, int nrows, int N, int K, int ksplit,
                                        const Epi& E, int bid, int G) {
    const int tid = threadIdx.x, lane = tid & 63, wid = tid >> 6, wr = wid >> 2, wc = wid & 3, fr = lane & 15, fq = lane >> 4;
    const int nN = N / 128, nT = (nrows / 64) * nN, nU = nT * ksplit, Ksl = K / ksplit, nk = Ksl / 128;
    constexpr int LS = 136;
    bf16_t* As = (bf16_t*)lds;
    bf16_t* Bs = As + 2 * 64 * LS;
    float* rs = (float*)(Bs + 2 * 128 * LS);
    const int arow = tid >> 3, ak = (tid & 7) * 8;
    for (int u = bid; u < nU; u += G) {
        const int ks = u / nT, t = u % nT, pm = t / nN, pn = t % nN, k0 = ks * Ksl;
        const bf16_t* Ab = (const bf16_t*)Av + (size_t)(row0 + pm * 64 + arow) * lda + k0 + ak;
        const float* Af = (const float*)Av + (size_t)(row0 + pm * 64 + arow) * lda + k0 + ak;
        const bf16_t* Bg = Bt + (size_t)(pn * 128 + arow) * K + k0 + ak;
        f32x4 acc[2][2];
#pragma unroll
        for (int m = 0; m < 2; ++m)
#pragma unroll
            for (int n = 0; n < 2; ++n) acc[m][n] = (f32x4){0.f, 0.f, 0.f, 0.f};
        float ssq = 0.f;
        u32x4 ra[2], rb[2][2];
        auto loadAB = [&](int kt) {
#pragma unroll
            for (int h = 0; h < 2; ++h) {
                if (AF32) { const f32x4 a = *(const f32x4*)(Af + kt * 128 + 64 * h), b = *(const f32x4*)(Af + kt * 128 + 64 * h + 4);
                    ssq += (a.x * a.x + a.y * a.y) + (a.z * a.z + a.w * a.w) + (b.x * b.x + b.y * b.y) + (b.z * b.z + b.w * b.w);
                    ra[h].x = cvt_pk_bf16(a.x, a.y); ra[h].y = cvt_pk_bf16(a.z, a.w); ra[h].z = cvt_pk_bf16(b.x, b.y); ra[h].w = cvt_pk_bf16(b.z, b.w); }
                else ra[h] = *(const u32x4*)(Ab + kt * 128 + 64 * h);
#pragma unroll
                for (int i = 0; i < 2; ++i) rb[i][h] = *(const u32x4*)(Bg + (size_t)(64 * i) * K + kt * 128 + 64 * h);
            }
        };
        auto storeAB = [&](int buf) {
#pragma unroll
            for (int h = 0; h < 2; ++h) {
                *(u32x4*)(As + buf * 64 * LS + arow * LS + ak + 64 * h) = ra[h];
#pragma unroll
                for (int i = 0; i < 2; ++i) *(u32x4*)(Bs + buf * 128 * LS + (arow + 64 * i) * LS + ak + 64 * h) = rb[i][h];
            }
        };
        loadAB(0);
        storeAB(0);
        __syncthreads();
        for (int kt = 0; kt < nk; ++kt) {
            const int buf = kt & 1;
            if (kt + 1 < nk) loadAB(kt + 1);
            const bf16_t* as = As + buf * 64 * LS; const bf16_t* bs = Bs + buf * 128 * LS;
#pragma unroll
            for (int kk = 0; kk < 4; ++kk) {
                bf16x8 af[2], bfr[2];
#pragma unroll
                for (int m = 0; m < 2; ++m) af[m] = *(const bf16x8*)(as + (32 * wr + 16 * m + fr) * LS + 32 * kk + 8 * fq);
#pragma unroll
                for (int n = 0; n < 2; ++n) bfr[n] = *(const bf16x8*)(bs + (32 * wc + 16 * n + fr) * LS + 32 * kk + 8 * fq);
#pragma unroll
                for (int m = 0; m < 2; ++m)
#pragma unroll
                    for (int n = 0; n < 2; ++n) acc[m][n] = MFMA32(bfr[n], af[m], acc[m][n]);
            }
            if (kt + 1 < nk) storeAB(buf ^ 1);
            __syncthreads();
        }
        if (AF32) {
            ssq += __shfl_xor(ssq, 1); ssq += __shfl_xor(ssq, 2); ssq += __shfl_xor(ssq, 4);
            if ((tid & 7) == 0) rs[arow] = rsqrtf(ssq * (1.f / 1024.f) + EPS);
            __syncthreads();
        }
#pragma unroll
        for (int m = 0; m < 2; ++m) {
            const int lr = 32 * wr + 16 * m + fr, r = row0 + pm * 64 + lr;
            const int cols[2] = {pn * 128 + 32 * wc + 4 * fq, pn * 128 + 32 * wc + 16 + 4 * fq};
            const f32x4 vv[2] = {acc[m][0], acc[m][1]};
            E.template row<2, false>(r, cols, vv, fq, AF32 ? rs[lr] : 1.f);
        }
    }
}

template <class Epi>
__device__ __forceinline__ void sgemm_phase(unsigned char* lds, const bf16_t* __restrict__ A, const bf16_t* __restrict__ Bt, int row0, int nrows, int N, int K,
                                            const Epi& E, int bid, int G) {
    const int tid = threadIdx.x, lane = tid & 63, wid = tid >> 6, wr = wid >> 2, wc = wid & 3, fr = lane & 15, fq = lane >> 4;
    const int nN = N / 128, nU = (nrows / 128) * nN, nk = K / 64;
    bf16_t* As = (bf16_t*)lds;
    bf16_t* Bs = As + 2 * 128 * 72;
    const int ldrow = tid >> 3, ldk = (tid & 7) * 8;
    for (int u = bid; u < nU; u += G) {
        const int pm = u / nN, pn = u % nN;
        const bf16_t* Ag = A + (size_t)(row0 + pm * 128 + ldrow) * K + ldk;
        const bf16_t* Bg = Bt + (size_t)(pn * 128 + ldrow) * K + ldk;
        f32x4 acc[4][2];
#pragma unroll
        for (int m = 0; m < 4; ++m)
#pragma unroll
            for (int n = 0; n < 2; ++n) acc[m][n] = (f32x4){0.f, 0.f, 0.f, 0.f};
        u32x4 ra[2], rb[2];
#pragma unroll
        for (int i = 0; i < 2; ++i) { ra[i] = *(const u32x4*)(Ag + (size_t)(64 * i) * K); rb[i] = *(const u32x4*)(Bg + (size_t)(64 * i) * K); }
#pragma unroll
        for (int i = 0; i < 2; ++i) { *(u32x4*)(As + (ldrow + 64 * i) * 72 + ldk) = ra[i]; *(u32x4*)(Bs + (ldrow + 64 * i) * 72 + ldk) = rb[i]; }
        __syncthreads();
        for (int kt = 0; kt < nk; ++kt) {
            const int buf = kt & 1;
            if (kt + 1 < nk) {
#pragma unroll
                for (int i = 0; i < 2; ++i) { ra[i] = *(const u32x4*)(Ag + (size_t)(64 * i) * K + (kt + 1) * 64); rb[i] = *(const u32x4*)(Bg + (size_t)(64 * i) * K + (kt + 1) * 64); }
            }
            const bf16_t* as = As + buf * 128 * 72; const bf16_t* bs = Bs + buf * 128 * 72;
#pragma unroll
            for (int kk = 0; kk < 2; ++kk) {
                bf16x8 af[4], bfr[2];
#pragma unroll
                for (int m = 0; m < 4; ++m) af[m] = *(const bf16x8*)(as + (64 * wr + 16 * m + fr) * 72 + 32 * kk + 8 * fq);
#pragma unroll
                for (int n = 0; n < 2; ++n) bfr[n] = *(const bf16x8*)(bs + (32 * wc + 16 * n + fr) * 72 + 32 * kk + 8 * fq);
#pragma unroll
                for (int m = 0; m < 4; ++m)
#pragma unroll
                    for (int n = 0; n < 2; ++n) acc[m][n] = MFMA32(bfr[n], af[m], acc[m][n]);
            }
            if (kt + 1 < nk) {
                bf16_t* an = As + (buf ^ 1) * 128 * 72; bf16_t* bn = Bs + (buf ^ 1) * 128 * 72;
#pragma unroll
                for (int i = 0; i < 2; ++i) { *(u32x4*)(an + (ldrow + 64 * i) * 72 + ldk) = ra[i]; *(u32x4*)(bn + (ldrow + 64 * i) * 72 + ldk) = rb[i]; }
            }
            __syncthreads();
        }
#pragma unroll
        for (int m = 0; m < 4; ++m) {
            const int r = row0 + pm * 128 + 64 * wr + 16 * m + fr;
            const int cols[2] = {pn * 128 + 32 * wc + 4 * fq, pn * 128 + 32 * wc + 16 + 4 * fq};
            const f32x4 vv[2] = {acc[m][0], acc[m][1]};
            E.template row<2, false>(r, cols, vv, fq, 1.f);
        }
    }
}

__device__ __forceinline__ void mlstm_local_unit(const Params& p, unsigned char* lds, int u) {
    const int tid = threadIdx.x, lane = tid & 63, wid = tid >> 6, fr = lane & 15, fq = lane >> 4;
    const int bh = u >> 6, c = u & 63, b = bh >> 2, h = bh & 3, base = b * 4096 + c * 64;
    unsigned char* ws = p.ws;
    const bf16_t* P = (const bf16_t*)(ws + WS_P); const float* gates = (const float*)(ws + WS_GATES);
    bf16_t* GS = (bf16_t*)p.out;
    bf16_t* kT = (bf16_t*)lds;
    bf16_t* vT = kT + 128 * 72;
    float* wk = (float*)(vT + 256 * 72);
    if (wid == 0) {
        const float lf = gates[(size_t)(base + lane) * 8 + 4 + h], li = gates[(size_t)(base + lane) * 8 + h];
        const float bc = scan_sum(lf, lane);
        const float B = __shfl(bc, 63);
        const float val = B - bc + li;
        const float ml = wave_max(val);
        wk[lane] = __expf(val - ml);
        if (lane == 0) { ((float*)(ws + WS_CHB))[u] = B; ((float*)(ws + WS_CHM))[u] = ml; }
    }
    __syncthreads();
    {
        const bf16_t* Pk = P + (size_t)(base + lane) * NIN + 512 + h * 128;
#pragma unroll
        for (int i = 0; i < 2; ++i) {
            const int dch = wid * 2 + i; const u32x4 r = *(const u32x4*)(Pk + dch * 8);
            bf16_t* dst = kT + (dch * 8) * 72 + lane;
            dst[0 * 72] = (bf16_t)(r.x & 0xffff); dst[1 * 72] = (bf16_t)(r.x >> 16); dst[2 * 72] = (bf16_t)(r.y & 0xffff); dst[3 * 72] = (bf16_t)(r.y >> 16);
            dst[4 * 72] = (bf16_t)(r.z & 0xffff); dst[5 * 72] = (bf16_t)(r.z >> 16); dst[6 * 72] = (bf16_t)(r.w & 0xffff); dst[7 * 72] = (bf16_t)(r.w >> 16);
        }
        const bf16_t* Pv = P + (size_t)(base + lane) * NIN + 1024 + h * 256;
        const float w = wk[lane];
#pragma unroll
        for (int i = 0; i < 4; ++i) {
            const int vch = wid * 4 + i; const u32x4 r = *(const u32x4*)(Pv + vch * 8);
            bf16_t* dst = vT + (vch * 8) * 72 + lane;
            dst[0 * 72] = f2bf(bflo(r.x) * w); dst[1 * 72] = f2bf(bfhi(r.x) * w); dst[2 * 72] = f2bf(bflo(r.y) * w); dst[3 * 72] = f2bf(bfhi(r.y) * w);
            dst[4 * 72] = f2bf(bflo(r.z) * w); dst[5 * 72] = f2bf(bfhi(r.z) * w); dst[6 * 72] = f2bf(bflo(r.w) * w); dst[7 * 72] = f2bf(bfhi(r.w) * w);
        }
    }
    __syncthreads();
    {
        f32x4 acc[2][8];
#pragma unroll
        for (int a = 0; a < 2; ++a)
#pragma unroll
            for (int d = 0; d < 8; ++d) acc[a][d] = (f32x4){0.f, 0.f, 0.f, 0.f};
#pragma unroll
        for (int ks = 0; ks < 2; ++ks) {
            bf16x8 yf[2];
#pragma unroll
            for (int vt = 0; vt < 2; ++vt) yf[vt] = *(const bf16x8*)(vT + (32 * wid + 16 * vt + fr) * 72 + 32 * ks + 8 * fq);
#pragma unroll
            for (int dt = 0; dt < 8; ++dt) {
                const bf16x8 xf = *(const bf16x8*)(kT + (16 * dt + fr) * 72 + 32 * ks + 8 * fq);
#pragma unroll
                for (int vt = 0; vt < 2; ++vt) acc[vt][dt] = MFMA32(xf, yf[vt], acc[vt][dt]);
            }
        }
        bf16_t* G = GS + (size_t)u * 32768;
#pragma unroll
        for (int vt = 0; vt < 2; ++vt)
#pragma unroll
            for (int dt = 0; dt < 8; ++dt) {
                u32x2 w; w.x = cvt_pk_bf16(acc[vt][dt].x, acc[vt][dt].y); w.y = cvt_pk_bf16(acc[vt][dt].z, acc[vt][dt].w);
                *(u32x2*)(G + (32 * wid + 16 * vt + fr) * 128 + 16 * dt + 4 * fq) = w;
            }
    }
    if (tid < 128) {
        float s = 0.f;
#pragma unroll 8
        for (int ss = 0; ss < 64; ++ss) s += bf2f(kT[tid * 72 + ss]) * wk[ss];
        ((float*)(ws + WS_GN))[(size_t)u * 128 + tid] = s;
    }
    __syncthreads();
}

__device__ __forceinline__ void mlstm_sample_unit(const Params& p, unsigned char* lds, int u) {
    const int tid = threadIdx.x, lane = tid & 63, wid = tid >> 6;
    const int b = u >> 2, h = u & 3, base = TP + b * 4;
    unsigned char* ws = p.ws;
    const bf16_t* P = (const bf16_t*)(ws + WS_P); const float* gates = (const float*)(ws + WS_GATES);
    float* q = (float*)lds;
    float* k = q + 512;
    float* v = k + 512;
    float* n0 = v + 1024;
    float* sc = n0 + 128;
    float* red = sc + 64;
    const float* C0 = p.st_C + (size_t)u * 32768;
    float* Cout = p.out + O_SC + (size_t)u * 32768;
    {
        const int t = tid >> 7, d = tid & 127;
        q[tid] = bf2f(P[(size_t)(base + t) * NIN + h * 128 + d]);
        k[tid] = bf2f(P[(size_t)(base + t) * NIN + 512 + h * 128 + d]);
        const int t2 = tid >> 8, vv = tid & 255;
        v[tid] = bf2f(P[(size_t)(base + t2) * NIN + 1024 + h * 256 + vv]);
        v[512 + tid] = bf2f(P[(size_t)(base + 2 + t2) * NIN + 1024 + h * 256 + vv]);
        if (tid < 128) n0[tid] = p.st_n[(size_t)u * 128 + tid];
    }
    if (tid == 0) {
        float li[4], bc[4]; float run = 0.f;
#pragma unroll
        for (int t = 0; t < 4; ++t) { li[t] = gates[(size_t)(base + t) * 8 + h]; run += gates[(size_t)(base + t) * 8 + 4 + h]; bc[t] = run; }
        const float m0 = p.st_m[u]; float mt[4];
#pragma unroll
        for (int t = 0; t < 4; ++t) {
            const float inter = bc[t] + m0; float mx = inter;
#pragma unroll
            for (int s = 0; s < 4; ++s) if (s <= t) mx = fmaxf(mx, bc[t] - bc[s] + li[s]);
            mt[t] = mx; sc[16 + t] = __expf(inter - mx); sc[28 + t] = __expf(-mx);
#pragma unroll
            for (int s = 0; s < 4; ++s) sc[t * 4 + s] = (s <= t) ? __expf(bc[t] - bc[s] + li[s] - mx) : 0.f;
        }
        const float mn = mt[3];
        sc[24] = __expf(bc[3] + m0 - mn);
#pragma unroll
        for (int s = 0; s < 4; ++s) sc[20 + s] = __expf(bc[3] - bc[s] + li[s] - mn);
        p.out[O_SM + u] = mn;
    }
    __syncthreads();
#pragma unroll
    for (int i = 0; i < 2; ++i) {
        const int pr = wid * 2 + i, t = pr >> 2, s = pr & 3;
        float a = q[t * 128 + lane] * k[s * 128 + lane] + q[t * 128 + 64 + lane] * k[s * 128 + 64 + lane];
        a = wave_sum(a);
        if (lane == 0) sc[32 + pr] = a * sc[pr];
    }
    if (wid < 4) { float a = q[wid * 128 + lane] * n0[lane] + q[wid * 128 + 64 + lane] * n0[64 + lane]; a = wave_sum(a); if (lane == 0) sc[48 + wid] = a; }
    if (tid < 8) sc[52 + tid] = 0.f;
    {
        const int vq = lane, dg = wid;
        f32x4 qc[4];
#pragma unroll
        for (int t = 0; t < 4; ++t) qc[t] = (f32x4){0.f, 0.f, 0.f, 0.f};
        const float decay = sc[24];
        f32x4 vs[4];
#pragma unroll
        for (int s = 0; s < 4; ++s) vs[s] = *(const f32x4*)(v + s * 256 + 4 * vq) * sc[20 + s];
#pragma unroll 4
        for (int dd = 0; dd < 16; ++dd) {
            const int d = dg * 16 + dd;
            const f32x4 c0 = *(const f32x4*)(C0 + (size_t)d * 256 + 4 * vq);
            f32x4 cn = c0 * decay;
#pragma unroll
            for (int s = 0; s < 4; ++s) cn += vs[s] * k[s * 128 + d];
            *(f32x4*)(Cout + (size_t)d * 256 + 4 * vq) = cn;
#pragma unroll
            for (int t = 0; t < 4; ++t) qc[t] += c0 * q[t * 128 + d];
        }
#pragma unroll
        for (int t = 0; t < 4; ++t) *(f32x4*)(red + (dg * 4 + t) * 256 + 4 * vq) = qc[t];
    }
    if (tid < 128) {
        float nn = sc[24] * n0[tid];
#pragma unroll
        for (int s = 0; s < 4; ++s) nn += sc[20 + s] * k[s * 128 + tid];
        p.out[O_SN + (size_t)u * 128 + tid] = nn;
    }
    __syncthreads();
    {
        const int t = tid >> 7, v0 = (tid & 127) * 2;
        float den = sc[16 + t] * sc[48 + t];
#pragma unroll
        for (int s = 0; s < 4; ++s) den += sc[32 + t * 4 + s];
        const float inv = 1.f / fmaxf(fabsf(den), sc[28 + t]);
        float hv[2]; float ssq = 0.f;
#pragma unroll
        for (int j = 0; j < 2; ++j) {
            float qC = 0.f;
#pragma unroll
            for (int g = 0; g < 8; ++g) qC += red[(g * 4 + t) * 256 + v0 + j];
            float num = sc[16 + t] * qC;
#pragma unroll
            for (int s = 0; s < 4; ++s) num += sc[32 + t * 4 + s] * v[s * 256 + v0 + j];
            hv[j] = num * inv; ssq += hv[j] * hv[j];
        }
        ssq = wave_sum(ssq);
        if (lane == 0) sc[52 + wid] = ssq;
        __syncthreads();
        const float tot = sc[52 + 2 * t] + sc[52 + 2 * t + 1];
        const float rstd = rsqrtf(tot * (1.f / 256.f) + EPS);
        const unsigned ob = *(const unsigned*)(P + (size_t)(base + t) * NIN + 2048 + h * 256 + v0);
        const float o0 = sigmoidf_(bflo(ob)), o1 = sigmoidf_(bfhi(ob));
        const float g0 = p.ml_head_g[h * 256 + v0], g1 = p.ml_head_g[h * 256 + v0 + 1];
        bf16_t* HG = (bf16_t*)(ws + WS_HG);
        *(unsigned*)(HG + (size_t)(base + t) * D + h * 256 + v0) = cvt_pk_bf16(hv[0] * rstd * g0 * o0, hv[1] * rstd * g1 * o1);
    }
    __syncthreads();
}

__device__ __forceinline__ void mlstm_scan(const Params& p, unsigned char* lds, int bid, int G) {
    unsigned char* ws = p.ws;
    bf16_t* GS = (bf16_t*)p.out;
    const float* CHB = (const float*)(ws + WS_CHB); const float* CHM = (const float*)(ws + WS_CHM);
    float* MPREV = (float*)(ws + WS_MPREV); float* GN = (float*)(ws + WS_GN);
    const int tid = threadIdx.x;
    float* decs = (float*)lds;
    float* scls = decs + 64;
    float* tile = scls + 64;
    for (int blk = bid; blk < 256; blk += G) {
        const int bh = blk >> 4;
        if (tid < 64) {
            const float B = CHB[bh * 64 + tid], ml = CHM[bh * 64 + tid];
            float a = B, b2 = ml;
#pragma unroll
            for (int o = 1; o < 64; o <<= 1) { const float ya = __shfl_up(a, o), yb = __shfl_up(b2, o); if (tid >= o) { b2 = fmaxf(yb + a, b2); a = ya + a; } }
            const float m = fmaxf(a, b2);
            float mp = __shfl_up(m, 1); if (tid == 0) mp = 0.f;
            decs[tid] = __expf(B + mp - m); scls[tid] = __expf(ml - m);
            if ((blk & 15) == 0) { MPREV[bh * 64 + tid] = mp; if (tid == 63) p.out[O_PM + bh] = m; }
        }
        float gnv[64]; float* gp = GN + (size_t)(bh * 64) * 128 + (blk & 15) * 8 + (tid & 7);
        if (tid < 8) {
#pragma unroll
            for (int c = 0; c < 64; ++c) gnv[c] = gp[(size_t)c * 128];
        }
        __syncthreads();
        const int e4 = blk * NTHREADS + tid;
        const int off = (e4 & 8191) * 4;
        bf16_t* ptr = GS + (size_t)bh * 64 * 32768 + off;
        float c0 = 0.f, c1 = 0.f, c2 = 0.f, c3 = 0.f;
#pragma unroll 1
        for (int cb = 0; cb < 64; cb += 16) {
            u32x2 g[16];
#pragma unroll
            for (int j = 0; j < 16; ++j) g[j] = *(const u32x2*)(ptr + (size_t)(cb + j) * 32768);
#pragma unroll
            for (int j = 0; j < 16; ++j) {
                const float dec = decs[cb + j], s = scls[cb + j];
                u32x2 w; w.x = cvt_pk_bf16(c0, c1); w.y = cvt_pk_bf16(c2, c3);
                *(u32x2*)(ptr + (size_t)(cb + j) * 32768) = w;
                c0 = dec * c0 + s * bflo(g[j].x); c1 = dec * c1 + s * bfhi(g[j].x); c2 = dec * c2 + s * bflo(g[j].y); c3 = dec * c3 + s * bfhi(g[j].y);
            }
        }
        {
            const int vl = (off >> 7) & 15, d = off & 127;
            tile[(d + 0) * 20 + vl] = c0; tile[(d + 1) * 20 + vl] = c1; tile[(d + 2) * 20 + vl] = c2; tile[(d + 3) * 20 + vl] = c3;
            __syncthreads();
            const int dd = tid >> 2, vq = tid & 3, v0 = (blk & 15) * 16;
            const f32x4 o = (f32x4){tile[dd * 20 + 4 * vq], tile[dd * 20 + 4 * vq + 1], tile[dd * 20 + 4 * vq + 2], tile[dd * 20 + 4 * vq + 3]};
            *(f32x4*)(p.out + O_PC + (size_t)bh * 32768 + (size_t)dd * 256 + v0 + 4 * vq) = o;
        }
        if (tid < 8) {
            float n = 0.f;
#pragma unroll
            for (int c = 0; c < 64; ++c) { gp[(size_t)c * 128] = n; n = decs[c] * n + scls[c] * gnv[c]; }
            p.out[O_PN + bh * 128 + (blk & 15) * 8 + tid] = n;
        }
        __syncthreads();
    }
}

__device__ __forceinline__ void mlstm_out_unit(const Params& p, unsigned char* lds, int u) {
    const int tid = threadIdx.x, lane = tid & 63, wid = tid >> 6, fr = lane & 15, fq = lane >> 4;
    const int bh = u >> 6, c = u & 63, b = bh >> 2, h = bh & 3, base = b * 4096 + c * 64;
    unsigned char* ws = p.ws;
    const bf16_t* P = (const bf16_t*)(ws + WS_P); const float* gates = (const float*)(ws + WS_GATES);
    const bf16_t* CT = (const bf16_t*)p.out + (size_t)u * 32768;
    bf16_t* Qs = (bf16_t*)lds;
    bf16_t* Ks = Qs + 64 * 136;
    bf16_t* Ac = Ks + 64 * 136;
    bf16_t* VT = Ac + 64 * 200;
    float* sm = (float*)(VT + 256 * 72);
    float *bt = sm, *lmb = sm + 64, *mt = sm + 128, *at = sm + 192, *den = sm + 256, *hss = sm + 320, *npv = sm + 384;
    bf16x8 cf[2][4];
#pragma unroll
    for (int vt = 0; vt < 2; ++vt)
#pragma unroll
        for (int kd = 0; kd < 4; ++kd) cf[vt][kd] = *(const bf16x8*)(CT + (32 * wid + 16 * vt + fr) * 128 + 32 * kd + 8 * fq);
    if (wid == 0) {
        const float lf = gates[(size_t)(base + lane) * 8 + 4 + h], li = gates[(size_t)(base + lane) * 8 + h];
        const float bc = scan_sum(lf, lane);
        const float lm = li - bc;
        const float pm = scan_max(lm, lane);
        const float mprev = ((const float*)(ws + WS_MPREV))[u];
        const float inter = bc + mprev;
        const float m_t = fmaxf(inter, bc + pm);
        bt[lane] = bc; lmb[lane] = lm; mt[lane] = m_t; at[lane] = __expf(inter - m_t); den[lane] = 0.f; hss[lane] = 0.f;
    }
    if (wid == 1) { const float* NP = (const float*)(ws + WS_GN) + (size_t)u * 128; npv[lane] = NP[lane]; npv[64 + lane] = NP[64 + lane]; }
    __syncthreads();
#pragma unroll
    for (int i = 0; i < 2; ++i) {
        const int ci = tid + 512 * i, t = ci >> 4, dch = ci & 15;
        const u32x4 qv = *(const u32x4*)(P + (size_t)(base + t) * NIN + h * 128 + dch * 8);
        const u32x4 kv = *(const u32x4*)(P + (size_t)(base + t) * NIN + 512 + h * 128 + dch * 8);
        *(u32x4*)(Qs + t * 136 + dch * 8) = qv;
        *(u32x4*)(Ks + t * 136 + dch * 8) = kv;
        const float a = at[t];
        u32x4 sq; sq.x = cvt_pk_bf16(bflo(qv.x) * a, bfhi(qv.x) * a); sq.y = cvt_pk_bf16(bflo(qv.y) * a, bfhi(qv.y) * a);
        sq.z = cvt_pk_bf16(bflo(qv.z) * a, bfhi(qv.z) * a); sq.w = cvt_pk_bf16(bflo(qv.w) * a, bfhi(qv.w) * a);
        *(u32x4*)(Ac + t * 200 + 64 + dch * 8) = sq;
    }
    {
        const bf16_t* Pv = P + (size_t)(base + lane) * NIN + 1024 + h * 256;
#pragma unroll
        for (int i = 0; i < 4; ++i) {
            const int vch = wid * 4 + i; const u32x4 r = *(const u32x4*)(Pv + vch * 8);
            bf16_t* dst = VT + (vch * 8) * 72 + lane;
            dst[0 * 72] = (bf16_t)(r.x & 0xffff); dst[1 * 72] = (bf16_t)(r.x >> 16); dst[2 * 72] = (bf16_t)(r.y & 0xffff); dst[3 * 72] = (bf16_t)(r.y >> 16);
            dst[4 * 72] = (bf16_t)(r.z & 0xffff); dst[5 * 72] = (bf16_t)(r.z >> 16); dst[6 * 72] = (bf16_t)(r.w & 0xffff); dst[7 * 72] = (bf16_t)(r.w >> 16);
        }
    }
    __syncthreads();
    {
        const int tt = wid >> 1;
#pragma unroll
        for (int j = 0; j < 2; ++j) {
            const int st = 2 * (wid & 1) + j;
            const int t = 16 * tt + fr, s0 = 16 * st + 4 * fq;
            u32x2 w; w.x = 0u; w.y = 0u;
            if (st <= tt) {
                f32x4 a = (f32x4){0.f, 0.f, 0.f, 0.f};
#pragma unroll
                for (int kd = 0; kd < 4; ++kd) {
                    const bf16x8 x = *(const bf16x8*)(Ks + (16 * st + fr) * 136 + 32 * kd + 8 * fq);
                    const bf16x8 y = *(const bf16x8*)(Qs + (16 * tt + fr) * 136 + 32 * kd + 8 * fq);
                    a = MFMA32(x, y, a);
                }
                const float e0 = bt[t] - mt[t];
                float vals[4];
#pragma unroll
                for (int i = 0; i < 4; ++i) { const int s = s0 + i; vals[i] = (s <= t) ? a[i] * __expf(e0 + lmb[s]) : 0.f; }
                float rs = (vals[0] + vals[1]) + (vals[2] + vals[3]);
                rs += __shfl_xor(rs, 16); rs += __shfl_xor(rs, 32);
                if (fq == 0) atomicAdd(&den[t], rs);
                w.x = cvt_pk_bf16(vals[0], vals[1]); w.y = cvt_pk_bf16(vals[2], vals[3]);
            }
            *(u32x2*)(Ac + t * 200 + s0) = w;
        }
#pragma unroll
        for (int i = 0; i < 8; ++i) {
            const int t = 8 * wid + i;
            float a = bf2f(Qs[t * 136 + lane]) * npv[lane] + bf2f(Qs[t * 136 + 64 + lane]) * npv[64 + lane];
            a = wave_sum(a);
            if (lane == 0) atomicAdd(&den[t], at[t] * a);
        }
    }
    __syncthreads();
    f32x4 acc[4][2];
#pragma unroll
    for (int a = 0; a < 4; ++a)
#pragma unroll
        for (int d = 0; d < 2; ++d) acc[a][d] = (f32x4){0.f, 0.f, 0.f, 0.f};
#pragma unroll
    for (int kk = 0; kk < 6; ++kk) {
        bf16x8 x[2];
#pragma unroll
        for (int vt = 0; vt < 2; ++vt) x[vt] = (kk < 2) ? *(const bf16x8*)(VT + (32 * wid + 16 * vt + fr) * 72 + 32 * kk + 8 * fq) : cf[vt][kk >= 2 ? kk - 2 : 0];
#pragma unroll
        for (int tt = 0; tt < 4; ++tt) {
            const bf16x8 y = *(const bf16x8*)(Ac + (16 * tt + fr) * 200 + 32 * kk + 8 * fq);
#pragma unroll
            for (int vt = 0; vt < 2; ++vt) acc[tt][vt] = MFMA32(x[vt], y, acc[tt][vt]);
        }
    }
#pragma unroll
    for (int tt = 0; tt < 4; ++tt) {
        const int t = 16 * tt + fr;
        const float inv = 1.f / fmaxf(fabsf(den[t]), __expf(-mt[t]));
        float ssq = 0.f;
#pragma unroll
        for (int vt = 0; vt < 2; ++vt) { acc[tt][vt] = acc[tt][vt] * inv; const f32x4 a = acc[tt][vt]; ssq += (a.x * a.x + a.y * a.y) + (a.z * a.z + a.w * a.w); }
        ssq += __shfl_xor(ssq, 16); ssq += __shfl_xor(ssq, 32);
        if (fq == 0) atomicAdd(&hss[t], ssq);
    }
    __syncthreads();
    {
        bf16_t* HG = (bf16_t*)(ws + WS_HG);
#pragma unroll
        for (int tt = 0; tt < 4; ++tt) {
            const int t = 16 * tt + fr;
            const float rstd = rsqrtf(hss[t] * (1.f / 256.f) + EPS);
#pragma unroll
            for (int vt = 0; vt < 2; ++vt) {
                const int v0 = 32 * wid + 16 * vt + 4 * fq;
                const u32x2 ob = *(const u32x2*)(P + (size_t)(base + t) * NIN + 2048 + h * 256 + v0);
                const f32x4 g = *(const f32x4*)(p.ml_head_g + h * 256 + v0);
                const f32x4 a = acc[tt][vt];
                u32x2 w;
                w.x = cvt_pk_bf16(a.x * rstd * g.x * sigmoidf_(bflo(ob.x)), a.y * rstd * g.y * sigmoidf_(bfhi(ob.x)));
                w.y = cvt_pk_bf16(a.z * rstd * g.z * sigmoidf_(bflo(ob.y)), a.w * rstd * g.w * sigmoidf_(bfhi(ob.y)));
                *(u32x2*)(HG + (size_t)(base + t) * D + h * 256 + v0) = w;
            }
        }
    }
    __syncthreads();
}

__device__ __forceinline__ void norm_frag(const u32x4 r0, const u32x4 r1, const float* __restrict__ g, float extra, int fq, bf16x8& o0, bf16x8& o1) {
    float f[16];
    f[0] = bflo(r0.x); f[1] = bfhi(r0.x); f[2] = bflo(r0.y); f[3] = bfhi(r0.y); f[4] = bflo(r0.z); f[5] = bfhi(r0.z); f[6] = bflo(r0.w); f[7] = bfhi(r0.w);
    f[8] = bflo(r1.x); f[9] = bfhi(r1.x); f[10] = bflo(r1.y); f[11] = bfhi(r1.y); f[12] = bflo(r1.z); f[13] = bfhi(r1.z); f[14] = bflo(r1.w); f[15] = bfhi(r1.w);
    float s = 0.f;
#pragma unroll
    for (int i = 0; i < 16; ++i) s += f[i] * f[i];
    s += __shfl_xor(s, 16); s += __shfl_xor(s, 32);
    const float rs = rsqrtf(s * (1.f / 64.f) + EPS) * extra;
    const f32x4 ga = *(const f32x4*)(g + 8 * fq), gb = *(const f32x4*)(g + 8 * fq + 4), gc = *(const f32x4*)(g + 32 + 8 * fq), gd = *(const f32x4*)(g + 32 + 8 * fq + 4);
    u32x4 a, b2;
    a.x = cvt_pk_bf16(f[0] * rs * ga.x, f[1] * rs * ga.y); a.y = cvt_pk_bf16(f[2] * rs * ga.z, f[3] * rs * ga.w);
    a.z = cvt_pk_bf16(f[4] * rs * gb.x, f[5] * rs * gb.y); a.w = cvt_pk_bf16(f[6] * rs * gb.z, f[7] * rs * gb.w);
    b2.x = cvt_pk_bf16(f[8] * rs * gc.x, f[9] * rs * gc.y); b2.y = cvt_pk_bf16(f[10] * rs * gc.z, f[11] * rs * gc.w);
    b2.z = cvt_pk_bf16(f[12] * rs * gd.x, f[13] * rs * gd.y); b2.w = cvt_pk_bf16(f[14] * rs * gd.z, f[15] * rs * gd.w);
    o0 = __builtin_bit_cast(bf16x8, a); o1 = __builtin_bit_cast(bf16x8, b2);
}

__device__ __forceinline__ void attn_prompt_unit(const Params& p, unsigned char* lds, int u) {
    const int tid = threadIdx.x, lane = tid & 63, wid = tid >> 6, fr = lane & 15, fq = lane >> 4;
    const int qb = u & 31, kvh = (u >> 5) & 3, b = u >> 7;
    unsigned char* ws = p.ws;
    const bf16_t* KVQ = (const bf16_t*)(ws + WS_KVQ);
    bf16_t* AO = (bf16_t*)(ws + WS_ATT);
    bf16_t* Ks = (bf16_t*)lds;
    bf16_t* VT = Ks + 256 * 72;
    const int pos0 = qb * 128 - 128;
    u32x4 qr[4][2];
    {
        const int g_ = wid >> 1, half_ = wid & 1, head_ = kvh * 4 + g_;
#pragma unroll
        for (int m = 0; m < 4; ++m) {
            const bf16_t* qp = KVQ + ((size_t)b * 4096 + qb * 128 + 64 * half_ + 16 * m + fr) * NKVQ + 512 + head_ * 64;
            qr[m][0] = *(const u32x4*)(qp + 8 * fq); qr[m][1] = *(const u32x4*)(qp + 32 + 8 * fq);
        }
    }
#pragma unroll
    for (int i = 0; i < 4; ++i) {
        const int ci = tid + 512 * i, j = ci >> 3, ch = ci & 7, pos = pos0 + j;
        u32x4 r = (u32x4){0u, 0u, 0u, 0u};
        if (pos >= 0) r = *(const u32x4*)(KVQ + (size_t)(b * 4096 + pos) * NKVQ + kvh * 64 + ch * 8);
        float f[8] = {bflo(r.x), bfhi(r.x), bflo(r.y), bfhi(r.y), bflo(r.z), bfhi(r.z), bflo(r.w), bfhi(r.w)};
        float s = 0.f;
#pragma unroll
        for (int e = 0; e < 8; ++e) s += f[e] * f[e];
        s += __shfl_xor(s, 1); s += __shfl_xor(s, 2); s += __shfl_xor(s, 4);
        const float rs = rsqrtf(s * (1.f / 64.f) + EPS);
        const f32x4 g0 = *(const f32x4*)(p.k_norm_g + ch * 8), g1 = *(const f32x4*)(p.k_norm_g + ch * 8 + 4);
        f[0] *= rs * g0.x; f[1] *= rs * g0.y; f[2] *= rs * g0.z; f[3] *= rs * g0.w; f[4] *= rs * g1.x; f[5] *= rs * g1.y; f[6] *= rs * g1.z; f[7] *= rs * g1.w;
        u32x4 w; w.x = cvt_pk_bf16(f[0], f[1]); w.y = cvt_pk_bf16(f[2], f[3]); w.z = cvt_pk_bf16(f[4], f[5]); w.w = cvt_pk_bf16(f[6], f[7]);
        *(u32x4*)(Ks + j * 72 + ch * 8) = w;
        if (qb == 31 && j >= 128) {
            float* o = p.out + O_PWK + ((size_t)(b * 128 + (j - 128)) * 4 + kvh) * 64 + ch * 8;
            *(f32x4*)o = (f32x4){f[0], f[1], f[2], f[3]}; *(f32x4*)(o + 4) = (f32x4){f[4], f[5], f[6], f[7]};
        }
    }
#pragma unroll
    for (int i = 0; i < 4; ++i) {
        const int ci = tid + 512 * i, j = ci & 255, ch = ci >> 8, pos = pos0 + j;
        u32x4 r = (u32x4){0u, 0u, 0u, 0u};
        if (pos >= 0) r = *(const u32x4*)(KVQ + (size_t)(b * 4096 + pos) * NKVQ + 256 + kvh * 64 + ch * 8);
        bf16_t* dst = VT + (ch * 8) * 264 + j;
        dst[0 * 264] = (bf16_t)(r.x & 0xffff); dst[1 * 264] = (bf16_t)(r.x >> 16); dst[2 * 264] = (bf16_t)(r.y & 0xffff); dst[3 * 264] = (bf16_t)(r.y >> 16);
        dst[4 * 264] = (bf16_t)(r.z & 0xffff); dst[5 * 264] = (bf16_t)(r.z >> 16); dst[6 * 264] = (bf16_t)(r.w & 0xffff); dst[7 * 264] = (bf16_t)(r.w >> 16);
        if (qb == 31 && j >= 128) {
            float* o = p.out + O_PWV + ((size_t)(b * 128 + (j - 128)) * 4 + kvh) * 64 + ch * 8;
            *(f32x4*)o = (f32x4){bflo(r.x), bfhi(r.x), bflo(r.y), bfhi(r.y)}; *(f32x4*)(o + 4) = (f32x4){bflo(r.z), bfhi(r.z), bflo(r.w), bfhi(r.w)};
        }
    }
    __syncthreads();
    const int g = wid >> 1, half = wid & 1, head = kvh * 4 + g;
    const float sink = p.att_sinks[head];
    const float* qg = p.q_norm_g;
#pragma unroll
    for (int m = 0; m < 4; ++m) {
        const int j0 = 64 * half + 16 * m;
        const size_t R = (size_t)b * 4096 + qb * 128 + j0 + fr;
        bf16x8 q0, q1; norm_frag(qr[m][0], qr[m][1], qg, 0.125f, fq, q0, q1);
        f32x4 s[9];
#pragma unroll
        for (int i = 0; i < 9; ++i) {
            s[i] = (f32x4){0.f, 0.f, 0.f, 0.f};
            const bf16_t* kr = Ks + (j0 + 16 * i + fr) * 72 + 8 * fq;
            s[i] = MFMA32(*(const bf16x8*)kr, q0, s[i]);
            s[i] = MFMA32(*(const bf16x8*)(kr + 32), q1, s[i]);
        }
        float mx = sink;
#pragma unroll
        for (int i = 0; i < 9; ++i)
#pragma unroll
            for (int e = 0; e < 4; ++e) {
                const int jr = 16 * i + 4 * fq + e;
                const bool ok = (jr >= fr) && (jr <= 128 + fr) && (pos0 + j0 + jr >= 0);
                s[i][e] = ok ? s[i][e] : -INFINITY;
                mx = fmaxf(mx, s[i][e]);
            }
        mx = fmaxf(mx, __shfl_xor(mx, 16)); mx = fmaxf(mx, __shfl_xor(mx, 32));
        float l = 0.f;
        bf16x4 pf[9];
#pragma unroll
        for (int i = 0; i < 9; ++i) {
            float e0 = __expf(s[i][0] - mx), e1 = __expf(s[i][1] - mx), e2 = __expf(s[i][2] - mx), e3 = __expf(s[i][3] - mx);
            l += (e0 + e1) + (e2 + e3);
            u32x2 w; w.x = cvt_pk_bf16(e0, e1); w.y = cvt_pk_bf16(e2, e3);
            pf[i] = __builtin_bit_cast(bf16x4, w);
        }
        l += __shfl_xor(l, 16); l += __shfl_xor(l, 32);
        l += __expf(sink - mx);
        const float inv = 1.f / l;
        f32x4 o[4];
#pragma unroll
        for (int dt = 0; dt < 4; ++dt) {
            o[dt] = (f32x4){0.f, 0.f, 0.f, 0.f};
#pragma unroll
            for (int i = 0; i < 9; ++i) {
                const bf16x4 vf = *(const bf16x4*)(VT + (16 * dt + fr) * 264 + j0 + 16 * i + 4 * fq);
                o[dt] = MFMA16(vf, pf[i], o[dt]);
            }
        }
#pragma unroll
        for (int dt = 0; dt < 4; ++dt) {
            u32x2 w; w.x = cvt_pk_bf16(o[dt].x * inv, o[dt].y * inv); w.y = cvt_pk_bf16(o[dt].z * inv, o[dt].w * inv);
            *(u32x2*)(AO + R * D + head * 64 + 16 * dt + 4 * fq) = w;
        }
    }
    __syncthreads();
}

__device__ __forceinline__ void attn_sample_unit(const Params& p, int u, int lane) {
    const int fr = lane & 15, fq = lane >> 4;
    const int b = u >> 2, kvh = u & 3;
    unsigned char* ws = p.ws;
    const bf16_t* KVQ = (const bf16_t*)(ws + WS_KVQ);
    bf16_t* AO = (bf16_t*)(ws + WS_ATT);
    const float* ck = p.cache_k + (size_t)b * 128 * 256 + kvh * 64;
    const float* cv = p.cache_v + (size_t)b * 128 * 256 + kvh * 64;
    float* owk = p.out + O_SWK + (size_t)b * 128 * 256 + kvh * 64;
    float* owv = p.out + O_SWV + (size_t)b * 128 * 256 + kvh * 64;
    const size_t rbase = (size_t)TP + b * 4;
    for (int i = lane; i < 124 * 16; i += 64) {
        const int j = i >> 4, d4 = (i & 15) * 4;
        *(f32x4*)(owk + (size_t)j * 256 + d4) = *(const f32x4*)(ck + (size_t)(j + 4) * 256 + d4);
        *(f32x4*)(owv + (size_t)j * 256 + d4) = *(const f32x4*)(cv + (size_t)(j + 4) * 256 + d4);
    }
    {
        const int t = lane >> 4, d4 = (lane & 15) * 4;
        const u32x2 kr = *(const u32x2*)(KVQ + (rbase + t) * NKVQ + kvh * 64 + d4);
        const u32x2 vr = *(const u32x2*)(KVQ + (rbase + t) * NKVQ + 256 + kvh * 64 + d4);
        float f0 = bflo(kr.x), f1 = bfhi(kr.x), f2 = bflo(kr.y), f3 = bfhi(kr.y);
        float s = (f0 * f0 + f1 * f1) + (f2 * f2 + f3 * f3);
        s += __shfl_xor(s, 1); s += __shfl_xor(s, 2); s += __shfl_xor(s, 4); s += __shfl_xor(s, 8);
        const float rs = rsqrtf(s * (1.f / 64.f) + EPS);
        const f32x4 g = *(const f32x4*)(p.k_norm_g + d4);
        *(f32x4*)(owk + (size_t)(124 + t) * 256 + d4) = (f32x4){f0 * rs * g.x, f1 * rs * g.y, f2 * rs * g.z, f3 * rs * g.w};
        *(f32x4*)(owv + (size_t)(124 + t) * 256 + d4) = (f32x4){bflo(vr.x), bfhi(vr.x), bflo(vr.y), bfhi(vr.y)};
    }
    const int g = fr >> 2, t = fr & 3, head = kvh * 4 + g;
    const bf16_t* qp = KVQ + (rbase + t) * NKVQ + 512 + head * 64;
    const u32x4 r0 = *(const u32x4*)(qp + 8 * fq), r1 = *(const u32x4*)(qp + 32 + 8 * fq);
    bf16x8 q0, q1; norm_frag(r0, r1, p.q_norm_g, 0.125f, fq, q0, q1);
    const float sink = p.att_sinks[head];
    bf16x8 nk0, nk1;
    {
        const bf16_t* kp = KVQ + (rbase + (fr & 3)) * NKVQ + kvh * 64;
        const u32x4 a0 = *(const u32x4*)(kp + 8 * fq), a1 = *(const u32x4*)(kp + 32 + 8 * fq);
        norm_frag(a0, a1, p.k_norm_g, 1.f, fq, nk0, nk1);
        if (fr >= 4) { nk0 = (bf16x8){0, 0, 0, 0, 0, 0, 0, 0}; nk1 = nk0; }
    }
    f32x4 s[9];
#pragma unroll
    for (int i = 0; i < 8; ++i) {
        const float* kr = ck + (size_t)(16 * i + fr) * 256 + 8 * fq;
        const f32x4 a = *(const f32x4*)kr, b2 = *(const f32x4*)(kr + 4), c = *(const f32x4*)(kr + 32), d = *(const f32x4*)(kr + 36);
        u32x4 x0, x1;
        x0.x = cvt_pk_bf16(a.x, a.y); x0.y = cvt_pk_bf16(a.z, a.w); x0.z = cvt_pk_bf16(b2.x, b2.y); x0.w = cvt_pk_bf16(b2.z, b2.w);
        x1.x = cvt_pk_bf16(c.x, c.y); x1.y = cvt_pk_bf16(c.z, c.w); x1.z = cvt_pk_bf16(d.x, d.y); x1.w = cvt_pk_bf16(d.z, d.w);
        s[i] = (f32x4){0.f, 0.f, 0.f, 0.f};
        s[i] = MFMA32(__builtin_bit_cast(bf16x8, x0), q0, s[i]);
        s[i] = MFMA32(__builtin_bit_cast(bf16x8, x1), q1, s[i]);
    }
    s[8] = (f32x4){0.f, 0.f, 0.f, 0.f};
    s[8] = MFMA32(nk0, q0, s[8]); s[8] = MFMA32(nk1, q1, s[8]);
    float mx = sink;
#pragma unroll
    for (int i = 0; i < 9; ++i)
#pragma unroll
        for (int e = 0; e < 4; ++e) {
            const int j = 16 * i + 4 * fq + e;
            const bool ok = (j >= t) && (j <= t + 128);
            s[i][e] = ok ? s[i][e] : -INFINITY;
            mx = fmaxf(mx, s[i][e]);
        }
    mx = fmaxf(mx, __shfl_xor(mx, 16)); mx = fmaxf(mx, __shfl_xor(mx, 32));
    float l = 0.f; bf16x4 pf[9];
#pragma unroll
    for (int i = 0; i < 9; ++i) {
        float e0 = __expf(s[i][0] - mx), e1 = __expf(s[i][1] - mx), e2 = __expf(s[i][2] - mx), e3 = __expf(s[i][3] - mx);
        l += (e0 + e1) + (e2 + e3);
        u32x2 w; w.x = cvt_pk_bf16(e0, e1); w.y = cvt_pk_bf16(e2, e3);
        pf[i] = __builtin_bit_cast(bf16x4, w);
    }
    l += __shfl_xor(l, 16); l += __shfl_xor(l, 32);
    l += __expf(sink - mx);
    const float inv = 1.f / l;
#pragma unroll
    for (int dt = 0; dt < 4; ++dt) {
        f32x4 o = (f32x4){0.f, 0.f, 0.f, 0.f};
#pragma unroll
        for (int i = 0; i < 8; ++i) {
            const float* vr = cv + (size_t)(16 * i + 4 * fq) * 256 + 16 * dt + fr;
            u32x2 w; w.x = cvt_pk_bf16(vr[0], vr[256]); w.y = cvt_pk_bf16(vr[512], vr[768]);
            o = MFMA16(__builtin_bit_cast(bf16x4, w), pf[i], o);
        }
        {
            u32x2 w; w.x = 0u; w.y = 0u;
            const bf16_t* vp = KVQ + rbase * NKVQ + 256 + kvh * 64 + 16 * dt + fr;
            const unsigned v0 = vp[0], v1 = vp[NKVQ], v2 = vp[2 * NKVQ], v3 = vp[3 * NKVQ];
            if (fq == 0) { w.x = v0 | (v1 << 16); w.y = v2 | (v3 << 16); }
            o = MFMA16(__builtin_bit_cast(bf16x4, w), pf[8], o);
        }
        u32x2 w; w.x = cvt_pk_bf16(o.x * inv, o.y * inv); w.y = cvt_pk_bf16(o.z * inv, o.w * inv);
        *(u32x2*)(AO + (rbase + t) * D + head * 64 + 16 * dt + 4 * fq) = w;
    }
}


__device__ __forceinline__ void attn_sample_block(const Params& p, unsigned char* lds, int u) {
    const int tid = threadIdx.x, lane = tid & 63, wid = tid >> 6, fr = lane & 15, fq = lane >> 4;
    const int b = u >> 2, kvh = u & 3;
    unsigned char* ws = p.ws;
    const bf16_t* KVQ = (const bf16_t*)(ws + WS_KVQ);
    bf16_t* AO = (bf16_t*)(ws + WS_ATT);
    const float* ck = p.cache_k + (size_t)b * 128 * 256 + kvh * 64;
    const float* cv = p.cache_v + (size_t)b * 128 * 256 + kvh * 64;
    float* owk = p.out + O_SWK + (size_t)b * 128 * 256 + kvh * 64;
    float* owv = p.out + O_SWV + (size_t)b * 128 * 256 + kvh * 64;
    const size_t rbase = (size_t)TP + b * 4;
    bf16_t* Ks = (bf16_t*)lds;
    bf16_t* VT = Ks + 144 * 72;
    f32x4 kf[4], vf[4];
#pragma unroll
    for (int i = 0; i < 4; ++i) { const int idx = tid + 512 * i, j = idx >> 4, c4 = (idx & 15) * 4; kf[i] = *(const f32x4*)(ck + (size_t)j * 256 + c4); vf[i] = *(const f32x4*)(cv + (size_t)j * 256 + c4); }
#pragma unroll
    for (int i = 0; i < 4; ++i) {
        const int idx = tid + 512 * i, j = idx >> 4, c4 = (idx & 15) * 4;
        if (j >= 4) { *(f32x4*)(owk + (size_t)(j - 4) * 256 + c4) = kf[i]; *(f32x4*)(owv + (size_t)(j - 4) * 256 + c4) = vf[i]; }
        u32x2 w; w.x = cvt_pk_bf16(kf[i].x, kf[i].y); w.y = cvt_pk_bf16(kf[i].z, kf[i].w);
        *(u32x2*)(Ks + j * 72 + c4) = w;
        VT[(c4 + 0) * 152 + j] = f2bf(vf[i].x); VT[(c4 + 1) * 152 + j] = f2bf(vf[i].y); VT[(c4 + 2) * 152 + j] = f2bf(vf[i].z); VT[(c4 + 3) * 152 + j] = f2bf(vf[i].w);
    }
    if (tid < 64) {
        const int t = tid >> 4, d4 = (tid & 15) * 4;
        const u32x2 kr = *(const u32x2*)(KVQ + (rbase + t) * NKVQ + kvh * 64 + d4);
        const u32x2 vr = *(const u32x2*)(KVQ + (rbase + t) * NKVQ + 256 + kvh * 64 + d4);
        float f0 = bflo(kr.x), f1 = bfhi(kr.x), f2 = bflo(kr.y), f3 = bfhi(kr.y);
        float s = (f0 * f0 + f1 * f1) + (f2 * f2 + f3 * f3);
        s += __shfl_xor(s, 1); s += __shfl_xor(s, 2); s += __shfl_xor(s, 4); s += __shfl_xor(s, 8);
        const float rs = rsqrtf(s * (1.f / 64.f) + EPS);
        const f32x4 g = *(const f32x4*)(p.k_norm_g + d4);
        f0 *= rs * g.x; f1 *= rs * g.y; f2 *= rs * g.z; f3 *= rs * g.w;
        *(f32x4*)(owk + (size_t)(124 + t) * 256 + d4) = (f32x4){f0, f1, f2, f3};
        *(f32x4*)(owv + (size_t)(124 + t) * 256 + d4) = (f32x4){bflo(vr.x), bfhi(vr.x), bflo(vr.y), bfhi(vr.y)};
        u32x2 w; w.x = cvt_pk_bf16(f0, f1); w.y = cvt_pk_bf16(f2, f3);
        *(u32x2*)(Ks + (128 + t) * 72 + d4) = w;
        VT[(d4 + 0) * 152 + 128 + t] = (bf16_t)(vr.x & 0xffff); VT[(d4 + 1) * 152 + 128 + t] = (bf16_t)(vr.x >> 16);
        VT[(d4 + 2) * 152 + 128 + t] = (bf16_t)(vr.y & 0xffff); VT[(d4 + 3) * 152 + 128 + t] = (bf16_t)(vr.y >> 16);
    } else if (tid < 64 + 192) {
        const int i = tid - 64;
        if (i < 96) { const int r = 132 + (i >> 3), c8 = (i & 7) * 8; *(u32x4*)(Ks + r * 72 + c8) = (u32x4){0u, 0u, 0u, 0u}; }
        else { const int d = i - 96; if (d < 64) { bf16_t* z = VT + d * 152 + 132; for (int e = 0; e < 12; ++e) z[e] = 0; } }
    }
    __syncthreads();
    if (wid < 4) {
        const int dt = wid;
        const int g = fr >> 2, t = fr & 3, head = kvh * 4 + g;
        const bf16_t* qp = KVQ + (rbase + t) * NKVQ + 512 + head * 64;
        const u32x4 r0 = *(const u32x4*)(qp + 8 * fq), r1 = *(const u32x4*)(qp + 32 + 8 * fq);
        bf16x8 q0, q1; norm_frag(r0, r1, p.q_norm_g, 0.125f, fq, q0, q1);
        const float sink = p.att_sinks[head];
        f32x4 s[9];
#pragma unroll
        for (int i = 0; i < 9; ++i) {
            s[i] = (f32x4){0.f, 0.f, 0.f, 0.f};
            const bf16_t* kr = Ks + (16 * i + fr) * 72 + 8 * fq;
            s[i] = MFMA32(*(const bf16x8*)kr, q0, s[i]);
            s[i] = MFMA32(*(const bf16x8*)(kr + 32), q1, s[i]);
        }
        float mx = sink;
#pragma unroll
        for (int i = 0; i < 9; ++i)
#pragma unroll
            for (int e = 0; e < 4; ++e) {
                const int j = 16 * i + 4 * fq + e;
                const bool ok = (j >= t) && (j <= t + 128);
                s[i][e] = ok ? s[i][e] : -INFINITY;
                mx = fmaxf(mx, s[i][e]);
            }
        mx = fmaxf(mx, __shfl_xor(mx, 16)); mx = fmaxf(mx, __shfl_xor(mx, 32));
        float l = 0.f;
        f32x4 o = (f32x4){0.f, 0.f, 0.f, 0.f};
#pragma unroll
        for (int i = 0; i < 9; ++i) {
            const float e0 = __expf(s[i][0] - mx), e1 = __expf(s[i][1] - mx), e2 = __expf(s[i][2] - mx), e3 = __expf(s[i][3] - mx);
            l += (e0 + e1) + (e2 + e3);
            u32x2 w; w.x = cvt_pk_bf16(e0, e1); w.y = cvt_pk_bf16(e2, e3);
            const bf16x4 vfr = *(const bf16x4*)(VT + (16 * dt + fr) * 152 + 16 * i + 4 * fq);
            o = MFMA16(vfr, __builtin_bit_cast(bf16x4, w), o);
        }
        l += __shfl_xor(l, 16); l += __shfl_xor(l, 32);
        l += __expf(sink - mx);
        const float inv = 1.f / l;
        u32x2 w; w.x = cvt_pk_bf16(o.x * inv, o.y * inv); w.y = cvt_pk_bf16(o.z * inv, o.w * inv);
        *(u32x2*)(AO + (rbase + t) * D + head * 64 + 16 * dt + 4 * fq) = w;
    }
    __syncthreads();
}

#define LAS __attribute__((address_space(3)))
#define XB_TMO      128
#define XB_XCNT(j)  (256  + 64 * (j))
#define XB_XSUB(j)  (1280 + 64 * (j))
#define XB_XGEN(j)  (2304 + 64 * (j))
#define XB_TOP      3328
#define XB_TOPGEN   3392
#define XCD_BAR_WORDS 3456
#define XB_SPIN_CAP (1u << 18)

__device__ __forceinline__ unsigned xb_ld(unsigned* p)              { return __hip_atomic_load(p, __ATOMIC_RELAXED, __HIP_MEMORY_SCOPE_AGENT); }
__device__ __forceinline__ unsigned xb_add(unsigned* p, unsigned v) { return __hip_atomic_fetch_add(p, v, __ATOMIC_RELAXED, __HIP_MEMORY_SCOPE_AGENT); }
__device__ __forceinline__ unsigned xb_xcc_id() { return (unsigned)__builtin_amdgcn_s_getreg((3 << 11) | 20) & 0xFu; }
#define XB_SPIN(cond, bar) do { unsigned _sp = 0; while (cond) { __builtin_amdgcn_s_sleep(1); \
    if ((++_sp & 255u) == 0u) { if (xb_ld(&(bar)[XB_TMO])) break; if (_sp > XB_SPIN_CAP) { atomicAdd(&(bar)[XB_TMO], 1u); break; } } } } while (0)

struct XcdBarrier {
    unsigned* bar; unsigned x;
    volatile LAS unsigned* st;
};

__device__ __forceinline__ XcdBarrier xcd_barrier_post(unsigned* bar, volatile LAS unsigned* st) {
    XcdBarrier b; b.bar = bar; b.x = xb_xcc_id(); b.st = st;
    if (threadIdx.x == 0) (void)xb_add(&bar[XB_XCNT(b.x)], 1u);
    return b;
}
__device__ __forceinline__ void xcd_barrier_complete(unsigned* bar, unsigned x, unsigned& nloc, unsigned& nx) {
    const unsigned G = gridDim.x * gridDim.y * gridDim.z;
    unsigned sum, cnt, mine, sp = 0u;
    for (;;) {
        sum = 0u; cnt = 0u; mine = 0u;
#pragma unroll
        for (unsigned j = 0; j < 16; ++j) { const unsigned c = xb_ld(&bar[XB_XCNT(j)]); sum += c; cnt += (c > 0u) ? 1u : 0u; mine = (j == x) ? c : mine; }
        if (sum == G) break;
        __builtin_amdgcn_s_sleep(1);
        if ((++sp & 255u) == 0u) { if (xb_ld(&bar[XB_TMO])) break; if (sp > XB_SPIN_CAP) { atomicAdd(&bar[XB_TMO], 1u); break; } }
    }
    nloc = mine > 0u ? mine : 1u; nx = cnt > 0u ? cnt : 1u;
}

__device__ __forceinline__ void xcd_barrier(const XcdBarrier& b) {
    asm volatile("s_waitcnt vmcnt(0)" ::: "memory");
    __syncthreads();
    if (threadIdx.x == 0) {
        unsigned* bar = b.bar;
        __builtin_amdgcn_s_waitcnt(0);
        unsigned nloc = b.st[0], nx = b.st[1];
        if (nloc == 0u) { xcd_barrier_complete(bar, b.x, nloc, nx); b.st[0] = nloc; b.st[1] = nx; }
        const unsigned old = xb_add(&bar[XB_XSUB(b.x)], 1u);
        const unsigned gen = old / nloc;
        if (old + 1u == (gen + 1u) * nloc) {
            __builtin_amdgcn_fence(__ATOMIC_RELEASE, "agent");
            asm volatile("s_waitcnt vmcnt(0)" ::: "memory");
            const unsigned og = xb_add(&bar[XB_TOP], 1u);
            const unsigned tg = og / nx;
            if (og + 1u == (tg + 1u) * nx) xb_add(&bar[XB_TOPGEN], 1u);
            else XB_SPIN(xb_ld(&bar[XB_TOPGEN]) == tg, bar);
            __builtin_amdgcn_fence(__ATOMIC_ACQUIRE, "agent");
            xb_add(&bar[XB_XGEN(b.x)], 1u);
            asm volatile("s_waitcnt vmcnt(0)" ::: "memory");
        } else {
            XB_SPIN(xb_ld(&bar[XB_XGEN(b.x)]) == gen, bar);
            __builtin_amdgcn_fence(__ATOMIC_ACQUIRE, "agent");
            asm volatile("s_waitcnt vmcnt(0)" ::: "memory");
        }
    }
    __syncthreads();
}

__global__ void __launch_bounds__(NTHREADS) yoco_fwd(Params p) {
    extern __shared__ __attribute__((aligned(16))) unsigned char lds[];
    const int bid = blockIdx.x, G = gridDim.x;
    unsigned char* ws = p.ws;
    float* SS = (float*)(ws + WS_SS);
    float* Y = p.out + O_Y;
    bf16_t* XB = (bf16_t*)(ws + WS_XB);

#define IN(k) (p.ph_lo <= (k) && (k) < p.ph_hi)
    volatile LAS unsigned* bst = (volatile LAS unsigned*)((LAS unsigned char*)lds + 131072 + 64);
    XcdBarrier xbar; xbar.bar = (unsigned*)(ws + WS_BAR); xbar.x = 0; xbar.st = bst;
    if (p.ph_hi - p.ph_lo > 1) {
        if (threadIdx.x < 2) bst[threadIdx.x] = 0u;
        __syncthreads();
        xbar = xcd_barrier_post((unsigned*)(ws + WS_BAR), bst);
    }
#define SEAM(k) do { if (IN(k) && IN((k) + 1)) xcd_barrier(xbar); } while (0)
    if (IN(0)) { for (int rep = 0; rep < REP_P0; ++rep) p0_prologue(p, lds, bid, G); }
    SEAM(0);
    PG8_LAS unsigned char* l3 = (PG8_LAS unsigned char*)lds;
    float* YS = Y;
#define PGEMM(Aptr, Bptr, Nn, Kk, EpiT, ...) do { pg8::Gemm g_{(const bf16_t*)(Aptr), (const bf16_t*)(Bptr), TP, (Nn), (Kk), ((Kk) == FF) ? 1 : 0}; pg8::StaticOrder S_; S_.init(TP, (Nn), G, bid); \
        Pg8Epi<EpiT> E_{EpiT{__VA_ARGS__}}; pg8::gemm_phase<Pg8Epi<EpiT>, pg8::StaticOrder, true, true>(l3, g_, S_, E_); } while (0)
    if (IN(1)) {
        for (int rep = 0; rep < REP_PG; ++rep) { PGEMM(XB, ws + WS_WIN, NIN, 1024, EpiBf16, (bf16_t*)(ws + WS_P), NIN, nullptr, 0); }
        { EpiBf16 E{(bf16_t*)(ws + WS_P), NIN, nullptr, 0}; for (int rep = 0; rep < REP_SG; ++rep) sgemm64<0>(lds, XB, 1024, (const bf16_t*)(ws + WS_WIN), TP, TS, NIN, 1024, 1, E, bid, G); }
    }
    SEAM(1);
    if (IN(2)) {
        for (int rep = 0; rep < REP_2AL; ++rep) for (int u = bid; u < 1024; u += G) mlstm_local_unit(p, lds, u);
        for (int rep = 0; rep < REP_2AS; ++rep) for (int u = bid; u < 512; u += G) mlstm_sample_unit(p, lds, u);
    }
    SEAM(2);
    if (IN(3)) mlstm_scan(p, lds, bid, G);
    SEAM(3);
    if (IN(4)) { for (int rep = 0; rep < REP_2C; ++rep) for (int u = bid; u < 1024; u += G) mlstm_out_unit(p, lds, u); }
    SEAM(4);
    if (IN(5)) {
        PGEMM(ws + WS_HG, ws + WS_WOUT, 1024, 1024, EpiResB, p.x_prompt, XB, nullptr, SS);
        { EpiAtomic E{YS}; sgemm64<0>(lds, ws + WS_HG, 1024, (const bf16_t*)(ws + WS_WOUT), TP, TS, 1024, 1024, 4, E, bid, G); }
    }
    SEAM(5);
    if (IN(6)) {
        for (int rep = 0; rep < REP_PG; ++rep) { PGEMM(XB, ws + WS_W1A, FF, 1024, EpiBf16, (bf16_t*)(ws + WS_HID), FF, SS, 1); }
        { EpiBf16 E{(bf16_t*)(ws + WS_HID), FF, nullptr, 1}; for (int rep = 0; rep < REP_SG; ++rep) sgemm64<1>(lds, Y, 1024, (const bf16_t*)(ws + WS_W1A), TP, TS, FF, 1024, 1, E, bid, G); }
    }
    SEAM(6);
    if (IN(7)) {
        PGEMM(ws + WS_HID, ws + WS_W2A, 1024, FF, EpiResB, nullptr, XB, nullptr, SS + T);
        { EpiAtomic E{YS}; sgemm64<0>(lds, ws + WS_HID, FF, (const bf16_t*)(ws + WS_W2A), TP, TS, 1024, FF, 4, E, bid, G); }
    }
    SEAM(7);
    if (IN(8)) {
        for (int rep = 0; rep < REP_PG; ++rep) { PGEMM(XB, ws + WS_WKVQ, NKVQ, 1024, EpiBf16, (bf16_t*)(ws + WS_KVQ), NKVQ, SS + T, 0); }
        { EpiBf16 E{(bf16_t*)(ws + WS_KVQ), NKVQ, nullptr, 0}; for (int rep = 0; rep < REP_SG; ++rep) sgemm64<1>(lds, Y, 1024, (const bf16_t*)(ws + WS_WKVQ), TP, TS, NKVQ, 1024, 1, E, (bid + G / 2) % G, G); }
        __syncthreads();
        if (bid >= G / 2) late_weights(p, lds, bid - G / 2, G - G / 2);
    }
    SEAM(8);
    if (IN(9)) {
        { const int vb = (G % 8 == 0) ? (bid % 8) * (G / 8) + bid / 8 : bid;
          for (int rep = 0; rep < REP_7P; ++rep) for (int u = vb; u < 512; u += G) attn_prompt_unit(p, lds, u); }
        for (int rep = 0; rep < REP_7S; ++rep) for (int u = bid; u < 512; u += G) attn_sample_block(p, lds, u);
    }
    SEAM(9);
    if (IN(10)) {
        PGEMM(ws + WS_ATT, ws + WS_WO, 1024, 1024, EpiResB, nullptr, XB, nullptr, SS + 2 * T);
        { EpiAtomic E{YS}; sgemm64<0>(lds, ws + WS_ATT, 1024, (const bf16_t*)(ws + WS_WO), TP, TS, 1024, 1024, 4, E, bid, G); }
    }
    SEAM(10);
    if (IN(11)) {
        for (int rep = 0; rep < REP_PG; ++rep) { PGEMM(XB, ws + WS_W1B, FF, 1024, EpiBf16, (bf16_t*)(ws + WS_HID), FF, SS + 2 * T, 1); }
        { EpiBf16 E{(bf16_t*)(ws + WS_HID), FF, nullptr, 1}; for (int rep = 0; rep < REP_SG; ++rep) sgemm64<1>(lds, Y, 1024, (const bf16_t*)(ws + WS_W1B), TP, TS, FF, 1024, 1, E, bid, G); }
    }
    SEAM(11);
    if (IN(12)) {
        PGEMM(ws + WS_HID, ws + WS_W2B, 1024, FF, EpiResB, nullptr, XB, Y, nullptr);
        { EpiAtomic E{YS}; sgemm64<0>(lds, ws + WS_HID, FF, (const bf16_t*)(ws + WS_W2B), TP, TS, 1024, FF, 4, E, bid, G); }
    }
#undef PGEMM
#undef IN
#undef SEAM
}

extern "C" void kernel_launch(void* const* d_in, const int* in_sizes, int n_in, void* d_out, int out_size, void* d_ws, size_t ws_size, hipStream_t stream) {
    static int grid_blocks = 0;
    if (!grid_blocks) {
        if (n_in != 24 || (size_t)out_size != O_END || ws_size < WS_END) { fprintf(stderr, "kernel_launch: unexpected shapes n_in=%d out=%d ws=%zu\n", n_in, out_size, ws_size); grid_blocks = -1; return; }
        int dev = 0, cus = 0, per_cu = 0;
        hipGetDevice(&dev);
        hipDeviceGetAttribute(&cus, hipDeviceAttributeMultiprocessorCount, dev);
        hipFuncSetAttribute((const void*)yoco_fwd, hipFuncAttributeMaxDynamicSharedMemorySize, LDS_BYTES);
        hipOccupancyMaxActiveBlocksPerMultiprocessor(&per_cu, (const void*)yoco_fwd, NTHREADS, LDS_BYTES);
        if (per_cu < 1) per_cu = 1;
        grid_blocks = cus * per_cu;
        (void)hipGetLastError();
    }
    if (grid_blocks < 0) return;
    Params p{};
    const float** pp = (const float**)&p;
    for (int i = 0; i < 24; ++i) pp[i] = (const float*)d_in[i];
    p.out = (float*)d_out; p.ws = (unsigned char*)d_ws;
#if N_LAUNCH_MODE == 1
    p.ph_lo = 0; p.ph_hi = 13;
    (void)hipMemsetAsync((char*)d_ws + WS_BAR, 0, BAR_BYTES, stream);
    void* args[] = {&p};
    hipError_t e = hipLaunchCooperativeKernel((const void*)yoco_fwd, dim3(grid_blocks), dim3(NTHREADS), args, LDS_BYTES, stream);
    if (e != hipSuccess) fprintf(stderr, "cooperative launch failed: %s (grid %d)\n", hipGetErrorString(e), grid_blocks);
#else
    for (int k = 0; k < MAX_PHASE; ++k) { p.ph_lo = k; p.ph_hi = k + 1; hipLaunchKernelGGL(yoco_fwd, dim3(grid_blocks), dim3(NTHREADS), LDS_BYTES, stream, p); }
#endif
}
```

```cpp
#include <hip/hip_runtime.h>
#include <hip/hip_cooperative_groups.h>
#include <cstdio>
#include <cstdint>
namespace cg = cooperative_groups;

typedef unsigned short bf16_t;
typedef short bf16x8 __attribute__((ext_vector_type(8)));
typedef short bf16x4 __attribute__((ext_vector_type(4)));
typedef float f32x4 __attribute__((ext_vector_type(4)));
typedef unsigned u32x4 __attribute__((ext_vector_type(4)));
typedef unsigned u32x2 __attribute__((ext_vector_type(2)));

constexpr int D = 1024, TP = 16384, TS = 512, T = TP + TS;
constexpr int NIN = 3072, LDW_IN = 3080, FF = 4096, NKVQ = 1536;
constexpr float EPS = 1e-6f;
constexpr int NTHREADS = 512;
constexpr int LDS_BYTES = 147456;
#ifndef REP_P0
#define REP_P0 1
#endif
#ifndef REP_2AL
#define REP_2AL 1
#endif
#ifndef REP_2AS
#define REP_2AS 1
#endif
#ifndef REP_2C
#define REP_2C 1
#endif
#ifndef REP_7P
#define REP_7P 1
#endif
#ifndef REP_7S
#define REP_7S 1
#endif
#ifndef REP_PG
#define REP_PG 1
#endif
#ifndef REP_SG
#define REP_SG 1
#endif
#ifndef MAX_PHASE
#define MAX_PHASE 13
#endif
#ifndef N_LAUNCH_MODE
#define N_LAUNCH_MODE 1
#endif

constexpr size_t MiB = 1u << 20;
constexpr size_t WS_SS = 0;
constexpr size_t WS_CHB = 256 * 1024, WS_CHM = WS_CHB + 4096, WS_MPREV = WS_CHM + 4096;
constexpr size_t WS_GATES = 1 * MiB;
constexpr size_t WS_GN = 2 * MiB;
constexpr size_t WS_BAR = 3 * MiB, BAR_BYTES = 16384;
constexpr size_t WS_WIN = 4 * MiB, WS_WOUT = 10 * MiB, WS_W1A = 12 * MiB, WS_W2A = 20 * MiB, WS_WKVQ = 28 * MiB, WS_WO = 31 * MiB, WS_W1B = 33 * MiB, WS_W2B = 41 * MiB;
constexpr size_t WS_XB = 49 * MiB;
constexpr size_t WS_P = 82 * MiB;
constexpr size_t WS_HG = 181 * MiB;
constexpr size_t WS_HID = 82 * MiB;
constexpr size_t WS_KVQ = 82 * MiB;
constexpr size_t WS_ATT = 132 * MiB;
constexpr size_t WS_END = 214 * MiB;

constexpr size_t O_Y = 0, O_PC = 17301504, O_PN = 17825792, O_PM = 17827840, O_PWK = 17827856, O_PWV = 17958928,
                 O_SC = 18090000, O_SN = 34867216, O_SM = 34932752, O_SWK = 34933264, O_SWV = 39127568, O_END = 43321872;

struct Params {
    const float *x_prompt, *x_sample, *st_C, *st_n, *st_m, *cache_k, *cache_v;
    const float *ml_norm_g, *ml_w_in, *ml_b_i, *ml_b_f, *ml_head_g, *ml_w_out;
    const float *kv_norm_g, *w_kv, *k_norm_g;
    const float *att_norm_g, *att_w_q, *q_norm_g, *att_sinks, *att_w_o;
    const float *mlp_norm_g, *mlp_w1, *mlp_w2;
    float* out; unsigned char* ws;
    int ph_lo, ph_hi;
};

typedef float f32x2 __attribute__((ext_vector_type(2)));
typedef __bf16 bf16x2n __attribute__((ext_vector_type(2)));
__device__ __forceinline__ unsigned cvt_pk_bf16(float lo, float hi) { const f32x2 v = {lo, hi}; const bf16x2n b = __builtin_convertvector(v, bf16x2n); return __builtin_bit_cast(unsigned, b); }
__device__ __forceinline__ bf16_t f2bf(float f) { return (bf16_t)(cvt_pk_bf16(f, 0.f) & 0xffffu); }
__device__ __forceinline__ float bf2f(bf16_t h) { return __uint_as_float(((unsigned)h) << 16); }
__device__ __forceinline__ float bflo(unsigned u) { return __uint_as_float(u << 16); }
__device__ __forceinline__ float bfhi(unsigned u) { return __uint_as_float(u & 0xffff0000u); }
__device__ __forceinline__ float wave_sum(float v) {
#pragma unroll
    for (int o = 1; o < 64; o <<= 1) v += __shfl_xor(v, o);
    return v;
}
__device__ __forceinline__ float wave_max(float v) {
#pragma unroll
    for (int o = 1; o < 64; o <<= 1) v = fmaxf(v, __shfl_xor(v, o));
    return v;
}
__device__ __forceinline__ float scan_sum(float x, int lane) {
#pragma unroll
    for (int o = 1; o < 64; o <<= 1) { float y = __shfl_up(x, o); if (lane >= o) x += y; }
    return x;
}
__device__ __forceinline__ float scan_max(float x, int lane) {
#pragma unroll
    for (int o = 1; o < 64; o <<= 1) { float y = __shfl_up(x, o); if (lane >= o) x = fmaxf(x, y); }
    return x;
}
__device__ __forceinline__ float softcap15(float x) { return 15.f * tanhf(x * (1.f / 15.f)); }
__device__ __forceinline__ float logsigmoid(float z) { return fminf(z, 0.f) - log1pf(__expf(-fabsf(z))); }
__device__ __forceinline__ float sigmoidf_(float z) { return 1.f / (1.f + __expf(-z)); }
#define LDS_WAIT() asm volatile("s_waitcnt lgkmcnt(0)" ::: "memory")
#define MFMA32(x, y, acc) __builtin_amdgcn_mfma_f32_16x16x32_bf16((x), (y), (acc), 0, 0, 0)
#define MFMA16(x, y, acc) __builtin_amdgcn_mfma_f32_16x16x16bf16_1k((x), (y), (acc), 0, 0, 0)

__device__ __forceinline__ void transpose_item(const float* __restrict__ W, int ldw, int K, const float* __restrict__ gk, float cs,
                                               bf16_t* WT, int row_off, int k0, int n0, float* scr, int lane) {
    {
        const int kr = lane >> 3, n4 = (lane & 7) * 4;
        f32x4 wv[8];
#pragma unroll
        for (int i = 0; i < 8; ++i) wv[i] = *(const f32x4*)(W + (size_t)(k0 + kr + 8 * i) * ldw + n0 + n4);
#pragma unroll
        for (int i = 0; i < 8; ++i) {
            const int kk = kr + 8 * i;
            const float g = gk ? gk[k0 + kk] * cs : cs;
            float* d = scr + kk * 33 + n4;
            d[0] = wv[i].x * g; d[1] = wv[i].y * g; d[2] = wv[i].z * g; d[3] = wv[i].w * g;
        }
    }
    LDS_WAIT();
    const int c = lane & 7;
#pragma unroll
    for (int j = 0; j < 4; ++j) {
        const int n = (lane >> 3) + 8 * j; const float* s = scr + (8 * c) * 33 + n;
        u32x4 o; o.x = cvt_pk_bf16(s[0 * 33], s[1 * 33]); o.y = cvt_pk_bf16(s[2 * 33], s[3 * 33]); o.z = cvt_pk_bf16(s[4 * 33], s[5 * 33]); o.w = cvt_pk_bf16(s[6 * 33], s[7 * 33]);
        *(u32x4*)(WT + (size_t)(row_off + n0 + n) * K + k0 + 8 * c) = o;
    }
    LDS_WAIT();
}

__device__ __forceinline__ void p0_prologue(const Params& p, unsigned char* lds, int bid, int G) {
    const int tid = threadIdx.x, lane = tid & 63, wid = tid >> 6;
    unsigned char* ws = p.ws;
    float* scr = (float*)(lds + wid * 8448);
    float* wif = (float*)(lds + 73728);
    for (int k = tid; k < 1024; k += NTHREADS) {
        const float g = p.ml_norm_g[k];
        const f32x4 a = *(const f32x4*)(p.ml_w_in + (size_t)k * LDW_IN + 3072), b = *(const f32x4*)(p.ml_w_in + (size_t)k * LDW_IN + 3076);
        wif[0 * 1024 + k] = a.x * g; wif[1 * 1024 + k] = a.y * g; wif[2 * 1024 + k] = a.z * g; wif[3 * 1024 + k] = a.w * g;
        wif[4 * 1024 + k] = b.x * g; wif[5 * 1024 + k] = b.y * g; wif[6 * 1024 + k] = b.z * g; wif[7 * 1024 + k] = b.w * g;
    }
    { float* ss = (float*)(ws + WS_SS); for (int i = bid * NTHREADS + tid; i < 3 * T; i += G * NTHREADS) ss[i] = 0.f; }
    __syncthreads();
    const int gw = bid * 8 + wid, NGW = G * 8;
    constexpr int I_IN = 16 * 96, I_SQ = 16 * 32, I_1 = 16 * 128, I_2 = 64 * 32, I_KV = 16 * 16;
    constexpr int NITEMS = I_IN + I_SQ + I_1 + I_2 + I_KV + I_SQ;
    for (int it = gw; it < NITEMS; it += NGW) {
        int r = it;
        if (r < I_IN) { const int kb = r / 96, nb = r % 96, n0 = nb * 32; const float cs = (n0 >= 512 && n0 < 1024) ? 0.08838834764831845f : 1.f;
            transpose_item(p.ml_w_in, LDW_IN, 1024, p.ml_norm_g, cs, (bf16_t*)(ws + WS_WIN), 0, kb * 64, n0, scr, lane); continue; } r -= I_IN;
        if (r < I_SQ) { transpose_item(p.ml_w_out, 1024, 1024, nullptr, 1.f, (bf16_t*)(ws + WS_WOUT), 0, (r / 32) * 64, (r % 32) * 32, scr, lane); continue; } r -= I_SQ;
        if (r < I_1) { transpose_item(p.mlp_w1, 4096, 1024, p.mlp_norm_g, 1.f, (bf16_t*)(ws + WS_W1A), 0, (r / 128) * 64, (r % 128) * 32, scr, lane); continue; } r -= I_1;
        if (r < I_2) { transpose_item(p.mlp_w2, 1024, 4096, nullptr, 1.f, (bf16_t*)(ws + WS_W2A), 0, (r / 32) * 64, (r % 32) * 32, scr, lane); continue; } r -= I_2;
        if (r < I_KV) { transpose_item(p.w_kv, 512, 1024, p.kv_norm_g, 1.f, (bf16_t*)(ws + WS_WKVQ), 0, (r / 16) * 64, (r % 16) * 32, scr, lane); continue; } r -= I_KV;
        transpose_item(p.att_w_q, 1024, 1024, p.att_norm_g, 1.f, (bf16_t*)(ws + WS_WKVQ), 512, (r / 32) * 64, (r % 32) * 32, scr, lane);
    }
    bf16_t* XB = (bf16_t*)(ws + WS_XB); float* gates = (float*)(ws + WS_GATES);
    for (int m = gw; m < T; m += NGW) {
        const float* xrow = m < TP ? p.x_prompt + (size_t)m * D : p.x_sample + (size_t)(m - TP) * D;
        f32x4 v[4]; float s = 0.f;
#pragma unroll
        for (int j = 0; j < 4; ++j) { v[j] = *(const f32x4*)(xrow + 4 * lane + 256 * j); s += (v[j].x * v[j].x + v[j].y * v[j].y) + (v[j].z * v[j].z + v[j].w * v[j].w); }
        const float rstd = rsqrtf(wave_sum(s) * (1.f / D) + EPS);
        if (m >= TP) {
#pragma unroll
            for (int j = 0; j < 4; ++j) *(f32x4*)(p.out + O_Y + (size_t)m * D + 4 * lane + 256 * j) = v[j];
        }
#pragma unroll
        for (int j = 0; j < 4; ++j) { u32x2 w; w.x = cvt_pk_bf16(v[j].x * rstd, v[j].y * rstd); w.y = cvt_pk_bf16(v[j].z * rstd, v[j].w * rstd); *(u32x2*)(XB + (size_t)m * D + 4 * lane + 256 * j) = w; }
        float mine = 0.f;
#pragma unroll
        for (int g = 0; g < 8; ++g) {
            float a = 0.f;
#pragma unroll
            for (int j = 0; j < 4; ++j) { const f32x4 w = *(const f32x4*)(wif + g * 1024 + 4 * lane + 256 * j); a += (v[j].x * w.x + v[j].y * w.y) + (v[j].z * w.z + v[j].w * w.w); }
            a = wave_sum(a) * rstd;
            if (lane == g) mine = a;
        }
        if (lane < 4) gates[(size_t)m * 8 + lane] = softcap15(mine + p.ml_b_i[lane]);
        else if (lane < 8) gates[(size_t)m * 8 + lane] = logsigmoid(softcap15(mine + p.ml_b_f[lane - 4]));
    }
}

__device__ __forceinline__ void late_weights(const Params& p, unsigned char* lds, int slot, int nslots) {
    const int tid = threadIdx.x, lane = tid & 63, wid = tid >> 6;
    unsigned char* ws = p.ws;
    float* scr = (float*)(lds + wid * 8448);
    constexpr int I_SQ = 16 * 32, I_1 = 16 * 128, I_2 = 64 * 32, NIT = I_SQ + I_1 + I_2;
    for (int it = slot * 8 + wid; it < NIT; it += nslots * 8) {
        int r = it;
        if (r < I_SQ) { transpose_item(p.att_w_o, 1024, 1024, nullptr, 1.f, (bf16_t*)(ws + WS_WO), 0, (r / 32) * 64, (r % 32) * 32, scr, lane); continue; } r -= I_SQ;
        if (r < I_1) { transpose_item(p.mlp_w1 + (size_t)1024 * 4096, 4096, 1024, p.mlp_norm_g + 1024, 1.f, (bf16_t*)(ws + WS_W1B), 0, (r / 128) * 64, (r % 128) * 32, scr, lane); continue; } r -= I_1;
        transpose_item(p.mlp_w2 + (size_t)4096 * 1024, 1024, 4096, nullptr, 1.f, (bf16_t*)(ws + WS_W2B), 0, (r / 32) * 64, (r % 32) * 32, scr, lane);
    }
}

struct EpiBf16 {
    bf16_t* out; int ld; const float* ss; int act;
    template <int NQ, bool PAIRED> __device__ __forceinline__ void row(int r, const int (&c)[NQ], const f32x4 (&v)[NQ], int fq, float rscale) const {
        float sc = rscale; if (ss) sc = rsqrtf(ss[r] * (1.f / 1024.f) + EPS);
        u32x2 w[NQ];
#pragma unroll
        for (int q = 0; q < NQ; ++q) {
            f32x4 x = v[q] * sc;
            if (act) { x.x = fmaxf(x.x, 0.f); x.y = fmaxf(x.y, 0.f); x.z = fmaxf(x.z, 0.f); x.w = fmaxf(x.w, 0.f); x = x * x; }
            w[q].x = cvt_pk_bf16(x.x, x.y); w[q].y = cvt_pk_bf16(x.z, x.w);
        }
        if (PAIRED) {
#pragma unroll
            for (int q = 0; q < NQ; q += 2) { u32x4 o; o.x = w[q].x; o.y = w[q].y; o.z = w[q + 1].x; o.w = w[q + 1].y; *(u32x4*)(out + (size_t)r * ld + c[q]) = o; }
        } else {
#pragma unroll
            for (int q = 0; q < NQ; ++q) *(u32x2*)(out + (size_t)r * ld + c[q]) = w[q];
        }
    }
};
struct EpiRes {
    const float* srcp; const float* srcs; float* dst; bf16_t* xb; float* ss;
    template <int NQ, bool PAIRED> __device__ __forceinline__ void row(int r, const int (&c)[NQ], const f32x4 (&v)[NQ], int fq, float rscale) const {
        const float* s = r < TP ? srcp + (size_t)r * D : srcs + (size_t)(r - TP) * D;
        float a2 = 0.f;
        u32x2 w[NQ];
#pragma unroll
        for (int q = 0; q < NQ; ++q) {
            const f32x4 o = *(const f32x4*)(s + c[q]) + v[q];
            *(f32x4*)(dst + (size_t)r * D + c[q]) = o;
            w[q].x = cvt_pk_bf16(o.x, o.y); w[q].y = cvt_pk_bf16(o.z, o.w);
            a2 += (o.x * o.x + o.y * o.y) + (o.z * o.z + o.w * o.w);
        }
        if (xb) {
            if (PAIRED) {
#pragma unroll
                for (int q = 0; q < NQ; q += 2) { u32x4 o; o.x = w[q].x; o.y = w[q].y; o.z = w[q + 1].x; o.w = w[q + 1].y; *(u32x4*)(xb + (size_t)r * D + c[q]) = o; }
            } else {
#pragma unroll
                for (int q = 0; q < NQ; ++q) *(u32x2*)(xb + (size_t)r * D + c[q]) = w[q];
            }
        }
        if (ss) { a2 += __shfl_xor(a2, 16); a2 += __shfl_xor(a2, 32); if (fq == 0) atomicAdd(ss + r, a2); }
    }
};

namespace pg8 {
#define PG8_LAS __attribute__((address_space(3)))
typedef unsigned short bf16_t;
typedef short bf16x8 __attribute__((ext_vector_type(8)));
typedef float f32x4 __attribute__((ext_vector_type(4)));
typedef unsigned u32x4 __attribute__((ext_vector_type(4)));
constexpr int BM = 256, BK = 64, HALF = 128, HTB = HALF * BK * 2  , STAGE_BYTES = 8 * HTB, NXCD = 8, WGM = 8;

__host__ __device__ __forceinline__ int lds_byte(int r, int c) { const int st = (r >> 4) * 2 + (c >> 5), rr = r & 15, cc = c & 31, ob = rr * 64 + cc * 2; return st * 1024 + (ob ^ (((ob >> 9) & 1) << 5)); }
__host__ __device__ __forceinline__ void stage_rc(int b, int& R, int& C) { const int st = b / 1024, sb = b % 1024, swz = sb ^ (((sb >> 9) & 1) << 5); R = (st >> 1) * 16 + swz / 64; C = (st & 1) * 32 + (swz % 64) / 2; }
__host__ __device__ __forceinline__ int perm32(int rho) { const int n = rho >> 4, i = rho & 15; return 8 * (i >> 2) + 4 * n + (i & 3); }

struct Unit { int pm, pn; };
struct Gemm { const bf16_t* A; const bf16_t* Bt; int M, N, K; int revk; };

struct StaticOrder {
    int nM, nN, nwg, G, c;
    __host__ __device__ void init(int M, int N, int G_, int c_) { nM = M / BM; nN = N / BM; nwg = nM * nN; G = G_; c = c_; }
    __host__ __device__ bool next(int i, Unit& u) const {
        const long L = (long)i * G + c; if (L >= nwg) return false;
        int wgid = (int)L; { const int q = nwg / NXCD, r = nwg % NXCD, xcd = wgid % NXCD, off = wgid / NXCD; wgid = (xcd < r ? xcd * (q + 1) : r * (q + 1) + (xcd - r) * q) + off; }
        const int nig = WGM * nN, gid = wgid / nig, fm = gid * WGM, gsz = (nM - fm) < WGM ? (nM - fm) : WGM;
        u.pm = fm + ((wgid % nig) % gsz); u.pn = (wgid % nig) / gsz; return true;
    }
    __device__ __forceinline__ void a_ready(const Unit&) const {}
    __device__ __forceinline__ void done(const Unit&) const {}
};


template <class Epi, class Sched, bool ALIGN_EPI = false, bool SP2 = false>
__device__ __forceinline__ void gemm_phase(PG8_LAS unsigned char* lds, const Gemm g, const Sched& S, const Epi& E) {
    const int tid = threadIdx.x, wid = __builtin_amdgcn_readfirstlane(tid >> 6), lane = tid & 63, wr = wid >> 2, wc = wid & 3, fr = lane & 15, fq = lane >> 4;
    const int K = g.K, nt = K / BK;
    unsigned voffA[2], voffB[2];
#pragma unroll
    for (int i = 0; i < 2; ++i) { int R, C; stage_rc(tid * 16 + i * 8192, R, C); const int Rb = Epi::PERM ? ((R & ~31) + perm32(R & 31)) : R;
        voffA[i] = (unsigned)(R * K + C) * 2u; voffB[i] = (unsigned)(Rb * K + C) * 2u; }
    const size_t kstep = g.revk ? (size_t)0 - (size_t)(BK * 2) : (size_t)(BK * 2);
    const size_t koff = g.revk ? (size_t)(K - BK) * 2 : (size_t)0;
    const size_t hstep = (size_t)HALF * K * 2;
    const size_t tstep = 2 * hstep;
    const unsigned ldsw = (unsigned)wid * 1024u;
    const int aoff = lds_byte(wr * 64 + fr, fq * 8), boff = lds_byte(wc * 32 + fr, fq * 8);
#define PG8_SA(b, h) (((b) * 2 + (h)) * HTB)
#define PG8_SB(b, h) ((4 + (b) * 2 + (h)) * HTB)
#define PG8_STAGE(bufoff, gbase, voff) do { _Pragma("unroll") for (int _i = 0; _i < 2; ++_i) \
        __builtin_amdgcn_global_load_lds((const unsigned*)((const char*)(gbase) + (voff)[_i]), (PG8_LAS unsigned*)(lds + (bufoff) + ldsw + _i * 8192), 16, 0, 0); } while (0)
#define PG8_LDA(dst, b, h) do { _Pragma("unroll") for (int m = 0; m < 4; ++m) _Pragma("unroll") for (int k = 0; k < 2; ++k) dst[m][k] = *(const PG8_LAS bf16x8*)(lds + PG8_SA(b, h) + aoff + m * 2048 + k * 1024); } while (0)
#define PG8_LDB(dst, b, h) do { _Pragma("unroll") for (int n = 0; n < 2; ++n) _Pragma("unroll") for (int k = 0; k < 2; ++k) dst[n][k] = *(const PG8_LAS bf16x8*)(lds + PG8_SB(b, h) + boff + n * 2048 + k * 1024); } while (0)
#define PG8_MMA(ai, bj, At, Bt) do { __builtin_amdgcn_s_setprio(1); _Pragma("unroll") for (int m = 0; m < 4; ++m) _Pragma("unroll") for (int n = 0; n < 2; ++n) _Pragma("unroll") for (int k = 0; k < 2; ++k) \
        acc[ai][bj][m][n] = __builtin_amdgcn_mfma_f32_16x16x32_bf16(Bt[n][k], At[m][k], acc[ai][bj][m][n], 0, 0, 0); __builtin_amdgcn_s_setprio(0); } while (0)
#define PG8_WAIT_V(n) asm volatile("s_waitcnt vmcnt(" #n ")" ::: "memory")
#define PG8_WAIT_L(n) asm volatile("s_waitcnt lgkmcnt(" #n ")" ::: "memory")
#define PG8_BAR __builtin_amdgcn_s_barrier()
#define PG8_SCHED __builtin_amdgcn_sched_barrier(0)
    Unit cur, nxt; int ui = 0;
    if (!S.next(0, cur)) return;
    f32x4 acc[2][2][4][2];
#pragma unroll
    for (int a = 0; a < 2; ++a)
#pragma unroll
        for (int b = 0; b < 2; ++b)
#pragma unroll
            for (int m = 0; m < 4; ++m)
#pragma unroll
                for (int n = 0; n < 2; ++n) acc[a][b][m][n] = (f32x4){0.f, 0.f, 0.f, 0.f};
    bf16x8 At[4][2], B0[2][2], B1[2][2];
    const char* cA = (const char*)g.A + (size_t)cur.pm * tstep + koff; const char* cB = (const char*)g.Bt + (size_t)cur.pn * tstep + koff;
    S.a_ready(cur);
    if constexpr (SP2) {
        PG8_STAGE(PG8_SB(0, 0), cB, voffB); PG8_STAGE(PG8_SB(0, 1), cB + hstep, voffB); PG8_STAGE(PG8_SA(0, 0), cA, voffA); PG8_STAGE(PG8_SA(0, 1), cA + hstep, voffA);
        if (wr == 1) PG8_BAR;
        PG8_WAIT_V(2); PG8_BAR;
        PG8_STAGE(PG8_SB(1, 0), cB + kstep, voffB); PG8_STAGE(PG8_SA(1, 0), cA + kstep, voffA); PG8_STAGE(PG8_SB(1, 1), cB + hstep + kstep, voffB);
        PG8_WAIT_V(6); PG8_BAR;
    } else {
        PG8_STAGE(PG8_SB(0, 0), cB, voffB); PG8_STAGE(PG8_SA(0, 0), cA, voffA); PG8_STAGE(PG8_SB(0, 1), cB + hstep, voffB); PG8_STAGE(PG8_SA(0, 1), cA + hstep, voffA);
        if (wr == 1) PG8_BAR;
        PG8_WAIT_V(4); PG8_BAR;
        PG8_STAGE(PG8_SB(1, 0), cB + kstep, voffB); PG8_STAGE(PG8_SA(1, 0), cA + kstep, voffA); PG8_STAGE(PG8_SB(1, 1), cB + hstep + kstep, voffB);
        PG8_WAIT_V(6); PG8_BAR;
    }
    for (;;) {
        const bool has_next = S.next(ui + 1, nxt);
        const char* nA = has_next ? (const char*)g.A + (size_t)nxt.pm * tstep + koff : cA; const char* nB = has_next ? (const char*)g.Bt + (size_t)nxt.pn * tstep + koff : cB;
        for (int t = 0; t < nt; t += 2) {
            const bool last = (t == nt - 2);
            const char* a1 = cA + (size_t)(t + 1) * kstep;
            const char* a2 = last ? nA : cA + (size_t)(t + 2) * kstep; const char* b2 = last ? nB : cB + (size_t)(t + 2) * kstep;
            const char* a3 = a2 + kstep; const char* b3 = b2 + kstep;
            if (last && has_next) S.a_ready(nxt);
            if constexpr (SP2) {
            PG8_LDB(B0, 0, 0); PG8_LDB(B1, 0, 1); PG8_SCHED; PG8_LDA(At, 0, 0); PG8_STAGE(PG8_SA(1, 1), a1 + hstep, voffA);
            PG8_WAIT_V(8); PG8_WAIT_L(0); PG8_BAR; PG8_MMA(0, 0, At, B0); PG8_MMA(0, 1, At, B1); PG8_BAR; PG8_SCHED;
            PG8_LDA(At, 0, 1); PG8_STAGE(PG8_SB(0, 0), b2, voffB); PG8_STAGE(PG8_SB(0, 1), b2 + hstep, voffB); PG8_STAGE(PG8_SA(0, 0), a2, voffA);
            PG8_WAIT_V(8); PG8_WAIT_L(0); PG8_BAR; PG8_MMA(1, 0, At, B0); PG8_MMA(1, 1, At, B1); PG8_BAR; PG8_SCHED;
            PG8_LDB(B0, 1, 0); PG8_LDB(B1, 1, 1); PG8_SCHED; PG8_LDA(At, 1, 0); PG8_STAGE(PG8_SA(0, 1), a2 + hstep, voffA);
            PG8_WAIT_V(8); PG8_WAIT_L(0); PG8_BAR; PG8_MMA(0, 0, At, B0); PG8_MMA(0, 1, At, B1); PG8_BAR; PG8_SCHED;
            PG8_LDA(At, 1, 1); PG8_STAGE(PG8_SB(1, 0), b3, voffB); PG8_STAGE(PG8_SB(1, 1), b3 + hstep, voffB); PG8_STAGE(PG8_SA(1, 0), a3, voffA);
            PG8_WAIT_V(8); PG8_WAIT_L(0); PG8_BAR; PG8_MMA(1, 0, At, B0); PG8_MMA(1, 1, At, B1); PG8_BAR; PG8_SCHED;
            } else {
            PG8_LDB(B0, 0, 0); PG8_SCHED; PG8_LDA(At, 0, 0); PG8_STAGE(PG8_SA(1, 1), a1 + hstep, voffA);
            PG8_WAIT_L(8); PG8_BAR; PG8_WAIT_L(0); PG8_MMA(0, 0, At, B0); PG8_BAR; PG8_SCHED;
            PG8_LDB(B1, 0, 1); PG8_STAGE(PG8_SB(0, 0), b2, voffB);
            PG8_BAR; PG8_WAIT_L(0); PG8_MMA(0, 1, At, B1); PG8_BAR;
            PG8_LDA(At, 0, 1); PG8_STAGE(PG8_SA(0, 0), a2, voffA);
            PG8_BAR; PG8_WAIT_L(0); PG8_MMA(1, 0, At, B0); PG8_BAR; PG8_SCHED;
            PG8_STAGE(PG8_SB(0, 1), b2 + hstep, voffB);
            PG8_WAIT_V(6); PG8_BAR; PG8_MMA(1, 1, At, B1); PG8_BAR;
            PG8_LDB(B0, 1, 0); PG8_SCHED; PG8_LDA(At, 1, 0); PG8_STAGE(PG8_SA(0, 1), a2 + hstep, voffA);
            PG8_WAIT_L(8); PG8_BAR; PG8_WAIT_L(0); PG8_MMA(0, 0, At, B0); PG8_BAR; PG8_SCHED;
            PG8_LDB(B1, 1, 1); PG8_STAGE(PG8_SB(1, 0), b3, voffB);
            PG8_BAR; PG8_WAIT_L(0); PG8_MMA(0, 1, At, B1); PG8_BAR;
            PG8_LDA(At, 1, 1); PG8_STAGE(PG8_SA(1, 0), a3, voffA);
            PG8_BAR; PG8_WAIT_L(0); PG8_MMA(1, 0, At, B0); PG8_BAR; PG8_SCHED;
            PG8_STAGE(PG8_SB(1, 1), b3 + hstep, voffB);
            PG8_WAIT_V(6); PG8_BAR; PG8_MMA(1, 1, At, B1); PG8_BAR;
            }
        }
        if constexpr (ALIGN_EPI) { if (wr == 0) PG8_BAR; }
        if constexpr (!Epi::AFTER_DRAIN) { E(acc, cur, wr, wc, fr, fq); S.done(cur); }
        if (!has_next) break;
#pragma unroll
        for (int a = 0; a < 2; ++a)
#pragma unroll
            for (int b = 0; b < 2; ++b)
#pragma unroll
                for (int m = 0; m < 4; ++m)
#pragma unroll
                    for (int n = 0; n < 2; ++n) acc[a][b][m][n] = (f32x4){0.f, 0.f, 0.f, 0.f};
        cur = nxt; cA = nA; cB = nB; ++ui;
        if constexpr (ALIGN_EPI) { if (wr == 1) PG8_BAR; }
    }
    PG8_WAIT_V(0);
    if constexpr (!ALIGN_EPI) { if (wr == 0) PG8_BAR; }
    PG8_BAR;
    if constexpr (Epi::AFTER_DRAIN) { E.fused(acc, cur, wr, wc, fr, fq, lds, wid, lane); S.done(cur); }
#undef PG8_SA
#undef PG8_SB
#undef PG8_STAGE
#undef PG8_LDA
#undef PG8_LDB
#undef PG8_MMA
#undef PG8_WAIT_V
#undef PG8_WAIT_L
#undef PG8_BAR
#undef PG8_SCHED
}
}


template <class Inner> struct Pg8Epi {
    static constexpr bool PERM = true, AFTER_DRAIN = false;
    Inner in;
    __device__ __forceinline__ void operator()(const f32x4 (&acc)[2][2][4][2], const pg8::Unit& u, int wr, int wc, int fr, int fq) const {
#pragma unroll
        for (int ai = 0; ai < 2; ++ai)
#pragma unroll
            for (int m = 0; m < 4; ++m) {
                const int r = u.pm * 256 + ai * 128 + wr * 64 + m * 16 + fr;
                const int c0 = u.pn * 256 + wc * 32 + 8 * fq;
                const int cols[4] = {c0, c0 + 4, c0 + 128, c0 + 132};
                const f32x4 vv[4] = {acc[ai][0][m][0], acc[ai][0][m][1], acc[ai][1][m][0], acc[ai][1][m][1]};
                in.template row<4, true>(r, cols, vv, fq, 1.f);
            }
    }
};
struct EpiResB {
    const float* srcf; bf16_t* xb; float* dstf; float* ss;
    template <int NQ, bool PAIRED> __device__ __forceinline__ void row(int r, const int (&c)[NQ], const f32x4 (&v)[NQ], int fq, float rscale) const {
        static_assert(PAIRED && NQ % 2 == 0, "EpiResB: paired quads only");
        float a2 = 0.f;
#pragma unroll
        for (int q = 0; q < NQ; q += 2) {
            f32x4 s0, s1;
            if (srcf) { s0 = *(const f32x4*)(srcf + (size_t)r * D + c[q]); s1 = *(const f32x4*)(srcf + (size_t)r * D + c[q] + 4); }
            else { const u32x4 xr = *(const u32x4*)(xb + (size_t)r * D + c[q]); s0 = (f32x4){bflo(xr.x), bfhi(xr.x), bflo(xr.y), bfhi(xr.y)}; s1 = (f32x4){bflo(xr.z), bfhi(xr.z), bflo(xr.w), bfhi(xr.w)}; }
            const f32x4 o0 = s0 + v[q], o1 = s1 + v[q + 1];
            if (dstf) { *(f32x4*)(dstf + (size_t)r * D + c[q]) = o0; *(f32x4*)(dstf + (size_t)r * D + c[q] + 4) = o1; }
            else {
                u32x4 w; w.x = cvt_pk_bf16(o0.x, o0.y); w.y = cvt_pk_bf16(o0.z, o0.w); w.z = cvt_pk_bf16(o1.x, o1.y); w.w = cvt_pk_bf16(o1.z, o1.w);
                *(u32x4*)(xb + (size_t)r * D + c[q]) = w;
                a2 += (o0.x * o0.x + o0.y * o0.y) + (o0.z * o0.z + o0.w * o0.w) + (o1.x * o1.x + o1.y * o1.y) + (o1.z * o1.z + o1.w * o1.w);
            }
        }
        if (ss) { a2 += __shfl_xor(a2, 16); a2 += __shfl_xor(a2, 32); if (fq == 0) atomicAdd(ss + r, a2); }
    }
};
struct EpiAddF32 {
    float* dst;
    template <int NQ, bool PAIRED> __device__ __forceinline__ void row(int r, const int (&c)[NQ], const f32x4 (&v)[NQ], int fq, float rscale) const {
#pragma unroll
        for (int q = 0; q < NQ; ++q) { f32x4* d = (f32x4*)(dst + (size_t)r * D + c[q]); *d = *d + v[q]; }
    }
};
struct EpiAtomic {
    float* dst;
    template <int NQ, bool PAIRED> __device__ __forceinline__ void row(int r, const int (&c)[NQ], const f32x4 (&v)[NQ], int fq, float rscale) const {
#pragma unroll
        for (int q = 0; q < NQ; ++q) { float* d = dst + (size_t)r * D + c[q]; atomicAdd(d, v[q].x); atomicAdd(d + 1, v[q].y); atomicAdd(d + 2, v[q].z); atomicAdd(d + 3, v[q].w); }
    }
};

template <int AF32, class Epi>
__device__ __forceinline__ void sgemm64(unsigned char* lds, const void* Av, int lda, const bf16_t* __restrict__ Bt, int row0, int nrows, int N, int K, int ksplit,
                                        const Epi& E, int bid, int G) {
    const int tid = threadIdx.x, lane = tid & 63, wid = tid >> 6, wr = wid >> 2, wc = wid & 3, fr = lane & 15, fq = lane >> 4;
    const int nN = N / 128, nT = (nrows / 64) * nN, nU = nT * ksplit, Ksl = K / ksplit, nk = Ksl / 128;
    constexpr int LS = 136;
    bf16_t* As = (bf16_t*)lds;
    bf16_t* Bs = As + 2 * 64 * LS;
    float* rs = (float*)(Bs + 2 * 128 * LS);
    const int arow = tid >> 3, ak = (tid & 7) * 8;
    for (int u = bid; u < nU; u += G) {
        const int ks = u / nT, t = u % nT, pm = t / nN, pn = t % nN, k0 = ks * Ksl;
        const bf16_t* Ab = (const bf16_t*)Av + (size_t)(row0 + pm * 64 + arow) * lda + k0 + ak;
        const float* Af = (const float*)Av + (size_t)(row0 + pm * 64 + arow) * lda + k0 + ak;
        const bf16_t* Bg = Bt + (size_t)(pn * 128 + arow) * K + k0 + ak;
        f32x4 acc[2][2];
#pragma unroll
        for (int m = 0; m < 2; ++m)
#pragma unroll
            for (int n = 0; n < 2; ++n) acc[m][n] = (f32x4){0.f, 0.f, 0.f, 0.f};
        float ssq = 0.f;
        u32x4 ra[2], rb[2][2];
        auto loadAB = [&](int kt) {
#pragma unroll
            for (int h = 0; h < 2; ++h) {
                if (AF32) { const f32x4 a = *(const f32x4*)(Af + kt * 128 + 64 * h), b = *(const f32x4*)(Af + kt * 128 + 64 * h + 4);
                    ssq += (a.x * a.x + a.y * a.y) + (a.z * a.z + a.w * a.w) + (b.x * b.x + b.y * b.y) + (b.z * b.z + b.w * b.w);
                    ra[h].x = cvt_pk_bf16(a.x, a.y); ra[h].y = cvt_pk_bf16(a.z, a.w); ra[h].z = cvt_pk_bf16(b.x, b.y); ra[h].w = cvt_pk_bf16(b.z, b.w); }
                else ra[h] = *(const u32x4*)(Ab + kt * 128 + 64 * h);
#pragma unroll
                for (int i = 0; i < 2; ++i) rb[i][h] = *(const u32x4*)(Bg + (size_t)(64 * i) * K + kt * 128 + 64 * h);
            }
        };
        auto storeAB = [&](int buf) {
#pragma unroll
            for (int h = 0; h < 2; ++h) {
                *(u32x4*)(As + buf * 64 * LS + arow * LS + ak + 64 * h) = ra[h];
#pragma unroll
                for (int i = 0; i < 2; ++i) *(u32x4*)(Bs + buf * 128 * LS + (arow + 64 * i) * LS + ak + 64 * h) = rb[i][h];
            }
        };
        loadAB(0);
        storeAB(0);
        __syncthreads();
        for (int kt = 0; kt < nk; ++kt) {
            const int buf = kt & 1;
            if (kt + 1 < nk) loadAB(kt + 1);
            const bf16_t* as = As + buf * 64 * LS; const bf16_t* bs = Bs + buf * 128 * LS;
#pragma unroll
            for (int kk = 0; kk < 4; ++kk) {
                bf16x8 af[2], bfr[2];
#pragma unroll
                for (int m = 0; m < 2; ++m) af[m] = *(const bf16x8*)(as + (32 * wr + 16 * m + fr) * LS + 32 * kk + 8 * fq);
#pragma unroll
                for (int n = 0; n < 2; ++n) bfr[n] = *(const bf16x8*)(bs + (32 * wc + 16 * n + fr) * LS + 32 * kk + 8 * fq);
#pragma unroll
                for (int m = 0; m < 2; ++m)
#pragma unroll
                    for (int n = 0; n < 2; ++n) acc[m][n] = MFMA32(bfr[n], af[m], acc[m][n]);
            }
            if (kt + 1 < nk) storeAB(buf ^ 1);
            __syncthreads();
        }
        if (AF32) {
            ssq += __shfl_xor(ssq, 1); ssq += __shfl_xor(ssq, 2); ssq += __shfl_xor(ssq, 4);
            if ((tid & 7) == 0) rs[arow] = rsqrtf(ssq * (1.f / 1024.f) + EPS);
            __syncthreads();
        }
#pragma unroll
        for (int m = 0; m < 2; ++m) {
            const int lr = 32 * wr + 16 * m + fr, r = row0 + pm * 64 + lr;
            const int cols[2] = {pn * 128 + 32 * wc + 4 * fq, pn * 128 + 32 * wc + 16 + 4 * fq};
            const f32x4 vv[2] = {acc[m][0], acc[m][1]};
            E.template row<2, false>(r, cols, vv, fq, AF32 ? rs[lr] : 1.f);
        }
    }
}

template <class Epi>
__device__ __forceinline__ void sgemm_phase(unsigned char* lds, const bf16_t* __restrict__ A, const bf16_t* __restrict__ Bt, int row0, int nrows, int N, int K,
                                            const Epi& E, int bid, int G) {
    const int tid = threadIdx.x, lane = tid & 63, wid = tid >> 6, wr = wid >> 2, wc = wid & 3, fr = lane & 15, fq = lane >> 4;
    const int nN = N / 128, nU = (nrows / 128) * nN, nk = K / 64;
    bf16_t* As = (bf16_t*)lds;
    bf16_t* Bs = As + 2 * 128 * 72;
    const int ldrow = tid >> 3, ldk = (tid & 7) * 8;
    for (int u = bid; u < nU; u += G) {
        const int pm = u / nN, pn = u % nN;
        const bf16_t* Ag = A + (size_t)(row0 + pm * 128 + ldrow) * K + ldk;
        const bf16_t* Bg = Bt + (size_t)(pn * 128 + ldrow) * K + ldk;
        f32x4 acc[4][2];
#pragma unroll
        for (int m = 0; m < 4; ++m)
#pragma unroll
            for (int n = 0; n < 2; ++n) acc[m][n] = (f32x4){0.f, 0.f, 0.f, 0.f};
        u32x4 ra[2], rb[2];
#pragma unroll
        for (int i = 0; i < 2; ++i) { ra[i] = *(const u32x4*)(Ag + (size_t)(64 * i) * K); rb[i] = *(const u32x4*)(Bg + (size_t)(64 * i) * K); }
#pragma unroll
        for (int i = 0; i < 2; ++i) { *(u32x4*)(As + (ldrow + 64 * i) * 72 + ldk) = ra[i]; *(u32x4*)(Bs + (ldrow + 64 * i) * 72 + ldk) = rb[i]; }
        __syncthreads();
        for (int kt = 0; kt < nk; ++kt) {
            const int buf = kt & 1;
            if (kt + 1 < nk) {
#pragma unroll
                for (int i = 0; i < 2; ++i) { ra[i] = *(const u32x4*)(Ag + (size_t)(64 * i) * K + (kt + 1) * 64); rb[i] = *(const u32x4*)(Bg + (size_t)(64 * i) * K + (kt + 1) * 64); }
            }
            const bf16_t* as = As + buf * 128 * 72; const bf16_t* bs = Bs + buf * 128 * 72;
#pragma unroll
            for (int kk = 0; kk < 2; ++kk) {
                bf16x8 af[4], bfr[2];
#pragma unroll
                for (int m = 0; m < 4; ++m) af[m] = *(const bf16x8*)(as + (64 * wr + 16 * m + fr) * 72 + 32 * kk + 8 * fq);
#pragma unroll
                for (int n = 0; n < 2; ++n) bfr[n] = *(const bf16x8*)(bs + (32 * wc + 16 * n + fr) * 72 + 32 * kk + 8 * fq);
#pragma unroll
                for (int m = 0; m < 4; ++m)
#pragma unroll
                    for (int n = 0; n < 2; ++n) acc[m][n] = MFMA32(bfr[n], af[m], acc[m][n]);
            }
            if (kt + 1 < nk) {
                bf16_t* an = As + (buf ^ 1) * 128 * 72; bf16_t* bn = Bs + (buf ^ 1) * 128 * 72;
#pragma unroll
                for (int i = 0; i < 2; ++i) { *(u32x4*)(an + (ldrow + 64 * i) * 72 + ldk) = ra[i]; *(u32x4*)(bn + (ldrow + 64 * i) * 72 + ldk) = rb[i]; }
            }
            __syncthreads();
        }
#pragma unroll
        for (int m = 0; m < 4; ++m) {
            const int r = row0 + pm * 128 + 64 * wr + 16 * m + fr;
            const int cols[2] = {pn * 128 + 32 * wc + 4 * fq, pn * 128 + 32 * wc + 16 + 4 * fq};
            const f32x4 vv[2] = {acc[m][0], acc[m][1]};
            E.template row<2, false>(r, cols, vv, fq, 1.f);
        }
    }
}

__device__ __forceinline__ void mlstm_local_unit(const Params& p, unsigned char* lds, int u) {
    const int tid = threadIdx.x, lane = tid & 63, wid = tid >> 6, fr = lane & 15, fq = lane >> 4;
    const int bh = u >> 6, c = u & 63, b = bh >> 2, h = bh & 3, base = b * 4096 + c * 64;
    unsigned char* ws = p.ws;
    const bf16_t* P = (const bf16_t*)(ws + WS_P); const float* gates = (const float*)(ws + WS_GATES);
    bf16_t* GS = (bf16_t*)p.out;
    bf16_t* kT = (bf16_t*)lds;
    bf16_t* vT = kT + 128 * 72;
    float* wk = (float*)(vT + 256 * 72);
    if (wid == 0) {
        const float lf = gates[(size_t)(base + lane) * 8 + 4 + h], li = gates[(size_t)(base + lane) * 8 + h];
        const float bc = scan_sum(lf, lane);
        const float B = __shfl(bc, 63);
        const float val = B - bc + li;
        const float ml = wave_max(val);
        wk[lane] = __expf(val - ml);
        if (lane == 0) { ((float*)(ws + WS_CHB))[u] = B; ((float*)(ws + WS_CHM))[u] = ml; }
    }
    __syncthreads();
    {
        const bf16_t* Pk = P + (size_t)(base + lane) * NIN + 512 + h * 128;
#pragma unroll
        for (int i = 0; i < 2; ++i) {
            const int dch = wid * 2 + i; const u32x4 r = *(const u32x4*)(Pk + dch * 8);
            bf16_t* dst = kT + (dch * 8) * 72 + lane;
            dst[0 * 72] = (bf16_t)(r.x & 0xffff); dst[1 * 72] = (bf16_t)(r.x >> 16); dst[2 * 72] = (bf16_t)(r.y & 0xffff); dst[3 * 72] = (bf16_t)(r.y >> 16);
            dst[4 * 72] = (bf16_t)(r.z & 0xffff); dst[5 * 72] = (bf16_t)(r.z >> 16); dst[6 * 72] = (bf16_t)(r.w & 0xffff); dst[7 * 72] = (bf16_t)(r.w >> 16);
        }
        const bf16_t* Pv = P + (size_t)(base + lane) * NIN + 1024 + h * 256;
        const float w = wk[lane];
#pragma unroll
        for (int i = 0; i < 4; ++i) {
            const int vch = wid * 4 + i; const u32x4 r = *(const u32x4*)(Pv + vch * 8);
            bf16_t* dst = vT + (vch * 8) * 72 + lane;
            dst[0 * 72] = f2bf(bflo(r.x) * w); dst[1 * 72] = f2bf(bfhi(r.x) * w); dst[2 * 72] = f2bf(bflo(r.y) * w); dst[3 * 72] = f2bf(bfhi(r.y) * w);
            dst[4 * 72] = f2bf(bflo(r.z) * w); dst[5 * 72] = f2bf(bfhi(r.z) * w); dst[6 * 72] = f2bf(bflo(r.w) * w); dst[7 * 72] = f2bf(bfhi(r.w) * w);
        }
    }
    __syncthreads();
    {
        f32x4 acc[2][8];
#pragma unroll
        for (int a = 0; a < 2; ++a)
#pragma unroll
            for (int d = 0; d < 8; ++d) acc[a][d] = (f32x4){0.f, 0.f, 0.f, 0.f};
#pragma unroll
        for (int ks = 0; ks < 2; ++ks) {
            bf16x8 yf[2];
#pragma unroll
            for (int vt = 0; vt < 2; ++vt) yf[vt] = *(const bf16x8*)(vT + (32 * wid + 16 * vt + fr) * 72 + 32 * ks + 8 * fq);
#pragma unroll
            for (int dt = 0; dt < 8; ++dt) {
                const bf16x8 xf = *(const bf16x8*)(kT + (16 * dt + fr) * 72 + 32 * ks + 8 * fq);
#pragma unroll
                for (int vt = 0; vt < 2; ++vt) acc[vt][dt] = MFMA32(xf, yf[vt], acc[vt][dt]);
            }
        }
        bf16_t* G = GS + (size_t)u * 32768;
#pragma unroll
        for (int vt = 0; vt < 2; ++vt)
#pragma unroll
            for (int dt = 0; dt < 8; ++dt) {
                u32x2 w; w.x = cvt_pk_bf16(acc[vt][dt].x, acc[vt][dt].y); w.y = cvt_pk_bf16(acc[vt][dt].z, acc[vt][dt].w);
                *(u32x2*)(G + (32 * wid + 16 * vt + fr) * 128 + 16 * dt + 4 * fq) = w;
            }
    }
    if (tid < 128) {
        float s = 0.f;
#pragma unroll 8
        for (int ss = 0; ss < 64; ++ss) s += bf2f(kT[tid * 72 + ss]) * wk[ss];
        ((float*)(ws + WS_GN))[(size_t)u * 128 + tid] = s;
    }
    __syncthreads();
}

__device__ __forceinline__ void mlstm_sample_unit(const Params& p, unsigned char* lds, int u) {
    const int tid = threadIdx.x, lane = tid & 63, wid = tid >> 6;
    const int b = u >> 2, h = u & 3, base = TP + b * 4;
    unsigned char* ws = p.ws;
    const bf16_t* P = (const bf16_t*)(ws + WS_P); const float* gates = (const float*)(ws + WS_GATES);
    float* q = (float*)lds;
    float* k = q + 512;
    float* v = k + 512;
    float* n0 = v + 1024;
    float* sc = n0 + 128;
    float* red = sc + 64;
    const float* C0 = p.st_C + (size_t)u * 32768;
    float* Cout = p.out + O_SC + (size_t)u * 32768;
    {
        const int t = tid >> 7, d = tid & 127;
        q[tid] = bf2f(P[(size_t)(base + t) * NIN + h * 128 + d]);
        k[tid] = bf2f(P[(size_t)(base + t) * NIN + 512 + h * 128 + d]);
        const int t2 = tid >> 8, vv = tid & 255;
        v[tid] = bf2f(P[(size_t)(base + t2) * NIN + 1024 + h * 256 + vv]);
        v[512 + tid] = bf2f(P[(size_t)(base + 2 + t2) * NIN + 1024 + h * 256 + vv]);
        if (tid < 128) n0[tid] = p.st_n[(size_t)u * 128 + tid];
    }
    if (tid == 0) {
        float li[4], bc[4]; float run = 0.f;
#pragma unroll
        for (int t = 0; t < 4; ++t) { li[t] = gates[(size_t)(base + t) * 8 + h]; run += gates[(size_t)(base + t) * 8 + 4 + h]; bc[t] = run; }
        const float m0 = p.st_m[u]; float mt[4];
#pragma unroll
        for (int t = 0; t < 4; ++t) {
            const float inter = bc[t] + m0; float mx = inter;
#pragma unroll
            for (int s = 0; s < 4; ++s) if (s <= t) mx = fmaxf(mx, bc[t] - bc[s] + li[s]);
            mt[t] = mx; sc[16 + t] = __expf(inter - mx); sc[28 + t] = __expf(-mx);
#pragma unroll
            for (int s = 0; s < 4; ++s) sc[t * 4 + s] = (s <= t) ? __expf(bc[t] - bc[s] + li[s] - mx) : 0.f;
        }
        const float mn = mt[3];
        sc[24] = __expf(bc[3] + m0 - mn);
#pragma unroll
        for (int s = 0; s < 4; ++s) sc[20 + s] = __expf(bc[3] - bc[s] + li[s] - mn);
        p.out[O_SM + u] = mn;
    }
    __syncthreads();
#pragma unroll
    for (int i = 0; i < 2; ++i) {
        const int pr = wid * 2 + i, t = pr >> 2, s = pr & 3;
        float a = q[t * 128 + lane] * k[s * 128 + lane] + q[t * 128 + 64 + lane] * k[s * 128 + 64 + lane];
        a = wave_sum(a);
        if (lane == 0) sc[32 + pr] = a * sc[pr];
    }
    if (wid < 4) { float a = q[wid * 128 + lane] * n0[lane] + q[wid * 128 + 64 + lane] * n0[64 + lane]; a = wave_sum(a); if (lane == 0) sc[48 + wid] = a; }
    if (tid < 8) sc[52 + tid] = 0.f;
    {
        const int vq = lane, dg = wid;
        f32x4 qc[4];
#pragma unroll
        for (int t = 0; t < 4; ++t) qc[t] = (f32x4){0.f, 0.f, 0.f, 0.f};
        const float decay = sc[24];
        f32x4 vs[4];
#pragma unroll
        for (int s = 0; s < 4; ++s) vs[s] = *(const f32x4*)(v + s * 256 + 4 * vq) * sc[20 + s];
#pragma unroll 4
        for (int dd = 0; dd < 16; ++dd) {
            const int d = dg * 16 + dd;
            const f32x4 c0 = *(const f32x4*)(C0 + (size_t)d * 256 + 4 * vq);
            f32x4 cn = c0 * decay;
#pragma unroll
            for (int s = 0; s < 4; ++s) cn += vs[s] * k[s * 128 + d];
            *(f32x4*)(Cout + (size_t)d * 256 + 4 * vq) = cn;
#pragma unroll
            for (int t = 0; t < 4; ++t) qc[t] += c0 * q[t * 128 + d];
        }
#pragma unroll
        for (int t = 0; t < 4; ++t) *(f32x4*)(red + (dg * 4 + t) * 256 + 4 * vq) = qc[t];
    }
    if (tid < 128) {
        float nn = sc[24] * n0[tid];
#pragma unroll
        for (int s = 0; s < 4; ++s) nn += sc[20 + s] * k[s * 128 + tid];
        p.out[O_SN + (size_t)u * 128 + tid] = nn;
    }
    __syncthreads();
    {
        const int t = tid >> 7, v0 = (tid & 127) * 2;
        float den = sc[16 + t] * sc[48 + t];
#pragma unroll
        for (int s = 0; s < 4; ++s) den += sc[32 + t * 4 + s];
        const float inv = 1.f / fmaxf(fabsf(den), sc[28 + t]);
        float hv[2]; float ssq = 0.f;
#pragma unroll
        for (int j = 0; j < 2; ++j) {
            float qC = 0.f;
#pragma unroll
            for (int g = 0; g < 8; ++g) qC += red[(g * 4 + t) * 256 + v0 + j];
            float num = sc[16 + t] * qC;
#pragma unroll
            for (int s = 0; s < 4; ++s) num += sc[32 + t * 4 + s] * v[s * 256 + v0 + j];
            hv[j] = num * inv; ssq += hv[j] * hv[j];
        }
        ssq = wave_sum(ssq);
        if (lane == 0) sc[52 + wid] = ssq;
        __syncthreads();
        const float tot = sc[52 + 2 * t] + sc[52 + 2 * t + 1];
        const float rstd = rsqrtf(tot * (1.f / 256.f) + EPS);
        const unsigned ob = *(const unsigned*)(P + (size_t)(base + t) * NIN + 2048 + h * 256 + v0);
        const float o0 = sigmoidf_(bflo(ob)), o1 = sigmoidf_(bfhi(ob));
        const float g0 = p.ml_head_g[h * 256 + v0], g1 = p.ml_head_g[h * 256 + v0 + 1];
        bf16_t* HG = (bf16_t*)(ws + WS_HG);
        *(unsigned*)(HG + (size_t)(base + t) * D + h * 256 + v0) = cvt_pk_bf16(hv[0] * rstd * g0 * o0, hv[1] * rstd * g1 * o1);
    }
    __syncthreads();
}

__device__ __forceinline__ void mlstm_scan(const Params& p, unsigned char* lds, int bid, int G) {
    unsigned char* ws = p.ws;
    bf16_t* GS = (bf16_t*)p.out;
    const float* CHB = (const float*)(ws + WS_CHB); const float* CHM = (const float*)(ws + WS_CHM);
    float* MPREV = (float*)(ws + WS_MPREV); float* GN = (float*)(ws + WS_GN);
    const int tid = threadIdx.x;
    float* decs = (float*)lds;
    float* scls = decs + 64;
    float* tile = scls + 64;
    for (int blk = bid; blk < 256; blk += G) {
        const int bh = blk >> 4;
        if (tid < 64) {
            const float B = CHB[bh * 64 + tid], ml = CHM[bh * 64 + tid];
            float a = B, b2 = ml;
#pragma unroll
            for (int o = 1; o < 64; o <<= 1) { const float ya = __shfl_up(a, o), yb = __shfl_up(b2, o); if (tid >= o) { b2 = fmaxf(yb + a, b2); a = ya + a; } }
            const float m = fmaxf(a, b2);
            float mp = __shfl_up(m, 1); if (tid == 0) mp = 0.f;
            decs[tid] = __expf(B + mp - m); scls[tid] = __expf(ml - m);
            if ((blk & 15) == 0) { MPREV[bh * 64 + tid] = mp; if (tid == 63) p.out[O_PM + bh] = m; }
        }
        float gnv[64]; float* gp = GN + (size_t)(bh * 64) * 128 + (blk & 15) * 8 + (tid & 7);
        if (tid < 8) {
#pragma unroll
            for (int c = 0; c < 64; ++c) gnv[c] = gp[(size_t)c * 128];
        }
        __syncthreads();
        const int e4 = blk * NTHREADS + tid;
        const int off = (e4 & 8191) * 4;
        bf16_t* ptr = GS + (size_t)bh * 64 * 32768 + off;
        float c0 = 0.f, c1 = 0.f, c2 = 0.f, c3 = 0.f;
#pragma unroll 1
        for (int cb = 0; cb < 64; cb += 16) {
            u32x2 g[16];
#pragma unroll
            for (int j = 0; j < 16; ++j) g[j] = *(const u32x2*)(ptr + (size_t)(cb + j) * 32768);
#pragma unroll
            for (int j = 0; j < 16; ++j) {
                const float dec = decs[cb + j], s = scls[cb + j];
                u32x2 w; w.x = cvt_pk_bf16(c0, c1); w.y = cvt_pk_bf16(c2, c3);
                *(u32x2*)(ptr + (size_t)(cb + j) * 32768) = w;
                c0 = dec * c0 + s * bflo(g[j].x); c1 = dec * c1 + s * bfhi(g[j].x); c2 = dec * c2 + s * bflo(g[j].y); c3 = dec * c3 + s * bfhi(g[j].y);
            }
        }
        {
            const int vl = (off >> 7) & 15, d = off & 127;
            tile[(d + 0) * 20 + vl] = c0; tile[(d + 1) * 20 + vl] = c1; tile[(d + 2) * 20 + vl] = c2; tile[(d + 3) * 20 + vl] = c3;
            __syncthreads();
            const int dd = tid >> 2, vq = tid & 3, v0 = (blk & 15) * 16;
            const f32x4 o = (f32x4){tile[dd * 20 + 4 * vq], tile[dd * 20 + 4 * vq + 1], tile[dd * 20 + 4 * vq + 2], tile[dd * 20 + 4 * vq + 3]};
            *(f32x4*)(p.out + O_PC + (size_t)bh * 32768 + (size_t)dd * 256 + v0 + 4 * vq) = o;
        }
        if (tid < 8) {
            float n = 0.f;
#pragma unroll
            for (int c = 0; c < 64; ++c) { gp[(size_t)c * 128] = n; n = decs[c] * n + scls[c] * gnv[c]; }
            p.out[O_PN + bh * 128 + (blk & 15) * 8 + tid] = n;
        }
        __syncthreads();
    }
}

__device__ __forceinline__ void mlstm_out_unit(const Params& p, unsigned char* lds, int u) {
    const int tid = threadIdx.x, lane = tid & 63, wid = tid >> 6, fr = lane & 15, fq = lane >> 4;
    const int bh = u >> 6, c = u & 63, b = bh >> 2, h = bh & 3, base = b * 4096 + c * 64;
    unsigned char* ws = p.ws;
    const bf16_t* P = (const bf16_t*)(ws + WS_P); const float* gates = (const float*)(ws + WS_GATES);
    const bf16_t* CT = (const bf16_t*)p.out + (size_t)u * 32768;
    bf16_t* Qs = (bf16_t*)lds;
    bf16_t* Ks = Qs + 64 * 136;
    bf16_t* Ac = Ks + 64 * 136;
    bf16_t* VT = Ac + 64 * 200;
    float* sm = (float*)(VT + 256 * 72);
    float *bt = sm, *lmb = sm + 64, *mt = sm + 128, *at = sm + 192, *den = sm + 256, *hss = sm + 320, *npv = sm + 384;
    bf16x8 cf[2][4];
#pragma unroll
    for (int vt = 0; vt < 2; ++vt)
#pragma unroll
        for (int kd = 0; kd < 4; ++kd) cf[vt][kd] = *(const bf16x8*)(CT + (32 * wid + 16 * vt + fr) * 128 + 32 * kd + 8 * fq);
    if (wid == 0) {
        const float lf = gates[(size_t)(base + lane) * 8 + 4 + h], li = gates[(size_t)(base + lane) * 8 + h];
        const float bc = scan_sum(lf, lane);
        const float lm = li - bc;
        const float pm = scan_max(lm, lane);
        const float mprev = ((const float*)(ws + WS_MPREV))[u];
        const float inter = bc + mprev;
        const float m_t = fmaxf(inter, bc + pm);
        bt[lane] = bc; lmb[lane] = lm; mt[lane] = m_t; at[lane] = __expf(inter - m_t); den[lane] = 0.f; hss[lane] = 0.f;
    }
    if (wid == 1) { const float* NP = (const float*)(ws + WS_GN) + (size_t)u * 128; npv[lane] = NP[lane]; npv[64 + lane] = NP[64 + lane]; }
    __syncthreads();
#pragma unroll
    for (int i = 0; i < 2; ++i) {
        const int ci = tid + 512 * i, t = ci >> 4, dch = ci & 15;
        const u32x4 qv = *(const u32x4*)(P + (size_t)(base + t) * NIN + h * 128 + dch * 8);
        const u32x4 kv = *(const u32x4*)(P + (size_t)(base + t) * NIN + 512 + h * 128 + dch * 8);
        *(u32x4*)(Qs + t * 136 + dch * 8) = qv;
        *(u32x4*)(Ks + t * 136 + dch * 8) = kv;
        const float a = at[t];
        u32x4 sq; sq.x = cvt_pk_bf16(bflo(qv.x) * a, bfhi(qv.x) * a); sq.y = cvt_pk_bf16(bflo(qv.y) * a, bfhi(qv.y) * a);
        sq.z = cvt_pk_bf16(bflo(qv.z) * a, bfhi(qv.z) * a); sq.w = cvt_pk_bf16(bflo(qv.w) * a, bfhi(qv.w) * a);
        *(u32x4*)(Ac + t * 200 + 64 + dch * 8) = sq;
    }
    {
        const bf16_t* Pv = P + (size_t)(base + lane) * NIN + 1024 + h * 256;
#pragma unroll
        for (int i = 0; i < 4; ++i) {
            const int vch = wid * 4 + i; const u32x4 r = *(const u32x4*)(Pv + vch * 8);
            bf16_t* dst = VT + (vch * 8) * 72 + lane;
            dst[0 * 72] = (bf16_t)(r.x & 0xffff); dst[1 * 72] = (bf16_t)(r.x >> 16); dst[2 * 72] = (bf16_t)(r.y & 0xffff); dst[3 * 72] = (bf16_t)(r.y >> 16);
            dst[4 * 72] = (bf16_t)(r.z & 0xffff); dst[5 * 72] = (bf16_t)(r.z >> 16); dst[6 * 72] = (bf16_t)(r.w & 0xffff); dst[7 * 72] = (bf16_t)(r.w >> 16);
        }
    }
    __syncthreads();
    {
        const int tt = wid >> 1;
#pragma unroll
        for (int j = 0; j < 2; ++j) {
            const int st = 2 * (wid & 1) + j;
            const int t = 16 * tt + fr, s0 = 16 * st + 4 * fq;
            u32x2 w; w.x = 0u; w.y = 0u;
            if (st <= tt) {
                f32x4 a = (f32x4){0.f, 0.f, 0.f, 0.f};
#pragma unroll
                for (int kd = 0; kd < 4; ++kd) {
                    const bf16x8 x = *(const bf16x8*)(Ks + (16 * st + fr) * 136 + 32 * kd + 8 * fq);
                    const bf16x8 y = *(const bf16x8*)(Qs + (16 * tt + fr) * 136 + 32 * kd + 8 * fq);
                    a = MFMA32(x, y, a);
                }
                const float e0 = bt[t] - mt[t];
                float vals[4];
#pragma unroll
                for (int i = 0; i < 4; ++i) { const int s = s0 + i; vals[i] = (s <= t) ? a[i] * __expf(e0 + lmb[s]) : 0.f; }
                float rs = (vals[0] + vals[1]) + (vals[2] + vals[3]);
                rs += __shfl_xor(rs, 16); rs += __shfl_xor(rs, 32);
                if (fq == 0) atomicAdd(&den[t], rs);
                w.x = cvt_pk_bf16(vals[0], vals[1]); w.y = cvt_pk_bf16(vals[2], vals[3]);
            }
            *(u32x2*)(Ac + t * 200 + s0) = w;
        }
#pragma unroll
        for (int i = 0; i < 8; ++i) {
            const int t = 8 * wid + i;
            float a = bf2f(Qs[t * 136 + lane]) * npv[lane] + bf2f(Qs[t * 136 + 64 + lane]) * npv[64 + lane];
            a = wave_sum(a);
            if (lane == 0) atomicAdd(&den[t], at[t] * a);
        }
    }
    __syncthreads();
    f32x4 acc[4][2];
#pragma unroll
    for (int a = 0; a < 4; ++a)
#pragma unroll
        for (int d = 0; d < 2; ++d) acc[a][d] = (f32x4){0.f, 0.f, 0.f, 0.f};
#pragma unroll
    for (int kk = 0; kk < 6; ++kk) {
        bf16x8 x[2];
#pragma unroll
        for (int vt = 0; vt < 2; ++vt) x[vt] = (kk < 2) ? *(const bf16x8*)(VT + (32 * wid + 16 * vt + fr) * 72 + 32 * kk + 8 * fq) : cf[vt][kk >= 2 ? kk - 2 : 0];
#pragma unroll
        for (int tt = 0; tt < 4; ++tt) {
            const bf16x8 y = *(const bf16x8*)(Ac + (16 * tt + fr) * 200 + 32 * kk + 8 * fq);
#pragma unroll
            for (int vt = 0; vt < 2; ++vt) acc[tt][vt] = MFMA32(x[vt], y, acc[tt][vt]);
        }
    }
#pragma unroll
    for (int tt = 0; tt < 4; ++tt) {
        const int t = 16 * tt + fr;
        const float inv = 1.f / fmaxf(fabsf(den[t]), __expf(-mt[t]));
        float ssq = 0.f;
#pragma unroll
        for (int vt = 0; vt < 2; ++vt) { acc[tt][vt] = acc[tt][vt] * inv; const f32x4 a = acc[tt][vt]; ssq += (a.x * a.x + a.y * a.y) + (a.z * a.z + a.w * a.w); }
        ssq += __shfl_xor(ssq, 16); ssq += __shfl_xor(ssq, 32);
        if (fq == 0) atomicAdd(&hss[t], ssq);
    }
    __syncthreads();
    {
        bf16_t* HG = (bf16_t*)(ws + WS_HG);
#pragma unroll
        for (int tt = 0; tt < 4; ++tt) {
            const int t = 16 * tt + fr;
            const float rstd = rsqrtf(hss[t] * (1.f / 256.f) + EPS);
#pragma unroll
            for (int vt = 0; vt < 2; ++vt) {
                const int v0 = 32 * wid + 16 * vt + 4 * fq;
                const u32x2 ob = *(const u32x2*)(P + (size_t)(base + t) * NIN + 2048 + h * 256 + v0);
                const f32x4 g = *(const f32x4*)(p.ml_head_g + h * 256 + v0);
                const f32x4 a = acc[tt][vt];
                u32x2 w;
                w.x = cvt_pk_bf16(a.x * rstd * g.x * sigmoidf_(bflo(ob.x)), a.y * rstd * g.y * sigmoidf_(bfhi(ob.x)));
                w.y = cvt_pk_bf16(a.z * rstd * g.z * sigmoidf_(bflo(ob.y)), a.w * rstd * g.w * sigmoidf_(bfhi(ob.y)));
                *(u32x2*)(HG + (size_t)(base + t) * D + h * 256 + v0) = w;
            }
        }
    }
    __syncthreads();
}

__device__ __forceinline__ void norm_frag(const u32x4 r0, const u32x4 r1, const float* __restrict__ g, float extra, int fq, bf16x8& o0, bf16x8& o1) {
    float f[16];
    f[0] = bflo(r0.x); f[1] = bfhi(r0.x); f[2] = bflo(r0.y); f[3] = bfhi(r0.y); f[4] = bflo(r0.z); f[5] = bfhi(r0.z); f[6] = bflo(r0.w); f[7] = bfhi(r0.w);
    f[8] = bflo(r1.x); f[9] = bfhi(r1.x); f[10] = bflo(r1.y); f[11] = bfhi(r1.y); f[12] = bflo(r1.z); f[13] = bfhi(r1.z); f[14] = bflo(r1.w); f[15] = bfhi(r1.w);
    float s = 0.f;
#pragma unroll
    for (int i = 0; i < 16; ++i) s += f[i] * f[i];
    s += __shfl_xor(s, 16); s += __shfl_xor(s, 32);
    const float rs = rsqrtf(s * (1.f / 64.f) + EPS) * extra;
    const f32x4 ga = *(const f32x4*)(g + 8 * fq), gb = *(const f32x4*)(g + 8 * fq + 4), gc = *(const f32x4*)(g + 32 + 8 * fq), gd = *(const f32x4*)(g + 32 + 8 * fq + 4);
    u32x4 a, b2;
    a.x = cvt_pk_bf16(f[0] * rs * ga.x, f[1] * rs * ga.y); a.y = cvt_pk_bf16(f[2] * rs * ga.z, f[3] * rs * ga.w);
    a.z = cvt_pk_bf16(f[4] * rs * gb.x, f[5] * rs * gb.y); a.w = cvt_pk_bf16(f[6] * rs * gb.z, f[7] * rs * gb.w);
    b2.x = cvt_pk_bf16(f[8] * rs * gc.x, f[9] * rs * gc.y); b2.y = cvt_pk_bf16(f[10] * rs * gc.z, f[11] * rs * gc.w);
    b2.z = cvt_pk_bf16(f[12] * rs * gd.x, f[13] * rs * gd.y); b2.w = cvt_pk_bf16(f[14] * rs * gd.z, f[15] * rs * gd.w);
    o0 = __builtin_bit_cast(bf16x8, a); o1 = __builtin_bit_cast(bf16x8, b2);
}

__device__ __forceinline__ void attn_prompt_unit(const Params& p, unsigned char* lds, int u) {
    const int tid = threadIdx.x, lane = tid & 63, wid = tid >> 6, fr = lane & 15, fq = lane >> 4;
    const int qb = u & 31, kvh = (u >> 5) & 3, b = u >> 7;
    unsigned char* ws = p.ws;
    const bf16_t* KVQ = (const bf16_t*)(ws + WS_KVQ);
    bf16_t* AO = (bf16_t*)(ws + WS_ATT);
    bf16_t* Ks = (bf16_t*)lds;
    bf16_t* VT = Ks + 256 * 72;
    const int pos0 = qb * 128 - 128;
    u32x4 qr[4][2];
    {
        const int g_ = wid >> 1, half_ = wid & 1, head_ = kvh * 4 + g_;
#pragma unroll
        for (int m = 0; m < 4; ++m) {
            const bf16_t* qp = KVQ + ((size_t)b * 4096 + qb * 128 + 64 * half_ + 16 * m + fr) * NKVQ + 512 + head_ * 64;
            qr[m][0] = *(const u32x4*)(qp + 8 * fq); qr[m][1] = *(const u32x4*)(qp + 32 + 8 * fq);
        }
    }
#pragma unroll
    for (int i = 0; i < 4; ++i) {
        const int ci = tid + 512 * i, j = ci >> 3, ch = ci & 7, pos = pos0 + j;
        u32x4 r = (u32x4){0u, 0u, 0u, 0u};
        if (pos >= 0) r = *(const u32x4*)(KVQ + (size_t)(b * 4096 + pos) * NKVQ + kvh * 64 + ch * 8);
        float f[8] = {bflo(r.x), bfhi(r.x), bflo(r.y), bfhi(r.y), bflo(r.z), bfhi(r.z), bflo(r.w), bfhi(r.w)};
        float s = 0.f;
#pragma unroll
        for (int e = 0; e < 8; ++e) s += f[e] * f[e];
        s += __shfl_xor(s, 1); s += __shfl_xor(s, 2); s += __shfl_xor(s, 4);
        const float rs = rsqrtf(s * (1.f / 64.f) + EPS);
        const f32x4 g0 = *(const f32x4*)(p.k_norm_g + ch * 8), g1 = *(const f32x4*)(p.k_norm_g + ch * 8 + 4);
        f[0] *= rs * g0.x; f[1] *= rs * g0.y; f[2] *= rs * g0.z; f[3] *= rs * g0.w; f[4] *= rs * g1.x; f[5] *= rs * g1.y; f[6] *= rs * g1.z; f[7] *= rs * g1.w;
        u32x4 w; w.x = cvt_pk_bf16(f[0], f[1]); w.y = cvt_pk_bf16(f[2], f[3]); w.z = cvt_pk_bf16(f[4], f[5]); w.w = cvt_pk_bf16(f[6], f[7]);
        *(u32x4*)(Ks + j * 72 + ch * 8) = w;
        if (qb == 31 && j >= 128) {
            float* o = p.out + O_PWK + ((size_t)(b * 128 + (j - 128)) * 4 + kvh) * 64 + ch * 8;
            *(f32x4*)o = (f32x4){f[0], f[1], f[2], f[3]}; *(f32x4*)(o + 4) = (f32x4){f[4], f[5], f[6], f[7]};
        }
    }
#pragma unroll
    for (int i = 0; i < 4; ++i) {
        const int ci = tid + 512 * i, j = ci & 255, ch = ci >> 8, pos = pos0 + j;
        u32x4 r = (u32x4){0u, 0u, 0u, 0u};
        if (pos >= 0) r = *(const u32x4*)(KVQ + (size_t)(b * 4096 + pos) * NKVQ + 256 + kvh * 64 + ch * 8);
        bf16_t* dst = VT + (ch * 8) * 264 + j;
        dst[0 * 264] = (bf16_t)(r.x & 0xffff); dst[1 * 264] = (bf16_t)(r.x >> 16); dst[2 * 264] = (bf16_t)(r.y & 0xffff); dst[3 * 264] = (bf16_t)(r.y >> 16);
        dst[4 * 264] = (bf16_t)(r.z & 0xffff); dst[5 * 264] = (bf16_t)(r.z >> 16); dst[6 * 264] = (bf16_t)(r.w & 0xffff); dst[7 * 264] = (bf16_t)(r.w >> 16);
        if (qb == 31 && j >= 128) {
            float* o = p.out + O_PWV + ((size_t)(b * 128 + (j - 128)) * 4 + kvh) * 64 + ch * 8;
            *(f32x4*)o = (f32x4){bflo(r.x), bfhi(r.x), bflo(r.y), bfhi(r.y)}; *(f32x4*)(o + 4) = (f32x4){bflo(r.z), bfhi(r.z), bflo(r.w), bfhi(r.w)};
        }
    }
    __syncthreads();
    const int g = wid >> 1, half = wid & 1, head = kvh * 4 + g;
    const float sink = p.att_sinks[head];
    const float* qg = p.q_norm_g;
#pragma unroll
    for (int m = 0; m < 4; ++m) {
        const int j0 = 64 * half + 16 * m;
        const size_t R = (size_t)b * 4096 + qb * 128 + j0 + fr;
        bf16x8 q0, q1; norm_frag(qr[m][0], qr[m][1], qg, 0.125f, fq, q0, q1);
        f32x4 s[9];
#pragma unroll
        for (int i = 0; i < 9; ++i) {
            s[i] = (f32x4){0.f, 0.f, 0.f, 0.f};
            const bf16_t* kr = Ks + (j0 + 16 * i + fr) * 72 + 8 * fq;
            s[i] = MFMA32(*(const bf16x8*)kr, q0, s[i]);
            s[i] = MFMA32(*(const bf16x8*)(kr + 32), q1, s[i]);
        }
        float mx = sink;
#pragma unroll
        for (int i = 0; i < 9; ++i)
#pragma unroll
            for (int e = 0; e < 4; ++e) {
                const int jr = 16 * i + 4 * fq + e;
                const bool ok = (jr >= fr) && (jr <= 128 + fr) && (pos0 + j0 + jr >= 0);
                s[i][e] = ok ? s[i][e] : -INFINITY;
                mx = fmaxf(mx, s[i][e]);
            }
        mx = fmaxf(mx, __shfl_xor(mx, 16)); mx = fmaxf(mx, __shfl_xor(mx, 32));
        float l = 0.f;
        bf16x4 pf[9];
#pragma unroll
        for (int i = 0; i < 9; ++i) {
            float e0 = __expf(s[i][0] - mx), e1 = __expf(s[i][1] - mx), e2 = __expf(s[i][2] - mx), e3 = __expf(s[i][3] - mx);
            l += (e0 + e1) + (e2 + e3);
            u32x2 w; w.x = cvt_pk_bf16(e0, e1); w.y = cvt_pk_bf16(e2, e3);
            pf[i] = __builtin_bit_cast(bf16x4, w);
        }
        l += __shfl_xor(l, 16); l += __shfl_xor(l, 32);
        l += __expf(sink - mx);
        const float inv = 1.f / l;
        f32x4 o[4];
#pragma unroll
        for (int dt = 0; dt < 4; ++dt) {
            o[dt] = (f32x4){0.f, 0.f, 0.f, 0.f};
#pragma unroll
            for (int i = 0; i < 9; ++i) {
                const bf16x4 vf = *(const bf16x4*)(VT + (16 * dt + fr) * 264 + j0 + 16 * i + 4 * fq);
                o[dt] = MFMA16(vf, pf[i], o[dt]);
            }
        }
#pragma unroll
        for (int dt = 0; dt < 4; ++dt) {
            u32x2 w; w.x = cvt_pk_bf16(o[dt].x * inv, o[dt].y * inv); w.y = cvt_pk_bf16(o[dt].z * inv, o[dt].w * inv);
            *(u32x2*)(AO + R * D + head * 64 + 16 * dt + 4 * fq) = w;
        }
    }
    __syncthreads();
}

__device__ __forceinline__ void attn_sample_unit(const Params& p, int u, int lane) {
    const int fr = lane & 15, fq = lane >> 4;
    const int b = u >> 2, kvh = u & 3;
    unsigned char* ws = p.ws;
    const bf16_t* KVQ = (const bf16_t*)(ws + WS_KVQ);
    bf16_t* AO = (bf16_t*)(ws + WS_ATT);
    const float* ck = p.cache_k + (size_t)b * 128 * 256 + kvh * 64;
    const float* cv = p.cache_v + (size_t)b * 128 * 256 + kvh * 64;
    float* owk = p.out + O_SWK + (size_t)b * 128 * 256 + kvh * 64;
    float* owv = p.out + O_SWV + (size_t)b * 128 * 256 + kvh * 64;
    const size_t rbase = (size_t)TP + b * 4;
    for (int i = lane; i < 124 * 16; i += 64) {
        const int j = i >> 4, d4 = (i & 15) * 4;
        *(f32x4*)(owk + (size_t)j * 256 + d4) = *(const f32x4*)(ck + (size_t)(j + 4) * 256 + d4);
        *(f32x4*)(owv + (size_t)j * 256 + d4) = *(const f32x4*)(cv + (size_t)(j + 4) * 256 + d4);
    }
    {
        const int t = lane >> 4, d4 = (lane & 15) * 4;
        const u32x2 kr = *(const u32x2*)(KVQ + (rbase + t) * NKVQ + kvh * 64 + d4);
        const u32x2 vr = *(const u32x2*)(KVQ + (rbase + t) * NKVQ + 256 + kvh * 64 + d4);
        float f0 = bflo(kr.x), f1 = bfhi(kr.x), f2 = bflo(kr.y), f3 = bfhi(kr.y);
        float s = (f0 * f0 + f1 * f1) + (f2 * f2 + f3 * f3);
        s += __shfl_xor(s, 1); s += __shfl_xor(s, 2); s += __shfl_xor(s, 4); s += __shfl_xor(s, 8);
        const float rs = rsqrtf(s * (1.f / 64.f) + EPS);
        const f32x4 g = *(const f32x4*)(p.k_norm_g + d4);
        *(f32x4*)(owk + (size_t)(124 + t) * 256 + d4) = (f32x4){f0 * rs * g.x, f1 * rs * g.y, f2 * rs * g.z, f3 * rs * g.w};
        *(f32x4*)(owv + (size_t)(124 + t) * 256 + d4) = (f32x4){bflo(vr.x), bfhi(vr.x), bflo(vr.y), bfhi(vr.y)};
    }
    const int g = fr >> 2, t = fr & 3, head = kvh * 4 + g;
    const bf16_t* qp = KVQ + (rbase + t) * NKVQ + 512 + head * 64;
    const u32x4 r0 = *(const u32x4*)(qp + 8 * fq), r1 = *(const u32x4*)(qp + 32 + 8 * fq);
    bf16x8 q0, q1; norm_frag(r0, r1, p.q_norm_g, 0.125f, fq, q0, q1);
    const float sink = p.att_sinks[head];
    bf16x8 nk0, nk1;
    {
        const bf16_t* kp = KVQ + (rbase + (fr & 3)) * NKVQ + kvh * 64;
        const u32x4 a0 = *(const u32x4*)(kp + 8 * fq), a1 = *(const u32x4*)(kp + 32 + 8 * fq);
        norm_frag(a0, a1, p.k_norm_g, 1.f, fq, nk0, nk1);
        if (fr >= 4) { nk0 = (bf16x8){0, 0, 0, 0, 0, 0, 0, 0}; nk1 = nk0; }
    }
    f32x4 s[9];
#pragma unroll
    for (int i = 0; i < 8; ++i) {
        const float* kr = ck + (size_t)(16 * i + fr) * 256 + 8 * fq;
        const f32x4 a = *(const f32x4*)kr, b2 = *(const f32x4*)(kr + 4), c = *(const f32x4*)(kr + 32), d = *(const f32x4*)(kr + 36);
        u32x4 x0, x1;
        x0.x = cvt_pk_bf16(a.x, a.y); x0.y = cvt_pk_bf16(a.z, a.w); x0.z = cvt_pk_bf16(b2.x, b2.y); x0.w = cvt_pk_bf16(b2.z, b2.w);
        x1.x = cvt_pk_bf16(c.x, c.y); x1.y = cvt_pk_bf16(c.z, c.w); x1.z = cvt_pk_bf16(d.x, d.y); x1.w = cvt_pk_bf16(d.z, d.w);
        s[i] = (f32x4){0.f, 0.f, 0.f, 0.f};
        s[i] = MFMA32(__builtin_bit_cast(bf16x8, x0), q0, s[i]);
        s[i] = MFMA32(__builtin_bit_cast(bf16x8, x1), q1, s[i]);
    }
    s[8] = (f32x4){0.f, 0.f, 0.f, 0.f};
    s[8] = MFMA32(nk0, q0, s[8]); s[8] = MFMA32(nk1, q1, s[8]);
    float mx = sink;
#pragma unroll
    for (int i = 0; i < 9; ++i)
#pragma unroll
        for (int e = 0; e < 4; ++e) {
            const int j = 16 * i + 4 * fq + e;
            const bool ok = (j >= t) && (j <= t + 128);
            s[i][e] = ok ? s[i][e] : -INFINITY;
            mx = fmaxf(mx, s[i][e]);
        }
    mx = fmaxf(mx, __shfl_xor(mx, 16)); mx = fmaxf(mx, __shfl_xor(mx, 32));
    float l = 0.f; bf16x4 pf[9];
#pragma unroll
    for (int i = 0; i < 9; ++i) {
        float e0 = __expf(s[i][0] - mx), e1 = __expf(s[i][1] - mx), e2 = __expf(s[i][2] - mx), e3 = __expf(s[i][3] - mx);
        l += (e0 + e1) + (e2 + e3);
        u32x2 w; w.x = cvt_pk_bf16(e0, e1); w.y = cvt_pk_bf16(e2, e3);
        pf[i] = __builtin_bit_cast(bf16x4, w);
    }
    l += __shfl_xor(l, 16); l += __shfl_xor(l, 32);
    l += __expf(sink - mx);
    const float inv = 1.f / l;
#pragma unroll
    for (int dt = 0; dt < 4; ++dt) {
        f32x4 o = (f32x4){0.f, 0.f, 0.f, 0.f};
#pragma unroll
        for (int i = 0; i < 8; ++i) {
            const float* vr = cv + (size_t)(16 * i + 4 * fq) * 256 + 16 * dt + fr;
            u32x2 w; w.x = cvt_pk_bf16(vr[0], vr[256]); w.y = cvt_pk_bf16(vr[512], vr[768]);
            o = MFMA16(__builtin_bit_cast(bf16x4, w), pf[i], o);
        }
        {
            u32x2 w; w.x = 0u; w.y = 0u;
            const bf16_t* vp = KVQ + rbase * NKVQ + 256 + kvh * 64 + 16 * dt + fr;
            const unsigned v0 = vp[0], v1 = vp[NKVQ], v2 = vp[2 * NKVQ], v3 = vp[3 * NKVQ];
            if (fq == 0) { w.x = v0 | (v1 << 16); w.y = v2 | (v3 << 16); }
            o = MFMA16(__builtin_bit_cast(bf16x4, w), pf[8], o);
        }
        u32x2 w; w.x = cvt_pk_bf16(o.x * inv, o.y * inv); w.y = cvt_pk_bf16(o.z * inv, o.w * inv);
        *(u32x2*)(AO + (rbase + t) * D + head * 64 + 16 * dt + 4 * fq) = w;
    }
}


__device__ __forceinline__ void attn_sample_block(const Params& p, unsigned char* lds, int u) {
    const int tid = threadIdx.x, lane = tid & 63, wid = tid >> 6, fr = lane & 15, fq = lane >> 4;
    const int b = u >> 2, kvh = u & 3;
    unsigned char* ws = p.ws;
    const bf16_t* KVQ = (const bf16_t*)(ws + WS_KVQ);
    bf16_t* AO = (bf16_t*)(ws + WS_ATT);
    const float* ck = p.cache_k + (size_t)b * 128 * 256 + kvh * 64;
    const float* cv = p.cache_v + (size_t)b * 128 * 256 + kvh * 64;
    float* owk = p.out + O_SWK + (size_t)b * 128 * 256 + kvh * 64;
    float* owv = p.out + O_SWV + (size_t)b * 128 * 256 + kvh * 64;
    const size_t rbase = (size_t)TP + b * 4;
    bf16_t* Ks = (bf16_t*)lds;
    bf16_t* VT = Ks + 144 * 72;
    f32x4 kf[4], vf[4];
#pragma unroll
    for (int i = 0; i < 4; ++i) { const int idx = tid + 512 * i, j = idx >> 4, c4 = (idx & 15) * 4; kf[i] = *(const f32x4*)(ck + (size_t)j * 256 + c4); vf[i] = *(const f32x4*)(cv + (size_t)j * 256 + c4); }
#pragma unroll
    for (int i = 0; i < 4; ++i) {
        const int idx = tid + 512 * i, j = idx >> 4, c4 = (idx & 15) * 4;
        if (j >= 4) { *(f32x4*)(owk + (size_t)(j - 4) * 256 + c4) = kf[i]; *(f32x4*)(owv + (size_t)(j - 4) * 256 + c4) = vf[i]; }
        u32x2 w; w.x = cvt_pk_bf16(kf[i].x, kf[i].y); w.y = cvt_pk_bf16(kf[i].z, kf[i].w);
        *(u32x2*)(Ks + j * 72 + c4) = w;
        VT[(c4 + 0) * 152 + j] = f2bf(vf[i].x); VT[(c4 + 1) * 152 + j] = f2bf(vf[i].y); VT[(c4 + 2) * 152 + j] = f2bf(vf[i].z); VT[(c4 + 3) * 152 + j] = f2bf(vf[i].w);
    }
    if (tid < 64) {
        const int t = tid >> 4, d4 = (tid & 15) * 4;
        const u32x2 kr = *(const u32x2*)(KVQ + (rbase + t) * NKVQ + kvh * 64 + d4);
        const u32x2 vr = *(const u32x2*)(KVQ + (rbase + t) * NKVQ + 256 + kvh * 64 + d4);
        float f0 = bflo(kr.x), f1 = bfhi(kr.x), f2 = bflo(kr.y), f3 = bfhi(kr.y);
        float s = (f0 * f0 + f1 * f1) + (f2 * f2 + f3 * f3);
        s += __shfl_xor(s, 1); s += __shfl_xor(s, 2); s += __shfl_xor(s, 4); s += __shfl_xor(s, 8);
        const float rs = rsqrtf(s * (1.f / 64.f) + EPS);
        const f32x4 g = *(const f32x4*)(p.k_norm_g + d4);
        f0 *= rs * g.x; f1 *= rs * g.y; f2 *= rs * g.z; f3 *= rs * g.w;
        *(f32x4*)(owk + (size_t)(124 + t) * 256 + d4) = (f32x4){f0, f1, f2, f3};
        *(f32x4*)(owv + (size_t)(124 + t) * 256 + d4) = (f32x4){bflo(vr.x), bfhi(vr.x), bflo(vr.y), bfhi(vr.y)};
        u32x2 w; w.x = cvt_pk_bf16(f0, f1); w.y = cvt_pk_bf16(f2, f3);
        *(u32x2*)(Ks + (128 + t) * 72 + d4) = w;
        VT[(d4 + 0) * 152 + 128 + t] = (bf16_t)(vr.x & 0xffff); VT[(d4 + 1) * 152 + 128 + t] = (bf16_t)(vr.x >> 16);
        VT[(d4 + 2) * 152 + 128 + t] = (bf16_t)(vr.y & 0xffff); VT[(d4 + 3) * 152 + 128 + t] = (bf16_t)(vr.y >> 16);
    } else if (tid < 64 + 192) {
        const int i = tid - 64;
        if (i < 96) { const int r = 132 + (i >> 3), c8 = (i & 7) * 8; *(u32x4*)(Ks + r * 72 + c8) = (u32x4){0u, 0u, 0u, 0u}; }
        else { const int d = i - 96; if (d < 64) { bf16_t* z = VT + d * 152 + 132; for (int e = 0; e < 12; ++e) z[e] = 0; } }
    }
    __syncthreads();
    if (wid < 4) {
        const int dt = wid;
        const int g = fr >> 2, t = fr & 3, head = kvh * 4 + g;
        const bf16_t* qp = KVQ + (rbase + t) * NKVQ + 512 + head * 64;
        const u32x4 r0 = *(const u32x4*)(qp + 8 * fq), r1 = *(const u32x4*)(qp + 32 + 8 * fq);
        bf16x8 q0, q1; norm_frag(r0, r1, p.q_norm_g, 0.125f, fq, q0, q1);
        const float sink = p.att_sinks[head];
        f32x4 s[9];
#pragma unroll
        for (int i = 0; i < 9; ++i) {
            s[i] = (f32x4){0.f, 0.f, 0.f, 0.f};
            const bf16_t* kr = Ks + (16 * i + fr) * 72 + 8 * fq;
            s[i] = MFMA32(*(const bf16x8*)kr, q0, s[i]);
            s[i] = MFMA32(*(const bf16x8*)(kr + 32), q1, s[i]);
        }
        float mx = sink;
#pragma unroll
        for (int i = 0; i < 9; ++i)
#pragma unroll
            for (int e = 0; e < 4; ++e) {
                const int j = 16 * i + 4 * fq + e;
                const bool ok = (j >= t) && (j <= t + 128);
                s[i][e] = ok ? s[i][e] : -INFINITY;
                mx = fmaxf(mx, s[i][e]);
            }
        mx = fmaxf(mx, __shfl_xor(mx, 16)); mx = fmaxf(mx, __shfl_xor(mx, 32));
        float l = 0.f;
        f32x4 o = (f32x4){0.f, 0.f, 0.f, 0.f};
#pragma unroll
        for (int i = 0; i < 9; ++i) {
            const float e0 = __expf(s[i][0] - mx), e1 = __expf(s[i][1] - mx), e2 = __expf(s[i][2] - mx), e3 = __expf(s[i][3] - mx);
            l += (e0 + e1) + (e2 + e3);
            u32x2 w; w.x = cvt_pk_bf16(e0, e1); w.y = cvt_pk_bf16(e2, e3);
            const bf16x4 vfr = *(const bf16x4*)(VT + (16 * dt + fr) * 152 + 16 * i + 4 * fq);
            o = MFMA16(vfr, __builtin_bit_cast(bf16x4, w), o);
        }
        l += __shfl_xor(l, 16); l += __shfl_xor(l, 32);
        l += __expf(sink - mx);
        const float inv = 1.f / l;
        u32x2 w; w.x = cvt_pk_bf16(o.x * inv, o.y * inv); w.y = cvt_pk_bf16(o.z * inv, o.w * inv);
        *(u32x2*)(AO + (rbase + t) * D + head * 64 + 16 * dt + 4 * fq) = w;
    }
    __syncthreads();
}

#define LAS __attribute__((address_space(3)))
#define XB_TMO      128
#define XB_XCNT(j)  (256  + 64 * (j))
#define XB_XSUB(j)  (1280 + 64 * (j))
#define XB_XGEN(j)  (2304 + 64 * (j))
#define XB_TOP      3328
#define XB_TOPGEN   3392
#define XCD_BAR_WORDS 3456
#define XB_SPIN_CAP (1u << 18)

__device__ __forceinline__ unsigned xb_ld(unsigned* p)              { return __hip_atomic_load(p, __ATOMIC_RELAXED, __HIP_MEMORY_SCOPE_AGENT); }
__device__ __forceinline__ unsigned xb_add(unsigned* p, unsigned v) { return __hip_atomic_fetch_add(p, v, __ATOMIC_RELAXED, __HIP_MEMORY_SCOPE_AGENT); }
__device__ __forceinline__ unsigned xb_xcc_id() { return (unsigned)__builtin_amdgcn_s_getreg((3 << 11) | 20) & 0xFu; }
#define XB_SPIN(cond, bar) do { unsigned _sp = 0; while (cond) { __builtin_amdgcn_s_sleep(1); \
    if ((++_sp & 255u) == 0u) { if (xb_ld(&(bar)[XB_TMO])) break; if (_sp > XB_SPIN_CAP) { atomicAdd(&(bar)[XB_TMO], 1u); break; } } } } while (0)

struct XcdBarrier {
    unsigned* bar; unsigned x;
    volatile LAS unsigned* st;
};

__device__ __forceinline__ XcdBarrier xcd_barrier_post(unsigned* bar, volatile LAS unsigned* st) {
    XcdBarrier b; b.bar = bar; b.x = xb_xcc_id(); b.st = st;
    if (threadIdx.x == 0) (void)xb_add(&bar[XB_XCNT(b.x)], 1u);
    return b;
}
__device__ __forceinline__ void xcd_barrier_complete(unsigned* bar, unsigned x, unsigned& nloc, unsigned& nx) {
    const unsigned G = gridDim.x * gridDim.y * gridDim.z;
    unsigned sum, cnt, mine, sp = 0u;
    for (;;) {
        sum = 0u; cnt = 0u; mine = 0u;
#pragma unroll
        for (unsigned j = 0; j < 16; ++j) { const unsigned c = xb_ld(&bar[XB_XCNT(j)]); sum += c; cnt += (c > 0u) ? 1u : 0u; mine = (j == x) ? c : mine; }
        if (sum == G) break;
        __builtin_amdgcn_s_sleep(1);
        if ((++sp & 255u) == 0u) { if (xb_ld(&bar[XB_TMO])) break; if (sp > XB_SPIN_CAP) { atomicAdd(&bar[XB_TMO], 1u); break; } }
    }
    nloc = mine > 0u ? mine : 1u; nx = cnt > 0u ? cnt : 1u;
}

__device__ __forceinline__ void xcd_barrier(const XcdBarrier& b) {
    asm volatile("s_waitcnt vmcnt(0)" ::: "memory");
    __syncthreads();
    if (threadIdx.x == 0) {
        unsigned* bar = b.bar;
        __builtin_amdgcn_s_waitcnt(0);
        unsigned nloc = b.st[0], nx = b.st[1];
        if (nloc == 0u) { xcd_barrier_complete(bar, b.x, nloc, nx); b.st[0] = nloc; b.st[1] = nx; }
        const unsigned old = xb_add(&bar[XB_XSUB(b.x)], 1u);
        const unsigned gen = old / nloc;
        if (old + 1u == (gen + 1u) * nloc) {
            __builtin_amdgcn_fence(__ATOMIC_RELEASE, "agent");
            asm volatile("s_waitcnt vmcnt(0)" ::: "memory");
            const unsigned og = xb_add(&bar[XB_TOP], 1u);
            const unsigned tg = og / nx;
            if (og + 1u == (tg + 1u) * nx) xb_add(&bar[XB_TOPGEN], 1u);
            else XB_SPIN(xb_ld(&bar[XB_TOPGEN]) == tg, bar);
            __builtin_amdgcn_fence(__ATOMIC_ACQUIRE, "agent");
            xb_add(&bar[XB_XGEN(b.x)], 1u);
            asm volatile("s_waitcnt vmcnt(0)" ::: "memory");
        } else {
            XB_SPIN(xb_ld(&bar[XB_XGEN(b.x)]) == gen, bar);
            __builtin_amdgcn_fence(__ATOMIC_ACQUIRE, "agent");
            asm volatile("s_waitcnt vmcnt(0)" ::: "memory");
        }
    }
    __syncthreads();
}

__global__ void __launch_bounds__(NTHREADS) yoco_fwd(Params p) {
    extern __shared__ __attribute__((aligned(16))) unsigned char lds[];
    const int bid = blockIdx.x, G = gridDim.x;
    unsigned char* ws = p.ws;
    float* SS = (float*)(ws + WS_SS);
    float* Y = p.out + O_Y;
    bf16_t* XB = (bf16_t*)(ws + WS_XB);

#define IN(k) (p.ph_lo <= (k) && (k) < p.ph_hi)
    volatile LAS unsigned* bst = (volatile LAS unsigned*)((LAS unsigned char*)lds + 131072 + 64);
    XcdBarrier xbar; xbar.bar = (unsigned*)(ws + WS_BAR); xbar.x = 0; xbar.st = bst;
    if (p.ph_hi - p.ph_lo > 1) {
        if (threadIdx.x < 2) bst[threadIdx.x] = 0u;
        __syncthreads();
        xbar = xcd_barrier_post((unsigned*)(ws + WS_BAR), bst);
    }
#define SEAM(k) do { if (IN(k) && IN((k) + 1)) xcd_barrier(xbar); } while (0)
    if (IN(0)) { for (int rep = 0; rep < REP_P0; ++rep) p0_prologue(p, lds, bid, G); }
    SEAM(0);
    PG8_LAS unsigned char* l3 = (PG8_LAS unsigned char*)lds;
    float* YS = Y;
#define PGEMM(Aptr, Bptr, Nn, Kk, EpiT, ...) do { pg8::Gemm g_{(const bf16_t*)(Aptr), (const bf16_t*)(Bptr), TP, (Nn), (Kk), ((Kk) == FF) ? 1 : 0}; pg8::StaticOrder S_; S_.init(TP, (Nn), G, bid); \
        Pg8Epi<EpiT> E_{EpiT{__VA_ARGS__}}; pg8::gemm_phase<Pg8Epi<EpiT>, pg8::StaticOrder, true, true>(l3, g_, S_, E_); } while (0)
    if (IN(1)) {
        for (int rep = 0; rep < REP_PG; ++rep) { PGEMM(XB, ws + WS_WIN, NIN, 1024, EpiBf16, (bf16_t*)(ws + WS_P), NIN, nullptr, 0); }
        { EpiBf16 E{(bf16_t*)(ws + WS_P), NIN, nullptr, 0}; for (int rep = 0; rep < REP_SG; ++rep) sgemm64<0>(lds, XB, 1024, (const bf16_t*)(ws + WS_WIN), TP, TS, NIN, 1024, 1, E, bid, G); }
    }
    SEAM(1);
    if (IN(2)) {
        for (int rep = 0; rep < REP_2AL; ++rep) for (int u = bid; u < 1024; u += G) mlstm_local_unit(p, lds, u);
        for (int rep = 0; rep < REP_2AS; ++rep) for (int u = bid; u < 512; u += G) mlstm_sample_unit(p, lds, u);
    }
    SEAM(2);
    if (IN(3)) mlstm_scan(p, lds, bid, G);
    SEAM(3);
    if (IN(4)) { for (int rep = 0; rep < REP_2C; ++rep) for (int u = bid; u < 1024; u += G) mlstm_out_unit(p, lds, u); }
    SEAM(4);
    if (IN(5)) {
        PGEMM(ws + WS_HG, ws + WS_WOUT, 1024, 1024, EpiResB, p.x_prompt, XB, nullptr, SS);
        { EpiAddF32 E{YS}; sgemm64<0>(lds, ws + WS_HG, 1024, (const bf16_t*)(ws + WS_WOUT), TP, TS, 1024, 1024, 1, E, bid, G); }
    }
    SEAM(5);
    if (IN(6)) {
        for (int rep = 0; rep < REP_PG; ++rep) { PGEMM(XB, ws + WS_W1A, FF, 1024, EpiBf16, (bf16_t*)(ws + WS_HID), FF, SS, 1); }
        { EpiBf16 E{(bf16_t*)(ws + WS_HID), FF, nullptr, 1}; for (int rep = 0; rep < REP_SG; ++rep) sgemm64<1>(lds, Y, 1024, (const bf16_t*)(ws + WS_W1A), TP, TS, FF, 1024, 1, E, bid, G); }
    }
    SEAM(6);
    if (IN(7)) {
        PGEMM(ws + WS_HID, ws + WS_W2A, 1024, FF, EpiResB, nullptr, XB, nullptr, SS + T);
        { EpiAtomic E{YS}; sgemm64<0>(lds, ws + WS_HID, FF, (const bf16_t*)(ws + WS_W2A), TP, TS, 1024, FF, 2, E, bid, G); }
    }
    SEAM(7);
    if (IN(8)) {
        for (int rep = 0; rep < REP_PG; ++rep) { PGEMM(XB, ws + WS_WKVQ, NKVQ, 1024, EpiBf16, (bf16_t*)(ws + WS_KVQ), NKVQ, SS + T, 0); }
        { EpiBf16 E{(bf16_t*)(ws + WS_KVQ), NKVQ, nullptr, 0}; for (int rep = 0; rep < REP_SG; ++rep) sgemm64<1>(lds, Y, 1024, (const bf16_t*)(ws + WS_WKVQ), TP, TS, NKVQ, 1024, 1, E, (bid + G / 2) % G, G); }
        __syncthreads();
        if (bid >= G / 2) late_weights(p, lds, bid - G / 2, G - G / 2);
    }
    SEAM(8);
    if (IN(9)) {
        { const int vb = (G % 8 == 0) ? (bid % 8) * (G / 8) + bid / 8 : bid;
          for (int rep = 0; rep < REP_7P; ++rep) for (int u = vb; u < 512; u += G) attn_prompt_unit(p, lds, u); }
        for (int rep = 0; rep < REP_7S; ++rep) for (int u = bid; u < 512; u += G) attn_sample_block(p, lds, u);
    }
    SEAM(9);
    if (IN(10)) {
        PGEMM(ws + WS_ATT, ws + WS_WO, 1024, 1024, EpiResB, nullptr, XB, nullptr, SS + 2 * T);
        { EpiAddF32 E{YS}; sgemm64<0>(lds, ws + WS_ATT, 1024, (const bf16_t*)(ws + WS_WO), TP, TS, 1024, 1024, 1, E, bid, G); }
    }
    SEAM(10);
    if (IN(11)) {
        for (int rep = 0; rep < REP_PG; ++rep) { PGEMM(XB, ws + WS_W1B, FF, 1024, EpiBf16, (bf16_t*)(ws + WS_HID), FF, SS + 2 * T, 1); }
        { EpiBf16 E{(bf16_t*)(ws + WS_HID), FF, nullptr, 1}; for (int rep = 0; rep < REP_SG; ++rep) sgemm64<1>(lds, Y, 1024, (const bf16_t*)(ws + WS_W1B), TP, TS, FF, 1024, 1, E, bid, G); }
    }
    SEAM(11);
    if (IN(12)) {
        PGEMM(ws + WS_HID, ws + WS_W2B, 1024, FF, EpiResB, nullptr, XB, Y, nullptr);
        { EpiAtomic E{YS}; sgemm64<0>(lds, ws + WS_HID, FF, (const bf16_t*)(ws + WS_W2B), TP, TS, 1024, FF, 2, E, bid, G); }
    }
#undef PGEMM
#undef IN
#undef SEAM
}

extern "C" void kernel_launch(void* const* d_in, const int* in_sizes, int n_in, void* d_out, int out_size, void* d_ws, size_t ws_size, hipStream_t stream) {
    static int grid_blocks = 0;
    if (!grid_blocks) {
        if (n_in != 24 || (size_t)out_size != O_END || ws_size < WS_END) { fprintf(stderr, "kernel_launch: unexpected shapes n_in=%d out=%d ws=%zu\n", n_in, out_size, ws_size); grid_blocks = -1; return; }
        int dev = 0, cus = 0, per_cu = 0;
        hipGetDevice(&dev);
        hipDeviceGetAttribute(&cus, hipDeviceAttributeMultiprocessorCount, dev);
        hipFuncSetAttribute((const void*)yoco_fwd, hipFuncAttributeMaxDynamicSharedMemorySize, LDS_BYTES);
        hipOccupancyMaxActiveBlocksPerMultiprocessor(&per_cu, (const void*)yoco_fwd, NTHREADS, LDS_BYTES);
        if (per_cu < 1) per_cu = 1;
        grid_blocks = cus * per_cu;
        (void)hipGetLastError();
    }
    if (grid_blocks < 0) return;
    Params p{};
    const float** pp = (const float**)&p;
    for (int i = 0; i < 24; ++i) pp[i] = (const float*)d_in[i];
    p.out = (float*)d_out; p.ws = (unsigned char*)d_ws;
#if N_LAUNCH_MODE == 1
    p.ph_lo = 0; p.ph_hi = 13;
    (void)hipMemsetAsync((char*)d_ws + WS_BAR, 0, BAR_BYTES, stream);
    void* args[] = {&p};
    hipError_t e = hipLaunchCooperativeKernel((const void*)yoco_fwd, dim3(grid_blocks), dim3(NTHREADS), args, LDS_BYTES, stream);
    if (e != hipSuccess) fprintf(stderr, "cooperative launch failed: %s (grid %d)\n", hipGetErrorString(e), grid_blocks);
#else
    for (int k = 0; k < MAX_PHASE; ++k) { p.ph_lo = k; p.ph_hi = k + 1; hipLaunchKernelGGL(yoco_fwd, dim3(grid_blocks), dim3(NTHREADS), LDS_BYTES, stream, p); }
#endif
}
```

```cpp
#include <hip/hip_runtime.h>
#include <hip/hip_cooperative_groups.h>
#include <cstdio>
#include <cstdint>
namespace cg = cooperative_groups;

typedef unsigned short bf16_t;
typedef short bf16x8 __attribute__((ext_vector_type(8)));
typedef short bf16x4 __attribute__((ext_vector_type(4)));
typedef float f32x4 __attribute__((ext_vector_type(4)));
typedef unsigned u32x4 __attribute__((ext_vector_type(4)));
typedef unsigned u32x2 __attribute__((ext_vector_type(2)));

constexpr int D = 1024, TP = 16384, TS = 512, T = TP + TS;
constexpr int NIN = 3072, LDW_IN = 3080, FF = 4096, NKVQ = 1536;
constexpr float EPS = 1e-6f;
constexpr int NTHREADS = 512;
constexpr int LDS_BYTES = 147456;
#ifndef REP_P0
#define REP_P0 1
#endif
#ifndef REP_2AL
#define REP_2AL 1
#endif
#ifndef REP_2AS
#define REP_2AS 1
#endif
#ifndef REP_2C
#define REP_2C 1
#endif
#ifndef REP_7P
#define REP_7P 1
#endif
#ifndef REP_7S
#define REP_7S 1
#endif
#ifndef REP_PG
#define REP_PG 1
#endif
#ifndef REP_SG
#define REP_SG 1
#endif
#ifndef MAX_PHASE
#define MAX_PHASE 13
#endif
#ifndef N_LAUNCH_MODE
#define N_LAUNCH_MODE 1
#endif

constexpr size_t MiB = 1u << 20;
constexpr size_t WS_SS = 0;
constexpr size_t WS_CHB = 256 * 1024, WS_CHM = WS_CHB + 4096, WS_MPREV = WS_CHM + 4096;
constexpr size_t WS_GATES = 1 * MiB;
constexpr size_t WS_GN = 2 * MiB;
constexpr size_t WS_BAR = 3 * MiB, BAR_BYTES = 16384;
constexpr size_t WS_WIN = 4 * MiB, WS_WOUT = 10 * MiB, WS_W1A = 12 * MiB, WS_W2A = 20 * MiB, WS_WKVQ = 28 * MiB, WS_WO = 31 * MiB, WS_W1B = 33 * MiB, WS_W2B = 41 * MiB;
constexpr size_t WS_XB = 49 * MiB;
constexpr size_t WS_P = 82 * MiB;
constexpr size_t WS_HG = 181 * MiB;
constexpr size_t WS_HID = 82 * MiB;
constexpr size_t WS_KVQ = 82 * MiB;
constexpr size_t WS_ATT = 132 * MiB;
constexpr size_t WS_END = 214 * MiB;

constexpr size_t O_Y = 0, O_PC = 17301504, O_PN = 17825792, O_PM = 17827840, O_PWK = 17827856, O_PWV = 17958928,
                 O_SC = 18090000, O_SN = 34867216, O_SM = 34932752, O_SWK = 34933264, O_SWV = 39127568, O_END = 43321872;

struct Params {
    const float *x_prompt, *x_sample, *st_C, *st_n, *st_m, *cache_k, *cache_v;
    const float *ml_norm_g, *ml_w_in, *ml_b_i, *ml_b_f, *ml_head_g, *ml_w_out;
    const float *kv_norm_g, *w_kv, *k_norm_g;
    const float *att_norm_g, *att_w_q, *q_norm_g, *att_sinks, *att_w_o;
    const float *mlp_norm_g, *mlp_w1, *mlp_w2;
    float* out; unsigned char* ws;
    int ph_lo, ph_hi;
};

typedef float f32x2 __attribute__((ext_vector_type(2)));
typedef __bf16 bf16x2n __attribute__((ext_vector_type(2)));
__device__ __forceinline__ unsigned cvt_pk_bf16(float lo, float hi) { const f32x2 v = {lo, hi}; const bf16x2n b = __builtin_convertvector(v, bf16x2n); return __builtin_bit_cast(unsigned, b); }
__device__ __forceinline__ bf16_t f2bf(float f) { return (bf16_t)(cvt_pk_bf16(f, 0.f) & 0xffffu); }
__device__ __forceinline__ float bf2f(bf16_t h) { return __uint_as_float(((unsigned)h) << 16); }
__device__ __forceinline__ float bflo(unsigned u) { return __uint_as_float(u << 16); }
__device__ __forceinline__ float bfhi(unsigned u) { return __uint_as_float(u & 0xffff0000u); }
__device__ __forceinline__ float wave_sum(float v) {
#pragma unroll
    for (int o = 1; o < 64; o <<= 1) v += __shfl_xor(v, o);
    return v;
}
__device__ __forceinline__ float wave_max(float v) {
#pragma unroll
    for (int o = 1; o < 64; o <<= 1) v = fmaxf(v, __shfl_xor(v, o));
    return v;
}
__device__ __forceinline__ float scan_sum(float x, int lane) {
#pragma unroll
    for (int o = 1; o < 64; o <<= 1) { float y = __shfl_up(x, o); if (lane >= o) x += y; }
    return x;
}
__device__ __forceinline__ float scan_max(float x, int lane) {
#pragma unroll
    for (int o = 1; o < 64; o <<= 1) { float y = __shfl_up(x, o); if (lane >= o) x = fmaxf(x, y); }
    return x;
}
__device__ __forceinline__ float softcap15(float x) { return 15.f * tanhf(x * (1.f / 15.f)); }
__device__ __forceinline__ float logsigmoid(float z) { return fminf(z, 0.f) - log1pf(__expf(-fabsf(z))); }
__device__ __forceinline__ float sigmoidf_(float z) { return 1.f / (1.f + __expf(-z)); }
#define LDS_WAIT() asm volatile("s_waitcnt lgkmcnt(0)" ::: "memory")
#define MFMA32(x, y, acc) __builtin_amdgcn_mfma_f32_16x16x32_bf16((x), (y), (acc), 0, 0, 0)
#define MFMA16(x, y, acc) __builtin_amdgcn_mfma_f32_16x16x16bf16_1k((x), (y), (acc), 0, 0, 0)

__device__ __forceinline__ void transpose_item(const float* __restrict__ W, int ldw, int K, const float* __restrict__ gk, float cs,
                                               bf16_t* WT, int row_off, int k0, int n0, float* scr, int lane) {
    {
        const int kr = lane >> 3, n4 = (lane & 7) * 4;
        f32x4 wv[8];
#pragma unroll
        for (int i = 0; i < 8; ++i) wv[i] = *(const f32x4*)(W + (size_t)(k0 + kr + 8 * i) * ldw + n0 + n4);
#pragma unroll
        for (int i = 0; i < 8; ++i) {
            const int kk = kr + 8 * i;
            const float g = gk ? gk[k0 + kk] * cs : cs;
            float* d = scr + kk * 33 + n4;
            d[0] = wv[i].x * g; d[1] = wv[i].y * g; d[2] = wv[i].z * g; d[3] = wv[i].w * g;
        }
    }
    LDS_WAIT();
    const int c = lane & 7;
#pragma unroll
    for (int j = 0; j < 4; ++j) {
        const int n = (lane >> 3) + 8 * j; const float* s = scr + (8 * c) * 33 + n;
        u32x4 o; o.x = cvt_pk_bf16(s[0 * 33], s[1 * 33]); o.y = cvt_pk_bf16(s[2 * 33], s[3 * 33]); o.z = cvt_pk_bf16(s[4 * 33], s[5 * 33]); o.w = cvt_pk_bf16(s[6 * 33], s[7 * 33]);
        *(u32x4*)(WT + (size_t)(row_off + n0 + n) * K + k0 + 8 * c) = o;
    }
    LDS_WAIT();
}

__device__ __forceinline__ void p0_prologue(const Params& p, unsigned char* lds, int bid, int G) {
    const int tid = threadIdx.x, lane = tid & 63, wid = tid >> 6;
    unsigned char* ws = p.ws;
    float* scr = (float*)(lds + wid * 8448);
    float* wif = (float*)(lds + 73728);
    for (int k = tid; k < 1024; k += NTHREADS) {
        const float g = p.ml_norm_g[k];
        const f32x4 a = *(const f32x4*)(p.ml_w_in + (size_t)k * LDW_IN + 3072), b = *(const f32x4*)(p.ml_w_in + (size_t)k * LDW_IN + 3076);
        wif[0 * 1024 + k] = a.x * g; wif[1 * 1024 + k] = a.y * g; wif[2 * 1024 + k] = a.z * g; wif[3 * 1024 + k] = a.w * g;
        wif[4 * 1024 + k] = b.x * g; wif[5 * 1024 + k] = b.y * g; wif[6 * 1024 + k] = b.z * g; wif[7 * 1024 + k] = b.w * g;
    }
    { float* ss = (float*)(ws + WS_SS); for (int i = bid * NTHREADS + tid; i < 3 * T; i += G * NTHREADS) ss[i] = 0.f; }
    __syncthreads();
    const int gw = bid * 8 + wid, NGW = G * 8;
    constexpr int I_IN = 16 * 96, I_SQ = 16 * 32, I_1 = 16 * 128, I_2 = 64 * 32, I_KV = 16 * 16;
    constexpr int NITEMS = I_IN + I_SQ + I_1 + I_2 + I_KV + I_SQ;
    for (int it = gw; it < NITEMS; it += NGW) {
        int r = it;
        if (r < I_IN) { const int kb = r / 96, nb = r % 96, n0 = nb * 32; const float cs = (n0 >= 512 && n0 < 1024) ? 0.08838834764831845f : 1.f;
            transpose_item(p.ml_w_in, LDW_IN, 1024, p.ml_norm_g, cs, (bf16_t*)(ws + WS_WIN), 0, kb * 64, n0, scr, lane); continue; } r -= I_IN;
        if (r < I_SQ) { transpose_item(p.ml_w_out, 1024, 1024, nullptr, 1.f, (bf16_t*)(ws + WS_WOUT), 0, (r / 32) * 64, (r % 32) * 32, scr, lane); continue; } r -= I_SQ;
        if (r < I_1) { transpose_item(p.mlp_w1, 4096, 1024, p.mlp_norm_g, 1.f, (bf16_t*)(ws + WS_W1A), 0, (r / 128) * 64, (r % 128) * 32, scr, lane); continue; } r -= I_1;
        if (r < I_2) { transpose_item(p.mlp_w2, 1024, 4096, nullptr, 1.f, (bf16_t*)(ws + WS_W2A), 0, (r / 32) * 64, (r % 32) * 32, scr, lane); continue; } r -= I_2;
        if (r < I_KV) { transpose_item(p.w_kv, 512, 1024, p.kv_norm_g, 1.f, (bf16_t*)(ws + WS_WKVQ), 0, (r / 16) * 64, (r % 16) * 32, scr, lane); continue; } r -= I_KV;
        transpose_item(p.att_w_q, 1024, 1024, p.att_norm_g, 1.f, (bf16_t*)(ws + WS_WKVQ), 512, (r / 32) * 64, (r % 32) * 32, scr, lane);
    }
    bf16_t* XB = (bf16_t*)(ws + WS_XB); float* gates = (float*)(ws + WS_GATES);
    for (int m = gw; m < T; m += NGW) {
        const float* xrow = m < TP ? p.x_prompt + (size_t)m * D : p.x_sample + (size_t)(m - TP) * D;
        f32x4 v[4]; float s = 0.f;
#pragma unroll
        for (int j = 0; j < 4; ++j) { v[j] = *(const f32x4*)(xrow + 4 * lane + 256 * j); s += (v[j].x * v[j].x + v[j].y * v[j].y) + (v[j].z * v[j].z + v[j].w * v[j].w); }
        const float rstd = rsqrtf(wave_sum(s) * (1.f / D) + EPS);
        if (m >= TP) {
#pragma unroll
            for (int j = 0; j < 4; ++j) *(f32x4*)(p.out + O_Y + (size_t)m * D + 4 * lane + 256 * j) = v[j];
        }
#pragma unroll
        for (int j = 0; j < 4; ++j) { u32x2 w; w.x = cvt_pk_bf16(v[j].x * rstd, v[j].y * rstd); w.y = cvt_pk_bf16(v[j].z * rstd, v[j].w * rstd); *(u32x2*)(XB + (size_t)m * D + 4 * lane + 256 * j) = w; }
        float mine = 0.f;
#pragma unroll
        for (int g = 0; g < 8; ++g) {
            float a = 0.f;
#pragma unroll
            for (int j = 0; j < 4; ++j) { const f32x4 w = *(const f32x4*)(wif + g * 1024 + 4 * lane + 256 * j); a += (v[j].x * w.x + v[j].y * w.y) + (v[j].z * w.z + v[j].w * w.w); }
            a = wave_sum(a) * rstd;
            if (lane == g) mine = a;
        }
        if (lane < 4) gates[(size_t)m * 8 + lane] = softcap15(mine + p.ml_b_i[lane]);
        else if (lane < 8) gates[(size_t)m * 8 + lane] = logsigmoid(softcap15(mine + p.ml_b_f[lane - 4]));
    }
}

__device__ __forceinline__ void late_weights(const Params& p, unsigned char* lds, int slot, int nslots) {
    const int tid = threadIdx.x, lane = tid & 63, wid = tid >> 6;
    unsigned char* ws = p.ws;
    float* scr = (float*)(lds + wid * 8448);
    constexpr int I_SQ = 16 * 32, I_1 = 16 * 128, I_2 = 64 * 32, NIT = I_SQ + I_1 + I_2;
    for (int it = slot * 8 + wid; it < NIT; it += nslots * 8) {
        int r = it;
        if (r < I_SQ) { transpose_item(p.att_w_o, 1024, 1024, nullptr, 1.f, (bf16_t*)(ws + WS_WO), 0, (r / 32) * 64, (r % 32) * 32, scr, lane); continue; } r -= I_SQ;
        if (r < I_1) { transpose_item(p.mlp_w1 + (size_t)1024 * 4096, 4096, 1024, p.mlp_norm_g + 1024, 1.f, (bf16_t*)(ws + WS_W1B), 0, (r / 128) * 64, (r % 128) * 32, scr, lane); continue; } r -= I_1;
        transpose_item(p.mlp_w2 + (size_t)4096 * 1024, 1024, 4096, nullptr, 1.f, (bf16_t*)(ws + WS_W2B), 0, (r / 32) * 64, (r % 32) * 32, scr, lane);
    }
}

struct EpiBf16 {
    bf16_t* out; int ld; const float* ss; int act;
    template <int NQ, bool PAIRED> __device__ __forceinline__ void row(int r, const int (&c)[NQ], const f32x4 (&v)[NQ], int fq, float rscale) const {
        float sc = rscale; if (ss) sc = rsqrtf(ss[r] * (1.f / 1024.f) + EPS);
        u32x2 w[NQ];
#pragma unroll
        for (int q = 0; q < NQ; ++q) {
            f32x4 x = v[q] * sc;
            if (act) { x.x = fmaxf(x.x, 0.f); x.y = fmaxf(x.y, 0.f); x.z = fmaxf(x.z, 0.f); x.w = fmaxf(x.w, 0.f); x = x * x; }
            w[q].x = cvt_pk_bf16(x.x, x.y); w[q].y = cvt_pk_bf16(x.z, x.w);
        }
        if (PAIRED) {
#pragma unroll
            for (int q = 0; q < NQ; q += 2) { u32x4 o; o.x = w[q].x; o.y = w[q].y; o.z = w[q + 1].x; o.w = w[q + 1].y; *(u32x4*)(out + (size_t)r * ld + c[q]) = o; }
        } else {
#pragma unroll
            for (int q = 0; q < NQ; ++q) *(u32x2*)(out + (size_t)r * ld + c[q]) = w[q];
        }
    }
};
struct EpiRes {
    const float* srcp; const float* srcs; float* dst; bf16_t* xb; float* ss;
    template <int NQ, bool PAIRED> __device__ __forceinline__ void row(int r, const int (&c)[NQ], const f32x4 (&v)[NQ], int fq, float rscale) const {
        const float* s = r < TP ? srcp + (size_t)r * D : srcs + (size_t)(r - TP) * D;
        float a2 = 0.f;
        u32x2 w[NQ];
#pragma unroll
        for (int q = 0; q < NQ; ++q) {
            const f32x4 o = *(const f32x4*)(s + c[q]) + v[q];
            *(f32x4*)(dst + (size_t)r * D + c[q]) = o;
            w[q].x = cvt_pk_bf16(o.x, o.y); w[q].y = cvt_pk_bf16(o.z, o.w);
            a2 += (o.x * o.x + o.y * o.y) + (o.z * o.z + o.w * o.w);
        }
        if (xb) {
            if (PAIRED) {
#pragma unroll
                for (int q = 0; q < NQ; q += 2) { u32x4 o; o.x = w[q].x; o.y = w[q].y; o.z = w[q + 1].x; o.w = w[q + 1].y; *(u32x4*)(xb + (size_t)r * D + c[q]) = o; }
            } else {
#pragma unroll
                for (int q = 0; q < NQ; ++q) *(u32x2*)(xb + (size_t)r * D + c[q]) = w[q];
            }
        }
        if (ss) { a2 += __shfl_xor(a2, 16); a2 += __shfl_xor(a2, 32); if (fq == 0) atomicAdd(ss + r, a2); }
    }
};

namespace pg8 {
#define PG8_LAS __attribute__((address_space(3)))
typedef unsigned short bf16_t;
typedef short bf16x8 __attribute__((ext_vector_type(8)));
typedef float f32x4 __attribute__((ext_vector_type(4)));
typedef unsigned u32x4 __attribute__((ext_vector_type(4)));
constexpr int BM = 256, BK = 64, HALF = 128, HTB = HALF * BK * 2  , STAGE_BYTES = 8 * HTB, NXCD = 8, WGM = 8;

__host__ __device__ __forceinline__ int lds_byte(int r, int c) { const int st = (r >> 4) * 2 + (c >> 5), rr = r & 15, cc = c & 31, ob = rr * 64 + cc * 2; return st * 1024 + (ob ^ (((ob >> 9) & 1) << 5)); }
__host__ __device__ __forceinline__ void stage_rc(int b, int& R, int& C) { const int st = b / 1024, sb = b % 1024, swz = sb ^ (((sb >> 9) & 1) << 5); R = (st >> 1) * 16 + swz / 64; C = (st & 1) * 32 + (swz % 64) / 2; }
__host__ __device__ __forceinline__ int perm32(int rho) { const int n = rho >> 4, i = rho & 15; return 8 * (i >> 2) + 4 * n + (i & 3); }

struct Unit { int pm, pn; };
struct Gemm { const bf16_t* A; const bf16_t* Bt; int M, N, K; int revk; };

struct StaticOrder {
    int nM, nN, nwg, G, c;
    __host__ __device__ void init(int M, int N, int G_, int c_) { nM = M / BM; nN = N / BM; nwg = nM * nN; G = G_; c = c_; }
    __host__ __device__ bool next(int i, Unit& u) const {
        const long L = (long)i * G + c; if (L >= nwg) return false;
        int wgid = (int)L; { const int q = nwg / NXCD, r = nwg % NXCD, xcd = wgid % NXCD, off = wgid / NXCD; wgid = (xcd < r ? xcd * (q + 1) : r * (q + 1) + (xcd - r) * q) + off; }
        const int nig = WGM * nN, gid = wgid / nig, fm = gid * WGM, gsz = (nM - fm) < WGM ? (nM - fm) : WGM;
        u.pm = fm + ((wgid % nig) % gsz); u.pn = (wgid % nig) / gsz; return true;
    }
    __device__ __forceinline__ void a_ready(const Unit&) const {}
    __device__ __forceinline__ void done(const Unit&) const {}
};


template <class Epi, class Sched, bool ALIGN_EPI = false, bool SP2 = false>
__device__ __forceinline__ void gemm_phase(PG8_LAS unsigned char* lds, const Gemm g, const Sched& S, const Epi& E) {
    const int tid = threadIdx.x, wid = __builtin_amdgcn_readfirstlane(tid >> 6), lane = tid & 63, wr = wid >> 2, wc = wid & 3, fr = lane & 15, fq = lane >> 4;
    const int K = g.K, nt = K / BK;
    unsigned voffA[2], voffB[2];
#pragma unroll
    for (int i = 0; i < 2; ++i) { int R, C; stage_rc(tid * 16 + i * 8192, R, C); const int Rb = Epi::PERM ? ((R & ~31) + perm32(R & 31)) : R;
        voffA[i] = (unsigned)(R * K + C) * 2u; voffB[i] = (unsigned)(Rb * K + C) * 2u; }
    const size_t kstep = g.revk ? (size_t)0 - (size_t)(BK * 2) : (size_t)(BK * 2);
    const size_t koff = g.revk ? (size_t)(K - BK) * 2 : (size_t)0;
    const size_t hstep = (size_t)HALF * K * 2;
    const size_t tstep = 2 * hstep;
    const unsigned ldsw = (unsigned)wid * 1024u;
    const int aoff = lds_byte(wr * 64 + fr, fq * 8), boff = lds_byte(wc * 32 + fr, fq * 8);
#define PG8_SA(b, h) (((b) * 2 + (h)) * HTB)
#define PG8_SB(b, h) ((4 + (b) * 2 + (h)) * HTB)
#define PG8_STAGE(bufoff, gbase, voff) do { _Pragma("unroll") for (int _i = 0; _i < 2; ++_i) \
        __builtin_amdgcn_global_load_lds((const unsigned*)((const char*)(gbase) + (voff)[_i]), (PG8_LAS unsigned*)(lds + (bufoff) + ldsw + _i * 8192), 16, 0, 0); } while (0)
#define PG8_LDA(dst, b, h) do { _Pragma("unroll") for (int m = 0; m < 4; ++m) _Pragma("unroll") for (int k = 0; k < 2; ++k) dst[m][k] = *(const PG8_LAS bf16x8*)(lds + PG8_SA(b, h) + aoff + m * 2048 + k * 1024); } while (0)
#define PG8_LDB(dst, b, h) do { _Pragma("unroll") for (int n = 0; n < 2; ++n) _Pragma("unroll") for (int k = 0; k < 2; ++k) dst[n][k] = *(const PG8_LAS bf16x8*)(lds + PG8_SB(b, h) + boff + n * 2048 + k * 1024); } while (0)
#define PG8_MMA(ai, bj, At, Bt) do { __builtin_amdgcn_s_setprio(1); _Pragma("unroll") for (int m = 0; m < 4; ++m) _Pragma("unroll") for (int n = 0; n < 2; ++n) _Pragma("unroll") for (int k = 0; k < 2; ++k) \
        acc[ai][bj][m][n] = __builtin_amdgcn_mfma_f32_16x16x32_bf16(Bt[n][k], At[m][k], acc[ai][bj][m][n], 0, 0, 0); __builtin_amdgcn_s_setprio(0); } while (0)
#define PG8_WAIT_V(n) asm volatile("s_waitcnt vmcnt(" #n ")" ::: "memory")
#define PG8_WAIT_L(n) asm volatile("s_waitcnt lgkmcnt(" #n ")" ::: "memory")
#define PG8_BAR __builtin_amdgcn_s_barrier()
#define PG8_SCHED __builtin_amdgcn_sched_barrier(0)
    Unit cur, nxt; int ui = 0;
    if (!S.next(0, cur)) return;
    f32x4 acc[2][2][4][2];
#pragma unroll
    for (int a = 0; a < 2; ++a)
#pragma unroll
        for (int b = 0; b < 2; ++b)
#pragma unroll
            for (int m = 0; m < 4; ++m)
#pragma unroll
                for (int n = 0; n < 2; ++n) acc[a][b][m][n] = (f32x4){0.f, 0.f, 0.f, 0.f};
    bf16x8 At[4][2], B0[2][2], B1[2][2];
    const char* cA = (const char*)g.A + (size_t)cur.pm * tstep + koff; const char* cB = (const char*)g.Bt + (size_t)cur.pn * tstep + koff;
    S.a_ready(cur);
    if constexpr (SP2) {
        PG8_STAGE(PG8_SB(0, 0), cB, voffB); PG8_STAGE(PG8_SB(0, 1), cB + hstep, voffB); PG8_STAGE(PG8_SA(0, 0), cA, voffA); PG8_STAGE(PG8_SA(0, 1), cA + hstep, voffA);
        if (wr == 1) PG8_BAR;
        PG8_WAIT_V(2); PG8_BAR;
        PG8_STAGE(PG8_SB(1, 0), cB + kstep, voffB); PG8_STAGE(PG8_SA(1, 0), cA + kstep, voffA); PG8_STAGE(PG8_SB(1, 1), cB + hstep + kstep, voffB);
        PG8_WAIT_V(6); PG8_BAR;
    } else {
        PG8_STAGE(PG8_SB(0, 0), cB, voffB); PG8_STAGE(PG8_SA(0, 0), cA, voffA); PG8_STAGE(PG8_SB(0, 1), cB + hstep, voffB); PG8_STAGE(PG8_SA(0, 1), cA + hstep, voffA);
        if (wr == 1) PG8_BAR;
        PG8_WAIT_V(4); PG8_BAR;
        PG8_STAGE(PG8_SB(1, 0), cB + kstep, voffB); PG8_STAGE(PG8_SA(1, 0), cA + kstep, voffA); PG8_STAGE(PG8_SB(1, 1), cB + hstep + kstep, voffB);
        PG8_WAIT_V(6); PG8_BAR;
    }
    for (;;) {
        const bool has_next = S.next(ui + 1, nxt);
        const char* nA = has_next ? (const char*)g.A + (size_t)nxt.pm * tstep + koff : cA; const char* nB = has_next ? (const char*)g.Bt + (size_t)nxt.pn * tstep + koff : cB;
        for (int t = 0; t < nt; t += 2) {
            const bool last = (t == nt - 2);
            const char* a1 = cA + (size_t)(t + 1) * kstep;
            const char* a2 = last ? nA : cA + (size_t)(t + 2) * kstep; const char* b2 = last ? nB : cB + (size_t)(t + 2) * kstep;
            const char* a3 = a2 + kstep; const char* b3 = b2 + kstep;
            if (last && has_next) S.a_ready(nxt);
            if constexpr (SP2) {
            PG8_LDB(B0, 0, 0); PG8_LDB(B1, 0, 1); PG8_SCHED; PG8_LDA(At, 0, 0); PG8_STAGE(PG8_SA(1, 1), a1 + hstep, voffA);
            PG8_WAIT_V(8); PG8_WAIT_L(0); PG8_BAR; PG8_MMA(0, 0, At, B0); PG8_MMA(0, 1, At, B1); PG8_BAR; PG8_SCHED;
            PG8_LDA(At, 0, 1); PG8_STAGE(PG8_SB(0, 0), b2, voffB); PG8_STAGE(PG8_SB(0, 1), b2 + hstep, voffB); PG8_STAGE(PG8_SA(0, 0), a2, voffA);
            PG8_WAIT_V(8); PG8_WAIT_L(0); PG8_BAR; PG8_MMA(1, 0, At, B0); PG8_MMA(1, 1, At, B1); PG8_BAR; PG8_SCHED;
            PG8_LDB(B0, 1, 0); PG8_LDB(B1, 1, 1); PG8_SCHED; PG8_LDA(At, 1, 0); PG8_STAGE(PG8_SA(0, 1), a2 + hstep, voffA);
            PG8_WAIT_V(8); PG8_WAIT_L(0); PG8_BAR; PG8_MMA(0, 0, At, B0); PG8_MMA(0, 1, At, B1); PG8_BAR; PG8_SCHED;
            PG8_LDA(At, 1, 1); PG8_STAGE(PG8_SB(1, 0), b3, voffB); PG8_STAGE(PG8_SB(1, 1), b3 + hstep, voffB); PG8_STAGE(PG8_SA(1, 0), a3, voffA);
            PG8_WAIT_V(8); PG8_WAIT_L(0); PG8_BAR; PG8_MMA(1, 0, At, B0); PG8_MMA(1, 1, At, B1); PG8_BAR; PG8_SCHED;
            } else {
            PG8_LDB(B0, 0, 0); PG8_SCHED; PG8_LDA(At, 0, 0); PG8_STAGE(PG8_SA(1, 1), a1 + hstep, voffA);
            PG8_WAIT_L(8); PG8_BAR; PG8_WAIT_L(0); PG8_MMA(0, 0, At, B0); PG8_BAR; PG8_SCHED;
            PG8_LDB(B1, 0, 1); PG8_STAGE(PG8_SB(0, 0), b2, voffB);
            PG8_BAR; PG8_WAIT_L(0); PG8_MMA(0, 1, At, B1); PG8_BAR;
            PG8_LDA(At, 0, 1); PG8_STAGE(PG8_SA(0, 0), a2, voffA);
            PG8_BAR; PG8_WAIT_L(0); PG8_MMA(1, 0, At, B0); PG8_BAR; PG8_SCHED;
            PG8_STAGE(PG8_SB(0, 1), b2 + hstep, voffB);
            PG8_WAIT_V(6); PG8_BAR; PG8_MMA(1, 1, At, B1); PG8_BAR;
            PG8_LDB(B0, 1, 0); PG8_SCHED; PG8_LDA(At, 1, 0); PG8_STAGE(PG8_SA(0, 1), a2 + hstep, voffA);
            PG8_WAIT_L(8); PG8_BAR; PG8_WAIT_L(0); PG8_MMA(0, 0, At, B0); PG8_BAR; PG8_SCHED;
            PG8_LDB(B1, 1, 1); PG8_STAGE(PG8_SB(1, 0), b3, voffB);
            PG8_BAR; PG8_WAIT_L(0); PG8_MMA(0, 1, At, B1); PG8_BAR;
            PG8_LDA(At, 1, 1); PG8_STAGE(PG8_SA(1, 0), a3, voffA);
            PG8_BAR; PG8_WAIT_L(0); PG8_MMA(1, 0, At, B0); PG8_BAR; PG8_SCHED;
            PG8_STAGE(PG8_SB(1, 1), b3 + hstep, voffB);
            PG8_WAIT_V(6); PG8_BAR; PG8_MMA(1, 1, At, B1); PG8_BAR;
            }
        }
        if constexpr (ALIGN_EPI) { if (wr == 0) PG8_BAR; }
        if constexpr (!Epi::AFTER_DRAIN) { E(acc, cur, wr, wc, fr, fq); S.done(cur); }
        if (!has_next) break;
#pragma unroll
        for (int a = 0; a < 2; ++a)
#pragma unroll
            for (int b = 0; b < 2; ++b)
#pragma unroll
                for (int m = 0; m < 4; ++m)
#pragma unroll
                    for (int n = 0; n < 2; ++n) acc[a][b][m][n] = (f32x4){0.f, 0.f, 0.f, 0.f};
        cur = nxt; cA = nA; cB = nB; ++ui;
        if constexpr (ALIGN_EPI) { if (wr == 1) PG8_BAR; }
    }
    PG8_WAIT_V(0);
    if constexpr (!ALIGN_EPI) { if (wr == 0) PG8_BAR; }
    PG8_BAR;
    if constexpr (Epi::AFTER_DRAIN) { E.fused(acc, cur, wr, wc, fr, fq, lds, wid, lane); S.done(cur); }
#undef PG8_SA
#undef PG8_SB
#undef PG8_STAGE
#undef PG8_LDA
#undef PG8_LDB
#undef PG8_MMA
#undef PG8_WAIT_V
#undef PG8_WAIT_L
#undef PG8_BAR
#undef PG8_SCHED
}
}


template <class Inner> struct Pg8Epi {
    static constexpr bool PERM = true, AFTER_DRAIN = false;
    Inner in;
    __device__ __forceinline__ void operator()(const f32x4 (&acc)[2][2][4][2], const pg8::Unit& u, int wr, int wc, int fr, int fq) const {
#pragma unroll
        for (int ai = 0; ai < 2; ++ai)
#pragma unroll
            for (int m = 0; m < 4; ++m) {
                const int r = u.pm * 256 + ai * 128 + wr * 64 + m * 16 + fr;
                const int c0 = u.pn * 256 + wc * 32 + 8 * fq;
                const int cols[4] = {c0, c0 + 4, c0 + 128, c0 + 132};
                const f32x4 vv[4] = {acc[ai][0][m][0], acc[ai][0][m][1], acc[ai][1][m][0], acc[ai][1][m][1]};
                in.template row<4, true>(r, cols, vv, fq, 1.f);
            }
    }
};
struct EpiResB {
    const float* srcf; bf16_t* xb; float* dstf; float* ss;
    template <int NQ, bool PAIRED> __device__ __forceinline__ void row(int r, const int (&c)[NQ], const f32x4 (&v)[NQ], int fq, float rscale) const {
        static_assert(PAIRED && NQ % 2 == 0, "EpiResB: paired quads only");
        float a2 = 0.f;
#pragma unroll
        for (int q = 0; q < NQ; q += 2) {
            f32x4 s0, s1;
            if (srcf) { s0 = *(const f32x4*)(srcf + (size_t)r * D + c[q]); s1 = *(const f32x4*)(srcf + (size_t)r * D + c[q] + 4); }
            else { const u32x4 xr = *(const u32x4*)(xb + (size_t)r * D + c[q]); s0 = (f32x4){bflo(xr.x), bfhi(xr.x), bflo(xr.y), bfhi(xr.y)}; s1 = (f32x4){bflo(xr.z), bfhi(xr.z), bflo(xr.w), bfhi(xr.w)}; }
            const f32x4 o0 = s0 + v[q], o1 = s1 + v[q + 1];
            if (dstf) { *(f32x4*)(dstf + (size_t)r * D + c[q]) = o0; *(f32x4*)(dstf + (size_t)r * D + c[q] + 4) = o1; }
            else {
                u32x4 w; w.x = cvt_pk_bf16(o0.x, o0.y); w.y = cvt_pk_bf16(o0.z, o0.w); w.z = cvt_pk_bf16(o1.x, o1.y); w.w = cvt_pk_bf16(o1.z, o1.w);
                *(u32x4*)(xb + (size_t)r * D + c[q]) = w;
                a2 += (o0.x * o0.x + o0.y * o0.y) + (o0.z * o0.z + o0.w * o0.w) + (o1.x * o1.x + o1.y * o1.y) + (o1.z * o1.z + o1.w * o1.w);
            }
        }
        if (ss) { a2 += __shfl_xor(a2, 16); a2 += __shfl_xor(a2, 32); if (fq == 0) atomicAdd(ss + r, a2); }
    }
};
struct EpiAddF32 {
    float* dst;
    template <int NQ, bool PAIRED> __device__ __forceinline__ void row(int r, const int (&c)[NQ], const f32x4 (&v)[NQ], int fq, float rscale) const {
#pragma unroll
        for (int q = 0; q < NQ; ++q) { f32x4* d = (f32x4*)(dst + (size_t)r * D + c[q]); *d = *d + v[q]; }
    }
};
struct EpiAtomic {
    float* dst;
    template <int NQ, bool PAIRED> __device__ __forceinline__ void row(int r, const int (&c)[NQ], const f32x4 (&v)[NQ], int fq, float rscale) const {
#pragma unroll
        for (int q = 0; q < NQ; ++q) { float* d = dst + (size_t)r * D + c[q]; atomicAdd(d, v[q].x); atomicAdd(d + 1, v[q].y); atomicAdd(d + 2, v[q].z); atomicAdd(d + 3, v[q].w); }
    }
};

template <int AF32, class Epi>
__device__ __forceinline__ void sgemm64(unsigned char* lds, const void* Av, int lda, const bf16_t* __restrict__ Bt, int row0, int nrows, int N, int K, int ksplit,
                                        const Epi& E, int bid, int G) {
    const int tid = threadIdx.x, lane = tid & 63, wid = tid >> 6, wr = wid >> 2, wc = wid & 3, fr = lane & 15, fq = lane >> 4;
    const int nN = N / 128, nT = (nrows / 64) * nN, nU = nT * ksplit, Ksl = K / ksplit, nk = Ksl / 128;
    constexpr int LS = 136;
    bf16_t* As = (bf16_t*)lds;
    bf16_t* Bs = As + 2 * 64 * LS;
    float* rs = (float*)(Bs + 2 * 128 * LS);
    const int arow = tid >> 3, ak = (tid & 7) * 8;
    for (int u = bid; u < nU; u += G) {
        const int ks = u / nT, t = u % nT, pm = t / nN, pn = t % nN, k0 = ks * Ksl;
        const bf16_t* Ab = (const bf16_t*)Av + (size_t)(row0 + pm * 64 + arow) * lda + k0 + ak;
        const float* Af = (const float*)Av + (size_t)(row0 + pm * 64 + arow) * lda + k0 + ak;
        const bf16_t* Bg = Bt + (size_t)(pn * 128 + arow) * K + k0 + ak;
        f32x4 acc[2][2];
#pragma unroll
        for (int m = 0; m < 2; ++m)
#pragma unroll
            for (int n = 0; n < 2; ++n) acc[m][n] = (f32x4){0.f, 0.f, 0.f, 0.f};
        float ssq = 0.f;
        u32x4 ra[2], rb[2][2];
        auto loadAB = [&](int kt) {
#pragma unroll
            for (int h = 0; h < 2; ++h) {
                if (AF32) { const f32x4 a = *(const f32x4*)(Af + kt * 128 + 64 * h), b = *(const f32x4*)(Af + kt * 128 + 64 * h + 4);
                    ssq += (a.x * a.x + a.y * a.y) + (a.z * a.z + a.w * a.w) + (b.x * b.x + b.y * b.y) + (b.z * b.z + b.w * b.w);
                    ra[h].x = cvt_pk_bf16(a.x, a.y); ra[h].y = cvt_pk_bf16(a.z, a.w); ra[h].z = cvt_pk_bf16(b.x, b.y); ra[h].w = cvt_pk_bf16(b.z, b.w); }
                else ra[h] = *(const u32x4*)(Ab + kt * 128 + 64 * h);
#pragma unroll
                for (int i = 0; i < 2; ++i) rb[i][h] = *(const u32x4*)(Bg + (size_t)(64 * i) * K + kt * 128 + 64 * h);
            }
        };
        auto storeAB = [&](int buf) {
#pragma unroll
            for (int h = 0; h < 2; ++h) {
                *(u32x4*)(As + buf * 64 * LS + arow * LS + ak + 64 * h) = ra[h];
#pragma unroll
                for (int i = 0; i < 2; ++i) *(u32x4*)(Bs + buf * 128 * LS + (arow + 64 * i) * LS + ak + 64 * h) = rb[i][h];
            }
        };
        loadAB(0);
        storeAB(0);
        __syncthreads();
        for (int kt = 0; kt < nk; ++kt) {
            const int buf = kt & 1;
            if (kt + 1 < nk) loadAB(kt + 1);
            const bf16_t* as = As + buf * 64 * LS; const bf16_t* bs = Bs + buf * 128 * LS;
#pragma unroll
            for (int kk = 0; kk < 4; ++kk) {
                bf16x8 af[2], bfr[2];
#pragma unroll
                for (int m = 0; m < 2; ++m) af[m] = *(const bf16x8*)(as + (32 * wr + 16 * m + fr) * LS + 32 * kk + 8 * fq);
#pragma unroll
                for (int n = 0; n < 2; ++n) bfr[n] = *(const bf16x8*)(bs + (32 * wc + 16 * n + fr) * LS + 32 * kk + 8 * fq);
#pragma unroll
                for (int m = 0; m < 2; ++m)
#pragma unroll
                    for (int n = 0; n < 2; ++n) acc[m][n] = MFMA32(bfr[n], af[m], acc[m][n]);
            }
            if (kt + 1 < nk) storeAB(buf ^ 1);
            __syncthreads();
        }
        if (AF32) {
            ssq += __shfl_xor(ssq, 1); ssq += __shfl_xor(ssq, 2); ssq += __shfl_xor(ssq, 4);
            if ((tid & 7) == 0) rs[arow] = rsqrtf(ssq * (1.f / 1024.f) + EPS);
            __syncthreads();
        }
#pragma unroll
        for (int m = 0; m < 2; ++m) {
            const int lr = 32 * wr + 16 * m + fr, r = row0 + pm * 64 + lr;
            const int cols[2] = {pn * 128 + 32 * wc + 4 * fq, pn * 128 + 32 * wc + 16 + 4 * fq};
            const f32x4 vv[2] = {acc[m][0], acc[m][1]};
            E.template row<2, false>(r, cols, vv, fq, AF32 ? rs[lr] : 1.f);
        }
    }
}

template <class Epi>
__device__ __forceinline__ void sgemm_phase(unsigned char* lds, const bf16_t* __restrict__ A, const bf16_t* __restrict__ Bt, int row0, int nrows, int N, int K,
                                            const Epi& E, int bid, int G) {
    const int tid = threadIdx.x, lane = tid & 63, wid = tid >> 6, wr = wid >> 2, wc = wid & 3, fr = lane & 15, fq = lane >> 4;
    const int nN = N / 128, nU = (nrows / 128) * nN, nk = K / 64;
    bf16_t* As = (bf16_t*)lds;
    bf16_t* Bs = As + 2 * 128 * 72;
    const int ldrow = tid >> 3, ldk = (tid & 7) * 8;
    for (int u = bid; u < nU; u += G) {
        const int pm = u / nN, pn = u % nN;
        const bf16_t* Ag = A + (size_t)(row0 + pm * 128 + ldrow) * K + ldk;
        const bf16_t* Bg = Bt + (size_t)(pn * 128 + ldrow) * K + ldk;
        f32x4 acc[4][2];
#pragma unroll
        for (int m = 0; m < 4; ++m)
#pragma unroll
            for (int n = 0; n < 2; ++n) acc[m][n] = (f32x4){0.f, 0.f, 0.f, 0.f};
        u32x4 ra[2], rb[2];
#pragma unroll
        for (int i = 0; i < 2; ++i) { ra[i] = *(const u32x4*)(Ag + (size_t)(64 * i) * K); rb[i] = *(const u32x4*)(Bg + (size_t)(64 * i) * K); }
#pragma unroll
        for (int i = 0; i < 2; ++i) { *(u32x4*)(As + (ldrow + 64 * i) * 72 + ldk) = ra[i]; *(u32x4*)(Bs + (ldrow + 64 * i) * 72 + ldk) = rb[i]; }
        __syncthreads();
        for (int kt = 0; kt < nk; ++kt) {
            const int buf = kt & 1;
            if (kt + 1 < nk) {
#pragma unroll
                for (int i = 0; i < 2; ++i) { ra[i] = *(const u32x4*)(Ag + (size_t)(64 * i) * K + (kt + 1) * 64); rb[i] = *(const u32x4*)(Bg + (size_t)(64 * i) * K + (kt + 1) * 64); }
            }
            const bf16_t* as = As + buf * 128 * 72; const bf16_t* bs = Bs + buf * 128 * 72;
#pragma unroll
            for (int kk = 0; kk < 2; ++kk) {
                bf16x8 af[4], bfr[2];
#pragma unroll
                for (int m = 0; m < 4; ++m) af[m] = *(const bf16x8*)(as + (64 * wr + 16 * m + fr) * 72 + 32 * kk + 8 * fq);
#pragma unroll
                for (int n = 0; n < 2; ++n) bfr[n] = *(const bf16x8*)(bs + (32 * wc + 16 * n + fr) * 72 + 32 * kk + 8 * fq);
#pragma unroll
                for (int m = 0; m < 4; ++m)
#pragma unroll
                    for (int n = 0; n < 2; ++n) acc[m][n] = MFMA32(bfr[n], af[m], acc[m][n]);
            }
            if (kt + 1 < nk) {
                bf16_t* an = As + (buf ^ 1) * 128 * 72; bf16_t* bn = Bs + (buf ^ 1) * 128 * 72;
#pragma unroll
                for (int i = 0; i < 2; ++i) { *(u32x4*)(an + (ldrow + 64 * i) * 72 + ldk) = ra[i]; *(u32x4*)(bn + (ldrow + 64 * i) * 72 + ldk) = rb[i]; }
            }
            __syncthreads();
        }
#pragma unroll
        for (int m = 0; m < 4; ++m) {
            const int r = row0 + pm * 128 + 64 * wr + 16 * m + fr;
            const int cols[2] = {pn * 128 + 32 * wc + 4 * fq, pn * 128 + 32 * wc + 16 + 4 * fq};
            const f32x4 vv[2] = {acc[m][0], acc[m][1]};
            E.template row<2, false>(r, cols, vv, fq, 1.f);
        }
    }
}

__device__ __forceinline__ void mlstm_local_unit(const Params& p, unsigned char* lds, int u) {
    const int tid = threadIdx.x, lane = tid & 63, wid = tid >> 6, fr = lane & 15, fq = lane >> 4;
    const int bh = u >> 6, c = u & 63, b = bh >> 2, h = bh & 3, base = b * 4096 + c * 64;
    unsigned char* ws = p.ws;
    const bf16_t* P = (const bf16_t*)(ws + WS_P); const float* gates = (const float*)(ws + WS_GATES);
    bf16_t* GS = (bf16_t*)p.out;
    bf16_t* kT = (bf16_t*)lds;
    bf16_t* vT = kT + 128 * 72;
    float* wk = (float*)(vT + 256 * 72);
    if (wid == 0) {
        const float lf = gates[(size_t)(base + lane) * 8 + 4 + h], li = gates[(size_t)(base + lane) * 8 + h];
        const float bc = scan_sum(lf, lane);
        const float B = __shfl(bc, 63);
        const float val = B - bc + li;
        const float ml = wave_max(val);
        wk[lane] = __expf(val - ml);
        if (lane == 0) { ((float*)(ws + WS_CHB))[u] = B; ((float*)(ws + WS_CHM))[u] = ml; }
    }
    __syncthreads();
    {
        const bf16_t* Pk = P + (size_t)(base + lane) * NIN + 512 + h * 128;
#pragma unroll
        for (int i = 0; i < 2; ++i) {
            const int dch = wid * 2 + i; const u32x4 r = *(const u32x4*)(Pk + dch * 8);
            bf16_t* dst = kT + (dch * 8) * 72 + lane;
            dst[0 * 72] = (bf16_t)(r.x & 0xffff); dst[1 * 72] = (bf16_t)(r.x >> 16); dst[2 * 72] = (bf16_t)(r.y & 0xffff); dst[3 * 72] = (bf16_t)(r.y >> 16);
            dst[4 * 72] = (bf16_t)(r.z & 0xffff); dst[5 * 72] = (bf16_t)(r.z >> 16); dst[6 * 72] = (bf16_t)(r.w & 0xffff); dst[7 * 72] = (bf16_t)(r.w >> 16);
        }
        const bf16_t* Pv = P + (size_t)(base + lane) * NIN + 1024 + h * 256;
        const float w = wk[lane];
#pragma unroll
        for (int i = 0; i < 4; ++i) {
            const int vch = wid * 4 + i; const u32x4 r = *(const u32x4*)(Pv + vch * 8);
            bf16_t* dst = vT + (vch * 8) * 72 + lane;
            dst[0 * 72] = f2bf(bflo(r.x) * w); dst[1 * 72] = f2bf(bfhi(r.x) * w); dst[2 * 72] = f2bf(bflo(r.y) * w); dst[3 * 72] = f2bf(bfhi(r.y) * w);
            dst[4 * 72] = f2bf(bflo(r.z) * w); dst[5 * 72] = f2bf(bfhi(r.z) * w); dst[6 * 72] = f2bf(bflo(r.w) * w); dst[7 * 72] = f2bf(bfhi(r.w) * w);
        }
    }
    __syncthreads();
    {
        f32x4 acc[2][8];
#pragma unroll
        for (int a = 0; a < 2; ++a)
#pragma unroll
            for (int d = 0; d < 8; ++d) acc[a][d] = (f32x4){0.f, 0.f, 0.f, 0.f};
#pragma unroll
        for (int ks = 0; ks < 2; ++ks) {
            bf16x8 yf[2];
#pragma unroll
            for (int vt = 0; vt < 2; ++vt) yf[vt] = *(const bf16x8*)(vT + (32 * wid + 16 * vt + fr) * 72 + 32 * ks + 8 * fq);
#pragma unroll
            for (int dt = 0; dt < 8; ++dt) {
                const bf16x8 xf = *(const bf16x8*)(kT + (16 * dt + fr) * 72 + 32 * ks + 8 * fq);
#pragma unroll
                for (int vt = 0; vt < 2; ++vt) acc[vt][dt] = MFMA32(xf, yf[vt], acc[vt][dt]);
            }
        }
        bf16_t* G = GS + (size_t)u * 32768;
#pragma unroll
        for (int vt = 0; vt < 2; ++vt)
#pragma unroll
            for (int dt = 0; dt < 8; ++dt) {
                u32x2 w; w.x = cvt_pk_bf16(acc[vt][dt].x, acc[vt][dt].y); w.y = cvt_pk_bf16(acc[vt][dt].z, acc[vt][dt].w);
                *(u32x2*)(G + (32 * wid + 16 * vt + fr) * 128 + 16 * dt + 4 * fq) = w;
            }
    }
    if (tid < 128) {
        float s = 0.f;
#pragma unroll 8
        for (int ss = 0; ss < 64; ++ss) s += bf2f(kT[tid * 72 + ss]) * wk[ss];
        ((float*)(ws + WS_GN))[(size_t)u * 128 + tid] = s;
    }
    __syncthreads();
}

__device__ __forceinline__ void mlstm_local_pair(const Params& p, unsigned char* lds, int u2) {
    const int tid = threadIdx.x, lane = tid & 63, wid = tid >> 6, fr = lane & 15, fq = lane >> 4;
    const int bh = u2 >> 5, c0 = (u2 & 31) * 2, b = bh >> 2, h = bh & 3, base = b * 4096 + c0 * 64, u0 = bh * 64 + c0;
    unsigned char* ws = p.ws;
    const bf16_t* P = (const bf16_t*)(ws + WS_P); const float* gates = (const float*)(ws + WS_GATES);
    bf16_t* GS = (bf16_t*)p.out;
    bf16_t* kT = (bf16_t*)lds;
    bf16_t* vT = kT + 2 * 128 * 72;
    float* wk = (float*)(vT + 2 * 256 * 72);
    u32x4 kr[4], vr[8];
#pragma unroll
    for (int i = 0; i < 4; ++i) { const int pr = wid * 4 + i, ch = pr >> 4, dch = pr & 15; kr[i] = *(const u32x4*)(P + (size_t)(base + ch * 64 + lane) * NIN + 512 + h * 128 + dch * 8); }
#pragma unroll
    for (int i = 0; i < 8; ++i) { const int pr = wid * 8 + i, ch = pr >> 5, vch = pr & 31; vr[i] = *(const u32x4*)(P + (size_t)(base + ch * 64 + lane) * NIN + 1024 + h * 256 + vch * 8); }
    if (wid < 2) {
        const int row = base + wid * 64 + lane;
        const float lf = gates[(size_t)row * 8 + 4 + h], li = gates[(size_t)row * 8 + h];
        const float bc = scan_sum(lf, lane);
        const float B = __shfl(bc, 63);
        const float val = B - bc + li;
        const float ml = wave_max(val);
        wk[wid * 64 + lane] = __expf(val - ml);
        if (lane == 0) { ((float*)(ws + WS_CHB))[u0 + wid] = B; ((float*)(ws + WS_CHM))[u0 + wid] = ml; }
    }
#pragma unroll
    for (int i = 0; i < 4; ++i) {
        const int pr = wid * 4 + i, ch = pr >> 4, dch = pr & 15; const u32x4 r = kr[i];
        bf16_t* dst = kT + ch * 128 * 72 + (dch * 8) * 72 + lane;
        dst[0 * 72] = (bf16_t)(r.x & 0xffff); dst[1 * 72] = (bf16_t)(r.x >> 16); dst[2 * 72] = (bf16_t)(r.y & 0xffff); dst[3 * 72] = (bf16_t)(r.y >> 16);
        dst[4 * 72] = (bf16_t)(r.z & 0xffff); dst[5 * 72] = (bf16_t)(r.z >> 16); dst[6 * 72] = (bf16_t)(r.w & 0xffff); dst[7 * 72] = (bf16_t)(r.w >> 16);
    }
    __syncthreads();
#pragma unroll
    for (int i = 0; i < 8; ++i) {
        const int pr = wid * 8 + i, ch = pr >> 5, vch = pr & 31; const u32x4 r = vr[i];
        const float w = wk[ch * 64 + lane];
        bf16_t* dst = vT + ch * 256 * 72 + (vch * 8) * 72 + lane;
        dst[0 * 72] = f2bf(bflo(r.x) * w); dst[1 * 72] = f2bf(bfhi(r.x) * w); dst[2 * 72] = f2bf(bflo(r.y) * w); dst[3 * 72] = f2bf(bfhi(r.y) * w);
        dst[4 * 72] = f2bf(bflo(r.z) * w); dst[5 * 72] = f2bf(bfhi(r.z) * w); dst[6 * 72] = f2bf(bflo(r.w) * w); dst[7 * 72] = f2bf(bfhi(r.w) * w);
    }
    __syncthreads();
#pragma unroll 1
    for (int ch = 0; ch < 2; ++ch) {
        const bf16_t* kTc = kT + ch * 128 * 72; const bf16_t* vTc = vT + ch * 256 * 72;
        f32x4 acc[2][8];
#pragma unroll
        for (int a = 0; a < 2; ++a)
#pragma unroll
            for (int d = 0; d < 8; ++d) acc[a][d] = (f32x4){0.f, 0.f, 0.f, 0.f};
#pragma unroll
        for (int ks = 0; ks < 2; ++ks) {
            bf16x8 yf[2];
#pragma unroll
            for (int vt = 0; vt < 2; ++vt) yf[vt] = *(const bf16x8*)(vTc + (32 * wid + 16 * vt + fr) * 72 + 32 * ks + 8 * fq);
#pragma unroll
            for (int dt = 0; dt < 8; ++dt) {
                const bf16x8 xf = *(const bf16x8*)(kTc + (16 * dt + fr) * 72 + 32 * ks + 8 * fq);
#pragma unroll
                for (int vt = 0; vt < 2; ++vt) acc[vt][dt] = MFMA32(xf, yf[vt], acc[vt][dt]);
            }
        }
        bf16_t* G = GS + (size_t)(u0 + ch) * 32768;
#pragma unroll
        for (int vt = 0; vt < 2; ++vt)
#pragma unroll
            for (int dt = 0; dt < 8; ++dt) {
                u32x2 w; w.x = cvt_pk_bf16(acc[vt][dt].x, acc[vt][dt].y); w.y = cvt_pk_bf16(acc[vt][dt].z, acc[vt][dt].w);
                *(u32x2*)(G + (32 * wid + 16 * vt + fr) * 128 + 16 * dt + 4 * fq) = w;
            }
    }
    if (tid < 256) {
        const int ch = tid >> 7, d = tid & 127;
        float s = 0.f;
#pragma unroll 8
        for (int ss = 0; ss < 64; ++ss) s += bf2f(kT[ch * 128 * 72 + d * 72 + ss]) * wk[ch * 64 + ss];
        ((float*)(ws + WS_GN))[(size_t)(u0 + ch) * 128 + d] = s;
    }
    __syncthreads();
}

__device__ __forceinline__ void mlstm_sample_unit(const Params& p, unsigned char* lds, int u) {
    const int tid = threadIdx.x, lane = tid & 63, wid = tid >> 6;
    const int b = u >> 2, h = u & 3, base = TP + b * 4;
    unsigned char* ws = p.ws;
    const bf16_t* P = (const bf16_t*)(ws + WS_P); const float* gates = (const float*)(ws + WS_GATES);
    float* q = (float*)lds;
    float* k = q + 512;
    float* v = k + 512;
    float* n0 = v + 1024;
    float* sc = n0 + 128;
    float* red = sc + 64;
    const float* C0 = p.st_C + (size_t)u * 32768;
    float* Cout = p.out + O_SC + (size_t)u * 32768;
    {
        const int t = tid >> 7, d = tid & 127;
        q[tid] = bf2f(P[(size_t)(base + t) * NIN + h * 128 + d]);
        k[tid] = bf2f(P[(size_t)(base + t) * NIN + 512 + h * 128 + d]);
        const int t2 = tid >> 8, vv = tid & 255;
        v[tid] = bf2f(P[(size_t)(base + t2) * NIN + 1024 + h * 256 + vv]);
        v[512 + tid] = bf2f(P[(size_t)(base + 2 + t2) * NIN + 1024 + h * 256 + vv]);
        if (tid < 128) n0[tid] = p.st_n[(size_t)u * 128 + tid];
    }
    if (tid == 0) {
        float li[4], bc[4]; float run = 0.f;
#pragma unroll
        for (int t = 0; t < 4; ++t) { li[t] = gates[(size_t)(base + t) * 8 + h]; run += gates[(size_t)(base + t) * 8 + 4 + h]; bc[t] = run; }
        const float m0 = p.st_m[u]; float mt[4];
#pragma unroll
        for (int t = 0; t < 4; ++t) {
            const float inter = bc[t] + m0; float mx = inter;
#pragma unroll
            for (int s = 0; s < 4; ++s) if (s <= t) mx = fmaxf(mx, bc[t] - bc[s] + li[s]);
            mt[t] = mx; sc[16 + t] = __expf(inter - mx); sc[28 + t] = __expf(-mx);
#pragma unroll
            for (int s = 0; s < 4; ++s) sc[t * 4 + s] = (s <= t) ? __expf(bc[t] - bc[s] + li[s] - mx) : 0.f;
        }
        const float mn = mt[3];
        sc[24] = __expf(bc[3] + m0 - mn);
#pragma unroll
        for (int s = 0; s < 4; ++s) sc[20 + s] = __expf(bc[3] - bc[s] + li[s] - mn);
        p.out[O_SM + u] = mn;
    }
    __syncthreads();
#pragma unroll
    for (int i = 0; i < 2; ++i) {
        const int pr = wid * 2 + i, t = pr >> 2, s = pr & 3;
        float a = q[t * 128 + lane] * k[s * 128 + lane] + q[t * 128 + 64 + lane] * k[s * 128 + 64 + lane];
        a = wave_sum(a);
        if (lane == 0) sc[32 + pr] = a * sc[pr];
    }
    if (wid < 4) { float a = q[wid * 128 + lane] * n0[lane] + q[wid * 128 + 64 + lane] * n0[64 + lane]; a = wave_sum(a); if (lane == 0) sc[48 + wid] = a; }
    if (tid < 8) sc[52 + tid] = 0.f;
    {
        const int vq = lane, dg = wid;
        f32x4 qc[4];
#pragma unroll
        for (int t = 0; t < 4; ++t) qc[t] = (f32x4){0.f, 0.f, 0.f, 0.f};
        const float decay = sc[24];
        f32x4 vs[4];
#pragma unroll
        for (int s = 0; s < 4; ++s) vs[s] = *(const f32x4*)(v + s * 256 + 4 * vq) * sc[20 + s];
#pragma unroll 4
        for (int dd = 0; dd < 16; ++dd) {
            const int d = dg * 16 + dd;
            const f32x4 c0 = *(const f32x4*)(C0 + (size_t)d * 256 + 4 * vq);
            f32x4 cn = c0 * decay;
#pragma unroll
            for (int s = 0; s < 4; ++s) cn += vs[s] * k[s * 128 + d];
            *(f32x4*)(Cout + (size_t)d * 256 + 4 * vq) = cn;
#pragma unroll
            for (int t = 0; t < 4; ++t) qc[t] += c0 * q[t * 128 + d];
        }
#pragma unroll
        for (int t = 0; t < 4; ++t) *(f32x4*)(red + (dg * 4 + t) * 256 + 4 * vq) = qc[t];
    }
    if (tid < 128) {
        float nn = sc[24] * n0[tid];
#pragma unroll
        for (int s = 0; s < 4; ++s) nn += sc[20 + s] * k[s * 128 + tid];
        p.out[O_SN + (size_t)u * 128 + tid] = nn;
    }
    __syncthreads();
    {
        const int t = tid >> 7, v0 = (tid & 127) * 2;
        float den = sc[16 + t] * sc[48 + t];
#pragma unroll
        for (int s = 0; s < 4; ++s) den += sc[32 + t * 4 + s];
        const float inv = 1.f / fmaxf(fabsf(den), sc[28 + t]);
        float hv[2]; float ssq = 0.f;
#pragma unroll
        for (int j = 0; j < 2; ++j) {
            float qC = 0.f;
#pragma unroll
            for (int g = 0; g < 8; ++g) qC += red[(g * 4 + t) * 256 + v0 + j];
            float num = sc[16 + t] * qC;
#pragma unroll
            for (int s = 0; s < 4; ++s) num += sc[32 + t * 4 + s] * v[s * 256 + v0 + j];
            hv[j] = num * inv; ssq += hv[j] * hv[j];
        }
        ssq = wave_sum(ssq);
        if (lane == 0) sc[52 + wid] = ssq;
        __syncthreads();
        const float tot = sc[52 + 2 * t] + sc[52 + 2 * t + 1];
        const float rstd = rsqrtf(tot * (1.f / 256.f) + EPS);
        const unsigned ob = *(const unsigned*)(P + (size_t)(base + t) * NIN + 2048 + h * 256 + v0);
        const float o0 = sigmoidf_(bflo(ob)), o1 = sigmoidf_(bfhi(ob));
        const float g0 = p.ml_head_g[h * 256 + v0], g1 = p.ml_head_g[h * 256 + v0 + 1];
        bf16_t* HG = (bf16_t*)(ws + WS_HG);
        *(unsigned*)(HG + (size_t)(base + t) * D + h * 256 + v0) = cvt_pk_bf16(hv[0] * rstd * g0 * o0, hv[1] * rstd * g1 * o1);
    }
    __syncthreads();
}

__device__ __forceinline__ void mlstm_scan(const Params& p, unsigned char* lds, int bid, int G) {
    unsigned char* ws = p.ws;
    bf16_t* GS = (bf16_t*)p.out;
    const float* CHB = (const float*)(ws + WS_CHB); const float* CHM = (const float*)(ws + WS_CHM);
    float* MPREV = (float*)(ws + WS_MPREV); float* GN = (float*)(ws + WS_GN);
    const int tid = threadIdx.x;
    float* decs = (float*)lds;
    float* scls = decs + 64;
    float* tile = scls + 64;
    for (int blk = bid; blk < 256; blk += G) {
        const int bh = blk >> 4;
        if (tid < 64) {
            const float B = CHB[bh * 64 + tid], ml = CHM[bh * 64 + tid];
            float a = B, b2 = ml;
#pragma unroll
            for (int o = 1; o < 64; o <<= 1) { const float ya = __shfl_up(a, o), yb = __shfl_up(b2, o); if (tid >= o) { b2 = fmaxf(yb + a, b2); a = ya + a; } }
            const float m = fmaxf(a, b2);
            float mp = __shfl_up(m, 1); if (tid == 0) mp = 0.f;
            decs[tid] = __expf(B + mp - m); scls[tid] = __expf(ml - m);
            if ((blk & 15) == 0) { MPREV[bh * 64 + tid] = mp; if (tid == 63) p.out[O_PM + bh] = m; }
        }
        float gnv[64]; float* gp = GN + (size_t)(bh * 64) * 128 + (blk & 15) * 8 + (tid & 7);
        if (tid < 8) {
#pragma unroll
            for (int c = 0; c < 64; ++c) gnv[c] = gp[(size_t)c * 128];
        }
        __syncthreads();
        const int e4 = blk * NTHREADS + tid;
        const int off = (e4 & 8191) * 4;
        bf16_t* ptr = GS + (size_t)bh * 64 * 32768 + off;
        float c0 = 0.f, c1 = 0.f, c2 = 0.f, c3 = 0.f;
#pragma unroll 1
        for (int cb = 0; cb < 64; cb += 16) {
            u32x2 g[16];
#pragma unroll
            for (int j = 0; j < 16; ++j) g[j] = *(const u32x2*)(ptr + (size_t)(cb + j) * 32768);
#pragma unroll
            for (int j = 0; j < 16; ++j) {
                const float dec = decs[cb + j], s = scls[cb + j];
                u32x2 w; w.x = cvt_pk_bf16(c0, c1); w.y = cvt_pk_bf16(c2, c3);
                *(u32x2*)(ptr + (size_t)(cb + j) * 32768) = w;
                c0 = dec * c0 + s * bflo(g[j].x); c1 = dec * c1 + s * bfhi(g[j].x); c2 = dec * c2 + s * bflo(g[j].y); c3 = dec * c3 + s * bfhi(g[j].y);
            }
        }
        {
            const int vl = (off >> 7) & 15, d = off & 127;
            tile[(d + 0) * 20 + vl] = c0; tile[(d + 1) * 20 + vl] = c1; tile[(d + 2) * 20 + vl] = c2; tile[(d + 3) * 20 + vl] = c3;
            __syncthreads();
            const int dd = tid >> 2, vq = tid & 3, v0 = (blk & 15) * 16;
            const f32x4 o = (f32x4){tile[dd * 20 + 4 * vq], tile[dd * 20 + 4 * vq + 1], tile[dd * 20 + 4 * vq + 2], tile[dd * 20 + 4 * vq + 3]};
            *(f32x4*)(p.out + O_PC + (size_t)bh * 32768 + (size_t)dd * 256 + v0 + 4 * vq) = o;
        }
        if (tid < 8) {
            float n = 0.f;
#pragma unroll
            for (int c = 0; c < 64; ++c) { gp[(size_t)c * 128] = n; n = decs[c] * n + scls[c] * gnv[c]; }
            p.out[O_PN + bh * 128 + (blk & 15) * 8 + tid] = n;
        }
        __syncthreads();
    }
}

__device__ __forceinline__ void mlstm_out_unit(const Params& p, unsigned char* lds, int u) {
    const int tid = threadIdx.x, lane = tid & 63, wid = tid >> 6, fr = lane & 15, fq = lane >> 4;
    const int bh = u >> 6, c = u & 63, b = bh >> 2, h = bh & 3, base = b * 4096 + c * 64;
    unsigned char* ws = p.ws;
    const bf16_t* P = (const bf16_t*)(ws + WS_P); const float* gates = (const float*)(ws + WS_GATES);
    const bf16_t* CT = (const bf16_t*)p.out + (size_t)u * 32768;
    bf16_t* Qs = (bf16_t*)lds;
    bf16_t* Ks = Qs + 64 * 136;
    bf16_t* Ac = Ks + 64 * 136;
    bf16_t* VT = Ac + 64 * 200;
    float* sm = (float*)(VT + 256 * 72);
    float *bt = sm, *lmb = sm + 64, *mt = sm + 128, *at = sm + 192, *den = sm + 256, *hss = sm + 320, *npv = sm + 384;
    bf16x8 cf[2][4];
#pragma unroll
    for (int vt = 0; vt < 2; ++vt)
#pragma unroll
        for (int kd = 0; kd < 4; ++kd) cf[vt][kd] = *(const bf16x8*)(CT + (32 * wid + 16 * vt + fr) * 128 + 32 * kd + 8 * fq);
    if (wid == 0) {
        const float lf = gates[(size_t)(base + lane) * 8 + 4 + h], li = gates[(size_t)(base + lane) * 8 + h];
        const float bc = scan_sum(lf, lane);
        const float lm = li - bc;
        const float pm = scan_max(lm, lane);
        const float mprev = ((const float*)(ws + WS_MPREV))[u];
        const float inter = bc + mprev;
        const float m_t = fmaxf(inter, bc + pm);
        bt[lane] = bc; lmb[lane] = lm; mt[lane] = m_t; at[lane] = __expf(inter - m_t); den[lane] = 0.f; hss[lane] = 0.f;
    }
    if (wid == 1) { const float* NP = (const float*)(ws + WS_GN) + (size_t)u * 128; npv[lane] = NP[lane]; npv[64 + lane] = NP[64 + lane]; }
    __syncthreads();
#pragma unroll
    for (int i = 0; i < 2; ++i) {
        const int ci = tid + 512 * i, t = ci >> 4, dch = ci & 15;
        const u32x4 qv = *(const u32x4*)(P + (size_t)(base + t) * NIN + h * 128 + dch * 8);
        const u32x4 kv = *(const u32x4*)(P + (size_t)(base + t) * NIN + 512 + h * 128 + dch * 8);
        *(u32x4*)(Qs + t * 136 + dch * 8) = qv;
        *(u32x4*)(Ks + t * 136 + dch * 8) = kv;
        const float a = at[t];
        u32x4 sq; sq.x = cvt_pk_bf16(bflo(qv.x) * a, bfhi(qv.x) * a); sq.y = cvt_pk_bf16(bflo(qv.y) * a, bfhi(qv.y) * a);
        sq.z = cvt_pk_bf16(bflo(qv.z) * a, bfhi(qv.z) * a); sq.w = cvt_pk_bf16(bflo(qv.w) * a, bfhi(qv.w) * a);
        *(u32x4*)(Ac + t * 200 + 64 + dch * 8) = sq;
    }
    {
        const bf16_t* Pv = P + (size_t)(base + lane) * NIN + 1024 + h * 256;
#pragma unroll
        for (int i = 0; i < 4; ++i) {
            const int vch = wid * 4 + i; const u32x4 r = *(const u32x4*)(Pv + vch * 8);
            bf16_t* dst = VT + (vch * 8) * 72 + lane;
            dst[0 * 72] = (bf16_t)(r.x & 0xffff); dst[1 * 72] = (bf16_t)(r.x >> 16); dst[2 * 72] = (bf16_t)(r.y & 0xffff); dst[3 * 72] = (bf16_t)(r.y >> 16);
            dst[4 * 72] = (bf16_t)(r.z & 0xffff); dst[5 * 72] = (bf16_t)(r.z >> 16); dst[6 * 72] = (bf16_t)(r.w & 0xffff); dst[7 * 72] = (bf16_t)(r.w >> 16);
        }
    }
    __syncthreads();
    {
        const int tt = wid >> 1;
#pragma unroll
        for (int j = 0; j < 2; ++j) {
            const int st = 2 * (wid & 1) + j;
            const int t = 16 * tt + fr, s0 = 16 * st + 4 * fq;
            u32x2 w; w.x = 0u; w.y = 0u;
            if (st <= tt) {
                f32x4 a = (f32x4){0.f, 0.f, 0.f, 0.f};
#pragma unroll
                for (int kd = 0; kd < 4; ++kd) {
                    const bf16x8 x = *(const bf16x8*)(Ks + (16 * st + fr) * 136 + 32 * kd + 8 * fq);
                    const bf16x8 y = *(const bf16x8*)(Qs + (16 * tt + fr) * 136 + 32 * kd + 8 * fq);
                    a = MFMA32(x, y, a);
                }
                const float e0 = bt[t] - mt[t];
                float vals[4];
#pragma unroll
                for (int i = 0; i < 4; ++i) { const int s = s0 + i; vals[i] = (s <= t) ? a[i] * __expf(e0 + lmb[s]) : 0.f; }
                float rs = (vals[0] + vals[1]) + (vals[2] + vals[3]);
                rs += __shfl_xor(rs, 16); rs += __shfl_xor(rs, 32);
                if (fq == 0) atomicAdd(&den[t], rs);
                w.x = cvt_pk_bf16(vals[0], vals[1]); w.y = cvt_pk_bf16(vals[2], vals[3]);
            }
            *(u32x2*)(Ac + t * 200 + s0) = w;
        }
#pragma unroll
        for (int i = 0; i < 8; ++i) {
            const int t = 8 * wid + i;
            float a = bf2f(Qs[t * 136 + lane]) * npv[lane] + bf2f(Qs[t * 136 + 64 + lane]) * npv[64 + lane];
            a = wave_sum(a);
            if (lane == 0) atomicAdd(&den[t], at[t] * a);
        }
    }
    __syncthreads();
    f32x4 acc[4][2];
#pragma unroll
    for (int a = 0; a < 4; ++a)
#pragma unroll
        for (int d = 0; d < 2; ++d) acc[a][d] = (f32x4){0.f, 0.f, 0.f, 0.f};
#pragma unroll
    for (int kk = 0; kk < 6; ++kk) {
        bf16x8 x[2];
#pragma unroll
        for (int vt = 0; vt < 2; ++vt) x[vt] = (kk < 2) ? *(const bf16x8*)(VT + (32 * wid + 16 * vt + fr) * 72 + 32 * kk + 8 * fq) : cf[vt][kk >= 2 ? kk - 2 : 0];
#pragma unroll
        for (int tt = 0; tt < 4; ++tt) {
            const bf16x8 y = *(const bf16x8*)(Ac + (16 * tt + fr) * 200 + 32 * kk + 8 * fq);
#pragma unroll
            for (int vt = 0; vt < 2; ++vt) acc[tt][vt] = MFMA32(x[vt], y, acc[tt][vt]);
        }
    }
#pragma unroll
    for (int tt = 0; tt < 4; ++tt) {
        const int t = 16 * tt + fr;
        const float inv = 1.f / fmaxf(fabsf(den[t]), __expf(-mt[t]));
        float ssq = 0.f;
#pragma unroll
        for (int vt = 0; vt < 2; ++vt) { acc[tt][vt] = acc[tt][vt] * inv; const f32x4 a = acc[tt][vt]; ssq += (a.x * a.x + a.y * a.y) + (a.z * a.z + a.w * a.w); }
        ssq += __shfl_xor(ssq, 16); ssq += __shfl_xor(ssq, 32);
        if (fq == 0) atomicAdd(&hss[t], ssq);
    }
    __syncthreads();
    {
        bf16_t* HG = (bf16_t*)(ws + WS_HG);
#pragma unroll
        for (int tt = 0; tt < 4; ++tt) {
            const int t = 16 * tt + fr;
            const float rstd = rsqrtf(hss[t] * (1.f / 256.f) + EPS);
#pragma unroll
            for (int vt = 0; vt < 2; ++vt) {
                const int v0 = 32 * wid + 16 * vt + 4 * fq;
                const u32x2 ob = *(const u32x2*)(P + (size_t)(base + t) * NIN + 2048 + h * 256 + v0);
                const f32x4 g = *(const f32x4*)(p.ml_head_g + h * 256 + v0);
                const f32x4 a = acc[tt][vt];
                u32x2 w;
                w.x = cvt_pk_bf16(a.x * rstd * g.x * sigmoidf_(bflo(ob.x)), a.y * rstd * g.y * sigmoidf_(bfhi(ob.x)));
                w.y = cvt_pk_bf16(a.z * rstd * g.z * sigmoidf_(bflo(ob.y)), a.w * rstd * g.w * sigmoidf_(bfhi(ob.y)));
                *(u32x2*)(HG + (size_t)(base + t) * D + h * 256 + v0) = w;
            }
        }
    }
    __syncthreads();
}

__device__ __forceinline__ void norm_frag(const u32x4 r0, const u32x4 r1, const float* __restrict__ g, float extra, int fq, bf16x8& o0, bf16x8& o1) {
    float f[16];
    f[0] = bflo(r0.x); f[1] = bfhi(r0.x); f[2] = bflo(r0.y); f[3] = bfhi(r0.y); f[4] = bflo(r0.z); f[5] = bfhi(r0.z); f[6] = bflo(r0.w); f[7] = bfhi(r0.w);
    f[8] = bflo(r1.x); f[9] = bfhi(r1.x); f[10] = bflo(r1.y); f[11] = bfhi(r1.y); f[12] = bflo(r1.z); f[13] = bfhi(r1.z); f[14] = bflo(r1.w); f[15] = bfhi(r1.w);
    float s = 0.f;
#pragma unroll
    for (int i = 0; i < 16; ++i) s += f[i] * f[i];
    s += __shfl_xor(s, 16); s += __shfl_xor(s, 32);
    const float rs = rsqrtf(s * (1.f / 64.f) + EPS) * extra;
    const f32x4 ga = *(const f32x4*)(g + 8 * fq), gb = *(const f32x4*)(g + 8 * fq + 4), gc = *(const f32x4*)(g + 32 + 8 * fq), gd = *(const f32x4*)(g + 32 + 8 * fq + 4);
    u32x4 a, b2;
    a.x = cvt_pk_bf16(f[0] * rs * ga.x, f[1] * rs * ga.y); a.y = cvt_pk_bf16(f[2] * rs * ga.z, f[3] * rs * ga.w);
    a.z = cvt_pk_bf16(f[4] * rs * gb.x, f[5] * rs * gb.y); a.w = cvt_pk_bf16(f[6] * rs * gb.z, f[7] * rs * gb.w);
    b2.x = cvt_pk_bf16(f[8] * rs * gc.x, f[9] * rs * gc.y); b2.y = cvt_pk_bf16(f[10] * rs * gc.z, f[11] * rs * gc.w);
    b2.z = cvt_pk_bf16(f[12] * rs * gd.x, f[13] * rs * gd.y); b2.w = cvt_pk_bf16(f[14] * rs * gd.z, f[15] * rs * gd.w);
    o0 = __builtin_bit_cast(bf16x8, a); o1 = __builtin_bit_cast(bf16x8, b2);
}

__device__ __forceinline__ void attn_prompt_unit(const Params& p, unsigned char* lds, int u) {
    const int tid = threadIdx.x, lane = tid & 63, wid = tid >> 6, fr = lane & 15, fq = lane >> 4;
    const int qb = u & 31, kvh = (u >> 5) & 3, b = u >> 7;
    unsigned char* ws = p.ws;
    const bf16_t* KVQ = (const bf16_t*)(ws + WS_KVQ);
    bf16_t* AO = (bf16_t*)(ws + WS_ATT);
    bf16_t* Ks = (bf16_t*)lds;
    bf16_t* VT = Ks + 256 * 72;
    const int pos0 = qb * 128 - 128;
    u32x4 qr[4][2];
    {
        const int g_ = wid >> 1, half_ = wid & 1, head_ = kvh * 4 + g_;
#pragma unroll
        for (int m = 0; m < 4; ++m) {
            const bf16_t* qp = KVQ + ((size_t)b * 4096 + qb * 128 + 64 * half_ + 16 * m + fr) * NKVQ + 512 + head_ * 64;
            qr[m][0] = *(const u32x4*)(qp + 8 * fq); qr[m][1] = *(const u32x4*)(qp + 32 + 8 * fq);
        }
    }
#pragma unroll
    for (int i = 0; i < 4; ++i) {
        const int ci = tid + 512 * i, j = ci >> 3, ch = ci & 7, pos = pos0 + j;
        u32x4 r = (u32x4){0u, 0u, 0u, 0u};
        if (pos >= 0) r = *(const u32x4*)(KVQ + (size_t)(b * 4096 + pos) * NKVQ + kvh * 64 + ch * 8);
        float f[8] = {bflo(r.x), bfhi(r.x), bflo(r.y), bfhi(r.y), bflo(r.z), bfhi(r.z), bflo(r.w), bfhi(r.w)};
        float s = 0.f;
#pragma unroll
        for (int e = 0; e < 8; ++e) s += f[e] * f[e];
        s += __shfl_xor(s, 1); s += __shfl_xor(s, 2); s += __shfl_xor(s, 4);
        const float rs = rsqrtf(s * (1.f / 64.f) + EPS);
        const f32x4 g0 = *(const f32x4*)(p.k_norm_g + ch * 8), g1 = *(const f32x4*)(p.k_norm_g + ch * 8 + 4);
        f[0] *= rs * g0.x; f[1] *= rs * g0.y; f[2] *= rs * g0.z; f[3] *= rs * g0.w; f[4] *= rs * g1.x; f[5] *= rs * g1.y; f[6] *= rs * g1.z; f[7] *= rs * g1.w;
        u32x4 w; w.x = cvt_pk_bf16(f[0], f[1]); w.y = cvt_pk_bf16(f[2], f[3]); w.z = cvt_pk_bf16(f[4], f[5]); w.w = cvt_pk_bf16(f[6], f[7]);
        *(u32x4*)(Ks + j * 72 + ch * 8) = w;
        if (qb == 31 && j >= 128) {
            float* o = p.out + O_PWK + ((size_t)(b * 128 + (j - 128)) * 4 + kvh) * 64 + ch * 8;
            *(f32x4*)o = (f32x4){f[0], f[1], f[2], f[3]}; *(f32x4*)(o + 4) = (f32x4){f[4], f[5], f[6], f[7]};
        }
    }
#pragma unroll
    for (int i = 0; i < 4; ++i) {
        const int ci = tid + 512 * i, j = ci & 255, ch = ci >> 8, pos = pos0 + j;
        u32x4 r = (u32x4){0u, 0u, 0u, 0u};
        if (pos >= 0) r = *(const u32x4*)(KVQ + (size_t)(b * 4096 + pos) * NKVQ + 256 + kvh * 64 + ch * 8);
        bf16_t* dst = VT + (ch * 8) * 264 + j;
        dst[0 * 264] = (bf16_t)(r.x & 0xffff); dst[1 * 264] = (bf16_t)(r.x >> 16); dst[2 * 264] = (bf16_t)(r.y & 0xffff); dst[3 * 264] = (bf16_t)(r.y >> 16);
        dst[4 * 264] = (bf16_t)(r.z & 0xffff); dst[5 * 264] = (bf16_t)(r.z >> 16); dst[6 * 264] = (bf16_t)(r.w & 0xffff); dst[7 * 264] = (bf16_t)(r.w >> 16);
        if (qb == 31 && j >= 128) {
            float* o = p.out + O_PWV + ((size_t)(b * 128 + (j - 128)) * 4 + kvh) * 64 + ch * 8;
            *(f32x4*)o = (f32x4){bflo(r.x), bfhi(r.x), bflo(r.y), bfhi(r.y)}; *(f32x4*)(o + 4) = (f32x4){bflo(r.z), bfhi(r.z), bflo(r.w), bfhi(r.w)};
        }
    }
    __syncthreads();
    const int g = wid >> 1, half = wid & 1, head = kvh * 4 + g;
    const float sink = p.att_sinks[head];
    const float* qg = p.q_norm_g;
#pragma unroll
    for (int m = 0; m < 4; ++m) {
        const int j0 = 64 * half + 16 * m;
        const size_t R = (size_t)b * 4096 + qb * 128 + j0 + fr;
        bf16x8 q0, q1; norm_frag(qr[m][0], qr[m][1], qg, 0.125f, fq, q0, q1);
        f32x4 s[9];
#pragma unroll
        for (int i = 0; i < 9; ++i) {
            s[i] = (f32x4){0.f, 0.f, 0.f, 0.f};
            const bf16_t* kr = Ks + (j0 + 16 * i + fr) * 72 + 8 * fq;
            s[i] = MFMA32(*(const bf16x8*)kr, q0, s[i]);
            s[i] = MFMA32(*(const bf16x8*)(kr + 32), q1, s[i]);
        }
        float mx = sink;
#pragma unroll
        for (int i = 0; i < 9; ++i)
#pragma unroll
            for (int e = 0; e < 4; ++e) {
                const int jr = 16 * i + 4 * fq + e;
                const bool ok = (jr >= fr) && (jr <= 128 + fr) && (pos0 + j0 + jr >= 0);
                s[i][e] = ok ? s[i][e] : -INFINITY;
                mx = fmaxf(mx, s[i][e]);
            }
        mx = fmaxf(mx, __shfl_xor(mx, 16)); mx = fmaxf(mx, __shfl_xor(mx, 32));
        float l = 0.f;
        bf16x4 pf[9];
#pragma unroll
        for (int i = 0; i < 9; ++i) {
            float e0 = __expf(s[i][0] - mx), e1 = __expf(s[i][1] - mx), e2 = __expf(s[i][2] - mx), e3 = __expf(s[i][3] - mx);
            l += (e0 + e1) + (e2 + e3);
            u32x2 w; w.x = cvt_pk_bf16(e0, e1); w.y = cvt_pk_bf16(e2, e3);
            pf[i] = __builtin_bit_cast(bf16x4, w);
        }
        l += __shfl_xor(l, 16); l += __shfl_xor(l, 32);
        l += __expf(sink - mx);
        const float inv = 1.f / l;
        f32x4 o[4];
#pragma unroll
        for (int dt = 0; dt < 4; ++dt) {
            o[dt] = (f32x4){0.f, 0.f, 0.f, 0.f};
#pragma unroll
            for (int i = 0; i < 9; ++i) {
                const bf16x4 vf = *(const bf16x4*)(VT + (16 * dt + fr) * 264 + j0 + 16 * i + 4 * fq);
                o[dt] = MFMA16(vf, pf[i], o[dt]);
            }
        }
#pragma unroll
        for (int dt = 0; dt < 4; ++dt) {
            u32x2 w; w.x = cvt_pk_bf16(o[dt].x * inv, o[dt].y * inv); w.y = cvt_pk_bf16(o[dt].z * inv, o[dt].w * inv);
            *(u32x2*)(AO + R * D + head * 64 + 16 * dt + 4 * fq) = w;
        }
    }
    __syncthreads();
}

__device__ __forceinline__ void attn_sample_unit(const Params& p, int u, int lane) {
    const int fr = lane & 15, fq = lane >> 4;
    const int b = u >> 2, kvh = u & 3;
    unsigned char* ws = p.ws;
    const bf16_t* KVQ = (const bf16_t*)(ws + WS_KVQ);
    bf16_t* AO = (bf16_t*)(ws + WS_ATT);
    const float* ck = p.cache_k + (size_t)b * 128 * 256 + kvh * 64;
    const float* cv = p.cache_v + (size_t)b * 128 * 256 + kvh * 64;
    float* owk = p.out + O_SWK + (size_t)b * 128 * 256 + kvh * 64;
    float* owv = p.out + O_SWV + (size_t)b * 128 * 256 + kvh * 64;
    const size_t rbase = (size_t)TP + b * 4;
    for (int i = lane; i < 124 * 16; i += 64) {
        const int j = i >> 4, d4 = (i & 15) * 4;
        *(f32x4*)(owk + (size_t)j * 256 + d4) = *(const f32x4*)(ck + (size_t)(j + 4) * 256 + d4);
        *(f32x4*)(owv + (size_t)j * 256 + d4) = *(const f32x4*)(cv + (size_t)(j + 4) * 256 + d4);
    }
    {
        const int t = lane >> 4, d4 = (lane & 15) * 4;
        const u32x2 kr = *(const u32x2*)(KVQ + (rbase + t) * NKVQ + kvh * 64 + d4);
        const u32x2 vr = *(const u32x2*)(KVQ + (rbase + t) * NKVQ + 256 + kvh * 64 + d4);
        float f0 = bflo(kr.x), f1 = bfhi(kr.x), f2 = bflo(kr.y), f3 = bfhi(kr.y);
        float s = (f0 * f0 + f1 * f1) + (f2 * f2 + f3 * f3);
        s += __shfl_xor(s, 1); s += __shfl_xor(s, 2); s += __shfl_xor(s, 4); s += __shfl_xor(s, 8);
        const float rs = rsqrtf(s * (1.f / 64.f) + EPS);
        const f32x4 g = *(const f32x4*)(p.k_norm_g + d4);
        *(f32x4*)(owk + (size_t)(124 + t) * 256 + d4) = (f32x4){f0 * rs * g.x, f1 * rs * g.y, f2 * rs * g.z, f3 * rs * g.w};
        *(f32x4*)(owv + (size_t)(124 + t) * 256 + d4) = (f32x4){bflo(vr.x), bfhi(vr.x), bflo(vr.y), bfhi(vr.y)};
    }
    const int g = fr >> 2, t = fr & 3, head = kvh * 4 + g;
    const bf16_t* qp = KVQ + (rbase + t) * NKVQ + 512 + head * 64;
    const u32x4 r0 = *(const u32x4*)(qp + 8 * fq), r1 = *(const u32x4*)(qp + 32 + 8 * fq);
    bf16x8 q0, q1; norm_frag(r0, r1, p.q_norm_g, 0.125f, fq, q0, q1);
    const float sink = p.att_sinks[head];
    bf16x8 nk0, nk1;
    {
        const bf16_t* kp = KVQ + (rbase + (fr & 3)) * NKVQ + kvh * 64;
        const u32x4 a0 = *(const u32x4*)(kp + 8 * fq), a1 = *(const u32x4*)(kp + 32 + 8 * fq);
        norm_frag(a0, a1, p.k_norm_g, 1.f, fq, nk0, nk1);
        if (fr >= 4) { nk0 = (bf16x8){0, 0, 0, 0, 0, 0, 0, 0}; nk1 = nk0; }
    }
    f32x4 s[9];
#pragma unroll
    for (int i = 0; i < 8; ++i) {
        const float* kr = ck + (size_t)(16 * i + fr) * 256 + 8 * fq;
        const f32x4 a = *(const f32x4*)kr, b2 = *(const f32x4*)(kr + 4), c = *(const f32x4*)(kr + 32), d = *(const f32x4*)(kr + 36);
        u32x4 x0, x1;
        x0.x = cvt_pk_bf16(a.x, a.y); x0.y = cvt_pk_bf16(a.z, a.w); x0.z = cvt_pk_bf16(b2.x, b2.y); x0.w = cvt_pk_bf16(b2.z, b2.w);
        x1.x = cvt_pk_bf16(c.x, c.y); x1.y = cvt_pk_bf16(c.z, c.w); x1.z = cvt_pk_bf16(d.x, d.y); x1.w = cvt_pk_bf16(d.z, d.w);
        s[i] = (f32x4){0.f, 0.f, 0.f, 0.f};
        s[i] = MFMA32(__builtin_bit_cast(bf16x8, x0), q0, s[i]);
        s[i] = MFMA32(__builtin_bit_cast(bf16x8, x1), q1, s[i]);
    }
    s[8] = (f32x4){0.f, 0.f, 0.f, 0.f};
    s[8] = MFMA32(nk0, q0, s[8]); s[8] = MFMA32(nk1, q1, s[8]);
    float mx = sink;
#pragma unroll
    for (int i = 0; i < 9; ++i)
#pragma unroll
        for (int e = 0; e < 4; ++e) {
            const int j = 16 * i + 4 * fq + e;
            const bool ok = (j >= t) && (j <= t + 128);
            s[i][e] = ok ? s[i][e] : -INFINITY;
            mx = fmaxf(mx, s[i][e]);
        }
    mx = fmaxf(mx, __shfl_xor(mx, 16)); mx = fmaxf(mx, __shfl_xor(mx, 32));
    float l = 0.f; bf16x4 pf[9];
#pragma unroll
    for (int i = 0; i < 9; ++i) {
        float e0 = __expf(s[i][0] - mx), e1 = __expf(s[i][1] - mx), e2 = __expf(s[i][2] - mx), e3 = __expf(s[i][3] - mx);
        l += (e0 + e1) + (e2 + e3);
        u32x2 w; w.x = cvt_pk_bf16(e0, e1); w.y = cvt_pk_bf16(e2, e3);
        pf[i] = __builtin_bit_cast(bf16x4, w);
    }
    l += __shfl_xor(l, 16); l += __shfl_xor(l, 32);
    l += __expf(sink - mx);
    const float inv = 1.f / l;
#pragma unroll
    for (int dt = 0; dt < 4; ++dt) {
        f32x4 o = (f32x4){0.f, 0.f, 0.f, 0.f};
#pragma unroll
        for (int i = 0; i < 8; ++i) {
            const float* vr = cv + (size_t)(16 * i + 4 * fq) * 256 + 16 * dt + fr;
            u32x2 w; w.x = cvt_pk_bf16(vr[0], vr[256]); w.y = cvt_pk_bf16(vr[512], vr[768]);
            o = MFMA16(__builtin_bit_cast(bf16x4, w), pf[i], o);
        }
        {
            u32x2 w; w.x = 0u; w.y = 0u;
            const bf16_t* vp = KVQ + rbase * NKVQ + 256 + kvh * 64 + 16 * dt + fr;
            const unsigned v0 = vp[0], v1 = vp[NKVQ], v2 = vp[2 * NKVQ], v3 = vp[3 * NKVQ];
            if (fq == 0) { w.x = v0 | (v1 << 16); w.y = v2 | (v3 << 16); }
            o = MFMA16(__builtin_bit_cast(bf16x4, w), pf[8], o);
        }
        u32x2 w; w.x = cvt_pk_bf16(o.x * inv, o.y * inv); w.y = cvt_pk_bf16(o.z * inv, o.w * inv);
        *(u32x2*)(AO + (rbase + t) * D + head * 64 + 16 * dt + 4 * fq) = w;
    }
}


__device__ __forceinline__ void attn_sample_block(const Params& p, unsigned char* lds, int u) {
    const int tid = threadIdx.x, lane = tid & 63, wid = tid >> 6, fr = lane & 15, fq = lane >> 4;
    const int b = u >> 2, kvh = u & 3;
    unsigned char* ws = p.ws;
    const bf16_t* KVQ = (const bf16_t*)(ws + WS_KVQ);
    bf16_t* AO = (bf16_t*)(ws + WS_ATT);
    const float* ck = p.cache_k + (size_t)b * 128 * 256 + kvh * 64;
    const float* cv = p.cache_v + (size_t)b * 128 * 256 + kvh * 64;
    float* owk = p.out + O_SWK + (size_t)b * 128 * 256 + kvh * 64;
    float* owv = p.out + O_SWV + (size_t)b * 128 * 256 + kvh * 64;
    const size_t rbase = (size_t)TP + b * 4;
    bf16_t* Ks = (bf16_t*)lds;
    bf16_t* VT = Ks + 144 * 72;
    f32x4 kf[4], vf[4];
#pragma unroll
    for (int i = 0; i < 4; ++i) { const int idx = tid + 512 * i, j = idx >> 4, c4 = (idx & 15) * 4; kf[i] = *(const f32x4*)(ck + (size_t)j * 256 + c4); vf[i] = *(const f32x4*)(cv + (size_t)j * 256 + c4); }
#pragma unroll
    for (int i = 0; i < 4; ++i) {
        const int idx = tid + 512 * i, j = idx >> 4, c4 = (idx & 15) * 4;
        if (j >= 4) { *(f32x4*)(owk + (size_t)(j - 4) * 256 + c4) = kf[i]; *(f32x4*)(owv + (size_t)(j - 4) * 256 + c4) = vf[i]; }
        u32x2 w; w.x = cvt_pk_bf16(kf[i].x, kf[i].y); w.y = cvt_pk_bf16(kf[i].z, kf[i].w);
        *(u32x2*)(Ks + j * 72 + c4) = w;
        VT[(c4 + 0) * 152 + j] = f2bf(vf[i].x); VT[(c4 + 1) * 152 + j] = f2bf(vf[i].y); VT[(c4 + 2) * 152 + j] = f2bf(vf[i].z); VT[(c4 + 3) * 152 + j] = f2bf(vf[i].w);
    }
    if (tid < 64) {
        const int t = tid >> 4, d4 = (tid & 15) * 4;
        const u32x2 kr = *(const u32x2*)(KVQ + (rbase + t) * NKVQ + kvh * 64 + d4);
        const u32x2 vr = *(const u32x2*)(KVQ + (rbase + t) * NKVQ + 256 + kvh * 64 + d4);
        float f0 = bflo(kr.x), f1 = bfhi(kr.x), f2 = bflo(kr.y), f3 = bfhi(kr.y);
        float s = (f0 * f0 + f1 * f1) + (f2 * f2 + f3 * f3);
        s += __shfl_xor(s, 1); s += __shfl_xor(s, 2); s += __shfl_xor(s, 4); s += __shfl_xor(s, 8);
        const float rs = rsqrtf(s * (1.f / 64.f) + EPS);
        const f32x4 g = *(const f32x4*)(p.k_norm_g + d4);
        f0 *= rs * g.x; f1 *= rs * g.y; f2 *= rs * g.z; f3 *= rs * g.w;
        *(f32x4*)(owk + (size_t)(124 + t) * 256 + d4) = (f32x4){f0, f1, f2, f3};
        *(f32x4*)(owv + (size_t)(124 + t) * 256 + d4) = (f32x4){bflo(vr.x), bfhi(vr.x), bflo(vr.y), bfhi(vr.y)};
        u32x2 w; w.x = cvt_pk_bf16(f0, f1); w.y = cvt_pk_bf16(f2, f3);
        *(u32x2*)(Ks + (128 + t) * 72 + d4) = w;
        VT[(d4 + 0) * 152 + 128 + t] = (bf16_t)(vr.x & 0xffff); VT[(d4 + 1) * 152 + 128 + t] = (bf16_t)(vr.x >> 16);
        VT[(d4 + 2) * 152 + 128 + t] = (bf16_t)(vr.y & 0xffff); VT[(d4 + 3) * 152 + 128 + t] = (bf16_t)(vr.y >> 16);
    } else if (tid < 64 + 192) {
        const int i = tid - 64;
        if (i < 96) { const int r = 132 + (i >> 3), c8 = (i & 7) * 8; *(u32x4*)(Ks + r * 72 + c8) = (u32x4){0u, 0u, 0u, 0u}; }
        else { const int d = i - 96; if (d < 64) { bf16_t* z = VT + d * 152 + 132; for (int e = 0; e < 12; ++e) z[e] = 0; } }
    }
    __syncthreads();
    if (wid < 4) {
        const int dt = wid;
        const int g = fr >> 2, t = fr & 3, head = kvh * 4 + g;
        const bf16_t* qp = KVQ + (rbase + t) * NKVQ + 512 + head * 64;
        const u32x4 r0 = *(const u32x4*)(qp + 8 * fq), r1 = *(const u32x4*)(qp + 32 + 8 * fq);
        bf16x8 q0, q1; norm_frag(r0, r1, p.q_norm_g, 0.125f, fq, q0, q1);
        const float sink = p.att_sinks[head];
        f32x4 s[9];
#pragma unroll
        for (int i = 0; i < 9; ++i) {
            s[i] = (f32x4){0.f, 0.f, 0.f, 0.f};
            const bf16_t* kr = Ks + (16 * i + fr) * 72 + 8 * fq;
            s[i] = MFMA32(*(const bf16x8*)kr, q0, s[i]);
            s[i] = MFMA32(*(const bf16x8*)(kr + 32), q1, s[i]);
        }
        float mx = sink;
#pragma unroll
        for (int i = 0; i < 9; ++i)
#pragma unroll
            for (int e = 0; e < 4; ++e) {
                const int j = 16 * i + 4 * fq + e;
                const bool ok = (j >= t) && (j <= t + 128);
                s[i][e] = ok ? s[i][e] : -INFINITY;
                mx = fmaxf(mx, s[i][e]);
            }
        mx = fmaxf(mx, __shfl_xor(mx, 16)); mx = fmaxf(mx, __shfl_xor(mx, 32));
        float l = 0.f;
        f32x4 o = (f32x4){0.f, 0.f, 0.f, 0.f};
#pragma unroll
        for (int i = 0; i < 9; ++i) {
            const float e0 = __expf(s[i][0] - mx), e1 = __expf(s[i][1] - mx), e2 = __expf(s[i][2] - mx), e3 = __expf(s[i][3] - mx);
            l += (e0 + e1) + (e2 + e3);
            u32x2 w; w.x = cvt_pk_bf16(e0, e1); w.y = cvt_pk_bf16(e2, e3);
            const bf16x4 vfr = *(const bf16x4*)(VT + (16 * dt + fr) * 152 + 16 * i + 4 * fq);
            o = MFMA16(vfr, __builtin_bit_cast(bf16x4, w), o);
        }
        l += __shfl_xor(l, 16); l += __shfl_xor(l, 32);
        l += __expf(sink - mx);
        const float inv = 1.f / l;
        u32x2 w; w.x = cvt_pk_bf16(o.x * inv, o.y * inv); w.y = cvt_pk_bf16(o.z * inv, o.w * inv);
        *(u32x2*)(AO + (rbase + t) * D + head * 64 + 16 * dt + 4 * fq) = w;
    }
    __syncthreads();
}

#define LAS __attribute__((address_space(3)))
#define XB_TMO      128
#define XB_XCNT(j)  (256  + 64 * (j))
#define XB_XSUB(j)  (1280 + 64 * (j))
#define XB_XGEN(j)  (2304 + 64 * (j))
#define XB_TOP      3328
#define XB_TOPGEN   3392
#define XCD_BAR_WORDS 3456
#define XB_SPIN_CAP (1u << 18)

__device__ __forceinline__ unsigned xb_ld(unsigned* p)              { return __hip_atomic_load(p, __ATOMIC_RELAXED, __HIP_MEMORY_SCOPE_AGENT); }
__device__ __forceinline__ unsigned xb_add(unsigned* p, unsigned v) { return __hip_atomic_fetch_add(p, v, __ATOMIC_RELAXED, __HIP_MEMORY_SCOPE_AGENT); }
__device__ __forceinline__ unsigned xb_xcc_id() { return (unsigned)__builtin_amdgcn_s_getreg((3 << 11) | 20) & 0xFu; }
#define XB_SPIN(cond, bar) do { unsigned _sp = 0; while (cond) { __builtin_amdgcn_s_sleep(1); \
    if ((++_sp & 255u) == 0u) { if (xb_ld(&(bar)[XB_TMO])) break; if (_sp > XB_SPIN_CAP) { atomicAdd(&(bar)[XB_TMO], 1u); break; } } } } while (0)

struct XcdBarrier {
    unsigned* bar; unsigned x;
    volatile LAS unsigned* st;
};

__device__ __forceinline__ XcdBarrier xcd_barrier_post(unsigned* bar, volatile LAS unsigned* st) {
    XcdBarrier b; b.bar = bar; b.x = xb_xcc_id(); b.st = st;
    if (threadIdx.x == 0) (void)xb_add(&bar[XB_XCNT(b.x)], 1u);
    return b;
}
__device__ __forceinline__ void xcd_barrier_complete(unsigned* bar, unsigned x, unsigned& nloc, unsigned& nx) {
    const unsigned G = gridDim.x * gridDim.y * gridDim.z;
    unsigned sum, cnt, mine, sp = 0u;
    for (;;) {
        sum = 0u; cnt = 0u; mine = 0u;
#pragma unroll
        for (unsigned j = 0; j < 16; ++j) { const unsigned c = xb_ld(&bar[XB_XCNT(j)]); sum += c; cnt += (c > 0u) ? 1u : 0u; mine = (j == x) ? c : mine; }
        if (sum == G) break;
        __builtin_amdgcn_s_sleep(1);
        if ((++sp & 255u) == 0u) { if (xb_ld(&bar[XB_TMO])) break; if (sp > XB_SPIN_CAP) { atomicAdd(&bar[XB_TMO], 1u); break; } }
    }
    nloc = mine > 0u ? mine : 1u; nx = cnt > 0u ? cnt : 1u;
}

__device__ __forceinline__ void xcd_barrier(const XcdBarrier& b) {
    asm volatile("s_waitcnt vmcnt(0)" ::: "memory");
    __syncthreads();
    if (threadIdx.x == 0) {
        unsigned* bar = b.bar;
        __builtin_amdgcn_s_waitcnt(0);
        unsigned nloc = b.st[0], nx = b.st[1];
        if (nloc == 0u) { xcd_barrier_complete(bar, b.x, nloc, nx); b.st[0] = nloc; b.st[1] = nx; }
        const unsigned old = xb_add(&bar[XB_XSUB(b.x)], 1u);
        const unsigned gen = old / nloc;
        if (old + 1u == (gen + 1u) * nloc) {
            __builtin_amdgcn_fence(__ATOMIC_RELEASE, "agent");
            asm volatile("s_waitcnt vmcnt(0)" ::: "memory");
            const unsigned og = xb_add(&bar[XB_TOP], 1u);
            const unsigned tg = og / nx;
            if (og + 1u == (tg + 1u) * nx) xb_add(&bar[XB_TOPGEN], 1u);
            else XB_SPIN(xb_ld(&bar[XB_TOPGEN]) == tg, bar);
            __builtin_amdgcn_fence(__ATOMIC_ACQUIRE, "agent");
            xb_add(&bar[XB_XGEN(b.x)], 1u);
            asm volatile("s_waitcnt vmcnt(0)" ::: "memory");
        } else {
            XB_SPIN(xb_ld(&bar[XB_XGEN(b.x)]) == gen, bar);
            __builtin_amdgcn_fence(__ATOMIC_ACQUIRE, "agent");
            asm volatile("s_waitcnt vmcnt(0)" ::: "memory");
        }
    }
    __syncthreads();
}

__global__ void __launch_bounds__(NTHREADS) yoco_fwd(Params p) {
    extern __shared__ __attribute__((aligned(16))) unsigned char lds[];
    const int bid = blockIdx.x, G = gridDim.x;
    unsigned char* ws = p.ws;
    float* SS = (float*)(ws + WS_SS);
    float* Y = p.out + O_Y;
    bf16_t* XB = (bf16_t*)(ws + WS_XB);

#define IN(k) (p.ph_lo <= (k) && (k) < p.ph_hi)
    volatile LAS unsigned* bst = (volatile LAS unsigned*)((LAS unsigned char*)lds + 131072 + 64);
    XcdBarrier xbar; xbar.bar = (unsigned*)(ws + WS_BAR); xbar.x = 0; xbar.st = bst;
    if (p.ph_hi - p.ph_lo > 1) {
        if (threadIdx.x < 2) bst[threadIdx.x] = 0u;
        __syncthreads();
        xbar = xcd_barrier_post((unsigned*)(ws + WS_BAR), bst);
    }
#define SEAM(k) do { if (IN(k) && IN((k) + 1)) xcd_barrier(xbar); } while (0)
    if (IN(0)) { for (int rep = 0; rep < REP_P0; ++rep) p0_prologue(p, lds, bid, G); }
    SEAM(0);
    PG8_LAS unsigned char* l3 = (PG8_LAS unsigned char*)lds;
    float* YS = Y;
#define PGEMM(Aptr, Bptr, Nn, Kk, EpiT, ...) do { pg8::Gemm g_{(const bf16_t*)(Aptr), (const bf16_t*)(Bptr), TP, (Nn), (Kk), ((Kk) == FF) ? 1 : 0}; pg8::StaticOrder S_; S_.init(TP, (Nn), G, bid); \
        Pg8Epi<EpiT> E_{EpiT{__VA_ARGS__}}; pg8::gemm_phase<Pg8Epi<EpiT>, pg8::StaticOrder, true, true>(l3, g_, S_, E_); } while (0)
    if (IN(1)) {
        for (int rep = 0; rep < REP_PG; ++rep) { PGEMM(XB, ws + WS_WIN, NIN, 1024, EpiBf16, (bf16_t*)(ws + WS_P), NIN, nullptr, 0); }
        { EpiBf16 E{(bf16_t*)(ws + WS_P), NIN, nullptr, 0}; for (int rep = 0; rep < REP_SG; ++rep) sgemm64<0>(lds, XB, 1024, (const bf16_t*)(ws + WS_WIN), TP, TS, NIN, 1024, 1, E, bid, G); }
    }
    SEAM(1);
    if (IN(2)) {
        for (int rep = 0; rep < REP_2AL; ++rep) for (int u = bid; u < 512; u += G) mlstm_local_pair(p, lds, u);
        for (int rep = 0; rep < REP_2AS; ++rep) for (int u = bid; u < 512; u += G) mlstm_sample_unit(p, lds, u);
    }
    SEAM(2);
    if (IN(3)) mlstm_scan(p, lds, bid, G);
    SEAM(3);
    if (IN(4)) { for (int rep = 0; rep < REP_2C; ++rep) for (int u = bid; u < 1024; u += G) mlstm_out_unit(p, lds, u); }
    SEAM(4);
    if (IN(5)) {
        PGEMM(ws + WS_HG, ws + WS_WOUT, 1024, 1024, EpiResB, p.x_prompt, XB, nullptr, SS);
        { EpiAddF32 E{YS}; sgemm64<0>(lds, ws + WS_HG, 1024, (const bf16_t*)(ws + WS_WOUT), TP, TS, 1024, 1024, 1, E, bid, G); }
    }
    SEAM(5);
    if (IN(6)) {
        for (int rep = 0; rep < REP_PG; ++rep) { PGEMM(XB, ws + WS_W1A, FF, 1024, EpiBf16, (bf16_t*)(ws + WS_HID), FF, SS, 1); }
        { EpiBf16 E{(bf16_t*)(ws + WS_HID), FF, nullptr, 1}; for (int rep = 0; rep < REP_SG; ++rep) sgemm64<1>(lds, Y, 1024, (const bf16_t*)(ws + WS_W1A), TP, TS, FF, 1024, 1, E, bid, G); }
    }
    SEAM(6);
    if (IN(7)) {
        PGEMM(ws + WS_HID, ws + WS_W2A, 1024, FF, EpiResB, nullptr, XB, nullptr, SS + T);
        { EpiAtomic E{YS}; sgemm64<0>(lds, ws + WS_HID, FF, (const bf16_t*)(ws + WS_W2A), TP, TS, 1024, FF, 2, E, bid, G); }
    }
    SEAM(7);
    if (IN(8)) {
        for (int rep = 0; rep < REP_PG; ++rep) { PGEMM(XB, ws + WS_WKVQ, NKVQ, 1024, EpiBf16, (bf16_t*)(ws + WS_KVQ), NKVQ, SS + T, 0); }
        { EpiBf16 E{(bf16_t*)(ws + WS_KVQ), NKVQ, nullptr, 0}; for (int rep = 0; rep < REP_SG; ++rep) sgemm64<1>(lds, Y, 1024, (const bf16_t*)(ws + WS_WKVQ), TP, TS, NKVQ, 1024, 1, E, (bid + G / 2) % G, G); }
        __syncthreads();
        if (bid >= G / 2) late_weights(p, lds, bid - G / 2, G - G / 2);
    }
    SEAM(8);
    if (IN(9)) {
        { const int vb = (G % 8 == 0) ? (bid % 8) * (G / 8) + bid / 8 : bid;
          for (int rep = 0; rep < REP_7P; ++rep) for (int u = vb; u < 512; u += G) attn_prompt_unit(p, lds, u); }
        for (int rep = 0; rep < REP_7S; ++rep) for (int u = bid; u < 512; u += G) attn_sample_block(p, lds, u);
    }
    SEAM(9);
    if (IN(10)) {
        PGEMM(ws + WS_ATT, ws + WS_WO, 1024, 1024, EpiResB, nullptr, XB, nullptr, SS + 2 * T);
        { EpiAddF32 E{YS}; sgemm64<0>(lds, ws + WS_ATT, 1024, (const bf16_t*)(ws + WS_WO), TP, TS, 1024, 1024, 1, E, bid, G); }
    }
    SEAM(10);
    if (IN(11)) {
        for (int rep = 0; rep < REP_PG; ++rep) { PGEMM(XB, ws + WS_W1B, FF, 1024, EpiBf16, (bf16_t*)(ws + WS_HID), FF, SS + 2 * T, 1); }
        { EpiBf16 E{(bf16_t*)(ws + WS_HID), FF, nullptr, 1}; for (int rep = 0; rep < REP_SG; ++rep) sgemm64<1>(lds, Y, 1024, (const bf16_t*)(ws + WS_W1B), TP, TS, FF, 1024, 1, E, bid, G); }
    }
    SEAM(11);
    if (IN(12)) {
        PGEMM(ws + WS_HID, ws + WS_W2B, 1024, FF, EpiResB, nullptr, XB, Y, nullptr);
        { EpiAtomic E{YS}; sgemm64<0>(lds, ws + WS_HID, FF, (const bf16_t*)(ws + WS_W2B), TP, TS, 1024, FF, 2, E, bid, G); }
    }
#undef PGEMM
#undef IN
#undef SEAM
}

extern "C" void kernel_launch(void* const* d_in, const int* in_sizes, int n_in, void* d_out, int out_size, void* d_ws, size_t ws_size, hipStream_t stream) {
    static int grid_blocks = 0;
    if (!grid_blocks) {
        if (n_in != 24 || (size_t)out_size != O_END || ws_size < WS_END) { fprintf(stderr, "kernel_launch: unexpected shapes n_in=%d out=%d ws=%zu\n", n_in, out_size, ws_size); grid_blocks = -1; return; }
        int dev = 0, cus = 0, per_cu = 0;
        hipGetDevice(&dev);
        hipDeviceGetAttribute(&cus, hipDeviceAttributeMultiprocessorCount, dev);
        hipFuncSetAttribute((const void*)yoco_fwd, hipFuncAttributeMaxDynamicSharedMemorySize, LDS_BYTES);
        hipOccupancyMaxActiveBlocksPerMultiprocessor(&per_cu, (const void*)yoco_fwd, NTHREADS, LDS_BYTES);
        if (per_cu < 1) per_cu = 1;
        grid_blocks = cus * per_cu;
        (void)hipGetLastError();
    }
    if (grid_blocks < 0) return;
    Params p{};
    const float** pp = (const float**)&p;
    for (int i = 0; i < 24; ++i) pp[i] = (const float*)d_in[i];
    p.out = (float*)d_out; p.ws = (unsigned char*)d_ws;
#if N_LAUNCH_MODE == 1
    p.ph_lo = 0; p.ph_hi = 13;
    (void)hipMemsetAsync((char*)d_ws + WS_BAR, 0, BAR_BYTES, stream);
    void* args[] = {&p};
    hipError_t e = hipLaunchCooperativeKernel((const void*)yoco_fwd, dim3(grid_blocks), dim3(NTHREADS), args, LDS_BYTES, stream);
    if (e != hipSuccess) fprintf(stderr, "cooperative launch failed: %s (grid %d)\n", hipGetErrorString(e), grid_blocks);
#else
    for (int k = 0; k < MAX_PHASE; ++k) { p.ph_lo = k; p.ph_hi = k + 1; hipLaunchKernelGGL(yoco_fwd, dim3(grid_blocks), dim3(NTHREADS), LDS_BYTES, stream, p); }
#endif
}
```

```cpp
#include <hip/hip_runtime.h>
#include <hip/hip_cooperative_groups.h>
#include <cstdio>
#include <cstdint>
namespace cg = cooperative_groups;

typedef unsigned short bf16_t;
typedef short bf16x8 __attribute__((ext_vector_type(8)));
typedef short bf16x4 __attribute__((ext_vector_type(4)));
typedef float f32x4 __attribute__((ext_vector_type(4)));
typedef unsigned u32x4 __attribute__((ext_vector_type(4)));
typedef unsigned u32x2 __attribute__((ext_vector_type(2)));

constexpr int D = 1024, TP = 16384, TS = 512, T = TP + TS;
constexpr int NIN = 3072, LDW_IN = 3080, FF = 4096, NKVQ = 1536;
constexpr float EPS = 1e-6f;
constexpr int NTHREADS = 512;
constexpr int LDS_BYTES = 147456;
#ifndef REP_P0
#define REP_P0 1
#endif
#ifndef REP_2AL
#define REP_2AL 1
#endif
#ifndef REP_2AS
#define REP_2AS 1
#endif
#ifndef REP_2C
#define REP_2C 1
#endif
#ifndef REP_7P
#define REP_7P 1
#endif
#ifndef REP_7S
#define REP_7S 1
#endif
#ifndef REP_PG
#define REP_PG 1
#endif
#ifndef REP_SG
#define REP_SG 1
#endif
#ifndef MAX_PHASE
#define MAX_PHASE 13
#endif
#ifndef N_LAUNCH_MODE
#define N_LAUNCH_MODE 1
#endif

constexpr size_t MiB = 1u << 20;
constexpr size_t WS_SS = 0;
constexpr size_t WS_CHB = 256 * 1024, WS_CHM = WS_CHB + 4096, WS_MPREV = WS_CHM + 4096;
constexpr size_t WS_GATES = 1 * MiB;
constexpr size_t WS_GN = 2 * MiB;
constexpr size_t WS_BAR = 3 * MiB, BAR_BYTES = 16384;
constexpr size_t WS_WIN = 4 * MiB, WS_WOUT = 10 * MiB, WS_W1A = 12 * MiB, WS_W2A = 20 * MiB, WS_WKVQ = 28 * MiB, WS_WO = 31 * MiB, WS_W1B = 33 * MiB, WS_W2B = 41 * MiB;
constexpr size_t WS_XB = 49 * MiB;
constexpr size_t WS_P = 82 * MiB;
constexpr size_t WS_HG = 181 * MiB;
constexpr size_t WS_HID = 82 * MiB;
constexpr size_t WS_KVQ = 82 * MiB;
constexpr size_t WS_ATT = 132 * MiB;
constexpr size_t WS_END = 214 * MiB;

constexpr size_t O_Y = 0, O_PC = 17301504, O_PN = 17825792, O_PM = 17827840, O_PWK = 17827856, O_PWV = 17958928,
                 O_SC = 18090000, O_SN = 34867216, O_SM = 34932752, O_SWK = 34933264, O_SWV = 39127568, O_END = 43321872;

struct Params {
    const float *x_prompt, *x_sample, *st_C, *st_n, *st_m, *cache_k, *cache_v;
    const float *ml_norm_g, *ml_w_in, *ml_b_i, *ml_b_f, *ml_head_g, *ml_w_out;
    const float *kv_norm_g, *w_kv, *k_norm_g;
    const float *att_norm_g, *att_w_q, *q_norm_g, *att_sinks, *att_w_o;
    const float *mlp_norm_g, *mlp_w1, *mlp_w2;
    float* out; unsigned char* ws;
    int ph_lo, ph_hi;
};

typedef float f32x2 __attribute__((ext_vector_type(2)));
typedef __bf16 bf16x2n __attribute__((ext_vector_type(2)));
__device__ __forceinline__ unsigned cvt_pk_bf16(float lo, float hi) { const f32x2 v = {lo, hi}; const bf16x2n b = __builtin_convertvector(v, bf16x2n); return __builtin_bit_cast(unsigned, b); }
__device__ __forceinline__ bf16_t f2bf(float f) { return (bf16_t)(cvt_pk_bf16(f, 0.f) & 0xffffu); }
__device__ __forceinline__ float bf2f(bf16_t h) { return __uint_as_float(((unsigned)h) << 16); }
__device__ __forceinline__ float bflo(unsigned u) { return __uint_as_float(u << 16); }
__device__ __forceinline__ float bfhi(unsigned u) { return __uint_as_float(u & 0xffff0000u); }
__device__ __forceinline__ float wave_sum(float v) {
#pragma unroll
    for (int o = 1; o < 64; o <<= 1) v += __shfl_xor(v, o);
    return v;
}
__device__ __forceinline__ float wave_max(float v) {
#pragma unroll
    for (int o = 1; o < 64; o <<= 1) v = fmaxf(v, __shfl_xor(v, o));
    return v;
}
__device__ __forceinline__ float scan_sum(float x, int lane) {
#pragma unroll
    for (int o = 1; o < 64; o <<= 1) { float y = __shfl_up(x, o); if (lane >= o) x += y; }
    return x;
}
__device__ __forceinline__ float scan_max(float x, int lane) {
#pragma unroll
    for (int o = 1; o < 64; o <<= 1) { float y = __shfl_up(x, o); if (lane >= o) x = fmaxf(x, y); }
    return x;
}
__device__ __forceinline__ float softcap15(float x) { return 15.f * tanhf(x * (1.f / 15.f)); }
__device__ __forceinline__ float logsigmoid(float z) { return fminf(z, 0.f) - log1pf(__expf(-fabsf(z))); }
__device__ __forceinline__ float sigmoidf_(float z) { return 1.f / (1.f + __expf(-z)); }
#define LDS_WAIT() asm volatile("s_waitcnt lgkmcnt(0)" ::: "memory")
#define MFMA32(x, y, acc) __builtin_amdgcn_mfma_f32_16x16x32_bf16((x), (y), (acc), 0, 0, 0)
#define MFMA16(x, y, acc) __builtin_amdgcn_mfma_f32_16x16x16bf16_1k((x), (y), (acc), 0, 0, 0)

__device__ __forceinline__ void transpose_item(const float* __restrict__ W, int ldw, int K, const float* __restrict__ gk, float cs,
                                               bf16_t* WT, int row_off, int k0, int n0, float* scr, int lane) {
    {
        const int kr = lane >> 3, n4 = (lane & 7) * 4;
        f32x4 wv[8];
#pragma unroll
        for (int i = 0; i < 8; ++i) wv[i] = *(const f32x4*)(W + (size_t)(k0 + kr + 8 * i) * ldw + n0 + n4);
#pragma unroll
        for (int i = 0; i < 8; ++i) {
            const int kk = kr + 8 * i;
            const float g = gk ? gk[k0 + kk] * cs : cs;
            float* d = scr + kk * 33 + n4;
            d[0] = wv[i].x * g; d[1] = wv[i].y * g; d[2] = wv[i].z * g; d[3] = wv[i].w * g;
        }
    }
    LDS_WAIT();
    const int c = lane & 7;
#pragma unroll
    for (int j = 0; j < 4; ++j) {
        const int n = (lane >> 3) + 8 * j; const float* s = scr + (8 * c) * 33 + n;
        u32x4 o; o.x = cvt_pk_bf16(s[0 * 33], s[1 * 33]); o.y = cvt_pk_bf16(s[2 * 33], s[3 * 33]); o.z = cvt_pk_bf16(s[4 * 33], s[5 * 33]); o.w = cvt_pk_bf16(s[6 * 33], s[7 * 33]);
        *(u32x4*)(WT + (size_t)(row_off + n0 + n) * K + k0 + 8 * c) = o;
    }
    LDS_WAIT();
}

__device__ __forceinline__ void p0_prologue(const Params& p, unsigned char* lds, int bid, int G) {
    const int tid = threadIdx.x, lane = tid & 63, wid = tid >> 6;
    unsigned char* ws = p.ws;
    float* scr = (float*)(lds + wid * 8448);
    float* wif = (float*)(lds + 73728);
    for (int k = tid; k < 1024; k += NTHREADS) {
        const float g = p.ml_norm_g[k];
        const f32x4 a = *(const f32x4*)(p.ml_w_in + (size_t)k * LDW_IN + 3072), b = *(const f32x4*)(p.ml_w_in + (size_t)k * LDW_IN + 3076);
        wif[0 * 1024 + k] = a.x * g; wif[1 * 1024 + k] = a.y * g; wif[2 * 1024 + k] = a.z * g; wif[3 * 1024 + k] = a.w * g;
        wif[4 * 1024 + k] = b.x * g; wif[5 * 1024 + k] = b.y * g; wif[6 * 1024 + k] = b.z * g; wif[7 * 1024 + k] = b.w * g;
    }
    { float* ss = (float*)(ws + WS_SS); for (int i = bid * NTHREADS + tid; i < 3 * T; i += G * NTHREADS) ss[i] = 0.f; }
    __syncthreads();
    const int gw = bid * 8 + wid, NGW = G * 8;
    constexpr int I_IN = 16 * 96, I_SQ = 16 * 32, I_1 = 16 * 128, I_2 = 64 * 32, I_KV = 16 * 16;
    constexpr int NITEMS = I_IN + I_SQ + I_1 + I_2 + I_KV + I_SQ;
    for (int it = gw; it < NITEMS; it += NGW) {
        int r = it;
        if (r < I_IN) { const int kb = r / 96, nb = r % 96, n0 = nb * 32; const float cs = (n0 >= 512 && n0 < 1024) ? 0.08838834764831845f : 1.f;
            transpose_item(p.ml_w_in, LDW_IN, 1024, p.ml_norm_g, cs, (bf16_t*)(ws + WS_WIN), 0, kb * 64, n0, scr, lane); continue; } r -= I_IN;
        if (r < I_SQ) { transpose_item(p.ml_w_out, 1024, 1024, nullptr, 1.f, (bf16_t*)(ws + WS_WOUT), 0, (r / 32) * 64, (r % 32) * 32, scr, lane); continue; } r -= I_SQ;
        if (r < I_1) { transpose_item(p.mlp_w1, 4096, 1024, p.mlp_norm_g, 1.f, (bf16_t*)(ws + WS_W1A), 0, (r / 128) * 64, (r % 128) * 32, scr, lane); continue; } r -= I_1;
        if (r < I_2) { transpose_item(p.mlp_w2, 1024, 4096, nullptr, 1.f, (bf16_t*)(ws + WS_W2A), 0, (r / 32) * 64, (r % 32) * 32, scr, lane); continue; } r -= I_2;
        if (r < I_KV) { transpose_item(p.w_kv, 512, 1024, p.kv_norm_g, 1.f, (bf16_t*)(ws + WS_WKVQ), 0, (r / 16) * 64, (r % 16) * 32, scr, lane); continue; } r -= I_KV;
        transpose_item(p.att_w_q, 1024, 1024, p.att_norm_g, 1.f, (bf16_t*)(ws + WS_WKVQ), 512, (r / 32) * 64, (r % 32) * 32, scr, lane);
    }
    bf16_t* XB = (bf16_t*)(ws + WS_XB); float* gates = (float*)(ws + WS_GATES);
    for (int m = gw; m < T; m += NGW) {
        const float* xrow = m < TP ? p.x_prompt + (size_t)m * D : p.x_sample + (size_t)(m - TP) * D;
        f32x4 v[4]; float s = 0.f;
#pragma unroll
        for (int j = 0; j < 4; ++j) { v[j] = *(const f32x4*)(xrow + 4 * lane + 256 * j); s += (v[j].x * v[j].x + v[j].y * v[j].y) + (v[j].z * v[j].z + v[j].w * v[j].w); }
        const float rstd = rsqrtf(wave_sum(s) * (1.f / D) + EPS);
        if (m >= TP) {
#pragma unroll
            for (int j = 0; j < 4; ++j) *(f32x4*)(p.out + O_Y + (size_t)m * D + 4 * lane + 256 * j) = v[j];
        }
#pragma unroll
        for (int j = 0; j < 4; ++j) { u32x2 w; w.x = cvt_pk_bf16(v[j].x * rstd, v[j].y * rstd); w.y = cvt_pk_bf16(v[j].z * rstd, v[j].w * rstd); *(u32x2*)(XB + (size_t)m * D + 4 * lane + 256 * j) = w; }
        float mine = 0.f;
#pragma unroll
        for (int g = 0; g < 8; ++g) {
            float a = 0.f;
#pragma unroll
            for (int j = 0; j < 4; ++j) { const f32x4 w = *(const f32x4*)(wif + g * 1024 + 4 * lane + 256 * j); a += (v[j].x * w.x + v[j].y * w.y) + (v[j].z * w.z + v[j].w * w.w); }
            a = wave_sum(a) * rstd;
            if (lane == g) mine = a;
        }
        if (lane < 4) gates[(size_t)m * 8 + lane] = softcap15(mine + p.ml_b_i[lane]);
        else if (lane < 8) gates[(size_t)m * 8 + lane] = logsigmoid(softcap15(mine + p.ml_b_f[lane - 4]));
    }
}

__device__ __forceinline__ void late_weights(const Params& p, unsigned char* lds, int slot, int nslots) {
    const int tid = threadIdx.x, lane = tid & 63, wid = tid >> 6;
    unsigned char* ws = p.ws;
    float* scr = (float*)(lds + wid * 8448);
    constexpr int I_SQ = 16 * 32, I_1 = 16 * 128, I_2 = 64 * 32, NIT = I_SQ + I_1 + I_2;
    for (int it = slot * 8 + wid; it < NIT; it += nslots * 8) {
        int r = it;
        if (r < I_SQ) { transpose_item(p.att_w_o, 1024, 1024, nullptr, 1.f, (bf16_t*)(ws + WS_WO), 0, (r / 32) * 64, (r % 32) * 32, scr, lane); continue; } r -= I_SQ;
        if (r < I_1) { transpose_item(p.mlp_w1 + (size_t)1024 * 4096, 4096, 1024, p.mlp_norm_g + 1024, 1.f, (bf16_t*)(ws + WS_W1B), 0, (r / 128) * 64, (r % 128) * 32, scr, lane); continue; } r -= I_1;
        transpose_item(p.mlp_w2 + (size_t)4096 * 1024, 1024, 4096, nullptr, 1.f, (bf16_t*)(ws + WS_W2B), 0, (r / 32) * 64, (r % 32) * 32, scr, lane);
    }
}

struct EpiBf16 {
    bf16_t* out; int ld; const float* ss; int act;
    template <int NQ, bool PAIRED> __device__ __forceinline__ void row(int r, const int (&c)[NQ], const f32x4 (&v)[NQ], int fq, float rscale) const {
        float sc = rscale; if (ss) sc = rsqrtf(ss[r] * (1.f / 1024.f) + EPS);
        u32x2 w[NQ];
#pragma unroll
        for (int q = 0; q < NQ; ++q) {
            f32x4 x = v[q] * sc;
            if (act) { x.x = fmaxf(x.x, 0.f); x.y = fmaxf(x.y, 0.f); x.z = fmaxf(x.z, 0.f); x.w = fmaxf(x.w, 0.f); x = x * x; }
            w[q].x = cvt_pk_bf16(x.x, x.y); w[q].y = cvt_pk_bf16(x.z, x.w);
        }
        if (PAIRED) {
#pragma unroll
            for (int q = 0; q < NQ; q += 2) { u32x4 o; o.x = w[q].x; o.y = w[q].y; o.z = w[q + 1].x; o.w = w[q + 1].y; *(u32x4*)(out + (size_t)r * ld + c[q]) = o; }
        } else {
#pragma unroll
            for (int q = 0; q < NQ; ++q) *(u32x2*)(out + (size_t)r * ld + c[q]) = w[q];
        }
    }
};
struct EpiRes {
    const float* srcp; const float* srcs; float* dst; bf16_t* xb; float* ss;
    template <int NQ, bool PAIRED> __device__ __forceinline__ void row(int r, const int (&c)[NQ], const f32x4 (&v)[NQ], int fq, float rscale) const {
        const float* s = r < TP ? srcp + (size_t)r * D : srcs + (size_t)(r - TP) * D;
        float a2 = 0.f;
        u32x2 w[NQ];
#pragma unroll
        for (int q = 0; q < NQ; ++q) {
            const f32x4 o = *(const f32x4*)(s + c[q]) + v[q];
            *(f32x4*)(dst + (size_t)r * D + c[q]) = o;
            w[q].x = cvt_pk_bf16(o.x, o.y); w[q].y = cvt_pk_bf16(o.z, o.w);
            a2 += (o.x * o.x + o.y * o.y) + (o.z * o.z + o.w * o.w);
        }
        if (xb) {
            if (PAIRED) {
#pragma unroll
                for (int q = 0; q < NQ; q += 2) { u32x4 o; o.x = w[q].x; o.y = w[q].y; o.z = w[q + 1].x; o.w = w[q + 1].y; *(u32x4*)(xb + (size_t)r * D + c[q]) = o; }
            } else {
#pragma unroll
                for (int q = 0; q < NQ; ++q) *(u32x2*)(xb + (size_t)r * D + c[q]) = w[q];
            }
        }
        if (ss) { a2 += __shfl_xor(a2, 16); a2 += __shfl_xor(a2, 32); if (fq == 0) atomicAdd(ss + r, a2); }
    }
};

namespace pg8 {
#define PG8_LAS __attribute__((address_space(3)))
typedef unsigned short bf16_t;
typedef short bf16x8 __attribute__((ext_vector_type(8)));
typedef float f32x4 __attribute__((ext_vector_type(4)));
typedef unsigned u32x4 __attribute__((ext_vector_type(4)));
constexpr int BM = 256, BK = 64, HALF = 128, HTB = HALF * BK * 2  , STAGE_BYTES = 8 * HTB, NXCD = 8, WGM = 8;

__host__ __device__ __forceinline__ int lds_byte(int r, int c) { const int st = (r >> 4) * 2 + (c >> 5), rr = r & 15, cc = c & 31, ob = rr * 64 + cc * 2; return st * 1024 + (ob ^ (((ob >> 9) & 1) << 5)); }
__host__ __device__ __forceinline__ void stage_rc(int b, int& R, int& C) { const int st = b / 1024, sb = b % 1024, swz = sb ^ (((sb >> 9) & 1) << 5); R = (st >> 1) * 16 + swz / 64; C = (st & 1) * 32 + (swz % 64) / 2; }
__host__ __device__ __forceinline__ int perm32(int rho) { const int n = rho >> 4, i = rho & 15; return 8 * (i >> 2) + 4 * n + (i & 3); }

struct Unit { int pm, pn; };
struct Gemm { const bf16_t* A; const bf16_t* Bt; int M, N, K; int revk; };

struct StaticOrder {
    int nM, nN, nwg, G, c;
    __host__ __device__ void init(int M, int N, int G_, int c_) { nM = M / BM; nN = N / BM; nwg = nM * nN; G = G_; c = c_; }
    __host__ __device__ bool next(int i, Unit& u) const {
        const long L = (long)i * G + c; if (L >= nwg) return false;
        int wgid = (int)L; { const int q = nwg / NXCD, r = nwg % NXCD, xcd = wgid % NXCD, off = wgid / NXCD; wgid = (xcd < r ? xcd * (q + 1) : r * (q + 1) + (xcd - r) * q) + off; }
        const int nig = WGM * nN, gid = wgid / nig, fm = gid * WGM, gsz = (nM - fm) < WGM ? (nM - fm) : WGM;
        u.pm = fm + ((wgid % nig) % gsz); u.pn = (wgid % nig) / gsz; return true;
    }
    __device__ __forceinline__ void a_ready(const Unit&) const {}
    __device__ __forceinline__ void done(const Unit&) const {}
};


template <class Epi, class Sched, bool ALIGN_EPI = false, bool SP2 = false>
__device__ __forceinline__ void gemm_phase(PG8_LAS unsigned char* lds, const Gemm g, const Sched& S, const Epi& E) {
    const int tid = threadIdx.x, wid = __builtin_amdgcn_readfirstlane(tid >> 6), lane = tid & 63, wr = wid >> 2, wc = wid & 3, fr = lane & 15, fq = lane >> 4;
    const int K = g.K, nt = K / BK;
    unsigned voffA[2], voffB[2];
#pragma unroll
    for (int i = 0; i < 2; ++i) { int R, C; stage_rc(tid * 16 + i * 8192, R, C); const int Rb = Epi::PERM ? ((R & ~31) + perm32(R & 31)) : R;
        voffA[i] = (unsigned)(R * K + C) * 2u; voffB[i] = (unsigned)(Rb * K + C) * 2u; }
    const size_t kstep = g.revk ? (size_t)0 - (size_t)(BK * 2) : (size_t)(BK * 2);
    const size_t koff = g.revk ? (size_t)(K - BK) * 2 : (size_t)0;
    const size_t hstep = (size_t)HALF * K * 2;
    const size_t tstep = 2 * hstep;
    const unsigned ldsw = (unsigned)wid * 1024u;
    const int aoff = lds_byte(wr * 64 + fr, fq * 8), boff = lds_byte(wc * 32 + fr, fq * 8);
#define PG8_SA(b, h) (((b) * 2 + (h)) * HTB)
#define PG8_SB(b, h) ((4 + (b) * 2 + (h)) * HTB)
#define PG8_STAGE(bufoff, gbase, voff) do { _Pragma("unroll") for (int _i = 0; _i < 2; ++_i) \
        __builtin_amdgcn_global_load_lds((const unsigned*)((const char*)(gbase) + (voff)[_i]), (PG8_LAS unsigned*)(lds + (bufoff) + ldsw + _i * 8192), 16, 0, 0); } while (0)
#define PG8_LDA(dst, b, h) do { _Pragma("unroll") for (int m = 0; m < 4; ++m) _Pragma("unroll") for (int k = 0; k < 2; ++k) dst[m][k] = *(const PG8_LAS bf16x8*)(lds + PG8_SA(b, h) + aoff + m * 2048 + k * 1024); } while (0)
#define PG8_LDB(dst, b, h) do { _Pragma("unroll") for (int n = 0; n < 2; ++n) _Pragma("unroll") for (int k = 0; k < 2; ++k) dst[n][k] = *(const PG8_LAS bf16x8*)(lds + PG8_SB(b, h) + boff + n * 2048 + k * 1024); } while (0)
#define PG8_MMA(ai, bj, At, Bt) do { __builtin_amdgcn_s_setprio(1); _Pragma("unroll") for (int m = 0; m < 4; ++m) _Pragma("unroll") for (int n = 0; n < 2; ++n) _Pragma("unroll") for (int k = 0; k < 2; ++k) \
        acc[ai][bj][m][n] = __builtin_amdgcn_mfma_f32_16x16x32_bf16(Bt[n][k], At[m][k], acc[ai][bj][m][n], 0, 0, 0); __builtin_amdgcn_s_setprio(0); } while (0)
#define PG8_WAIT_V(n) asm volatile("s_waitcnt vmcnt(" #n ")" ::: "memory")
#define PG8_WAIT_L(n) asm volatile("s_waitcnt lgkmcnt(" #n ")" ::: "memory")
#define PG8_BAR __builtin_amdgcn_s_barrier()
#define PG8_SCHED __builtin_amdgcn_sched_barrier(0)
    Unit cur, nxt; int ui = 0;
    if (!S.next(0, cur)) return;
    f32x4 acc[2][2][4][2];
#pragma unroll
    for (int a = 0; a < 2; ++a)
#pragma unroll
        for (int b = 0; b < 2; ++b)
#pragma unroll
            for (int m = 0; m < 4; ++m)
#pragma unroll
                for (int n = 0; n < 2; ++n) acc[a][b][m][n] = (f32x4){0.f, 0.f, 0.f, 0.f};
    bf16x8 At[4][2], B0[2][2], B1[2][2];
    const char* cA = (const char*)g.A + (size_t)cur.pm * tstep + koff; const char* cB = (const char*)g.Bt + (size_t)cur.pn * tstep + koff;
    S.a_ready(cur);
    if constexpr (SP2) {
        PG8_STAGE(PG8_SB(0, 0), cB, voffB); PG8_STAGE(PG8_SB(0, 1), cB + hstep, voffB); PG8_STAGE(PG8_SA(0, 0), cA, voffA); PG8_STAGE(PG8_SA(0, 1), cA + hstep, voffA);
        if (wr == 1) PG8_BAR;
        PG8_WAIT_V(2); PG8_BAR;
        PG8_STAGE(PG8_SB(1, 0), cB + kstep, voffB); PG8_STAGE(PG8_SA(1, 0), cA + kstep, voffA); PG8_STAGE(PG8_SB(1, 1), cB + hstep + kstep, voffB);
        PG8_WAIT_V(6); PG8_BAR;
    } else {
        PG8_STAGE(PG8_SB(0, 0), cB, voffB); PG8_STAGE(PG8_SA(0, 0), cA, voffA); PG8_STAGE(PG8_SB(0, 1), cB + hstep, voffB); PG8_STAGE(PG8_SA(0, 1), cA + hstep, voffA);
        if (wr == 1) PG8_BAR;
        PG8_WAIT_V(4); PG8_BAR;
        PG8_STAGE(PG8_SB(1, 0), cB + kstep, voffB); PG8_STAGE(PG8_SA(1, 0), cA + kstep, voffA); PG8_STAGE(PG8_SB(1, 1), cB + hstep + kstep, voffB);
        PG8_WAIT_V(6); PG8_BAR;
    }
    for (;;) {
        const bool has_next = S.next(ui + 1, nxt);
        const char* nA = has_next ? (const char*)g.A + (size_t)nxt.pm * tstep + koff : cA; const char* nB = has_next ? (const char*)g.Bt + (size_t)nxt.pn * tstep + koff : cB;
        for (int t = 0; t < nt; t += 2) {
            const bool last = (t == nt - 2);
            const char* a1 = cA + (size_t)(t + 1) * kstep;
            const char* a2 = last ? nA : cA + (size_t)(t + 2) * kstep; const char* b2 = last ? nB : cB + (size_t)(t + 2) * kstep;
            const char* a3 = a2 + kstep; const char* b3 = b2 + kstep;
            if (last && has_next) S.a_ready(nxt);
            if constexpr (SP2) {
            PG8_LDB(B0, 0, 0); PG8_LDB(B1, 0, 1); PG8_SCHED; PG8_LDA(At, 0, 0); PG8_STAGE(PG8_SA(1, 1), a1 + hstep, voffA);
            PG8_WAIT_V(8); PG8_WAIT_L(0); PG8_BAR; PG8_MMA(0, 0, At, B0); PG8_MMA(0, 1, At, B1); PG8_BAR; PG8_SCHED;
            PG8_LDA(At, 0, 1); PG8_STAGE(PG8_SB(0, 0), b2, voffB); PG8_STAGE(PG8_SB(0, 1), b2 + hstep, voffB); PG8_STAGE(PG8_SA(0, 0), a2, voffA);
            PG8_WAIT_V(8); PG8_WAIT_L(0); PG8_BAR; PG8_MMA(1, 0, At, B0); PG8_MMA(1, 1, At, B1); PG8_BAR; PG8_SCHED;
            PG8_LDB(B0, 1, 0); PG8_LDB(B1, 1, 1); PG8_SCHED; PG8_LDA(At, 1, 0); PG8_STAGE(PG8_SA(0, 1), a2 + hstep, voffA);
            PG8_WAIT_V(8); PG8_WAIT_L(0); PG8_BAR; PG8_MMA(0, 0, At, B0); PG8_MMA(0, 1, At, B1); PG8_BAR; PG8_SCHED;
            PG8_LDA(At, 1, 1); PG8_STAGE(PG8_SB(1, 0), b3, voffB); PG8_STAGE(PG8_SB(1, 1), b3 + hstep, voffB); PG8_STAGE(PG8_SA(1, 0), a3, voffA);
            PG8_WAIT_V(8); PG8_WAIT_L(0); PG8_BAR; PG8_MMA(1, 0, At, B0); PG8_MMA(1, 1, At, B1); PG8_BAR; PG8_SCHED;
            } else {
            PG8_LDB(B0, 0, 0); PG8_SCHED; PG8_LDA(At, 0, 0); PG8_STAGE(PG8_SA(1, 1), a1 + hstep, voffA);
            PG8_WAIT_L(8); PG8_BAR; PG8_WAIT_L(0); PG8_MMA(0, 0, At, B0); PG8_BAR; PG8_SCHED;
            PG8_LDB(B1, 0, 1); PG8_STAGE(PG8_SB(0, 0), b2, voffB);
            PG8_BAR; PG8_WAIT_L(0); PG8_MMA(0, 1, At, B1); PG8_BAR;
            PG8_LDA(At, 0, 1); PG8_STAGE(PG8_SA(0, 0), a2, voffA);
            PG8_BAR; PG8_WAIT_L(0); PG8_MMA(1, 0, At, B0); PG8_BAR; PG8_SCHED;
            PG8_STAGE(PG8_SB(0, 1), b2 + hstep, voffB);
            PG8_WAIT_V(6); PG8_BAR; PG8_MMA(1, 1, At, B1); PG8_BAR;
            PG8_LDB(B0, 1, 0); PG8_SCHED; PG8_LDA(At, 1, 0); PG8_STAGE(PG8_SA(0, 1), a2 + hstep, voffA);
            PG8_WAIT_L(8); PG8_BAR; PG8_WAIT_L(0); PG8_MMA(0, 0, At, B0); PG8_BAR; PG8_SCHED;
            PG8_LDB(B1, 1, 1); PG8_STAGE(PG8_SB(1, 0), b3, voffB);
            PG8_BAR; PG8_WAIT_L(0); PG8_MMA(0, 1, At, B1); PG8_BAR;
            PG8_LDA(At, 1, 1); PG8_STAGE(PG8_SA(1, 0), a3, voffA);
            PG8_BAR; PG8_WAIT_L(0); PG8_MMA(1, 0, At, B0); PG8_BAR; PG8_SCHED;
            PG8_STAGE(PG8_SB(1, 1), b3 + hstep, voffB);
            PG8_WAIT_V(6); PG8_BAR; PG8_MMA(1, 1, At, B1); PG8_BAR;
            }
        }
        if constexpr (ALIGN_EPI) { if (wr == 0) PG8_BAR; }
        if constexpr (!Epi::AFTER_DRAIN) { E(acc, cur, wr, wc, fr, fq); S.done(cur); }
        if (!has_next) break;
#pragma unroll
        for (int a = 0; a < 2; ++a)
#pragma unroll
            for (int b = 0; b < 2; ++b)
#pragma unroll
                for (int m = 0; m < 4; ++m)
#pragma unroll
                    for (int n = 0; n < 2; ++n) acc[a][b][m][n] = (f32x4){0.f, 0.f, 0.f, 0.f};
        cur = nxt; cA = nA; cB = nB; ++ui;
        if constexpr (ALIGN_EPI) { if (wr == 1) PG8_BAR; }
    }
    PG8_WAIT_V(0);
    if constexpr (!ALIGN_EPI) { if (wr == 0) PG8_BAR; }
    PG8_BAR;
    if constexpr (Epi::AFTER_DRAIN) { E.fused(acc, cur, wr, wc, fr, fq, lds, wid, lane); S.done(cur); }
#undef PG8_SA
#undef PG8_SB
#undef PG8_STAGE
#undef PG8_LDA
#undef PG8_LDB
#undef PG8_MMA
#undef PG8_WAIT_V
#undef PG8_WAIT_L
#undef PG8_BAR
#undef PG8_SCHED
}
}


template <class Inner> struct Pg8Epi {
    static constexpr bool PERM = true, AFTER_DRAIN = false;
    Inner in;
    __device__ __forceinline__ void operator()(const f32x4 (&acc)[2][2][4][2], const pg8::Unit& u, int wr, int wc, int fr, int fq) const {
#pragma unroll
        for (int ai = 0; ai < 2; ++ai)
#pragma unroll
            for (int m = 0; m < 4; ++m) {
                const int r = u.pm * 256 + ai * 128 + wr * 64 + m * 16 + fr;
                const int c0 = u.pn * 256 + wc * 32 + 8 * fq;
                const int cols[4] = {c0, c0 + 4, c0 + 128, c0 + 132};
                const f32x4 vv[4] = {acc[ai][0][m][0], acc[ai][0][m][1], acc[ai][1][m][0], acc[ai][1][m][1]};
                in.template row<4, true>(r, cols, vv, fq, 1.f);
            }
    }
};
struct EpiResB {
    const float* srcf; bf16_t* xb; float* dstf; float* ss;
    template <int NQ, bool PAIRED> __device__ __forceinline__ void row(int r, const int (&c)[NQ], const f32x4 (&v)[NQ], int fq, float rscale) const {
        static_assert(PAIRED && NQ % 2 == 0, "EpiResB: paired quads only");
        float a2 = 0.f;
#pragma unroll
        for (int q = 0; q < NQ; q += 2) {
            f32x4 s0, s1;
            if (srcf) { s0 = *(const f32x4*)(srcf + (size_t)r * D + c[q]); s1 = *(const f32x4*)(srcf + (size_t)r * D + c[q] + 4); }
            else { const u32x4 xr = *(const u32x4*)(xb + (size_t)r * D + c[q]); s0 = (f32x4){bflo(xr.x), bfhi(xr.x), bflo(xr.y), bfhi(xr.y)}; s1 = (f32x4){bflo(xr.z), bfhi(xr.z), bflo(xr.w), bfhi(xr.w)}; }
            const f32x4 o0 = s0 + v[q], o1 = s1 + v[q + 1];
            if (dstf) { *(f32x4*)(dstf + (size_t)r * D + c[q]) = o0; *(f32x4*)(dstf + (size_t)r * D + c[q] + 4) = o1; }
            else {
                u32x4 w; w.x = cvt_pk_bf16(o0.x, o0.y); w.y = cvt_pk_bf16(o0.z, o0.w); w.z = cvt_pk_bf16(o1.x, o1.y); w.w = cvt_pk_bf16(o1.z, o1.w);
                *(u32x4*)(xb + (size_t)r * D + c[q]) = w;
                a2 += (o0.x * o0.x + o0.y * o0.y) + (o0.z * o0.z + o0.w * o0.w) + (o1.x * o1.x + o1.y * o1.y) + (o1.z * o1.z + o1.w * o1.w);
            }
        }
        if (ss) { a2 += __shfl_xor(a2, 16); a2 += __shfl_xor(a2, 32); if (fq == 0) atomicAdd(ss + r, a2); }
    }
};
struct EpiAddF32 {
    float* dst;
    template <int NQ, bool PAIRED> __device__ __forceinline__ void row(int r, const int (&c)[NQ], const f32x4 (&v)[NQ], int fq, float rscale) const {
#pragma unroll
        for (int q = 0; q < NQ; ++q) { f32x4* d = (f32x4*)(dst + (size_t)r * D + c[q]); *d = *d + v[q]; }
    }
};
struct EpiAtomic {
    float* dst;
    template <int NQ, bool PAIRED> __device__ __forceinline__ void row(int r, const int (&c)[NQ], const f32x4 (&v)[NQ], int fq, float rscale) const {
#pragma unroll
        for (int q = 0; q < NQ; ++q) { float* d = dst + (size_t)r * D + c[q]; atomicAdd(d, v[q].x); atomicAdd(d + 1, v[q].y); atomicAdd(d + 2, v[q].z); atomicAdd(d + 3, v[q].w); }
    }
};

template <int AF32, class Epi>
__device__ __forceinline__ void sgemm64(unsigned char* lds, const void* Av, int lda, const bf16_t* __restrict__ Bt, int row0, int nrows, int N, int K, int ksplit,
                                        const Epi& E, int bid, int G) {
    const int tid = threadIdx.x, lane = tid & 63, wid = tid >> 6, wr = wid >> 2, wc = wid & 3, fr = lane & 15, fq = lane >> 4;
    const int nN = N / 128, nT = (nrows / 64) * nN, nU = nT * ksplit, Ksl = K / ksplit, nk = Ksl / 128;
    constexpr int LS = 136;
    bf16_t* As = (bf16_t*)lds;
    bf16_t* Bs = As + 2 * 64 * LS;
    float* rs = (float*)(Bs + 2 * 128 * LS);
    const int arow = tid >> 3, ak = (tid & 7) * 8;
    for (int u = bid; u < nU; u += G) {
        const int ks = u / nT, t = u % nT, pm = t / nN, pn = t % nN, k0 = ks * Ksl;
        const bf16_t* Ab = (const bf16_t*)Av + (size_t)(row0 + pm * 64 + arow) * lda + k0 + ak;
        const float* Af = (const float*)Av + (size_t)(row0 + pm * 64 + arow) * lda + k0 + ak;
        const bf16_t* Bg = Bt + (size_t)(pn * 128 + arow) * K + k0 + ak;
        f32x4 acc[2][2];
#pragma unroll
        for (int m = 0; m < 2; ++m)
#pragma unroll
            for (int n = 0; n < 2; ++n) acc[m][n] = (f32x4){0.f, 0.f, 0.f, 0.f};
        float ssq = 0.f;
        u32x4 ra[2], rb[2][2];
        auto loadAB = [&](int kt) {
#pragma unroll
            for (int h = 0; h < 2; ++h) {
                if (AF32) { const f32x4 a = *(const f32x4*)(Af + kt * 128 + 64 * h), b = *(const f32x4*)(Af + kt * 128 + 64 * h + 4);
                    ssq += (a.x * a.x + a.y * a.y) + (a.z * a.z + a.w * a.w) + (b.x * b.x + b.y * b.y) + (b.z * b.z + b.w * b.w);
                    ra[h].x = cvt_pk_bf16(a.x, a.y); ra[h].y = cvt_pk_bf16(a.z, a.w); ra[h].z = cvt_pk_bf16(b.x, b.y); ra[h].w = cvt_pk_bf16(b.z, b.w); }
                else ra[h] = *(const u32x4*)(Ab + kt * 128 + 64 * h);
#pragma unroll
                for (int i = 0; i < 2; ++i) rb[i][h] = *(const u32x4*)(Bg + (size_t)(64 * i) * K + kt * 128 + 64 * h);
            }
        };
        auto storeAB = [&](int buf) {
#pragma unroll
            for (int h = 0; h < 2; ++h) {
                *(u32x4*)(As + buf * 64 * LS + arow * LS + ak + 64 * h) = ra[h];
#pragma unroll
                for (int i = 0; i < 2; ++i) *(u32x4*)(Bs + buf * 128 * LS + (arow + 64 * i) * LS + ak + 64 * h) = rb[i][h];
            }
        };
        loadAB(0);
        storeAB(0);
        __syncthreads();
        for (int kt = 0; kt < nk; ++kt) {
            const int buf = kt & 1;
            if (kt + 1 < nk) loadAB(kt + 1);
            const bf16_t* as = As + buf * 64 * LS; const bf16_t* bs = Bs + buf * 128 * LS;
#pragma unroll
            for (int kk = 0; kk < 4; ++kk) {
                bf16x8 af[2], bfr[2];
#pragma unroll
                for (int m = 0; m < 2; ++m) af[m] = *(const bf16x8*)(as + (32 * wr + 16 * m + fr) * LS + 32 * kk + 8 * fq);
#pragma unroll
                for (int n = 0; n < 2; ++n) bfr[n] = *(const bf16x8*)(bs + (32 * wc + 16 * n + fr) * LS + 32 * kk + 8 * fq);
#pragma unroll
                for (int m = 0; m < 2; ++m)
#pragma unroll
                    for (int n = 0; n < 2; ++n) acc[m][n] = MFMA32(bfr[n], af[m], acc[m][n]);
            }
            if (kt + 1 < nk) storeAB(buf ^ 1);
            __syncthreads();
        }
        if (AF32) {
            ssq += __shfl_xor(ssq, 1); ssq += __shfl_xor(ssq, 2); ssq += __shfl_xor(ssq, 4);
            if ((tid & 7) == 0) rs[arow] = rsqrtf(ssq * (1.f / 1024.f) + EPS);
            __syncthreads();
        }
#pragma unroll
        for (int m = 0; m < 2; ++m) {
            const int lr = 32 * wr + 16 * m + fr, r = row0 + pm * 64 + lr;
            const int cols[2] = {pn * 128 + 32 * wc + 4 * fq, pn * 128 + 32 * wc + 16 + 4 * fq};
            const f32x4 vv[2] = {acc[m][0], acc[m][1]};
            E.template row<2, false>(r, cols, vv, fq, AF32 ? rs[lr] : 1.f);
        }
    }
}

template <class Epi>
__device__ __forceinline__ void sgemm_phase(unsigned char* lds, const bf16_t* __restrict__ A, const bf16_t* __restrict__ Bt, int row0, int nrows, int N, int K,
                                            const Epi& E, int bid, int G) {
    const int tid = threadIdx.x, lane = tid & 63, wid = tid >> 6, wr = wid >> 2, wc = wid & 3, fr = lane & 15, fq = lane >> 4;
    const int nN = N / 128, nU = (nrows / 128) * nN, nk = K / 64;
    bf16_t* As = (bf16_t*)lds;
    bf16_t* Bs = As + 2 * 128 * 72;
    const int ldrow = tid >> 3, ldk = (tid & 7) * 8;
    for (int u = bid; u < nU; u += G) {
        const int pm = u / nN, pn = u % nN;
        const bf16_t* Ag = A + (size_t)(row0 + pm * 128 + ldrow) * K + ldk;
        const bf16_t* Bg = Bt + (size_t)(pn * 128 + ldrow) * K + ldk;
        f32x4 acc[4][2];
#pragma unroll
        for (int m = 0; m < 4; ++m)
#pragma unroll
            for (int n = 0; n < 2; ++n) acc[m][n] = (f32x4){0.f, 0.f, 0.f, 0.f};
        u32x4 ra[2], rb[2];
#pragma unroll
        for (int i = 0; i < 2; ++i) { ra[i] = *(const u32x4*)(Ag + (size_t)(64 * i) * K); rb[i] = *(const u32x4*)(Bg + (size_t)(64 * i) * K); }
#pragma unroll
        for (int i = 0; i < 2; ++i) { *(u32x4*)(As + (ldrow + 64 * i) * 72 + ldk) = ra[i]; *(u32x4*)(Bs + (ldrow + 64 * i) * 72 + ldk) = rb[i]; }
        __syncthreads();
        for (int kt = 0; kt < nk; ++kt) {
            const int buf = kt & 1;
            if (kt + 1 < nk) {
#pragma unroll
                for (int i = 0; i < 2; ++i) { ra[i] = *(const u32x4*)(Ag + (size_t)(64 * i) * K + (kt + 1) * 64); rb[i] = *(const u32x4*)(Bg + (size_t)(64 * i) * K + (kt + 1) * 64); }
            }
            const bf16_t* as = As + buf * 128 * 72; const bf16_t* bs = Bs + buf * 128 * 72;
#pragma unroll
            for (int kk = 0; kk < 2; ++kk) {
                bf16x8 af[4], bfr[2];
#pragma unroll
                for (int m = 0; m < 4; ++m) af[m] = *(const bf16x8*)(as + (64 * wr + 16 * m + fr) * 72 + 32 * kk + 8 * fq);
#pragma unroll
                for (int n = 0; n < 2; ++n) bfr[n] = *(const bf16x8*)(bs + (32 * wc + 16 * n + fr) * 72 + 32 * kk + 8 * fq);
#pragma unroll
                for (int m = 0; m < 4; ++m)
#pragma unroll
                    for (int n = 0; n < 2; ++n) acc[m][n] = MFMA32(bfr[n], af[m], acc[m][n]);
            }
            if (kt + 1 < nk) {
                bf16_t* an = As + (buf ^ 1) * 128 * 72; bf16_t* bn = Bs + (buf ^ 1) * 128 * 72;
#pragma unroll
                for (int i = 0; i < 2; ++i) { *(u32x4*)(an + (ldrow + 64 * i) * 72 + ldk) = ra[i]; *(u32x4*)(bn + (ldrow + 64 * i) * 72 + ldk) = rb[i]; }
            }
            __syncthreads();
        }
#pragma unroll
        for (int m = 0; m < 4; ++m) {
            const int r = row0 + pm * 128 + 64 * wr + 16 * m + fr;
            const int cols[2] = {pn * 128 + 32 * wc + 4 * fq, pn * 128 + 32 * wc + 16 + 4 * fq};
            const f32x4 vv[2] = {acc[m][0], acc[m][1]};
            E.template row<2, false>(r, cols, vv, fq, 1.f);
        }
    }
}

__device__ __forceinline__ void mlstm_local_unit(const Params& p, unsigned char* lds, int u) {
    const int tid = threadIdx.x, lane = tid & 63, wid = tid >> 6, fr = lane & 15, fq = lane >> 4;
    const int bh = u >> 6, c = u & 63, b = bh >> 2, h = bh & 3, base = b * 4096 + c * 64;
    unsigned char* ws = p.ws;
    const bf16_t* P = (const bf16_t*)(ws + WS_P); const float* gates = (const float*)(ws + WS_GATES);
    bf16_t* GS = (bf16_t*)p.out;
    bf16_t* kT = (bf16_t*)lds;
    bf16_t* vT = kT + 128 * 72;
    float* wk = (float*)(vT + 256 * 72);
    if (wid == 0) {
        const float lf = gates[(size_t)(base + lane) * 8 + 4 + h], li = gates[(size_t)(base + lane) * 8 + h];
        const float bc = scan_sum(lf, lane);
        const float B = __shfl(bc, 63);
        const float val = B - bc + li;
        const float ml = wave_max(val);
        wk[lane] = __expf(val - ml);
        if (lane == 0) { ((float*)(ws + WS_CHB))[u] = B; ((float*)(ws + WS_CHM))[u] = ml; }
    }
    __syncthreads();
    {
        const bf16_t* Pk = P + (size_t)(base + lane) * NIN + 512 + h * 128;
#pragma unroll
        for (int i = 0; i < 2; ++i) {
            const int dch = wid * 2 + i; const u32x4 r = *(const u32x4*)(Pk + dch * 8);
            bf16_t* dst = kT + (dch * 8) * 72 + lane;
            dst[0 * 72] = (bf16_t)(r.x & 0xffff); dst[1 * 72] = (bf16_t)(r.x >> 16); dst[2 * 72] = (bf16_t)(r.y & 0xffff); dst[3 * 72] = (bf16_t)(r.y >> 16);
            dst[4 * 72] = (bf16_t)(r.z & 0xffff); dst[5 * 72] = (bf16_t)(r.z >> 16); dst[6 * 72] = (bf16_t)(r.w & 0xffff); dst[7 * 72] = (bf16_t)(r.w >> 16);
        }
        const bf16_t* Pv = P + (size_t)(base + lane) * NIN + 1024 + h * 256;
        const float w = wk[lane];
#pragma unroll
        for (int i = 0; i < 4; ++i) {
            const int vch = wid * 4 + i; const u32x4 r = *(const u32x4*)(Pv + vch * 8);
            bf16_t* dst = vT + (vch * 8) * 72 + lane;
            dst[0 * 72] = f2bf(bflo(r.x) * w); dst[1 * 72] = f2bf(bfhi(r.x) * w); dst[2 * 72] = f2bf(bflo(r.y) * w); dst[3 * 72] = f2bf(bfhi(r.y) * w);
            dst[4 * 72] = f2bf(bflo(r.z) * w); dst[5 * 72] = f2bf(bfhi(r.z) * w); dst[6 * 72] = f2bf(bflo(r.w) * w); dst[7 * 72] = f2bf(bfhi(r.w) * w);
        }
    }
    __syncthreads();
    {
        f32x4 acc[2][8];
#pragma unroll
        for (int a = 0; a < 2; ++a)
#pragma unroll
            for (int d = 0; d < 8; ++d) acc[a][d] = (f32x4){0.f, 0.f, 0.f, 0.f};
#pragma unroll
        for (int ks = 0; ks < 2; ++ks) {
            bf16x8 yf[2];
#pragma unroll
            for (int vt = 0; vt < 2; ++vt) yf[vt] = *(const bf16x8*)(vT + (32 * wid + 16 * vt + fr) * 72 + 32 * ks + 8 * fq);
#pragma unroll
            for (int dt = 0; dt < 8; ++dt) {
                const bf16x8 xf = *(const bf16x8*)(kT + (16 * dt + fr) * 72 + 32 * ks + 8 * fq);
#pragma unroll
                for (int vt = 0; vt < 2; ++vt) acc[vt][dt] = MFMA32(xf, yf[vt], acc[vt][dt]);
            }
        }
        bf16_t* G = GS + (size_t)u * 32768;
#pragma unroll
        for (int vt = 0; vt < 2; ++vt)
#pragma unroll
            for (int dt = 0; dt < 8; ++dt) {
                u32x2 w; w.x = cvt_pk_bf16(acc[vt][dt].x, acc[vt][dt].y); w.y = cvt_pk_bf16(acc[vt][dt].z, acc[vt][dt].w);
                *(u32x2*)(G + (32 * wid + 16 * vt + fr) * 128 + 16 * dt + 4 * fq) = w;
            }
    }
    if (tid < 128) {
        float s = 0.f;
#pragma unroll 8
        for (int ss = 0; ss < 64; ++ss) s += bf2f(kT[tid * 72 + ss]) * wk[ss];
        ((float*)(ws + WS_GN))[(size_t)u * 128 + tid] = s;
    }
    __syncthreads();
}

__device__ __forceinline__ void mlstm_sample_unit(const Params& p, unsigned char* lds, int u) {
    const int tid = threadIdx.x, lane = tid & 63, wid = tid >> 6;
    const int b = u >> 2, h = u & 3, base = TP + b * 4;
    unsigned char* ws = p.ws;
    const bf16_t* P = (const bf16_t*)(ws + WS_P); const float* gates = (const float*)(ws + WS_GATES);
    float* q = (float*)lds;
    float* k = q + 512;
    float* v = k + 512;
    float* n0 = v + 1024;
    float* sc = n0 + 128;
    float* red = sc + 64;
    const float* C0 = p.st_C + (size_t)u * 32768;
    float* Cout = p.out + O_SC + (size_t)u * 32768;
    {
        const int t = tid >> 7, d = tid & 127;
        q[tid] = bf2f(P[(size_t)(base + t) * NIN + h * 128 + d]);
        k[tid] = bf2f(P[(size_t)(base + t) * NIN + 512 + h * 128 + d]);
        const int t2 = tid >> 8, vv = tid & 255;
        v[tid] = bf2f(P[(size_t)(base + t2) * NIN + 1024 + h * 256 + vv]);
        v[512 + tid] = bf2f(P[(size_t)(base + 2 + t2) * NIN + 1024 + h * 256 + vv]);
        if (tid < 128) n0[tid] = p.st_n[(size_t)u * 128 + tid];
    }
    if (tid == 0) {
        float li[4], bc[4]; float run = 0.f;
#pragma unroll
        for (int t = 0; t < 4; ++t) { li[t] = gates[(size_t)(base + t) * 8 + h]; run += gates[(size_t)(base + t) * 8 + 4 + h]; bc[t] = run; }
        const float m0 = p.st_m[u]; float mt[4];
#pragma unroll
        for (int t = 0; t < 4; ++t) {
            const float inter = bc[t] + m0; float mx = inter;
#pragma unroll
            for (int s = 0; s < 4; ++s) if (s <= t) mx = fmaxf(mx, bc[t] - bc[s] + li[s]);
            mt[t] = mx; sc[16 + t] = __expf(inter - mx); sc[28 + t] = __expf(-mx);
#pragma unroll
            for (int s = 0; s < 4; ++s) sc[t * 4 + s] = (s <= t) ? __expf(bc[t] - bc[s] + li[s] - mx) : 0.f;
        }
        const float mn = mt[3];
        sc[24] = __expf(bc[3] + m0 - mn);
#pragma unroll
        for (int s = 0; s < 4; ++s) sc[20 + s] = __expf(bc[3] - bc[s] + li[s] - mn);
        p.out[O_SM + u] = mn;
    }
    __syncthreads();
#pragma unroll
    for (int i = 0; i < 2; ++i) {
        const int pr = wid * 2 + i, t = pr >> 2, s = pr & 3;
        float a = q[t * 128 + lane] * k[s * 128 + lane] + q[t * 128 + 64 + lane] * k[s * 128 + 64 + lane];
        a = wave_sum(a);
        if (lane == 0) sc[32 + pr] = a * sc[pr];
    }
    if (wid < 4) { float a = q[wid * 128 + lane] * n0[lane] + q[wid * 128 + 64 + lane] * n0[64 + lane]; a = wave_sum(a); if (lane == 0) sc[48 + wid] = a; }
    if (tid < 8) sc[52 + tid] = 0.f;
    {
        const int vq = lane, dg = wid;
        f32x4 qc[4];
#pragma unroll
        for (int t = 0; t < 4; ++t) qc[t] = (f32x4){0.f, 0.f, 0.f, 0.f};
        const float decay = sc[24];
        f32x4 vs[4];
#pragma unroll
        for (int s = 0; s < 4; ++s) vs[s] = *(const f32x4*)(v + s * 256 + 4 * vq) * sc[20 + s];
#pragma unroll 4
        for (int dd = 0; dd < 16; ++dd) {
            const int d = dg * 16 + dd;
            const f32x4 c0 = *(const f32x4*)(C0 + (size_t)d * 256 + 4 * vq);
            f32x4 cn = c0 * decay;
#pragma unroll
            for (int s = 0; s < 4; ++s) cn += vs[s] * k[s * 128 + d];
            *(f32x4*)(Cout + (size_t)d * 256 + 4 * vq) = cn;
#pragma unroll
            for (int t = 0; t < 4; ++t) qc[t] += c0 * q[t * 128 + d];
        }
#pragma unroll
        for (int t = 0; t < 4; ++t) *(f32x4*)(red + (dg * 4 + t) * 256 + 4 * vq) = qc[t];
    }
    if (tid < 128) {
        float nn = sc[24] * n0[tid];
#pragma unroll
        for (int s = 0; s < 4; ++s) nn += sc[20 + s] * k[s * 128 + tid];
        p.out[O_SN + (size_t)u * 128 + tid] = nn;
    }
    __syncthreads();
    {
        const int t = tid >> 7, v0 = (tid & 127) * 2;
        float den = sc[16 + t] * sc[48 + t];
#pragma unroll
        for (int s = 0; s < 4; ++s) den += sc[32 + t * 4 + s];
        const float inv = 1.f / fmaxf(fabsf(den), sc[28 + t]);
        float hv[2]; float ssq = 0.f;
#pragma unroll
        for (int j = 0; j < 2; ++j) {
            float qC = 0.f;
#pragma unroll
            for (int g = 0; g < 8; ++g) qC += red[(g * 4 + t) * 256 + v0 + j];
            float num = sc[16 + t] * qC;
#pragma unroll
            for (int s = 0; s < 4; ++s) num += sc[32 + t * 4 + s] * v[s * 256 + v0 + j];
            hv[j] = num * inv; ssq += hv[j] * hv[j];
        }
        ssq = wave_sum(ssq);
        if (lane == 0) sc[52 + wid] = ssq;
        __syncthreads();
        const float tot = sc[52 + 2 * t] + sc[52 + 2 * t + 1];
        const float rstd = rsqrtf(tot * (1.f / 256.f) + EPS);
        const unsigned ob = *(const unsigned*)(P + (size_t)(base + t) * NIN + 2048 + h * 256 + v0);
        const float o0 = sigmoidf_(bflo(ob)), o1 = sigmoidf_(bfhi(ob));
        const float g0 = p.ml_head_g[h * 256 + v0], g1 = p.ml_head_g[h * 256 + v0 + 1];
        bf16_t* HG = (bf16_t*)(ws + WS_HG);
        *(unsigned*)(HG + (size_t)(base + t) * D + h * 256 + v0) = cvt_pk_bf16(hv[0] * rstd * g0 * o0, hv[1] * rstd * g1 * o1);
    }
    __syncthreads();
}

__device__ __forceinline__ void mlstm_scan(const Params& p, unsigned char* lds, int bid, int G) {
    unsigned char* ws = p.ws;
    bf16_t* GS = (bf16_t*)p.out;
    const float* CHB = (const float*)(ws + WS_CHB); const float* CHM = (const float*)(ws + WS_CHM);
    float* MPREV = (float*)(ws + WS_MPREV); float* GN = (float*)(ws + WS_GN);
    const int tid = threadIdx.x;
    float* decs = (float*)lds;
    float* scls = decs + 64;
    float* tile = scls + 64;
    for (int blk = bid; blk < 256; blk += G) {
        const int bh = blk >> 4;
        if (tid < 64) {
            const float B = CHB[bh * 64 + tid], ml = CHM[bh * 64 + tid];
            float a = B, b2 = ml;
#pragma unroll
            for (int o = 1; o < 64; o <<= 1) { const float ya = __shfl_up(a, o), yb = __shfl_up(b2, o); if (tid >= o) { b2 = fmaxf(yb + a, b2); a = ya + a; } }
            const float m = fmaxf(a, b2);
            float mp = __shfl_up(m, 1); if (tid == 0) mp = 0.f;
            decs[tid] = __expf(B + mp - m); scls[tid] = __expf(ml - m);
            if ((blk & 15) == 0) { MPREV[bh * 64 + tid] = mp; if (tid == 63) p.out[O_PM + bh] = m; }
        }
        float gnv[64]; float* gp = GN + (size_t)(bh * 64) * 128 + (blk & 15) * 8 + (tid & 7);
        if (tid < 8) {
#pragma unroll
            for (int c = 0; c < 64; ++c) gnv[c] = gp[(size_t)c * 128];
        }
        __syncthreads();
        const int e4 = blk * NTHREADS + tid;
        const int off = (e4 & 8191) * 4;
        bf16_t* ptr = GS + (size_t)bh * 64 * 32768 + off;
        float c0 = 0.f, c1 = 0.f, c2 = 0.f, c3 = 0.f;
#pragma unroll 1
        for (int cb = 0; cb < 64; cb += 16) {
            u32x2 g[16];
#pragma unroll
            for (int j = 0; j < 16; ++j) g[j] = *(const u32x2*)(ptr + (size_t)(cb + j) * 32768);
#pragma unroll
            for (int j = 0; j < 16; ++j) {
                const float dec = decs[cb + j], s = scls[cb + j];
                u32x2 w; w.x = cvt_pk_bf16(c0, c1); w.y = cvt_pk_bf16(c2, c3);
                *(u32x2*)(ptr + (size_t)(cb + j) * 32768) = w;
                c0 = dec * c0 + s * bflo(g[j].x); c1 = dec * c1 + s * bfhi(g[j].x); c2 = dec * c2 + s * bflo(g[j].y); c3 = dec * c3 + s * bfhi(g[j].y);
            }
        }
        {
            const int vl = (off >> 7) & 15, d = off & 127;
            tile[(d + 0) * 20 + vl] = c0; tile[(d + 1) * 20 + vl] = c1; tile[(d + 2) * 20 + vl] = c2; tile[(d + 3) * 20 + vl] = c3;
            __syncthreads();
            const int dd = tid >> 2, vq = tid & 3, v0 = (blk & 15) * 16;
            const f32x4 o = (f32x4){tile[dd * 20 + 4 * vq], tile[dd * 20 + 4 * vq + 1], tile[dd * 20 + 4 * vq + 2], tile[dd * 20 + 4 * vq + 3]};
            *(f32x4*)(p.out + O_PC + (size_t)bh * 32768 + (size_t)dd * 256 + v0 + 4 * vq) = o;
        }
        if (tid < 8) {
            float n = 0.f;
#pragma unroll
            for (int c = 0; c < 64; ++c) { gp[(size_t)c * 128] = n; n = decs[c] * n + scls[c] * gnv[c]; }
            p.out[O_PN + bh * 128 + (blk & 15) * 8 + tid] = n;
        }
        __syncthreads();
    }
}

__device__ __forceinline__ void mlstm_out_unit(const Params& p, unsigned char* lds, int u) {
    const int tid = threadIdx.x, lane = tid & 63, wid = tid >> 6, fr = lane & 15, fq = lane >> 4;
    const int bh = u >> 6, c = u & 63, b = bh >> 2, h = bh & 3, base = b * 4096 + c * 64;
    unsigned char* ws = p.ws;
    const bf16_t* P = (const bf16_t*)(ws + WS_P); const float* gates = (const float*)(ws + WS_GATES);
    const bf16_t* CT = (const bf16_t*)p.out + (size_t)u * 32768;
    bf16_t* Qs = (bf16_t*)lds;
    bf16_t* Ks = Qs + 64 * 136;
    bf16_t* Ac = Ks + 64 * 136;
    bf16_t* VT = Ac + 64 * 200;
    float* sm = (float*)(VT + 256 * 72);
    float *bt = sm, *lmb = sm + 64, *mt = sm + 128, *at = sm + 192, *den = sm + 256, *hss = sm + 320, *npv = sm + 384;
    bf16x8 cf[2][4];
#pragma unroll
    for (int vt = 0; vt < 2; ++vt)
#pragma unroll
        for (int kd = 0; kd < 4; ++kd) cf[vt][kd] = *(const bf16x8*)(CT + (32 * wid + 16 * vt + fr) * 128 + 32 * kd + 8 * fq);
    if (wid == 0) {
        const float lf = gates[(size_t)(base + lane) * 8 + 4 + h], li = gates[(size_t)(base + lane) * 8 + h];
        const float bc = scan_sum(lf, lane);
        const float lm = li - bc;
        const float pm = scan_max(lm, lane);
        const float mprev = ((const float*)(ws + WS_MPREV))[u];
        const float inter = bc + mprev;
        const float m_t = fmaxf(inter, bc + pm);
        bt[lane] = bc; lmb[lane] = lm; mt[lane] = m_t; at[lane] = __expf(inter - m_t); den[lane] = 0.f; hss[lane] = 0.f;
    }
    if (wid == 1) { const float* NP = (const float*)(ws + WS_GN) + (size_t)u * 128; npv[lane] = NP[lane]; npv[64 + lane] = NP[64 + lane]; }
    __syncthreads();
#pragma unroll
    for (int i = 0; i < 2; ++i) {
        const int ci = tid + 512 * i, t = ci >> 4, dch = ci & 15;
        const u32x4 qv = *(const u32x4*)(P + (size_t)(base + t) * NIN + h * 128 + dch * 8);
        const u32x4 kv = *(const u32x4*)(P + (size_t)(base + t) * NIN + 512 + h * 128 + dch * 8);
        *(u32x4*)(Qs + t * 136 + dch * 8) = qv;
        *(u32x4*)(Ks + t * 136 + dch * 8) = kv;
        const float a = at[t];
        u32x4 sq; sq.x = cvt_pk_bf16(bflo(qv.x) * a, bfhi(qv.x) * a); sq.y = cvt_pk_bf16(bflo(qv.y) * a, bfhi(qv.y) * a);
        sq.z = cvt_pk_bf16(bflo(qv.z) * a, bfhi(qv.z) * a); sq.w = cvt_pk_bf16(bflo(qv.w) * a, bfhi(qv.w) * a);
        *(u32x4*)(Ac + t * 200 + 64 + dch * 8) = sq;
    }
    {
        const bf16_t* Pv = P + (size_t)(base + lane) * NIN + 1024 + h * 256;
#pragma unroll
        for (int i = 0; i < 4; ++i) {
            const int vch = wid * 4 + i; const u32x4 r = *(const u32x4*)(Pv + vch * 8);
            bf16_t* dst = VT + (vch * 8) * 72 + lane;
            dst[0 * 72] = (bf16_t)(r.x & 0xffff); dst[1 * 72] = (bf16_t)(r.x >> 16); dst[2 * 72] = (bf16_t)(r.y & 0xffff); dst[3 * 72] = (bf16_t)(r.y >> 16);
            dst[4 * 72] = (bf16_t)(r.z & 0xffff); dst[5 * 72] = (bf16_t)(r.z >> 16); dst[6 * 72] = (bf16_t)(r.w & 0xffff); dst[7 * 72] = (bf16_t)(r.w >> 16);
        }
    }
    __syncthreads();
    {
        const int tt = wid >> 1;
#pragma unroll
        for (int j = 0; j < 2; ++j) {
            const int st = 2 * (wid & 1) + j;
            const int t = 16 * tt + fr, s0 = 16 * st + 4 * fq;
            u32x2 w; w.x = 0u; w.y = 0u;
            if (st <= tt) {
                f32x4 a = (f32x4){0.f, 0.f, 0.f, 0.f};
#pragma unroll
                for (int kd = 0; kd < 4; ++kd) {
                    const bf16x8 x = *(const bf16x8*)(Ks + (16 * st + fr) * 136 + 32 * kd + 8 * fq);
                    const bf16x8 y = *(const bf16x8*)(Qs + (16 * tt + fr) * 136 + 32 * kd + 8 * fq);
                    a = MFMA32(x, y, a);
                }
                const float e0 = bt[t] - mt[t];
                float vals[4];
#pragma unroll
                for (int i = 0; i < 4; ++i) { const int s = s0 + i; vals[i] = (s <= t) ? a[i] * __expf(e0 + lmb[s]) : 0.f; }
                float rs = (vals[0] + vals[1]) + (vals[2] + vals[3]);
                rs += __shfl_xor(rs, 16); rs += __shfl_xor(rs, 32);
                if (fq == 0) atomicAdd(&den[t], rs);
                w.x = cvt_pk_bf16(vals[0], vals[1]); w.y = cvt_pk_bf16(vals[2], vals[3]);
            }
            *(u32x2*)(Ac + t * 200 + s0) = w;
        }
#pragma unroll
        for (int i = 0; i < 8; ++i) {
            const int t = 8 * wid + i;
            float a = bf2f(Qs[t * 136 + lane]) * npv[lane] + bf2f(Qs[t * 136 + 64 + lane]) * npv[64 + lane];
            a = wave_sum(a);
            if (lane == 0) atomicAdd(&den[t], at[t] * a);
        }
    }
    __syncthreads();
    f32x4 acc[4][2];
#pragma unroll
    for (int a = 0; a < 4; ++a)
#pragma unroll
        for (int d = 0; d < 2; ++d) acc[a][d] = (f32x4){0.f, 0.f, 0.f, 0.f};
#pragma unroll
    for (int kk = 0; kk < 6; ++kk) {
        bf16x8 x[2];
#pragma unroll
        for (int vt = 0; vt < 2; ++vt) x[vt] = (kk < 2) ? *(const bf16x8*)(VT + (32 * wid + 16 * vt + fr) * 72 + 32 * kk + 8 * fq) : cf[vt][kk >= 2 ? kk - 2 : 0];
#pragma unroll
        for (int tt = 0; tt < 4; ++tt) {
            const bf16x8 y = *(const bf16x8*)(Ac + (16 * tt + fr) * 200 + 32 * kk + 8 * fq);
#pragma unroll
            for (int vt = 0; vt < 2; ++vt) acc[tt][vt] = MFMA32(x[vt], y, acc[tt][vt]);
        }
    }
#pragma unroll
    for (int tt = 0; tt < 4; ++tt) {
        const int t = 16 * tt + fr;
        const float inv = 1.f / fmaxf(fabsf(den[t]), __expf(-mt[t]));
        float ssq = 0.f;
#pragma unroll
        for (int vt = 0; vt < 2; ++vt) { acc[tt][vt] = acc[tt][vt] * inv; const f32x4 a = acc[tt][vt]; ssq += (a.x * a.x + a.y * a.y) + (a.z * a.z + a.w * a.w); }
        ssq += __shfl_xor(ssq, 16); ssq += __shfl_xor(ssq, 32);
        if (fq == 0) atomicAdd(&hss[t], ssq);
    }
    __syncthreads();
    {
        bf16_t* HG = (bf16_t*)(ws + WS_HG);
#pragma unroll
        for (int tt = 0; tt < 4; ++tt) {
            const int t = 16 * tt + fr;
            const float rstd = rsqrtf(hss[t] * (1.f / 256.f) + EPS);
#pragma unroll
            for (int vt = 0; vt < 2; ++vt) {
                const int v0 = 32 * wid + 16 * vt + 4 * fq;
                const u32x2 ob = *(const u32x2*)(P + (size_t)(base + t) * NIN + 2048 + h * 256 + v0);
                const f32x4 g = *(const f32x4*)(p.ml_head_g + h * 256 + v0);
                const f32x4 a = acc[tt][vt];
                u32x2 w;
                w.x = cvt_pk_bf16(a.x * rstd * g.x * sigmoidf_(bflo(ob.x)), a.y * rstd * g.y * sigmoidf_(bfhi(ob.x)));
                w.y = cvt_pk_bf16(a.z * rstd * g.z * sigmoidf_(bflo(ob.y)), a.w * rstd * g.w * sigmoidf_(bfhi(ob.y)));
                *(u32x2*)(HG + (size_t)(base + t) * D + h * 256 + v0) = w;
            }
        }
    }
    __syncthreads();
}

__device__ __forceinline__ void norm_frag(const u32x4 r0, const u32x4 r1, const float* __restrict__ g, float extra, int fq, bf16x8& o0, bf16x8& o1) {
    float f[16];
    f[0] = bflo(r0.x); f[1] = bfhi(r0.x); f[2] = bflo(r0.y); f[3] = bfhi(r0.y); f[4] = bflo(r0.z); f[5] = bfhi(r0.z); f[6] = bflo(r0.w); f[7] = bfhi(r0.w);
    f[8] = bflo(r1.x); f[9] = bfhi(r1.x); f[10] = bflo(r1.y); f[11] = bfhi(r1.y); f[12] = bflo(r1.z); f[13] = bfhi(r1.z); f[14] = bflo(r1.w); f[15] = bfhi(r1.w);
    float s = 0.f;
#pragma unroll
    for (int i = 0; i < 16; ++i) s += f[i] * f[i];
    s += __shfl_xor(s, 16); s += __shfl_xor(s, 32);
    const float rs = rsqrtf(s * (1.f / 64.f) + EPS) * extra;
    const f32x4 ga = *(const f32x4*)(g + 8 * fq), gb = *(const f32x4*)(g + 8 * fq + 4), gc = *(const f32x4*)(g + 32 + 8 * fq), gd = *(const f32x4*)(g + 32 + 8 * fq + 4);
    u32x4 a, b2;
    a.x = cvt_pk_bf16(f[0] * rs * ga.x, f[1] * rs * ga.y); a.y = cvt_pk_bf16(f[2] * rs * ga.z, f[3] * rs * ga.w);
    a.z = cvt_pk_bf16(f[4] * rs * gb.x, f[5] * rs * gb.y); a.w = cvt_pk_bf16(f[6] * rs * gb.z, f[7] * rs * gb.w);
    b2.x = cvt_pk_bf16(f[8] * rs * gc.x, f[9] * rs * gc.y); b2.y = cvt_pk_bf16(f[10] * rs * gc.z, f[11] * rs * gc.w);
    b2.z = cvt_pk_bf16(f[12] * rs * gd.x, f[13] * rs * gd.y); b2.w = cvt_pk_bf16(f[14] * rs * gd.z, f[15] * rs * gd.w);
    o0 = __builtin_bit_cast(bf16x8, a); o1 = __builtin_bit_cast(bf16x8, b2);
}

__device__ __forceinline__ void attn_prompt_unit(const Params& p, unsigned char* lds, int u) {
    const int tid = threadIdx.x, lane = tid & 63, wid = tid >> 6, fr = lane & 15, fq = lane >> 4;
    const int qb = u & 31, kvh = (u >> 5) & 3, b = u >> 7;
    unsigned char* ws = p.ws;
    const bf16_t* KVQ = (const bf16_t*)(ws + WS_KVQ);
    bf16_t* AO = (bf16_t*)(ws + WS_ATT);
    bf16_t* Ks = (bf16_t*)lds;
    bf16_t* VT = Ks + 256 * 72;
    const int pos0 = qb * 128 - 128;
    u32x4 qr[4][2];
    {
        const int g_ = wid >> 1, half_ = wid & 1, head_ = kvh * 4 + g_;
#pragma unroll
        for (int m = 0; m < 4; ++m) {
            const bf16_t* qp = KVQ + ((size_t)b * 4096 + qb * 128 + 64 * half_ + 16 * m + fr) * NKVQ + 512 + head_ * 64;
            qr[m][0] = *(const u32x4*)(qp + 8 * fq); qr[m][1] = *(const u32x4*)(qp + 32 + 8 * fq);
        }
    }
#pragma unroll
    for (int i = 0; i < 4; ++i) {
        const int ci = tid + 512 * i, j = ci >> 3, ch = ci & 7, pos = pos0 + j;
        u32x4 r = (u32x4){0u, 0u, 0u, 0u};
        if (pos >= 0) r = *(const u32x4*)(KVQ + (size_t)(b * 4096 + pos) * NKVQ + kvh * 64 + ch * 8);
        float f[8] = {bflo(r.x), bfhi(r.x), bflo(r.y), bfhi(r.y), bflo(r.z), bfhi(r.z), bflo(r.w), bfhi(r.w)};
        float s = 0.f;
#pragma unroll
        for (int e = 0; e < 8; ++e) s += f[e] * f[e];
        s += __shfl_xor(s, 1); s += __shfl_xor(s, 2); s += __shfl_xor(s, 4);
        const float rs = rsqrtf(s * (1.f / 64.f) + EPS);
        const f32x4 g0 = *(const f32x4*)(p.k_norm_g + ch * 8), g1 = *(const f32x4*)(p.k_norm_g + ch * 8 + 4);
        f[0] *= rs * g0.x; f[1] *= rs * g0.y; f[2] *= rs * g0.z; f[3] *= rs * g0.w; f[4] *= rs * g1.x; f[5] *= rs * g1.y; f[6] *= rs * g1.z; f[7] *= rs * g1.w;
        u32x4 w; w.x = cvt_pk_bf16(f[0], f[1]); w.y = cvt_pk_bf16(f[2], f[3]); w.z = cvt_pk_bf16(f[4], f[5]); w.w = cvt_pk_bf16(f[6], f[7]);
        *(u32x4*)(Ks + j * 72 + ch * 8) = w;
        if (qb == 31 && j >= 128) {
            float* o = p.out + O_PWK + ((size_t)(b * 128 + (j - 128)) * 4 + kvh) * 64 + ch * 8;
            *(f32x4*)o = (f32x4){f[0], f[1], f[2], f[3]}; *(f32x4*)(o + 4) = (f32x4){f[4], f[5], f[6], f[7]};
        }
    }
#pragma unroll
    for (int i = 0; i < 4; ++i) {
        const int ci = tid + 512 * i, j = ci & 255, ch = ci >> 8, pos = pos0 + j;
        u32x4 r = (u32x4){0u, 0u, 0u, 0u};
        if (pos >= 0) r = *(const u32x4*)(KVQ + (size_t)(b * 4096 + pos) * NKVQ + 256 + kvh * 64 + ch * 8);
        bf16_t* dst = VT + (ch * 8) * 264 + j;
        dst[0 * 264] = (bf16_t)(r.x & 0xffff); dst[1 * 264] = (bf16_t)(r.x >> 16); dst[2 * 264] = (bf16_t)(r.y & 0xffff); dst[3 * 264] = (bf16_t)(r.y >> 16);
        dst[4 * 264] = (bf16_t)(r.z & 0xffff); dst[5 * 264] = (bf16_t)(r.z >> 16); dst[6 * 264] = (bf16_t)(r.w & 0xffff); dst[7 * 264] = (bf16_t)(r.w >> 16);
        if (qb == 31 && j >= 128) {
            float* o = p.out + O_PWV + ((size_t)(b * 128 + (j - 128)) * 4 + kvh) * 64 + ch * 8;
            *(f32x4*)o = (f32x4){bflo(r.x), bfhi(r.x), bflo(r.y), bfhi(r.y)}; *(f32x4*)(o + 4) = (f32x4){bflo(r.z), bfhi(r.z), bflo(r.w), bfhi(r.w)};
        }
    }
    __syncthreads();
    const int g = wid >> 1, half = wid & 1, head = kvh * 4 + g;
    const float sink = p.att_sinks[head];
    const float* qg = p.q_norm_g;
#pragma unroll
    for (int m = 0; m < 4; ++m) {
        const int j0 = 64 * half + 16 * m;
        const size_t R = (size_t)b * 4096 + qb * 128 + j0 + fr;
        bf16x8 q0, q1; norm_frag(qr[m][0], qr[m][1], qg, 0.125f, fq, q0, q1);
        f32x4 s[9];
#pragma unroll
        for (int i = 0; i < 9; ++i) {
            s[i] = (f32x4){0.f, 0.f, 0.f, 0.f};
            const bf16_t* kr = Ks + (j0 + 16 * i + fr) * 72 + 8 * fq;
            s[i] = MFMA32(*(const bf16x8*)kr, q0, s[i]);
            s[i] = MFMA32(*(const bf16x8*)(kr + 32), q1, s[i]);
        }
        float mx = sink;
#pragma unroll
        for (int i = 0; i < 9; ++i)
#pragma unroll
            for (int e = 0; e < 4; ++e) {
                const int jr = 16 * i + 4 * fq + e;
                const bool ok = (jr >= fr) && (jr <= 128 + fr) && (pos0 + j0 + jr >= 0);
                s[i][e] = ok ? s[i][e] : -INFINITY;
                mx = fmaxf(mx, s[i][e]);
            }
        mx = fmaxf(mx, __shfl_xor(mx, 16)); mx = fmaxf(mx, __shfl_xor(mx, 32));
        float l = 0.f;
        bf16x4 pf[9];
#pragma unroll
        for (int i = 0; i < 9; ++i) {
            float e0 = __expf(s[i][0] - mx), e1 = __expf(s[i][1] - mx), e2 = __expf(s[i][2] - mx), e3 = __expf(s[i][3] - mx);
            l += (e0 + e1) + (e2 + e3);
            u32x2 w; w.x = cvt_pk_bf16(e0, e1); w.y = cvt_pk_bf16(e2, e3);
            pf[i] = __builtin_bit_cast(bf16x4, w);
        }
        l += __shfl_xor(l, 16); l += __shfl_xor(l, 32);
        l += __expf(sink - mx);
        const float inv = 1.f / l;
        f32x4 o[4];
#pragma unroll
        for (int dt = 0; dt < 4; ++dt) {
            o[dt] = (f32x4){0.f, 0.f, 0.f, 0.f};
#pragma unroll
            for (int i = 0; i < 9; ++i) {
                const bf16x4 vf = *(const bf16x4*)(VT + (16 * dt + fr) * 264 + j0 + 16 * i + 4 * fq);
                o[dt] = MFMA16(vf, pf[i], o[dt]);
            }
        }
#pragma unroll
        for (int dt = 0; dt < 4; ++dt) {
            u32x2 w; w.x = cvt_pk_bf16(o[dt].x * inv, o[dt].y * inv); w.y = cvt_pk_bf16(o[dt].z * inv, o[dt].w * inv);
            *(u32x2*)(AO + R * D + head * 64 + 16 * dt + 4 * fq) = w;
        }
    }
    __syncthreads();
}

__device__ __forceinline__ void attn_sample_unit(const Params& p, int u, int lane) {
    const int fr = lane & 15, fq = lane >> 4;
    const int b = u >> 2, kvh = u & 3;
    unsigned char* ws = p.ws;
    const bf16_t* KVQ = (const bf16_t*)(ws + WS_KVQ);
    bf16_t* AO = (bf16_t*)(ws + WS_ATT);
    const float* ck = p.cache_k + (size_t)b * 128 * 256 + kvh * 64;
    const float* cv = p.cache_v + (size_t)b * 128 * 256 + kvh * 64;
    float* owk = p.out + O_SWK + (size_t)b * 128 * 256 + kvh * 64;
    float* owv = p.out + O_SWV + (size_t)b * 128 * 256 + kvh * 64;
    const size_t rbase = (size_t)TP + b * 4;
    for (int i = lane; i < 124 * 16; i += 64) {
        const int j = i >> 4, d4 = (i & 15) * 4;
        *(f32x4*)(owk + (size_t)j * 256 + d4) = *(const f32x4*)(ck + (size_t)(j + 4) * 256 + d4);
        *(f32x4*)(owv + (size_t)j * 256 + d4) = *(const f32x4*)(cv + (size_t)(j + 4) * 256 + d4);
    }
    {
        const int t = lane >> 4, d4 = (lane & 15) * 4;
        const u32x2 kr = *(const u32x2*)(KVQ + (rbase + t) * NKVQ + kvh * 64 + d4);
        const u32x2 vr = *(const u32x2*)(KVQ + (rbase + t) * NKVQ + 256 + kvh * 64 + d4);
        float f0 = bflo(kr.x), f1 = bfhi(kr.x), f2 = bflo(kr.y), f3 = bfhi(kr.y);
        float s = (f0 * f0 + f1 * f1) + (f2 * f2 + f3 * f3);
        s += __shfl_xor(s, 1); s += __shfl_xor(s, 2); s += __shfl_xor(s, 4); s += __shfl_xor(s, 8);
        const float rs = rsqrtf(s * (1.f / 64.f) + EPS);
        const f32x4 g = *(const f32x4*)(p.k_norm_g + d4);
        *(f32x4*)(owk + (size_t)(124 + t) * 256 + d4) = (f32x4){f0 * rs * g.x, f1 * rs * g.y, f2 * rs * g.z, f3 * rs * g.w};
        *(f32x4*)(owv + (size_t)(124 + t) * 256 + d4) = (f32x4){bflo(vr.x), bfhi(vr.x), bflo(vr.y), bfhi(vr.y)};
    }
    const int g = fr >> 2, t = fr & 3, head = kvh * 4 + g;
    const bf16_t* qp = KVQ + (rbase + t) * NKVQ + 512 + head * 64;
    const u32x4 r0 = *(const u32x4*)(qp + 8 * fq), r1 = *(const u32x4*)(qp + 32 + 8 * fq);
    bf16x8 q0, q1; norm_frag(r0, r1, p.q_norm_g, 0.125f, fq, q0, q1);
    const float sink = p.att_sinks[head];
    bf16x8 nk0, nk1;
    {
        const bf16_t* kp = KVQ + (rbase + (fr & 3)) * NKVQ + kvh * 64;
        const u32x4 a0 = *(const u32x4*)(kp + 8 * fq), a1 = *(const u32x4*)(kp + 32 + 8 * fq);
        norm_frag(a0, a1, p.k_norm_g, 1.f, fq, nk0, nk1);
        if (fr >= 4) { nk0 = (bf16x8){0, 0, 0, 0, 0, 0, 0, 0}; nk1 = nk0; }
    }
    f32x4 s[9];
#pragma unroll
    for (int i = 0; i < 8; ++i) {
        const float* kr = ck + (size_t)(16 * i + fr) * 256 + 8 * fq;
        const f32x4 a = *(const f32x4*)kr, b2 = *(const f32x4*)(kr + 4), c = *(const f32x4*)(kr + 32), d = *(const f32x4*)(kr + 36);
        u32x4 x0, x1;
        x0.x = cvt_pk_bf16(a.x, a.y); x0.y = cvt_pk_bf16(a.z, a.w); x0.z = cvt_pk_bf16(b2.x, b2.y); x0.w = cvt_pk_bf16(b2.z, b2.w);
        x1.x = cvt_pk_bf16(c.x, c.y); x1.y = cvt_pk_bf16(c.z, c.w); x1.z = cvt_pk_bf16(d.x, d.y); x1.w = cvt_pk_bf16(d.z, d.w);
        s[i] = (f32x4){0.f, 0.f, 0.f, 0.f};
        s[i] = MFMA32(__builtin_bit_cast(bf16x8, x0), q0, s[i]);
        s[i] = MFMA32(__builtin_bit_cast(bf16x8, x1), q1, s[i]);
    }
    s[8] = (f32x4){0.f, 0.f, 0.f, 0.f};
    s[8] = MFMA32(nk0, q0, s[8]); s[8] = MFMA32(nk1, q1, s[8]);
    float mx = sink;
#pragma unroll
    for (int i = 0; i < 9; ++i)
#pragma unroll
        for (int e = 0; e < 4; ++e) {
            const int j = 16 * i + 4 * fq + e;
            const bool ok = (j >= t) && (j <= t + 128);
            s[i][e] = ok ? s[i][e] : -INFINITY;
            mx = fmaxf(mx, s[i][e]);
        }
    mx = fmaxf(mx, __shfl_xor(mx, 16)); mx = fmaxf(mx, __shfl_xor(mx, 32));
    float l = 0.f; bf16x4 pf[9];
#pragma unroll
    for (int i = 0; i < 9; ++i) {
        float e0 = __expf(s[i][0] - mx), e1 = __expf(s[i][1] - mx), e2 = __expf(s[i][2] - mx), e3 = __expf(s[i][3] - mx);
        l += (e0 + e1) + (e2 + e3);
        u32x2 w; w.x = cvt_pk_bf16(e0, e1); w.y = cvt_pk_bf16(e2, e3);
        pf[i] = __builtin_bit_cast(bf16x4, w);
    }
    l += __shfl_xor(l, 16); l += __shfl_xor(l, 32);
    l += __expf(sink - mx);
    const float inv = 1.f / l;
#pragma unroll
    for (int dt = 0; dt < 4; ++dt) {
        f32x4 o = (f32x4){0.f, 0.f, 0.f, 0.f};
#pragma unroll
        for (int i = 0; i < 8; ++i) {
            const float* vr = cv + (size_t)(16 * i + 4 * fq) * 256 + 16 * dt + fr;
            u32x2 w; w.x = cvt_pk_bf16(vr[0], vr[256]); w.y = cvt_pk_bf16(vr[512], vr[768]);
            o = MFMA16(__builtin_bit_cast(bf16x4, w), pf[i], o);
        }
        {
            u32x2 w; w.x = 0u; w.y = 0u;
            const bf16_t* vp = KVQ + rbase * NKVQ + 256 + kvh * 64 + 16 * dt + fr;
            const unsigned v0 = vp[0], v1 = vp[NKVQ], v2 = vp[2 * NKVQ], v3 = vp[3 * NKVQ];
            if (fq == 0) { w.x = v0 | (v1 << 16); w.y = v2 | (v3 << 16); }
            o = MFMA16(__builtin_bit_cast(bf16x4, w), pf[8], o);
        }
        u32x2 w; w.x = cvt_pk_bf16(o.x * inv, o.y * inv); w.y = cvt_pk_bf16(o.z * inv, o.w * inv);
        *(u32x2*)(AO + (rbase + t) * D + head * 64 + 16 * dt + 4 * fq) = w;
    }
}


__device__ __forceinline__ void attn_sample_block(const Params& p, unsigned char* lds, int u) {
    const int tid = threadIdx.x, lane = tid & 63, wid = tid >> 6, fr = lane & 15, fq = lane >> 4;
    const int b = u >> 2, kvh = u & 3;
    unsigned char* ws = p.ws;
    const bf16_t* KVQ = (const bf16_t*)(ws + WS_KVQ);
    bf16_t* AO = (bf16_t*)(ws + WS_ATT);
    const float* ck = p.cache_k + (size_t)b * 128 * 256 + kvh * 64;
    const float* cv = p.cache_v + (size_t)b * 128 * 256 + kvh * 64;
    float* owk = p.out + O_SWK + (size_t)b * 128 * 256 + kvh * 64;
    float* owv = p.out + O_SWV + (size_t)b * 128 * 256 + kvh * 64;
    const size_t rbase = (size_t)TP + b * 4;
    bf16_t* Ks = (bf16_t*)lds;
    bf16_t* VT = Ks + 144 * 72;
    f32x4 kf[4], vf[4];
#pragma unroll
    for (int i = 0; i < 4; ++i) { const int idx = tid + 512 * i, j = idx >> 4, c4 = (idx & 15) * 4; kf[i] = *(const f32x4*)(ck + (size_t)j * 256 + c4); vf[i] = *(const f32x4*)(cv + (size_t)j * 256 + c4); }
#pragma unroll
    for (int i = 0; i < 4; ++i) {
        const int idx = tid + 512 * i, j = idx >> 4, c4 = (idx & 15) * 4;
        if (j >= 4) { *(f32x4*)(owk + (size_t)(j - 4) * 256 + c4) = kf[i]; *(f32x4*)(owv + (size_t)(j - 4) * 256 + c4) = vf[i]; }
        u32x2 w; w.x = cvt_pk_bf16(kf[i].x, kf[i].y); w.y = cvt_pk_bf16(kf[i].z, kf[i].w);
        *(u32x2*)(Ks + j * 72 + c4) = w;
        VT[(c4 + 0) * 152 + j] = f2bf(vf[i].x); VT[(c4 + 1) * 152 + j] = f2bf(vf[i].y); VT[(c4 + 2) * 152 + j] = f2bf(vf[i].z); VT[(c4 + 3) * 152 + j] = f2bf(vf[i].w);
    }
    if (tid < 64) {
        const int t = tid >> 4, d4 = (tid & 15) * 4;
        const u32x2 kr = *(const u32x2*)(KVQ + (rbase + t) * NKVQ + kvh * 64 + d4);
        const u32x2 vr = *(const u32x2*)(KVQ + (rbase + t) * NKVQ + 256 + kvh * 64 + d4);
        float f0 = bflo(kr.x), f1 = bfhi(kr.x), f2 = bflo(kr.y), f3 = bfhi(kr.y);
        float s = (f0 * f0 + f1 * f1) + (f2 * f2 + f3 * f3);
        s += __shfl_xor(s, 1); s += __shfl_xor(s, 2); s += __shfl_xor(s, 4); s += __shfl_xor(s, 8);
        const float rs = rsqrtf(s * (1.f / 64.f) + EPS);
        const f32x4 g = *(const f32x4*)(p.k_norm_g + d4);
        f0 *= rs * g.x; f1 *= rs * g.y; f2 *= rs * g.z; f3 *= rs * g.w;
        *(f32x4*)(owk + (size_t)(124 + t) * 256 + d4) = (f32x4){f0, f1, f2, f3};
        *(f32x4*)(owv + (size_t)(124 + t) * 256 + d4) = (f32x4){bflo(vr.x), bfhi(vr.x), bflo(vr.y), bfhi(vr.y)};
        u32x2 w; w.x = cvt_pk_bf16(f0, f1); w.y = cvt_pk_bf16(f2, f3);
        *(u32x2*)(Ks + (128 + t) * 72 + d4) = w;
        VT[(d4 + 0) * 152 + 128 + t] = (bf16_t)(vr.x & 0xffff); VT[(d4 + 1) * 152 + 128 + t] = (bf16_t)(vr.x >> 16);
        VT[(d4 + 2) * 152 + 128 + t] = (bf16_t)(vr.y & 0xffff); VT[(d4 + 3) * 152 + 128 + t] = (bf16_t)(vr.y >> 16);
    } else if (tid < 64 + 192) {
        const int i = tid - 64;
        if (i < 96) { const int r = 132 + (i >> 3), c8 = (i & 7) * 8; *(u32x4*)(Ks + r * 72 + c8) = (u32x4){0u, 0u, 0u, 0u}; }
        else { const int d = i - 96; if (d < 64) { bf16_t* z = VT + d * 152 + 132; for (int e = 0; e < 12; ++e) z[e] = 0; } }
    }
    __syncthreads();
    if (wid < 4) {
        const int dt = wid;
        const int g = fr >> 2, t = fr & 3, head = kvh * 4 + g;
        const bf16_t* qp = KVQ + (rbase + t) * NKVQ + 512 + head * 64;
        const u32x4 r0 = *(const u32x4*)(qp + 8 * fq), r1 = *(const u32x4*)(qp + 32 + 8 * fq);
        bf16x8 q0, q1; norm_frag(r0, r1, p.q_norm_g, 0.125f, fq, q0, q1);
        const float sink = p.att_sinks[head];
        f32x4 s[9];
#pragma unroll
        for (int i = 0; i < 9; ++i) {
            s[i] = (f32x4){0.f, 0.f, 0.f, 0.f};
            const bf16_t* kr = Ks + (16 * i + fr) * 72 + 8 * fq;
            s[i] = MFMA32(*(const bf16x8*)kr, q0, s[i]);
            s[i] = MFMA32(*(const bf16x8*)(kr + 32), q1, s[i]);
        }
        float mx = sink;
#pragma unroll
        for (int i = 0; i < 9; ++i)
#pragma unroll
            for (int e = 0; e < 4; ++e) {
                const int j = 16 * i + 4 * fq + e;
                const bool ok = (j >= t) && (j <= t + 128);
                s[i][e] = ok ? s[i][e] : -INFINITY;
                mx = fmaxf(mx, s[i][e]);
            }
        mx = fmaxf(mx, __shfl_xor(mx, 16)); mx = fmaxf(mx, __shfl_xor(mx, 32));
        float l = 0.f;
        f32x4 o = (f32x4){0.f, 0.f, 0.f, 0.f};
#pragma unroll
        for (int i = 0; i < 9; ++i) {
            const float e0 = __expf(s[i][0] - mx), e1 = __expf(s[i][1] - mx), e2 = __expf(s[i][2] - mx), e3 = __expf(s[i][3] - mx);
            l += (e0 + e1) + (e2 + e3);
            u32x2 w; w.x = cvt_pk_bf16(e0, e1); w.y = cvt_pk_bf16(e2, e3);
            const bf16x4 vfr = *(const bf16x4*)(VT + (16 * dt + fr) * 152 + 16 * i + 4 * fq);
            o = MFMA16(vfr, __builtin_bit_cast(bf16x4, w), o);
        }
        l += __shfl_xor(l, 16); l += __shfl_xor(l, 32);
        l += __expf(sink - mx);
        const float inv = 1.f / l;
        u32x2 w; w.x = cvt_pk_bf16(o.x * inv, o.y * inv); w.y = cvt_pk_bf16(o.z * inv, o.w * inv);
        *(u32x2*)(AO + (rbase + t) * D + head * 64 + 16 * dt + 4 * fq) = w;
    }
    __syncthreads();
}

#define LAS __attribute__((address_space(3)))
#define XB_TMO      128
#define XB_XCNT(j)  (256  + 64 * (j))
#define XB_XSUB(j)  (1280 + 64 * (j))
#define XB_XGEN(j)  (2304 + 64 * (j))
#define XB_TOP      3328
#define XB_TOPGEN   3392
#define XCD_BAR_WORDS 3456
#define XB_SPIN_CAP (1u << 18)

__device__ __forceinline__ unsigned xb_ld(unsigned* p)              { return __hip_atomic_load(p, __ATOMIC_RELAXED, __HIP_MEMORY_SCOPE_AGENT); }
__device__ __forceinline__ unsigned xb_add(unsigned* p, unsigned v) { return __hip_atomic_fetch_add(p, v, __ATOMIC_RELAXED, __HIP_MEMORY_SCOPE_AGENT); }
__device__ __forceinline__ unsigned xb_xcc_id() { return (unsigned)__builtin_amdgcn_s_getreg((3 << 11) | 20) & 0xFu; }
#define XB_SPIN(cond, bar) do { unsigned _sp = 0; while (cond) { __builtin_amdgcn_s_sleep(1); \
    if ((++_sp & 255u) == 0u) { if (xb_ld(&(bar)[XB_TMO])) break; if (_sp > XB_SPIN_CAP) { atomicAdd(&(bar)[XB_TMO], 1u); break; } } } } while (0)

struct XcdBarrier {
    unsigned* bar; unsigned x;
    volatile LAS unsigned* st;
};

__device__ __forceinline__ XcdBarrier xcd_barrier_post(unsigned* bar, volatile LAS unsigned* st) {
    XcdBarrier b; b.bar = bar; b.x = xb_xcc_id(); b.st = st;
    if (threadIdx.x == 0) (void)xb_add(&bar[XB_XCNT(b.x)], 1u);
    return b;
}
__device__ __forceinline__ void xcd_barrier_complete(unsigned* bar, unsigned x, unsigned& nloc, unsigned& nx) {
    const unsigned G = gridDim.x * gridDim.y * gridDim.z;
    unsigned sum, cnt, mine, sp = 0u;
    for (;;) {
        sum = 0u; cnt = 0u; mine = 0u;
#pragma unroll
        for (unsigned j = 0; j < 16; ++j) { const unsigned c = xb_ld(&bar[XB_XCNT(j)]); sum += c; cnt += (c > 0u) ? 1u : 0u; mine = (j == x) ? c : mine; }
        if (sum == G) break;
        __builtin_amdgcn_s_sleep(1);
        if ((++sp & 255u) == 0u) { if (xb_ld(&bar[XB_TMO])) break; if (sp > XB_SPIN_CAP) { atomicAdd(&bar[XB_TMO], 1u); break; } }
    }
    nloc = mine > 0u ? mine : 1u; nx = cnt > 0u ? cnt : 1u;
}

__device__ __forceinline__ void xcd_barrier(const XcdBarrier& b) {
    asm volatile("s_waitcnt vmcnt(0)" ::: "memory");
    __syncthreads();
    if (threadIdx.x == 0) {
        unsigned* bar = b.bar;
        __builtin_amdgcn_s_waitcnt(0);
        unsigned nloc = b.st[0], nx = b.st[1];
        if (nloc == 0u) { xcd_barrier_complete(bar, b.x, nloc, nx); b.st[0] = nloc; b.st[1] = nx; }
        const unsigned old = xb_add(&bar[XB_XSUB(b.x)], 1u);
        const unsigned gen = old / nloc;
        if (old + 1u == (gen + 1u) * nloc) {
            __builtin_amdgcn_fence(__ATOMIC_RELEASE, "agent");
            asm volatile("s_waitcnt vmcnt(0)" ::: "memory");
            const unsigned og = xb_add(&bar[XB_TOP], 1u);
            const unsigned tg = og / nx;
            if (og + 1u == (tg + 1u) * nx) xb_add(&bar[XB_TOPGEN], 1u);
            else XB_SPIN(xb_ld(&bar[XB_TOPGEN]) == tg, bar);
            __builtin_amdgcn_fence(__ATOMIC_ACQUIRE, "agent");
            xb_add(&bar[XB_XGEN(b.x)], 1u);
            asm volatile("s_waitcnt vmcnt(0)" ::: "memory");
        } else {
            XB_SPIN(xb_ld(&bar[XB_XGEN(b.x)]) == gen, bar);
            __builtin_amdgcn_fence(__ATOMIC_ACQUIRE, "agent");
            asm volatile("s_waitcnt vmcnt(0)" ::: "memory");
        }
    }
    __syncthreads();
}

__global__ void __launch_bounds__(NTHREADS) yoco_fwd(Params p) {
    extern __shared__ __attribute__((aligned(16))) unsigned char lds[];
    const int bid = blockIdx.x, G = gridDim.x;
    unsigned char* ws = p.ws;
    float* SS = (float*)(ws + WS_SS);
    float* Y = p.out + O_Y;
    bf16_t* XB = (bf16_t*)(ws + WS_XB);

#define IN(k) (p.ph_lo <= (k) && (k) < p.ph_hi)
    volatile LAS unsigned* bst = (volatile LAS unsigned*)((LAS unsigned char*)lds + 131072 + 64);
    XcdBarrier xbar; xbar.bar = (unsigned*)(ws + WS_BAR); xbar.x = 0; xbar.st = bst;
    int cv = bid;
    if (p.ph_hi - p.ph_lo > 1) {
        if (threadIdx.x < 8) bst[threadIdx.x] = 0u;
        __syncthreads();
        xbar.x = xb_xcc_id();
        if (threadIdx.x == 0) bst[2] = xb_add(&xbar.bar[XB_XCNT(xbar.x)], 1u);
    }
#define SEAM(k) do { if (IN(k) && IN((k) + 1)) xcd_barrier(xbar); } while (0)
    if (IN(0)) { for (int rep = 0; rep < REP_P0; ++rep) p0_prologue(p, lds, bid, G); }
    SEAM(0);
    if (p.ph_hi - p.ph_lo > 1 && IN(0) && IN(1)) {
        if (threadIdx.x == 0) {
            bool ok = (G % 8 == 0) && xbar.x < 8u;
            for (unsigned j = 0; j < 8; ++j) ok = ok && (xb_ld(&xbar.bar[XB_XCNT(j)]) == (unsigned)(G / 8));
            const unsigned rank = bst[2];
            bst[3] = (ok && rank < (unsigned)(G / 8)) ? (xbar.x + 8u * rank) : (unsigned)bid;
        }
        __syncthreads();
        cv = __builtin_amdgcn_readfirstlane((int)bst[3]);
    }
    PG8_LAS unsigned char* l3 = (PG8_LAS unsigned char*)lds;
    float* YS = Y;
#define PGEMM(Aptr, Bptr, Nn, Kk, EpiT, ...) do { pg8::Gemm g_{(const bf16_t*)(Aptr), (const bf16_t*)(Bptr), TP, (Nn), (Kk), ((Kk) == FF) ? 1 : 0}; pg8::StaticOrder S_; S_.init(TP, (Nn), G, cv); \
        Pg8Epi<EpiT> E_{EpiT{__VA_ARGS__}}; pg8::gemm_phase<Pg8Epi<EpiT>, pg8::StaticOrder, true, true>(l3, g_, S_, E_); } while (0)
    if (IN(1)) {
        for (int rep = 0; rep < REP_PG; ++rep) { PGEMM(XB, ws + WS_WIN, NIN, 1024, EpiBf16, (bf16_t*)(ws + WS_P), NIN, nullptr, 0); }
        { EpiBf16 E{(bf16_t*)(ws + WS_P), NIN, nullptr, 0}; for (int rep = 0; rep < REP_SG; ++rep) sgemm64<0>(lds, XB, 1024, (const bf16_t*)(ws + WS_WIN), TP, TS, NIN, 1024, 1, E, bid, G); }
    }
    SEAM(1);
    if (IN(2)) {
        for (int rep = 0; rep < REP_2AL; ++rep) for (int u = bid; u < 1024; u += G) mlstm_local_unit(p, lds, u);
        for (int rep = 0; rep < REP_2AS; ++rep) for (int u = bid; u < 512; u += G) mlstm_sample_unit(p, lds, u);
    }
    SEAM(2);
    if (IN(3)) mlstm_scan(p, lds, bid, G);
    SEAM(3);
    if (IN(4)) { for (int rep = 0; rep < REP_2C; ++rep) for (int u = bid; u < 1024; u += G) mlstm_out_unit(p, lds, u); }
    SEAM(4);
    if (IN(5)) {
        PGEMM(ws + WS_HG, ws + WS_WOUT, 1024, 1024, EpiResB, p.x_prompt, XB, nullptr, SS);
        { EpiAddF32 E{YS}; sgemm64<0>(lds, ws + WS_HG, 1024, (const bf16_t*)(ws + WS_WOUT), TP, TS, 1024, 1024, 1, E, bid, G); }
    }
    SEAM(5);
    if (IN(6)) {
        for (int rep = 0; rep < REP_PG; ++rep) { PGEMM(XB, ws + WS_W1A, FF, 1024, EpiBf16, (bf16_t*)(ws + WS_HID), FF, SS, 1); }
        { EpiBf16 E{(bf16_t*)(ws + WS_HID), FF, nullptr, 1}; for (int rep = 0; rep < REP_SG; ++rep) sgemm64<1>(lds, Y, 1024, (const bf16_t*)(ws + WS_W1A), TP, TS, FF, 1024, 1, E, bid, G); }
    }
    SEAM(6);
    if (IN(7)) {
        PGEMM(ws + WS_HID, ws + WS_W2A, 1024, FF, EpiResB, nullptr, XB, nullptr, SS + T);
        { EpiAtomic E{YS}; sgemm64<0>(lds, ws + WS_HID, FF, (const bf16_t*)(ws + WS_W2A), TP, TS, 1024, FF, 2, E, bid, G); }
    }
    SEAM(7);
    if (IN(8)) {
        for (int rep = 0; rep < REP_PG; ++rep) { PGEMM(XB, ws + WS_WKVQ, NKVQ, 1024, EpiBf16, (bf16_t*)(ws + WS_KVQ), NKVQ, SS + T, 0); }
        { EpiBf16 E{(bf16_t*)(ws + WS_KVQ), NKVQ, nullptr, 0}; for (int rep = 0; rep < REP_SG; ++rep) sgemm64<1>(lds, Y, 1024, (const bf16_t*)(ws + WS_WKVQ), TP, TS, NKVQ, 1024, 1, E, (cv + G / 2) % G, G); }
        __syncthreads();
        if (cv >= G / 2) late_weights(p, lds, cv - G / 2, G - G / 2);
    }
    SEAM(8);
    if (IN(9)) {
        { const int vb = (G % 8 == 0) ? (cv % 8) * (G / 8) + cv / 8 : cv;
          for (int rep = 0; rep < REP_7P; ++rep) for (int u = vb; u < 512; u += G) attn_prompt_unit(p, lds, u); }
        for (int rep = 0; rep < REP_7S; ++rep) for (int u = bid; u < 512; u += G) attn_sample_block(p, lds, u);
    }
    SEAM(9);
    if (IN(10)) {
        PGEMM(ws + WS_ATT, ws + WS_WO, 1024, 1024, EpiResB, nullptr, XB, nullptr, SS + 2 * T);
        { EpiAddF32 E{YS}; sgemm64<0>(lds, ws + WS_ATT, 1024, (const bf16_t*)(ws + WS_WO), TP, TS, 1024, 1024, 1, E, bid, G); }
    }
    SEAM(10);
    if (IN(11)) {
        for (int rep = 0; rep < REP_PG; ++rep) { PGEMM(XB, ws + WS_W1B, FF, 1024, EpiBf16, (bf16_t*)(ws + WS_HID), FF, SS + 2 * T, 1); }
        { EpiBf16 E{(bf16_t*)(ws + WS_HID), FF, nullptr, 1}; for (int rep = 0; rep < REP_SG; ++rep) sgemm64<1>(lds, Y, 1024, (const bf16_t*)(ws + WS_W1B), TP, TS, FF, 1024, 1, E, bid, G); }
    }
    SEAM(11);
    if (IN(12)) {
        PGEMM(ws + WS_HID, ws + WS_W2B, 1024, FF, EpiResB, nullptr, XB, Y, nullptr);
        { EpiAtomic E{YS}; sgemm64<0>(lds, ws + WS_HID, FF, (const bf16_t*)(ws + WS_W2B), TP, TS, 1024, FF, 2, E, bid, G); }
    }
#undef PGEMM
#undef IN
#undef SEAM
}

extern "C" void kernel_launch(void* const* d_in, const int* in_sizes, int n_in, void* d_out, int out_size, void* d_ws, size_t ws_size, hipStream_t stream) {
    static int grid_blocks = 0;
    if (!grid_blocks) {
        if (n_in != 24 || (size_t)out_size != O_END || ws_size < WS_END) { fprintf(stderr, "kernel_launch: unexpected shapes n_in=%d out=%d ws=%zu\n", n_in, out_size, ws_size); grid_blocks = -1; return; }
        int dev = 0, cus = 0, per_cu = 0;
        hipGetDevice(&dev);
        hipDeviceGetAttribute(&cus, hipDeviceAttributeMultiprocessorCount, dev);
        hipFuncSetAttribute((const void*)yoco_fwd, hipFuncAttributeMaxDynamicSharedMemorySize, LDS_BYTES);
        hipOccupancyMaxActiveBlocksPerMultiprocessor(&per_cu, (const void*)yoco_fwd, NTHREADS, LDS_BYTES);
        if (per_cu < 1) per_cu = 1;
        grid_blocks = cus * per_cu;
        (void)hipGetLastError();
    }
    if (grid_blocks < 0) return;
    Params p{};
    const float** pp = (const float**)&p;
    for (int i = 0; i < 24; ++i) pp[i] = (const float*)d_in[i];
    p.out = (float*)d_out; p.ws = (unsigned char*)d_ws;
#if N_LAUNCH_MODE == 1
    p.ph_lo = 0; p.ph_hi = 13;
    (void)hipMemsetAsync((char*)d_ws + WS_BAR, 0, BAR_BYTES, stream);
    void* args[] = {&p};
    hipError_t e = hipLaunchCooperativeKernel((const void*)yoco_fwd, dim3(grid_blocks), dim3(NTHREADS), args, LDS_BYTES, stream);
    if (e != hipSuccess) fprintf(stderr, "cooperative launch failed: %s (grid %d)\n", hipGetErrorString(e), grid_blocks);
#else
    for (int k = 0; k < MAX_PHASE; ++k) { p.ph_lo = k; p.ph_hi = k + 1; hipLaunchKernelGGL(yoco_fwd, dim3(grid_blocks), dim3(NTHREADS), LDS_BYTES, stream, p); }
#endif
}
```

```cpp
#include <hip/hip_runtime.h>
#include <hip/hip_cooperative_groups.h>
#include <cstdio>
#include <cstdint>
namespace cg = cooperative_groups;

typedef unsigned short bf16_t;
typedef short bf16x8 __attribute__((ext_vector_type(8)));
typedef short bf16x4 __attribute__((ext_vector_type(4)));
typedef float f32x4 __attribute__((ext_vector_type(4)));
typedef unsigned u32x4 __attribute__((ext_vector_type(4)));
typedef unsigned u32x2 __attribute__((ext_vector_type(2)));

constexpr int D = 1024, TP = 16384, TS = 512, T = TP + TS;
constexpr int NIN = 3072, LDW_IN = 3080, FF = 4096, NKVQ = 1536;
constexpr float EPS = 1e-6f;
constexpr int NTHREADS = 512;
constexpr int LDS_BYTES = 147456;
#ifndef REP_P0
#define REP_P0 1
#endif
#ifndef REP_2AL
#define REP_2AL 1
#endif
#ifndef REP_2AS
#define REP_2AS 1
#endif
#ifndef REP_2C
#define REP_2C 1
#endif
#ifndef REP_7P
#define REP_7P 1
#endif
#ifndef REP_7S
#define REP_7S 1
#endif
#ifndef REP_PG
#define REP_PG 1
#endif
#ifndef REP_SG
#define REP_SG 1
#endif
#ifndef MAX_PHASE
#define MAX_PHASE 13
#endif
#ifndef N_LAUNCH_MODE
#define N_LAUNCH_MODE 1
#endif

constexpr size_t MiB = 1u << 20;
constexpr size_t WS_SS = 0;
constexpr size_t WS_CHB = 256 * 1024, WS_CHM = WS_CHB + 4096, WS_MPREV = WS_CHM + 4096;
constexpr size_t WS_GATES = 1 * MiB;
constexpr size_t WS_GN = 2 * MiB;
constexpr size_t WS_BAR = 3 * MiB, BAR_BYTES = 16384;
constexpr size_t WS_WIN = 4 * MiB, WS_WOUT = 10 * MiB, WS_W1A = 12 * MiB, WS_W2A = 20 * MiB, WS_WKVQ = 28 * MiB, WS_WO = 31 * MiB, WS_W1B = 33 * MiB, WS_W2B = 41 * MiB;
constexpr size_t WS_XB = 49 * MiB;
constexpr size_t WS_P = 82 * MiB;
constexpr size_t WS_HG = 181 * MiB;
constexpr size_t WS_HID = 82 * MiB;
constexpr size_t WS_KVQ = 82 * MiB;
constexpr size_t WS_ATT = 132 * MiB;
constexpr size_t WS_END = 214 * MiB;

constexpr size_t O_Y = 0, O_PC = 17301504, O_PN = 17825792, O_PM = 17827840, O_PWK = 17827856, O_PWV = 17958928,
                 O_SC = 18090000, O_SN = 34867216, O_SM = 34932752, O_SWK = 34933264, O_SWV = 39127568, O_END = 43321872;

struct Params {
    const float *x_prompt, *x_sample, *st_C, *st_n, *st_m, *cache_k, *cache_v;
    const float *ml_norm_g, *ml_w_in, *ml_b_i, *ml_b_f, *ml_head_g, *ml_w_out;
    const float *kv_norm_g, *w_kv, *k_norm_g;
    const float *att_norm_g, *att_w_q, *q_norm_g, *att_sinks, *att_w_o;
    const float *mlp_norm_g, *mlp_w1, *mlp_w2;
    float* out; unsigned char* ws;
    int ph_lo, ph_hi;
};

typedef float f32x2 __attribute__((ext_vector_type(2)));
typedef __bf16 bf16x2n __attribute__((ext_vector_type(2)));
__device__ __forceinline__ unsigned cvt_pk_bf16(float lo, float hi) { const f32x2 v = {lo, hi}; const bf16x2n b = __builtin_convertvector(v, bf16x2n); return __builtin_bit_cast(unsigned, b); }
__device__ __forceinline__ bf16_t f2bf(float f) { return (bf16_t)(cvt_pk_bf16(f, 0.f) & 0xffffu); }
__device__ __forceinline__ float bf2f(bf16_t h) { return __uint_as_float(((unsigned)h) << 16); }
__device__ __forceinline__ float bflo(unsigned u) { return __uint_as_float(u << 16); }
__device__ __forceinline__ float bfhi(unsigned u) { return __uint_as_float(u & 0xffff0000u); }
__device__ __forceinline__ float wave_sum(float v) {
#pragma unroll
    for (int o = 1; o < 64; o <<= 1) v += __shfl_xor(v, o);
    return v;
}
__device__ __forceinline__ float wave_max(float v) {
#pragma unroll
    for (int o = 1; o < 64; o <<= 1) v = fmaxf(v, __shfl_xor(v, o));
    return v;
}
__device__ __forceinline__ float scan_sum(float x, int lane) {
#pragma unroll
    for (int o = 1; o < 64; o <<= 1) { float y = __shfl_up(x, o); if (lane >= o) x += y; }
    return x;
}
__device__ __forceinline__ float scan_max(float x, int lane) {
#pragma unroll
    for (int o = 1; o < 64; o <<= 1) { float y = __shfl_up(x, o); if (lane >= o) x = fmaxf(x, y); }
    return x;
}
__device__ __forceinline__ float softcap15(float x) { return 15.f * tanhf(x * (1.f / 15.f)); }
__device__ __forceinline__ float logsigmoid(float z) { return fminf(z, 0.f) - log1pf(__expf(-fabsf(z))); }
__device__ __forceinline__ float sigmoidf_(float z) { return 1.f / (1.f + __expf(-z)); }
#define LDS_WAIT() asm volatile("s_waitcnt lgkmcnt(0)" ::: "memory")
#define MFMA32(x, y, acc) __builtin_amdgcn_mfma_f32_16x16x32_bf16((x), (y), (acc), 0, 0, 0)
#define MFMA16(x, y, acc) __builtin_amdgcn_mfma_f32_16x16x16bf16_1k((x), (y), (acc), 0, 0, 0)

__device__ __forceinline__ void transpose_item(const float* __restrict__ W, int ldw, int K, const float* __restrict__ gk, float cs,
                                               bf16_t* WT, int row_off, int k0, int n0, float* scr, int lane) {
    {
        const int kr = lane >> 3, n4 = (lane & 7) * 4;
        f32x4 wv[8];
#pragma unroll
        for (int i = 0; i < 8; ++i) wv[i] = *(const f32x4*)(W + (size_t)(k0 + kr + 8 * i) * ldw + n0 + n4);
#pragma unroll
        for (int i = 0; i < 8; ++i) {
            const int kk = kr + 8 * i;
            const float g = gk ? gk[k0 + kk] * cs : cs;
            float* d = scr + kk * 33 + n4;
            d[0] = wv[i].x * g; d[1] = wv[i].y * g; d[2] = wv[i].z * g; d[3] = wv[i].w * g;
        }
    }
    LDS_WAIT();
    const int c = lane & 7;
#pragma unroll
    for (int j = 0; j < 4; ++j) {
        const int n = (lane >> 3) + 8 * j; const float* s = scr + (8 * c) * 33 + n;
        u32x4 o; o.x = cvt_pk_bf16(s[0 * 33], s[1 * 33]); o.y = cvt_pk_bf16(s[2 * 33], s[3 * 33]); o.z = cvt_pk_bf16(s[4 * 33], s[5 * 33]); o.w = cvt_pk_bf16(s[6 * 33], s[7 * 33]);
        *(u32x4*)(WT + (size_t)(row_off + n0 + n) * K + k0 + 8 * c) = o;
    }
    LDS_WAIT();
}

__device__ __forceinline__ void p0_prologue(const Params& p, unsigned char* lds, int bid, int G) {
    const int tid = threadIdx.x, lane = tid & 63, wid = tid >> 6;
    unsigned char* ws = p.ws;
    float* scr = (float*)(lds + wid * 8448);
    float* wif = (float*)(lds + 73728);
    for (int k = tid; k < 1024; k += NTHREADS) {
        const float g = p.ml_norm_g[k];
        const f32x4 a = *(const f32x4*)(p.ml_w_in + (size_t)k * LDW_IN + 3072), b = *(const f32x4*)(p.ml_w_in + (size_t)k * LDW_IN + 3076);
        wif[0 * 1024 + k] = a.x * g; wif[1 * 1024 + k] = a.y * g; wif[2 * 1024 + k] = a.z * g; wif[3 * 1024 + k] = a.w * g;
        wif[4 * 1024 + k] = b.x * g; wif[5 * 1024 + k] = b.y * g; wif[6 * 1024 + k] = b.z * g; wif[7 * 1024 + k] = b.w * g;
    }
    { float* ss = (float*)(ws + WS_SS); for (int i = bid * NTHREADS + tid; i < 3 * T; i += G * NTHREADS) ss[i] = 0.f; }
    __syncthreads();
    const int gw = bid * 8 + wid, NGW = G * 8;
    constexpr int I_IN = 16 * 96, I_SQ = 16 * 32, I_1 = 16 * 128, I_2 = 64 * 32, I_KV = 16 * 16;
    constexpr int NITEMS = I_IN + I_SQ + I_1 + I_2 + I_KV + I_SQ;
    for (int it = gw; it < NITEMS; it += NGW) {
        int r = it;
        if (r < I_IN) { const int kb = r / 96, nb = r % 96, n0 = nb * 32; const float cs = (n0 >= 512 && n0 < 1024) ? 0.08838834764831845f : 1.f;
            transpose_item(p.ml_w_in, LDW_IN, 1024, p.ml_norm_g, cs, (bf16_t*)(ws + WS_WIN), 0, kb * 64, n0, scr, lane); continue; } r -= I_IN;
        if (r < I_SQ) { transpose_item(p.ml_w_out, 1024, 1024, nullptr, 1.f, (bf16_t*)(ws + WS_WOUT), 0, (r / 32) * 64, (r % 32) * 32, scr, lane); continue; } r -= I_SQ;
        if (r < I_1) { transpose_item(p.mlp_w1, 4096, 1024, p.mlp_norm_g, 1.f, (bf16_t*)(ws + WS_W1A), 0, (r / 128) * 64, (r % 128) * 32, scr, lane); continue; } r -= I_1;
        if (r < I_2) { transpose_item(p.mlp_w2, 1024, 4096, nullptr, 1.f, (bf16_t*)(ws + WS_W2A), 0, (r / 32) * 64, (r % 32) * 32, scr, lane); continue; } r -= I_2;
        if (r < I_KV) { transpose_item(p.w_kv, 512, 1024, p.kv_norm_g, 1.f, (bf16_t*)(ws + WS_WKVQ), 0, (r / 16) * 64, (r % 16) * 32, scr, lane); continue; } r -= I_KV;
        transpose_item(p.att_w_q, 1024, 1024, p.att_norm_g, 1.f, (bf16_t*)(ws + WS_WKVQ), 512, (r / 32) * 64, (r % 32) * 32, scr, lane);
    }
    bf16_t* XB = (bf16_t*)(ws + WS_XB); float* gates = (float*)(ws + WS_GATES);
    for (int m = gw; m < T; m += NGW) {
        const float* xrow = m < TP ? p.x_prompt + (size_t)m * D : p.x_sample + (size_t)(m - TP) * D;
        f32x4 v[4]; float s = 0.f;
#pragma unroll
        for (int j = 0; j < 4; ++j) { v[j] = *(const f32x4*)(xrow + 4 * lane + 256 * j); s += (v[j].x * v[j].x + v[j].y * v[j].y) + (v[j].z * v[j].z + v[j].w * v[j].w); }
        const float rstd = rsqrtf(wave_sum(s) * (1.f / D) + EPS);
        if (m >= TP) {
#pragma unroll
            for (int j = 0; j < 4; ++j) *(f32x4*)(p.out + O_Y + (size_t)m * D + 4 * lane + 256 * j) = v[j];
        }
#pragma unroll
        for (int j = 0; j < 4; ++j) { u32x2 w; w.x = cvt_pk_bf16(v[j].x * rstd, v[j].y * rstd); w.y = cvt_pk_bf16(v[j].z * rstd, v[j].w * rstd); *(u32x2*)(XB + (size_t)m * D + 4 * lane + 256 * j) = w; }
        float mine = 0.f;
#pragma unroll
        for (int g = 0; g < 8; ++g) {
            float a = 0.f;
#pragma unroll
            for (int j = 0; j < 4; ++j) { const f32x4 w = *(const f32x4*)(wif + g * 1024 + 4 * lane + 256 * j); a += (v[j].x * w.x + v[j].y * w.y) + (v[j].z * w.z + v[j].w * w.w); }
            a = wave_sum(a) * rstd;
            if (lane == g) mine = a;
        }
        if (lane < 4) gates[(size_t)m * 8 + lane] = softcap15(mine + p.ml_b_i[lane]);
        else if (lane < 8) gates[(size_t)m * 8 + lane] = logsigmoid(softcap15(mine + p.ml_b_f[lane - 4]));
    }
}

__device__ __forceinline__ void late_weights(const Params& p, unsigned char* lds, int slot, int nslots) {
    const int tid = threadIdx.x, lane = tid & 63, wid = tid >> 6;
    unsigned char* ws = p.ws;
    float* scr = (float*)(lds + wid * 8448);
    constexpr int I_SQ = 16 * 32, I_1 = 16 * 128, I_2 = 64 * 32, NIT = I_SQ + I_1 + I_2;
    for (int it = slot * 8 + wid; it < NIT; it += nslots * 8) {
        int r = it;
        if (r < I_SQ) { transpose_item(p.att_w_o, 1024, 1024, nullptr, 1.f, (bf16_t*)(ws + WS_WO), 0, (r / 32) * 64, (r % 32) * 32, scr, lane); continue; } r -= I_SQ;
        if (r < I_1) { transpose_item(p.mlp_w1 + (size_t)1024 * 4096, 4096, 1024, p.mlp_norm_g + 1024, 1.f, (bf16_t*)(ws + WS_W1B), 0, (r / 128) * 64, (r % 128) * 32, scr, lane); continue; } r -= I_1;
        transpose_item(p.mlp_w2 + (size_t)4096 * 1024, 1024, 4096, nullptr, 1.f, (bf16_t*)(ws + WS_W2B), 0, (r / 32) * 64, (r % 32) * 32, scr, lane);
    }
}

struct EpiBf16 {
    bf16_t* out; int ld; const float* ss; int act;
    template <int NQ, bool PAIRED> __device__ __forceinline__ void row(int r, const int (&c)[NQ], const f32x4 (&v)[NQ], int fq, float rscale) const {
        float sc = rscale; if (ss) sc = rsqrtf(ss[r] * (1.f / 1024.f) + EPS);
        u32x2 w[NQ];
#pragma unroll
        for (int q = 0; q < NQ; ++q) {
            f32x4 x = v[q] * sc;
            if (act) { x.x = fmaxf(x.x, 0.f); x.y = fmaxf(x.y, 0.f); x.z = fmaxf(x.z, 0.f); x.w = fmaxf(x.w, 0.f); x = x * x; }
            w[q].x = cvt_pk_bf16(x.x, x.y); w[q].y = cvt_pk_bf16(x.z, x.w);
        }
        if (PAIRED) {
#pragma unroll
            for (int q = 0; q < NQ; q += 2) { u32x4 o; o.x = w[q].x; o.y = w[q].y; o.z = w[q + 1].x; o.w = w[q + 1].y; *(u32x4*)(out + (size_t)r * ld + c[q]) = o; }
        } else {
#pragma unroll
            for (int q = 0; q < NQ; ++q) *(u32x2*)(out + (size_t)r * ld + c[q]) = w[q];
        }
    }
};
struct EpiRes {
    const float* srcp; const float* srcs; float* dst; bf16_t* xb; float* ss;
    template <int NQ, bool PAIRED> __device__ __forceinline__ void row(int r, const int (&c)[NQ], const f32x4 (&v)[NQ], int fq, float rscale) const {
        const float* s = r < TP ? srcp + (size_t)r * D : srcs + (size_t)(r - TP) * D;
        float a2 = 0.f;
        u32x2 w[NQ];
#pragma unroll
        for (int q = 0; q < NQ; ++q) {
            const f32x4 o = *(const f32x4*)(s + c[q]) + v[q];
            *(f32x4*)(dst + (size_t)r * D + c[q]) = o;
            w[q].x = cvt_pk_bf16(o.x, o.y); w[q].y = cvt_pk_bf16(o.z, o.w);
            a2 += (o.x * o.x + o.y * o.y) + (o.z * o.z + o.w * o.w);
        }
        if (xb) {
            if (PAIRED) {
#pragma unroll
                for (int q = 0; q < NQ; q += 2) { u32x4 o; o.x = w[q].x; o.y = w[q].y; o.z = w[q + 1].x; o.w = w[q + 1].y; *(u32x4*)(xb + (size_t)r * D + c[q]) = o; }
            } else {
#pragma unroll
                for (int q = 0; q < NQ; ++q) *(u32x2*)(xb + (size_t)r * D + c[q]) = w[q];
            }
        }
        if (ss) { a2 += __shfl_xor(a2, 16); a2 += __shfl_xor(a2, 32); if (fq == 0) atomicAdd(ss + r, a2); }
    }
};

namespace pg8 {
#define PG8_LAS __attribute__((address_space(3)))
typedef unsigned short bf16_t;
typedef short bf16x8 __attribute__((ext_vector_type(8)));
typedef float f32x4 __attribute__((ext_vector_type(4)));
typedef unsigned u32x4 __attribute__((ext_vector_type(4)));
constexpr int BM = 256, BK = 64, HALF = 128, HTB = HALF * BK * 2  , STAGE_BYTES = 8 * HTB, NXCD = 8, WGM = 8;

__host__ __device__ __forceinline__ int lds_byte(int r, int c) { const int st = (r >> 4) * 2 + (c >> 5), rr = r & 15, cc = c & 31, ob = rr * 64 + cc * 2; return st * 1024 + (ob ^ (((ob >> 9) & 1) << 5)); }
__host__ __device__ __forceinline__ void stage_rc(int b, int& R, int& C) { const int st = b / 1024, sb = b % 1024, swz = sb ^ (((sb >> 9) & 1) << 5); R = (st >> 1) * 16 + swz / 64; C = (st & 1) * 32 + (swz % 64) / 2; }
__host__ __device__ __forceinline__ int perm32(int rho) { const int n = rho >> 4, i = rho & 15; return 8 * (i >> 2) + 4 * n + (i & 3); }

struct Unit { int pm, pn; };
struct Gemm { const bf16_t* A; const bf16_t* Bt; int M, N, K; int revk; };

struct StaticOrder {
    int nM, nN, nwg, G, c;
    __host__ __device__ void init(int M, int N, int G_, int c_) { nM = M / BM; nN = N / BM; nwg = nM * nN; G = G_; c = c_; }
    __host__ __device__ bool next(int i, Unit& u) const {
        const long L = (long)i * G + c; if (L >= nwg) return false;
        int wgid = (int)L; { const int q = nwg / NXCD, r = nwg % NXCD, xcd = wgid % NXCD, off = wgid / NXCD; wgid = (xcd < r ? xcd * (q + 1) : r * (q + 1) + (xcd - r) * q) + off; }
        const int nig = WGM * nN, gid = wgid / nig, fm = gid * WGM, gsz = (nM - fm) < WGM ? (nM - fm) : WGM;
        u.pm = fm + ((wgid % nig) % gsz); u.pn = (wgid % nig) / gsz; return true;
    }
    __device__ __forceinline__ void a_ready(const Unit&) const {}
    __device__ __forceinline__ void done(const Unit&) const {}
};


template <class Epi, class Sched, bool ALIGN_EPI = false, bool SP2 = false>
__device__ __forceinline__ void gemm_phase(PG8_LAS unsigned char* lds, const Gemm g, const Sched& S, const Epi& E) {
    const int tid = threadIdx.x, wid = __builtin_amdgcn_readfirstlane(tid >> 6), lane = tid & 63, wr = wid >> 2, wc = wid & 3, fr = lane & 15, fq = lane >> 4;
    const int K = g.K, nt = K / BK;
    unsigned voffA[2], voffB[2];
#pragma unroll
    for (int i = 0; i < 2; ++i) { int R, C; stage_rc(tid * 16 + i * 8192, R, C); const int Rb = Epi::PERM ? ((R & ~31) + perm32(R & 31)) : R;
        voffA[i] = (unsigned)(R * K + C) * 2u; voffB[i] = (unsigned)(Rb * K + C) * 2u; }
    const size_t kstep = g.revk ? (size_t)0 - (size_t)(BK * 2) : (size_t)(BK * 2);
    const size_t koff = g.revk ? (size_t)(K - BK) * 2 : (size_t)0;
    const size_t hstep = (size_t)HALF * K * 2;
    const size_t tstep = 2 * hstep;
    const unsigned ldsw = (unsigned)wid * 1024u;
    const int aoff = lds_byte(wr * 64 + fr, fq * 8), boff = lds_byte(wc * 32 + fr, fq * 8);
#define PG8_SA(b, h) (((b) * 2 + (h)) * HTB)
#define PG8_SB(b, h) ((4 + (b) * 2 + (h)) * HTB)
#define PG8_STAGE(bufoff, gbase, voff) do { _Pragma("unroll") for (int _i = 0; _i < 2; ++_i) \
        __builtin_amdgcn_global_load_lds((const unsigned*)((const char*)(gbase) + (voff)[_i]), (PG8_LAS unsigned*)(lds + (bufoff) + ldsw + _i * 8192), 16, 0, 0); } while (0)
#define PG8_LDA(dst, b, h) do { _Pragma("unroll") for (int m = 0; m < 4; ++m) _Pragma("unroll") for (int k = 0; k < 2; ++k) dst[m][k] = *(const PG8_LAS bf16x8*)(lds + PG8_SA(b, h) + aoff + m * 2048 + k * 1024); } while (0)
#define PG8_LDB(dst, b, h) do { _Pragma("unroll") for (int n = 0; n < 2; ++n) _Pragma("unroll") for (int k = 0; k < 2; ++k) dst[n][k] = *(const PG8_LAS bf16x8*)(lds + PG8_SB(b, h) + boff + n * 2048 + k * 1024); } while (0)
#define PG8_MMA(ai, bj, At, Bt) do { __builtin_amdgcn_s_setprio(1); _Pragma("unroll") for (int m = 0; m < 4; ++m) _Pragma("unroll") for (int n = 0; n < 2; ++n) _Pragma("unroll") for (int k = 0; k < 2; ++k) \
        acc[ai][bj][m][n] = __builtin_amdgcn_mfma_f32_16x16x32_bf16(Bt[n][k], At[m][k], acc[ai][bj][m][n], 0, 0, 0); __builtin_amdgcn_s_setprio(0); } while (0)
#define PG8_WAIT_V(n) asm volatile("s_waitcnt vmcnt(" #n ")" ::: "memory")
#define PG8_WAIT_L(n) asm volatile("s_waitcnt lgkmcnt(" #n ")" ::: "memory")
#define PG8_BAR __builtin_amdgcn_s_barrier()
#define PG8_SCHED __builtin_amdgcn_sched_barrier(0)
    Unit cur, nxt; int ui = 0;
    if (!S.next(0, cur)) return;
    f32x4 acc[2][2][4][2];
#pragma unroll
    for (int a = 0; a < 2; ++a)
#pragma unroll
        for (int b = 0; b < 2; ++b)
#pragma unroll
            for (int m = 0; m < 4; ++m)
#pragma unroll
                for (int n = 0; n < 2; ++n) acc[a][b][m][n] = (f32x4){0.f, 0.f, 0.f, 0.f};
    bf16x8 At[4][2], B0[2][2], B1[2][2];
    const char* cA = (const char*)g.A + (size_t)cur.pm * tstep + koff; const char* cB = (const char*)g.Bt + (size_t)cur.pn * tstep + koff;
    S.a_ready(cur);
    if constexpr (SP2) {
        PG8_STAGE(PG8_SB(0, 0), cB, voffB); PG8_STAGE(PG8_SB(0, 1), cB + hstep, voffB); PG8_STAGE(PG8_SA(0, 0), cA, voffA); PG8_STAGE(PG8_SA(0, 1), cA + hstep, voffA);
        if (wr == 1) PG8_BAR;
        PG8_WAIT_V(2); PG8_BAR;
        PG8_STAGE(PG8_SB(1, 0), cB + kstep, voffB); PG8_STAGE(PG8_SA(1, 0), cA + kstep, voffA); PG8_STAGE(PG8_SB(1, 1), cB + hstep + kstep, voffB);
        PG8_WAIT_V(6); PG8_BAR;
    } else {
        PG8_STAGE(PG8_SB(0, 0), cB, voffB); PG8_STAGE(PG8_SA(0, 0), cA, voffA); PG8_STAGE(PG8_SB(0, 1), cB + hstep, voffB); PG8_STAGE(PG8_SA(0, 1), cA + hstep, voffA);
        if (wr == 1) PG8_BAR;
        PG8_WAIT_V(4); PG8_BAR;
        PG8_STAGE(PG8_SB(1, 0), cB + kstep, voffB); PG8_STAGE(PG8_SA(1, 0), cA + kstep, voffA); PG8_STAGE(PG8_SB(1, 1), cB + hstep + kstep, voffB);
        PG8_WAIT_V(6); PG8_BAR;
    }
    for (;;) {
        const bool has_next = S.next(ui + 1, nxt);
        const char* nA = has_next ? (const char*)g.A + (size_t)nxt.pm * tstep + koff : cA; const char* nB = has_next ? (const char*)g.Bt + (size_t)nxt.pn * tstep + koff : cB;
        for (int t = 0; t < nt; t += 2) {
            const bool last = (t == nt - 2);
            const char* a1 = cA + (size_t)(t + 1) * kstep;
            const char* a2 = last ? nA : cA + (size_t)(t + 2) * kstep; const char* b2 = last ? nB : cB + (size_t)(t + 2) * kstep;
            const char* a3 = a2 + kstep; const char* b3 = b2 + kstep;
            if (last && has_next) S.a_ready(nxt);
            if constexpr (SP2) {
            PG8_LDB(B0, 0, 0); PG8_LDB(B1, 0, 1); PG8_SCHED; PG8_LDA(At, 0, 0); PG8_STAGE(PG8_SA(1, 1), a1 + hstep, voffA);
            PG8_WAIT_V(8); PG8_WAIT_L(0); PG8_BAR; PG8_MMA(0, 0, At, B0); PG8_MMA(0, 1, At, B1); PG8_BAR; PG8_SCHED;
            PG8_LDA(At, 0, 1); PG8_STAGE(PG8_SB(0, 0), b2, voffB); PG8_STAGE(PG8_SB(0, 1), b2 + hstep, voffB); PG8_STAGE(PG8_SA(0, 0), a2, voffA);
            PG8_WAIT_V(8); PG8_WAIT_L(0); PG8_BAR; PG8_MMA(1, 0, At, B0); PG8_MMA(1, 1, At, B1); PG8_BAR; PG8_SCHED;
            PG8_LDB(B0, 1, 0); PG8_LDB(B1, 1, 1); PG8_SCHED; PG8_LDA(At, 1, 0); PG8_STAGE(PG8_SA(0, 1), a2 + hstep, voffA);
            PG8_WAIT_V(8); PG8_WAIT_L(0); PG8_BAR; PG8_MMA(0, 0, At, B0); PG8_MMA(0, 1, At, B1); PG8_BAR; PG8_SCHED;
            PG8_LDA(At, 1, 1); PG8_STAGE(PG8_SB(1, 0), b3, voffB); PG8_STAGE(PG8_SB(1, 1), b3 + hstep, voffB); PG8_STAGE(PG8_SA(1, 0), a3, voffA);
            PG8_WAIT_V(8); PG8_WAIT_L(0); PG8_BAR; PG8_MMA(1, 0, At, B0); PG8_MMA(1, 1, At, B1); PG8_BAR; PG8_SCHED;
            } else {
            PG8_LDB(B0, 0, 0); PG8_SCHED; PG8_LDA(At, 0, 0); PG8_STAGE(PG8_SA(1, 1), a1 + hstep, voffA);
            PG8_WAIT_L(8); PG8_BAR; PG8_WAIT_L(0); PG8_MMA(0, 0, At, B0); PG8_BAR; PG8_SCHED;
            PG8_LDB(B1, 0, 1); PG8_STAGE(PG8_SB(0, 0), b2, voffB);
            PG8_BAR; PG8_WAIT_L(0); PG8_MMA(0, 1, At, B1); PG8_BAR;
            PG8_LDA(At, 0, 1); PG8_STAGE(PG8_SA(0, 0), a2, voffA);
            PG8_BAR; PG8_WAIT_L(0); PG8_MMA(1, 0, At, B0); PG8_BAR; PG8_SCHED;
            PG8_STAGE(PG8_SB(0, 1), b2 + hstep, voffB);
            PG8_WAIT_V(6); PG8_BAR; PG8_MMA(1, 1, At, B1); PG8_BAR;
            PG8_LDB(B0, 1, 0); PG8_SCHED; PG8_LDA(At, 1, 0); PG8_STAGE(PG8_SA(0, 1), a2 + hstep, voffA);
            PG8_WAIT_L(8); PG8_BAR; PG8_WAIT_L(0); PG8_MMA(0, 0, At, B0); PG8_BAR; PG8_SCHED;
            PG8_LDB(B1, 1, 1); PG8_STAGE(PG8_SB(1, 0), b3, voffB);
            PG8_BAR; PG8_WAIT_L(0); PG8_MMA(0, 1, At, B1); PG8_BAR;
            PG8_LDA(At, 1, 1); PG8_STAGE(PG8_SA(1, 0), a3, voffA);
            PG8_BAR; PG8_WAIT_L(0); PG8_MMA(1, 0, At, B0); PG8_BAR; PG8_SCHED;
            PG8_STAGE(PG8_SB(1, 1), b3 + hstep, voffB);
            PG8_WAIT_V(6); PG8_BAR; PG8_MMA(1, 1, At, B1); PG8_BAR;
            }
        }
        if constexpr (ALIGN_EPI) { if (wr == 0) PG8_BAR; }
        if constexpr (!Epi::AFTER_DRAIN) { E(acc, cur, wr, wc, fr, fq); S.done(cur); }
        if (!has_next) break;
#pragma unroll
        for (int a = 0; a < 2; ++a)
#pragma unroll
            for (int b = 0; b < 2; ++b)
#pragma unroll
                for (int m = 0; m < 4; ++m)
#pragma unroll
                    for (int n = 0; n < 2; ++n) acc[a][b][m][n] = (f32x4){0.f, 0.f, 0.f, 0.f};
        cur = nxt; cA = nA; cB = nB; ++ui;
        if constexpr (ALIGN_EPI) { if (wr == 1) PG8_BAR; }
    }
    PG8_WAIT_V(0);
    if constexpr (!ALIGN_EPI) { if (wr == 0) PG8_BAR; }
    PG8_BAR;
    if constexpr (Epi::AFTER_DRAIN) { E.fused(acc, cur, wr, wc, fr, fq, lds, wid, lane); S.done(cur); }
#undef PG8_SA
#undef PG8_SB
#undef PG8_STAGE
#undef PG8_LDA
#undef PG8_LDB
#undef PG8_MMA
#undef PG8_WAIT_V
#undef PG8_WAIT_L
#undef PG8_BAR
#undef PG8_SCHED
}
}


template <class Inner> struct Pg8Epi {
    static constexpr bool PERM = true, AFTER_DRAIN = false;
    Inner in;
    __device__ __forceinline__ void operator()(const f32x4 (&acc)[2][2][4][2], const pg8::Unit& u, int wr, int wc, int fr, int fq) const {
#pragma unroll
        for (int ai = 0; ai < 2; ++ai)
#pragma unroll
            for (int m = 0; m < 4; ++m) {
                const int r = u.pm * 256 + ai * 128 + wr * 64 + m * 16 + fr;
                const int c0 = u.pn * 256 + wc * 32 + 8 * fq;
                const int cols[4] = {c0, c0 + 4, c0 + 128, c0 + 132};
                const f32x4 vv[4] = {acc[ai][0][m][0], acc[ai][0][m][1], acc[ai][1][m][0], acc[ai][1][m][1]};
                in.template row<4, true>(r, cols, vv, fq, 1.f);
            }
    }
};
struct EpiResB {
    const float* srcf; bf16_t* xb; float* dstf; float* ss;
    template <int NQ, bool PAIRED> __device__ __forceinline__ void row(int r, const int (&c)[NQ], const f32x4 (&v)[NQ], int fq, float rscale) const {
        static_assert(PAIRED && NQ % 2 == 0, "EpiResB: paired quads only");
        float a2 = 0.f;
#pragma unroll
        for (int q = 0; q < NQ; q += 2) {
            f32x4 s0, s1;
            if (srcf) { s0 = *(const f32x4*)(srcf + (size_t)r * D + c[q]); s1 = *(const f32x4*)(srcf + (size_t)r * D + c[q] + 4); }
            else { const u32x4 xr = *(const u32x4*)(xb + (size_t)r * D + c[q]); s0 = (f32x4){bflo(xr.x), bfhi(xr.x), bflo(xr.y), bfhi(xr.y)}; s1 = (f32x4){bflo(xr.z), bfhi(xr.z), bflo(xr.w), bfhi(xr.w)}; }
            const f32x4 o0 = s0 + v[q], o1 = s1 + v[q + 1];
            if (dstf) { *(f32x4*)(dstf + (size_t)r * D + c[q]) = o0; *(f32x4*)(dstf + (size_t)r * D + c[q] + 4) = o1; }
            else {
                u32x4 w; w.x = cvt_pk_bf16(o0.x, o0.y); w.y = cvt_pk_bf16(o0.z, o0.w); w.z = cvt_pk_bf16(o1.x, o1.y); w.w = cvt_pk_bf16(o1.z, o1.w);
                *(u32x4*)(xb + (size_t)r * D + c[q]) = w;
                a2 += (o0.x * o0.x + o0.y * o0.y) + (o0.z * o0.z + o0.w * o0.w) + (o1.x * o1.x + o1.y * o1.y) + (o1.z * o1.z + o1.w * o1.w);
            }
        }
        if (ss) { a2 += __shfl_xor(a2, 16); a2 += __shfl_xor(a2, 32); if (fq == 0) atomicAdd(ss + r, a2); }
    }
};
struct EpiAddF32 {
    float* dst;
    template <int NQ, bool PAIRED> __device__ __forceinline__ void row(int r, const int (&c)[NQ], const f32x4 (&v)[NQ], int fq, float rscale) const {
#pragma unroll
        for (int q = 0; q < NQ; ++q) { f32x4* d = (f32x4*)(dst + (size_t)r * D + c[q]); *d = *d + v[q]; }
    }
};
struct EpiAtomic {
    float* dst;
    template <int NQ, bool PAIRED> __device__ __forceinline__ void row(int r, const int (&c)[NQ], const f32x4 (&v)[NQ], int fq, float rscale) const {
#pragma unroll
        for (int q = 0; q < NQ; ++q) { float* d = dst + (size_t)r * D + c[q]; atomicAdd(d, v[q].x); atomicAdd(d + 1, v[q].y); atomicAdd(d + 2, v[q].z); atomicAdd(d + 3, v[q].w); }
    }
};

template <int AF32, class Epi>
__device__ __forceinline__ void sgemm64(unsigned char* lds, const void* Av, int lda, const bf16_t* __restrict__ Bt, int row0, int nrows, int N, int K, int ksplit,
                                        const Epi& E, int bid, int G) {
    const int tid = threadIdx.x, lane = tid & 63, wid = tid >> 6, wr = wid >> 2, wc = wid & 3, fr = lane & 15, fq = lane >> 4;
    const int nN = N / 128, nT = (nrows / 64) * nN, nU = nT * ksplit, Ksl = K / ksplit, nk = Ksl / 128;
    constexpr int LS = 136;
    bf16_t* As = (bf16_t*)lds;
    bf16_t* Bs = As + 2 * 64 * LS;
    float* rs = (float*)(Bs + 2 * 128 * LS);
    const int arow = tid >> 3, ak = (tid & 7) * 8;
    for (int u = bid; u < nU; u += G) {
        const int ks = u / nT, t = u % nT, pm = t / nN, pn = t % nN, k0 = ks * Ksl;
        const bf16_t* Ab = (const bf16_t*)Av + (size_t)(row0 + pm * 64 + arow) * lda + k0 + ak;
        const float* Af = (const float*)Av + (size_t)(row0 + pm * 64 + arow) * lda + k0 + ak;
        const bf16_t* Bg = Bt + (size_t)(pn * 128 + arow) * K + k0 + ak;
        f32x4 acc[2][2];
#pragma unroll
        for (int m = 0; m < 2; ++m)
#pragma unroll
            for (int n = 0; n < 2; ++n) acc[m][n] = (f32x4){0.f, 0.f, 0.f, 0.f};
        float ssq = 0.f;
        u32x4 ra[2], rb[2][2];
        auto loadAB = [&](int kt) {
#pragma unroll
            for (int h = 0; h < 2; ++h) {
                if (AF32) { const f32x4 a = *(const f32x4*)(Af + kt * 128 + 64 * h), b = *(const f32x4*)(Af + kt * 128 + 64 * h + 4);
                    ssq += (a.x * a.x + a.y * a.y) + (a.z * a.z + a.w * a.w) + (b.x * b.x + b.y * b.y) + (b.z * b.z + b.w * b.w);
                    ra[h].x = cvt_pk_bf16(a.x, a.y); ra[h].y = cvt_pk_bf16(a.z, a.w); ra[h].z = cvt_pk_bf16(b.x, b.y); ra[h].w = cvt_pk_bf16(b.z, b.w); }
                else ra[h] = *(const u32x4*)(Ab + kt * 128 + 64 * h);
#pragma unroll
                for (int i = 0; i < 2; ++i) rb[i][h] = *(const u32x4*)(Bg + (size_t)(64 * i) * K + kt * 128 + 64 * h);
            }
        };
        auto storeAB = [&](int buf) {
#pragma unroll
            for (int h = 0; h < 2; ++h) {
                *(u32x4*)(As + buf * 64 * LS + arow * LS + ak + 64 * h) = ra[h];
#pragma unroll
                for (int i = 0; i < 2; ++i) *(u32x4*)(Bs + buf * 128 * LS + (arow + 64 * i) * LS + ak + 64 * h) = rb[i][h];
            }
        };
        loadAB(0);
        storeAB(0);
        __syncthreads();
        for (int kt = 0; kt < nk; ++kt) {
            const int buf = kt & 1;
            if (kt + 1 < nk) loadAB(kt + 1);
            const bf16_t* as = As + buf * 64 * LS; const bf16_t* bs = Bs + buf * 128 * LS;
#pragma unroll
            for (int kk = 0; kk < 4; ++kk) {
                bf16x8 af[2], bfr[2];
#pragma unroll
                for (int m = 0; m < 2; ++m) af[m] = *(const bf16x8*)(as + (32 * wr + 16 * m + fr) * LS + 32 * kk + 8 * fq);
#pragma unroll
                for (int n = 0; n < 2; ++n) bfr[n] = *(const bf16x8*)(bs + (32 * wc + 16 * n + fr) * LS + 32 * kk + 8 * fq);
#pragma unroll
                for (int m = 0; m < 2; ++m)
#pragma unroll
                    for (int n = 0; n < 2; ++n) acc[m][n] = MFMA32(bfr[n], af[m], acc[m][n]);
            }
            if (kt + 1 < nk) storeAB(buf ^ 1);
            __syncthreads();
        }
        if (AF32) {
            ssq += __shfl_xor(ssq, 1); ssq += __shfl_xor(ssq, 2); ssq += __shfl_xor(ssq, 4);
            if ((tid & 7) == 0) rs[arow] = rsqrtf(ssq * (1.f / 1024.f) + EPS);
            __syncthreads();
        }
#pragma unroll
        for (int m = 0; m < 2; ++m) {
            const int lr = 32 * wr + 16 * m + fr, r = row0 + pm * 64 + lr;
            const int cols[2] = {pn * 128 + 32 * wc + 4 * fq, pn * 128 + 32 * wc + 16 + 4 * fq};
            const f32x4 vv[2] = {acc[m][0], acc[m][1]};
            E.template row<2, false>(r, cols, vv, fq, AF32 ? rs[lr] : 1.f);
        }
    }
}

template <class Epi>
__device__ __forceinline__ void sgemm_phase(unsigned char* lds, const bf16_t* __restrict__ A, const bf16_t* __restrict__ Bt, int row0, int nrows, int N, int K,
                                            const Epi& E, int bid, int G) {
    const int tid = threadIdx.x, lane = tid & 63, wid = tid >> 6, wr = wid >> 2, wc = wid & 3, fr = lane & 15, fq = lane >> 4;
    const int nN = N / 128, nU = (nrows / 128) * nN, nk = K / 64;
    bf16_t* As = (bf16_t*)lds;
    bf16_t* Bs = As + 2 * 128 * 72;
    const int ldrow = tid >> 3, ldk = (tid & 7) * 8;
    for (int u = bid; u < nU; u += G) {
        const int pm = u / nN, pn = u % nN;
        const bf16_t* Ag = A + (size_t)(row0 + pm * 128 + ldrow) * K + ldk;
        const bf16_t* Bg = Bt + (size_t)(pn * 128 + ldrow) * K + ldk;
        f32x4 acc[4][2];
#pragma unroll
        for (int m = 0; m < 4; ++m)
#pragma unroll
            for (int n = 0; n < 2; ++n) acc[m][n] = (f32x4){0.f, 0.f, 0.f, 0.f};
        u32x4 ra[2], rb[2];
#pragma unroll
        for (int i = 0; i < 2; ++i) { ra[i] = *(const u32x4*)(Ag + (size_t)(64 * i) * K); rb[i] = *(const u32x4*)(Bg + (size_t)(64 * i) * K); }
#pragma unroll
        for (int i = 0; i < 2; ++i) { *(u32x4*)(As + (ldrow + 64 * i) * 72 + ldk) = ra[i]; *(u32x4*)(Bs + (ldrow + 64 * i) * 72 + ldk) = rb[i]; }
        __syncthreads();
        for (int kt = 0; kt < nk; ++kt) {
            const int buf = kt & 1;
            if (kt + 1 < nk) {
#pragma unroll
                for (int i = 0; i < 2; ++i) { ra[i] = *(const u32x4*)(Ag + (size_t)(64 * i) * K + (kt + 1) * 64); rb[i] = *(const u32x4*)(Bg + (size_t)(64 * i) * K + (kt + 1) * 64); }
            }
            const bf16_t* as = As + buf * 128 * 72; const bf16_t* bs = Bs + buf * 128 * 72;
#pragma unroll
            for (int kk = 0; kk < 2; ++kk) {
                bf16x8 af[4], bfr[2];
#pragma unroll
                for (int m = 0; m < 4; ++m) af[m] = *(const bf16x8*)(as + (64 * wr + 16 * m + fr) * 72 + 32 * kk + 8 * fq);
#pragma unroll
                for (int n = 0; n < 2; ++n) bfr[n] = *(const bf16x8*)(bs + (32 * wc + 16 * n + fr) * 72 + 32 * kk + 8 * fq);
#pragma unroll
                for (int m = 0; m < 4; ++m)
#pragma unroll
                    for (int n = 0; n < 2; ++n) acc[m][n] = MFMA32(bfr[n], af[m], acc[m][n]);
            }
            if (kt + 1 < nk) {
                bf16_t* an = As + (buf ^ 1) * 128 * 72; bf16_t* bn = Bs + (buf ^ 1) * 128 * 72;
#pragma unroll
                for (int i = 0; i < 2; ++i) { *(u32x4*)(an + (ldrow + 64 * i) * 72 + ldk) = ra[i]; *(u32x4*)(bn + (ldrow + 64 * i) * 72 + ldk) = rb[i]; }
            }
            __syncthreads();
        }
#pragma unroll
        for (int m = 0; m < 4; ++m) {
            const int r = row0 + pm * 128 + 64 * wr + 16 * m + fr;
            const int cols[2] = {pn * 128 + 32 * wc + 4 * fq, pn * 128 + 32 * wc + 16 + 4 * fq};
            const f32x4 vv[2] = {acc[m][0], acc[m][1]};
            E.template row<2, false>(r, cols, vv, fq, 1.f);
        }
    }
}

__device__ __forceinline__ void mlstm_local_unit(const Params& p, unsigned char* lds, int u) {
    const int tid = threadIdx.x, lane = tid & 63, wid = tid >> 6, fr = lane & 15, fq = lane >> 4;
    const int bh = u >> 6, c = u & 63, b = bh >> 2, h = bh & 3, base = b * 4096 + c * 64;
    unsigned char* ws = p.ws;
    const bf16_t* P = (const bf16_t*)(ws + WS_P); const float* gates = (const float*)(ws + WS_GATES);
    bf16_t* GS = (bf16_t*)p.out;
    bf16_t* kT = (bf16_t*)lds;
    bf16_t* vT = kT + 128 * 72;
    float* wk = (float*)(vT + 256 * 72);
    if (wid == 0) {
        const float lf = gates[(size_t)(base + lane) * 8 + 4 + h], li = gates[(size_t)(base + lane) * 8 + h];
        const float bc = scan_sum(lf, lane);
        const float B = __shfl(bc, 63);
        const float val = B - bc + li;
        const float ml = wave_max(val);
        wk[lane] = __expf(val - ml);
        if (lane == 0) { ((float*)(ws + WS_CHB))[u] = B; ((float*)(ws + WS_CHM))[u] = ml; }
    }
    __syncthreads();
    {
        const bf16_t* Pk = P + (size_t)(base + lane) * NIN + 512 + h * 128;
#pragma unroll
        for (int i = 0; i < 2; ++i) {
            const int dch = wid * 2 + i; const u32x4 r = *(const u32x4*)(Pk + dch * 8);
            bf16_t* dst = kT + (dch * 8) * 72 + lane;
            dst[0 * 72] = (bf16_t)(r.x & 0xffff); dst[1 * 72] = (bf16_t)(r.x >> 16); dst[2 * 72] = (bf16_t)(r.y & 0xffff); dst[3 * 72] = (bf16_t)(r.y >> 16);
            dst[4 * 72] = (bf16_t)(r.z & 0xffff); dst[5 * 72] = (bf16_t)(r.z >> 16); dst[6 * 72] = (bf16_t)(r.w & 0xffff); dst[7 * 72] = (bf16_t)(r.w >> 16);
        }
        const bf16_t* Pv = P + (size_t)(base + lane) * NIN + 1024 + h * 256;
        const float w = wk[lane];
#pragma unroll
        for (int i = 0; i < 4; ++i) {
            const int vch = wid * 4 + i; const u32x4 r = *(const u32x4*)(Pv + vch * 8);
            bf16_t* dst = vT + (vch * 8) * 72 + lane;
            dst[0 * 72] = f2bf(bflo(r.x) * w); dst[1 * 72] = f2bf(bfhi(r.x) * w); dst[2 * 72] = f2bf(bflo(r.y) * w); dst[3 * 72] = f2bf(bfhi(r.y) * w);
            dst[4 * 72] = f2bf(bflo(r.z) * w); dst[5 * 72] = f2bf(bfhi(r.z) * w); dst[6 * 72] = f2bf(bflo(r.w) * w); dst[7 * 72] = f2bf(bfhi(r.w) * w);
        }
    }
    __syncthreads();
    {
        f32x4 acc[2][8];
#pragma unroll
        for (int a = 0; a < 2; ++a)
#pragma unroll
            for (int d = 0; d < 8; ++d) acc[a][d] = (f32x4){0.f, 0.f, 0.f, 0.f};
#pragma unroll
        for (int ks = 0; ks < 2; ++ks) {
            bf16x8 yf[2];
#pragma unroll
            for (int vt = 0; vt < 2; ++vt) yf[vt] = *(const bf16x8*)(vT + (32 * wid + 16 * vt + fr) * 72 + 32 * ks + 8 * fq);
#pragma unroll
            for (int dt = 0; dt < 8; ++dt) {
                const bf16x8 xf = *(const bf16x8*)(kT + (16 * dt + fr) * 72 + 32 * ks + 8 * fq);
#pragma unroll
                for (int vt = 0; vt < 2; ++vt) acc[vt][dt] = MFMA32(xf, yf[vt], acc[vt][dt]);
            }
        }
        bf16_t* G = GS + (size_t)u * 32768;
#pragma unroll
        for (int vt = 0; vt < 2; ++vt)
#pragma unroll
            for (int dt = 0; dt < 8; ++dt) {
                u32x2 w; w.x = cvt_pk_bf16(acc[vt][dt].x, acc[vt][dt].y); w.y = cvt_pk_bf16(acc[vt][dt].z, acc[vt][dt].w);
                *(u32x2*)(G + (32 * wid + 16 * vt + fr) * 128 + 16 * dt + 4 * fq) = w;
            }
    }
    if (tid < 128) {
        float s = 0.f;
#pragma unroll 8
        for (int ss = 0; ss < 64; ++ss) s += bf2f(kT[tid * 72 + ss]) * wk[ss];
        ((float*)(ws + WS_GN))[(size_t)u * 128 + tid] = s;
    }
    __syncthreads();
}

__device__ __forceinline__ void mlstm_sample_unit(const Params& p, unsigned char* lds, int u) {
    const int tid = threadIdx.x, lane = tid & 63, wid = tid >> 6;
    const int b = u >> 2, h = u & 3, base = TP + b * 4;
    unsigned char* ws = p.ws;
    const bf16_t* P = (const bf16_t*)(ws + WS_P); const float* gates = (const float*)(ws + WS_GATES);
    float* q = (float*)lds;
    float* k = q + 512;
    float* v = k + 512;
    float* n0 = v + 1024;
    float* sc = n0 + 128;
    float* red = sc + 64;
    const float* C0 = p.st_C + (size_t)u * 32768;
    float* Cout = p.out + O_SC + (size_t)u * 32768;
    {
        const int t = tid >> 7, d = tid & 127;
        q[tid] = bf2f(P[(size_t)(base + t) * NIN + h * 128 + d]);
        k[tid] = bf2f(P[(size_t)(base + t) * NIN + 512 + h * 128 + d]);
        const int t2 = tid >> 8, vv = tid & 255;
        v[tid] = bf2f(P[(size_t)(base + t2) * NIN + 1024 + h * 256 + vv]);
        v[512 + tid] = bf2f(P[(size_t)(base + 2 + t2) * NIN + 1024 + h * 256 + vv]);
        if (tid < 128) n0[tid] = p.st_n[(size_t)u * 128 + tid];
    }
    if (tid == 0) {
        float li[4], bc[4]; float run = 0.f;
#pragma unroll
        for (int t = 0; t < 4; ++t) { li[t] = gates[(size_t)(base + t) * 8 + h]; run += gates[(size_t)(base + t) * 8 + 4 + h]; bc[t] = run; }
        const float m0 = p.st_m[u]; float mt[4];
#pragma unroll
        for (int t = 0; t < 4; ++t) {
            const float inter = bc[t] + m0; float mx = inter;
#pragma unroll
            for (int s = 0; s < 4; ++s) if (s <= t) mx = fmaxf(mx, bc[t] - bc[s] + li[s]);
            mt[t] = mx; sc[16 + t] = __expf(inter - mx); sc[28 + t] = __expf(-mx);
#pragma unroll
            for (int s = 0; s < 4; ++s) sc[t * 4 + s] = (s <= t) ? __expf(bc[t] - bc[s] + li[s] - mx) : 0.f;
        }
        const float mn = mt[3];
        sc[24] = __expf(bc[3] + m0 - mn);
#pragma unroll
        for (int s = 0; s < 4; ++s) sc[20 + s] = __expf(bc[3] - bc[s] + li[s] - mn);
        p.out[O_SM + u] = mn;
    }
    __syncthreads();
#pragma unroll
    for (int i = 0; i < 2; ++i) {
        const int pr = wid * 2 + i, t = pr >> 2, s = pr & 3;
        float a = q[t * 128 + lane] * k[s * 128 + lane] + q[t * 128 + 64 + lane] * k[s * 128 + 64 + lane];
        a = wave_sum(a);
        if (lane == 0) sc[32 + pr] = a * sc[pr];
    }
    if (wid < 4) { float a = q[wid * 128 + lane] * n0[lane] + q[wid * 128 + 64 + lane] * n0[64 + lane]; a = wave_sum(a); if (lane == 0) sc[48 + wid] = a; }
    if (tid < 8) sc[52 + tid] = 0.f;
    {
        const int vq = lane, dg = wid;
        f32x4 qc[4];
#pragma unroll
        for (int t = 0; t < 4; ++t) qc[t] = (f32x4){0.f, 0.f, 0.f, 0.f};
        const float decay = sc[24];
        f32x4 vs[4];
#pragma unroll
        for (int s = 0; s < 4; ++s) vs[s] = *(const f32x4*)(v + s * 256 + 4 * vq) * sc[20 + s];
#pragma unroll 4
        for (int dd = 0; dd < 16; ++dd) {
            const int d = dg * 16 + dd;
            const f32x4 c0 = *(const f32x4*)(C0 + (size_t)d * 256 + 4 * vq);
            f32x4 cn = c0 * decay;
#pragma unroll
            for (int s = 0; s < 4; ++s) cn += vs[s] * k[s * 128 + d];
            *(f32x4*)(Cout + (size_t)d * 256 + 4 * vq) = cn;
#pragma unroll
            for (int t = 0; t < 4; ++t) qc[t] += c0 * q[t * 128 + d];
        }
#pragma unroll
        for (int t = 0; t < 4; ++t) *(f32x4*)(red + (dg * 4 + t) * 256 + 4 * vq) = qc[t];
    }
    if (tid < 128) {
        float nn = sc[24] * n0[tid];
#pragma unroll
        for (int s = 0; s < 4; ++s) nn += sc[20 + s] * k[s * 128 + tid];
        p.out[O_SN + (size_t)u * 128 + tid] = nn;
    }
    __syncthreads();
    {
        const int t = tid >> 7, v0 = (tid & 127) * 2;
        float den = sc[16 + t] * sc[48 + t];
#pragma unroll
        for (int s = 0; s < 4; ++s) den += sc[32 + t * 4 + s];
        const float inv = 1.f / fmaxf(fabsf(den), sc[28 + t]);
        float hv[2]; float ssq = 0.f;
#pragma unroll
        for (int j = 0; j < 2; ++j) {
            float qC = 0.f;
#pragma unroll
            for (int g = 0; g < 8; ++g) qC += red[(g * 4 + t) * 256 + v0 + j];
            float num = sc[16 + t] * qC;
#pragma unroll
            for (int s = 0; s < 4; ++s) num += sc[32 + t * 4 + s] * v[s * 256 + v0 + j];
            hv[j] = num * inv; ssq += hv[j] * hv[j];
        }
        ssq = wave_sum(ssq);
        if (lane == 0) sc[52 + wid] = ssq;
        __syncthreads();
        const float tot = sc[52 + 2 * t] + sc[52 + 2 * t + 1];
        const float rstd = rsqrtf(tot * (1.f / 256.f) + EPS);
        const unsigned ob = *(const unsigned*)(P + (size_t)(base + t) * NIN + 2048 + h * 256 + v0);
        const float o0 = sigmoidf_(bflo(ob)), o1 = sigmoidf_(bfhi(ob));
        const float g0 = p.ml_head_g[h * 256 + v0], g1 = p.ml_head_g[h * 256 + v0 + 1];
        bf16_t* HG = (bf16_t*)(ws + WS_HG);
        *(unsigned*)(HG + (size_t)(base + t) * D + h * 256 + v0) = cvt_pk_bf16(hv[0] * rstd * g0 * o0, hv[1] * rstd * g1 * o1);
    }
    __syncthreads();
}

__device__ __forceinline__ void mlstm_scan(const Params& p, unsigned char* lds, int bid, int G) {
    unsigned char* ws = p.ws;
    bf16_t* GS = (bf16_t*)p.out;
    const float* CHB = (const float*)(ws + WS_CHB); const float* CHM = (const float*)(ws + WS_CHM);
    float* MPREV = (float*)(ws + WS_MPREV); float* GN = (float*)(ws + WS_GN);
    const int tid = threadIdx.x;
    float* decs = (float*)lds;
    float* scls = decs + 64;
    float* tile = scls + 64;
    for (int blk = bid; blk < 256; blk += G) {
        const int bh = blk >> 4;
        if (tid < 64) {
            const float B = CHB[bh * 64 + tid], ml = CHM[bh * 64 + tid];
            float a = B, b2 = ml;
#pragma unroll
            for (int o = 1; o < 64; o <<= 1) { const float ya = __shfl_up(a, o), yb = __shfl_up(b2, o); if (tid >= o) { b2 = fmaxf(yb + a, b2); a = ya + a; } }
            const float m = fmaxf(a, b2);
            float mp = __shfl_up(m, 1); if (tid == 0) mp = 0.f;
            decs[tid] = __expf(B + mp - m); scls[tid] = __expf(ml - m);
            if ((blk & 15) == 0) { MPREV[bh * 64 + tid] = mp; if (tid == 63) p.out[O_PM + bh] = m; }
        }
        float gnv[64]; float* gp = GN + (size_t)(bh * 64) * 128 + (blk & 15) * 8 + (tid & 7);
        if (tid < 8) {
#pragma unroll
            for (int c = 0; c < 64; ++c) gnv[c] = gp[(size_t)c * 128];
        }
        __syncthreads();
        const int e4 = blk * NTHREADS + tid;
        const int off = (e4 & 8191) * 4;
        bf16_t* ptr = GS + (size_t)bh * 64 * 32768 + off;
        float c0 = 0.f, c1 = 0.f, c2 = 0.f, c3 = 0.f;
#pragma unroll 1
        for (int cb = 0; cb < 64; cb += 16) {
            u32x2 g[16];
#pragma unroll
            for (int j = 0; j < 16; ++j) g[j] = *(const u32x2*)(ptr + (size_t)(cb + j) * 32768);
#pragma unroll
            for (int j = 0; j < 16; ++j) {
                const float dec = decs[cb + j], s = scls[cb + j];
                u32x2 w; w.x = cvt_pk_bf16(c0, c1); w.y = cvt_pk_bf16(c2, c3);
                *(u32x2*)(ptr + (size_t)(cb + j) * 32768) = w;
                c0 = dec * c0 + s * bflo(g[j].x); c1 = dec * c1 + s * bfhi(g[j].x); c2 = dec * c2 + s * bflo(g[j].y); c3 = dec * c3 + s * bfhi(g[j].y);
            }
        }
        {
            const int vl = (off >> 7) & 15, d = off & 127;
            tile[(d + 0) * 20 + vl] = c0; tile[(d + 1) * 20 + vl] = c1; tile[(d + 2) * 20 + vl] = c2; tile[(d + 3) * 20 + vl] = c3;
            __syncthreads();
            const int dd = tid >> 2, vq = tid & 3, v0 = (blk & 15) * 16;
            const f32x4 o = (f32x4){tile[dd * 20 + 4 * vq], tile[dd * 20 + 4 * vq + 1], tile[dd * 20 + 4 * vq + 2], tile[dd * 20 + 4 * vq + 3]};
            *(f32x4*)(p.out + O_PC + (size_t)bh * 32768 + (size_t)dd * 256 + v0 + 4 * vq) = o;
        }
        if (tid < 8) {
            float n = 0.f;
#pragma unroll
            for (int c = 0; c < 64; ++c) { gp[(size_t)c * 128] = n; n = decs[c] * n + scls[c] * gnv[c]; }
            p.out[O_PN + bh * 128 + (blk & 15) * 8 + tid] = n;
        }
        __syncthreads();
    }
}

__device__ __forceinline__ void mlstm_out_unit(const Params& p, unsigned char* lds, int u) {
    const int tid = threadIdx.x, lane = tid & 63, wid = tid >> 6, fr = lane & 15, fq = lane >> 4;
    const int bh = u >> 6, c = u & 63, b = bh >> 2, h = bh & 3, base = b * 4096 + c * 64;
    unsigned char* ws = p.ws;
    const bf16_t* P = (const bf16_t*)(ws + WS_P); const float* gates = (const float*)(ws + WS_GATES);
    const bf16_t* CT = (const bf16_t*)p.out + (size_t)u * 32768;
    bf16_t* Qs = (bf16_t*)lds;
    bf16_t* Ks = Qs + 64 * 136;
    bf16_t* Ac = Ks + 64 * 136;
    bf16_t* VT = Ac + 64 * 200;
    float* sm = (float*)(VT + 256 * 72);
    float *bt = sm, *lmb = sm + 64, *mt = sm + 128, *at = sm + 192, *den = sm + 256, *hss = sm + 320, *npv = sm + 384;
    bf16x8 cf[2][4];
#pragma unroll
    for (int vt = 0; vt < 2; ++vt)
#pragma unroll
        for (int kd = 0; kd < 4; ++kd) cf[vt][kd] = *(const bf16x8*)(CT + (32 * wid + 16 * vt + fr) * 128 + 32 * kd + 8 * fq);
    if (wid == 0) {
        const float lf = gates[(size_t)(base + lane) * 8 + 4 + h], li = gates[(size_t)(base + lane) * 8 + h];
        const float bc = scan_sum(lf, lane);
        const float lm = li - bc;
        const float pm = scan_max(lm, lane);
        const float mprev = ((const float*)(ws + WS_MPREV))[u];
        const float inter = bc + mprev;
        const float m_t = fmaxf(inter, bc + pm);
        bt[lane] = bc; lmb[lane] = lm; mt[lane] = m_t; at[lane] = __expf(inter - m_t); den[lane] = 0.f; hss[lane] = 0.f;
    }
    if (wid == 1) { const float* NP = (const float*)(ws + WS_GN) + (size_t)u * 128; npv[lane] = NP[lane]; npv[64 + lane] = NP[64 + lane]; }
    __syncthreads();
#pragma unroll
    for (int i = 0; i < 2; ++i) {
        const int ci = tid + 512 * i, t = ci >> 4, dch = ci & 15;
        const u32x4 qv = *(const u32x4*)(P + (size_t)(base + t) * NIN + h * 128 + dch * 8);
        const u32x4 kv = *(const u32x4*)(P + (size_t)(base + t) * NIN + 512 + h * 128 + dch * 8);
        *(u32x4*)(Qs + t * 136 + dch * 8) = qv;
        *(u32x4*)(Ks + t * 136 + dch * 8) = kv;
        const float a = at[t];
        u32x4 sq; sq.x = cvt_pk_bf16(bflo(qv.x) * a, bfhi(qv.x) * a); sq.y = cvt_pk_bf16(bflo(qv.y) * a, bfhi(qv.y) * a);
        sq.z = cvt_pk_bf16(bflo(qv.z) * a, bfhi(qv.z) * a); sq.w = cvt_pk_bf16(bflo(qv.w) * a, bfhi(qv.w) * a);
        *(u32x4*)(Ac + t * 200 + 64 + dch * 8) = sq;
    }
    {
        const bf16_t* Pv = P + (size_t)(base + lane) * NIN + 1024 + h * 256;
#pragma unroll
        for (int i = 0; i < 4; ++i) {
            const int vch = wid * 4 + i; const u32x4 r = *(const u32x4*)(Pv + vch * 8);
            bf16_t* dst = VT + (vch * 8) * 72 + lane;
            dst[0 * 72] = (bf16_t)(r.x & 0xffff); dst[1 * 72] = (bf16_t)(r.x >> 16); dst[2 * 72] = (bf16_t)(r.y & 0xffff); dst[3 * 72] = (bf16_t)(r.y >> 16);
            dst[4 * 72] = (bf16_t)(r.z & 0xffff); dst[5 * 72] = (bf16_t)(r.z >> 16); dst[6 * 72] = (bf16_t)(r.w & 0xffff); dst[7 * 72] = (bf16_t)(r.w >> 16);
        }
    }
    __syncthreads();
    {
        const int tt = wid >> 1;
#pragma unroll
        for (int j = 0; j < 2; ++j) {
            const int st = 2 * (wid & 1) + j;
            const int t = 16 * tt + fr, s0 = 16 * st + 4 * fq;
            u32x2 w; w.x = 0u; w.y = 0u;
            if (st <= tt) {
                f32x4 a = (f32x4){0.f, 0.f, 0.f, 0.f};
#pragma unroll
                for (int kd = 0; kd < 4; ++kd) {
                    const bf16x8 x = *(const bf16x8*)(Ks + (16 * st + fr) * 136 + 32 * kd + 8 * fq);
                    const bf16x8 y = *(const bf16x8*)(Qs + (16 * tt + fr) * 136 + 32 * kd + 8 * fq);
                    a = MFMA32(x, y, a);
                }
                const float e0 = bt[t] - mt[t];
                float vals[4];
#pragma unroll
                for (int i = 0; i < 4; ++i) { const int s = s0 + i; vals[i] = (s <= t) ? a[i] * __expf(e0 + lmb[s]) : 0.f; }
                float rs = (vals[0] + vals[1]) + (vals[2] + vals[3]);
                rs += __shfl_xor(rs, 16); rs += __shfl_xor(rs, 32);
                if (fq == 0) atomicAdd(&den[t], rs);
                w.x = cvt_pk_bf16(vals[0], vals[1]); w.y = cvt_pk_bf16(vals[2], vals[3]);
            }
            *(u32x2*)(Ac + t * 200 + s0) = w;
        }
#pragma unroll
        for (int i = 0; i < 8; ++i) {
            const int t = 8 * wid + i;
            float a = bf2f(Qs[t * 136 + lane]) * npv[lane] + bf2f(Qs[t * 136 + 64 + lane]) * npv[64 + lane];
            a = wave_sum(a);
            if (lane == 0) atomicAdd(&den[t], at[t] * a);
        }
    }
    __syncthreads();
    f32x4 acc[4][2];
#pragma unroll
    for (int a = 0; a < 4; ++a)
#pragma unroll
        for (int d = 0; d < 2; ++d) acc[a][d] = (f32x4){0.f, 0.f, 0.f, 0.f};
#pragma unroll
    for (int kk = 0; kk < 6; ++kk) {
        bf16x8 x[2];
#pragma unroll
        for (int vt = 0; vt < 2; ++vt) x[vt] = (kk < 2) ? *(const bf16x8*)(VT + (32 * wid + 16 * vt + fr) * 72 + 32 * kk + 8 * fq) : cf[vt][kk >= 2 ? kk - 2 : 0];
#pragma unroll
        for (int tt = 0; tt < 4; ++tt) {
            const bf16x8 y = *(const bf16x8*)(Ac + (16 * tt + fr) * 200 + 32 * kk + 8 * fq);
#pragma unroll
            for (int vt = 0; vt < 2; ++vt) acc[tt][vt] = MFMA32(x[vt], y, acc[tt][vt]);
        }
    }
#pragma unroll
    for (int tt = 0; tt < 4; ++tt) {
        const int t = 16 * tt + fr;
        const float inv = 1.f / fmaxf(fabsf(den[t]), __expf(-mt[t]));
        float ssq = 0.f;
#pragma unroll
        for (int vt = 0; vt < 2; ++vt) { acc[tt][vt] = acc[tt][vt] * inv; const f32x4 a = acc[tt][vt]; ssq += (a.x * a.x + a.y * a.y) + (a.z * a.z + a.w * a.w); }
        ssq += __shfl_xor(ssq, 16); ssq += __shfl_xor(ssq, 32);
        if (fq == 0) atomicAdd(&hss[t], ssq);
    }
    __syncthreads();
    {
        bf16_t* HG = (bf16_t*)(ws + WS_HG);
#pragma unroll
        for (int tt = 0; tt < 4; ++tt) {
            const int t = 16 * tt + fr;
            const float rstd = rsqrtf(hss[t] * (1.f / 256.f) + EPS);
#pragma unroll
            for (int vt = 0; vt < 2; ++vt) {
                const int v0 = 32 * wid + 16 * vt + 4 * fq;
                const u32x2 ob = *(const u32x2*)(P + (size_t)(base + t) * NIN + 2048 + h * 256 + v0);
                const f32x4 g = *(const f32x4*)(p.ml_head_g + h * 256 + v0);
                const f32x4 a = acc[tt][vt];
                u32x2 w;
                w.x = cvt_pk_bf16(a.x * rstd * g.x * sigmoidf_(bflo(ob.x)), a.y * rstd * g.y * sigmoidf_(bfhi(ob.x)));
                w.y = cvt_pk_bf16(a.z * rstd * g.z * sigmoidf_(bflo(ob.y)), a.w * rstd * g.w * sigmoidf_(bfhi(ob.y)));
                *(u32x2*)(HG + (size_t)(base + t) * D + h * 256 + v0) = w;
            }
        }
    }
    __syncthreads();
}

__device__ __forceinline__ void norm_frag(const u32x4 r0, const u32x4 r1, const float* __restrict__ g, float extra, int fq, bf16x8& o0, bf16x8& o1) {
    float f[16];
    f[0] = bflo(r0.x); f[1] = bfhi(r0.x); f[2] = bflo(r0.y); f[3] = bfhi(r0.y); f[4] = bflo(r0.z); f[5] = bfhi(r0.z); f[6] = bflo(r0.w); f[7] = bfhi(r0.w);
    f[8] = bflo(r1.x); f[9] = bfhi(r1.x); f[10] = bflo(r1.y); f[11] = bfhi(r1.y); f[12] = bflo(r1.z); f[13] = bfhi(r1.z); f[14] = bflo(r1.w); f[15] = bfhi(r1.w);
    float s = 0.f;
#pragma unroll
    for (int i = 0; i < 16; ++i) s += f[i] * f[i];
    s += __shfl_xor(s, 16); s += __shfl_xor(s, 32);
    const float rs = rsqrtf(s * (1.f / 64.f) + EPS) * extra;
    const f32x4 ga = *(const f32x4*)(g + 8 * fq), gb = *(const f32x4*)(g + 8 * fq + 4), gc = *(const f32x4*)(g + 32 + 8 * fq), gd = *(const f32x4*)(g + 32 + 8 * fq + 4);
    u32x4 a, b2;
    a.x = cvt_pk_bf16(f[0] * rs * ga.x, f[1] * rs * ga.y); a.y = cvt_pk_bf16(f[2] * rs * ga.z, f[3] * rs * ga.w);
    a.z = cvt_pk_bf16(f[4] * rs * gb.x, f[5] * rs * gb.y); a.w = cvt_pk_bf16(f[6] * rs * gb.z, f[7] * rs * gb.w);
    b2.x = cvt_pk_bf16(f[8] * rs * gc.x, f[9] * rs * gc.y); b2.y = cvt_pk_bf16(f[10] * rs * gc.z, f[11] * rs * gc.w);
    b2.z = cvt_pk_bf16(f[12] * rs * gd.x, f[13] * rs * gd.y); b2.w = cvt_pk_bf16(f[14] * rs * gd.z, f[15] * rs * gd.w);
    o0 = __builtin_bit_cast(bf16x8, a); o1 = __builtin_bit_cast(bf16x8, b2);
}

__device__ __forceinline__ void attn_prompt_unit(const Params& p, unsigned char* lds, int u) {
    const int tid = threadIdx.x, lane = tid & 63, wid = tid >> 6, fr = lane & 15, fq = lane >> 4;
    const int qb = u & 31, kvh = (u >> 5) & 3, b = u >> 7;
    unsigned char* ws = p.ws;
    const bf16_t* KVQ = (const bf16_t*)(ws + WS_KVQ);
    bf16_t* AO = (bf16_t*)(ws + WS_ATT);
    bf16_t* Ks = (bf16_t*)lds;
    bf16_t* VT = Ks + 256 * 72;
    const int pos0 = qb * 128 - 128;
    u32x4 qr[4][2];
    {
        const int g_ = wid >> 1, half_ = wid & 1, head_ = kvh * 4 + g_;
#pragma unroll
        for (int m = 0; m < 4; ++m) {
            const bf16_t* qp = KVQ + ((size_t)b * 4096 + qb * 128 + 64 * half_ + 16 * m + fr) * NKVQ + 512 + head_ * 64;
            qr[m][0] = *(const u32x4*)(qp + 8 * fq); qr[m][1] = *(const u32x4*)(qp + 32 + 8 * fq);
        }
    }
#pragma unroll
    for (int i = 0; i < 4; ++i) {
        const int ci = tid + 512 * i, j = ci >> 3, ch = ci & 7, pos = pos0 + j;
        u32x4 r = (u32x4){0u, 0u, 0u, 0u};
        if (pos >= 0) r = *(const u32x4*)(KVQ + (size_t)(b * 4096 + pos) * NKVQ + kvh * 64 + ch * 8);
        float f[8] = {bflo(r.x), bfhi(r.x), bflo(r.y), bfhi(r.y), bflo(r.z), bfhi(r.z), bflo(r.w), bfhi(r.w)};
        float s = 0.f;
#pragma unroll
        for (int e = 0; e < 8; ++e) s += f[e] * f[e];
        s += __shfl_xor(s, 1); s += __shfl_xor(s, 2); s += __shfl_xor(s, 4);
        const float rs = rsqrtf(s * (1.f / 64.f) + EPS);
        const f32x4 g0 = *(const f32x4*)(p.k_norm_g + ch * 8), g1 = *(const f32x4*)(p.k_norm_g + ch * 8 + 4);
        f[0] *= rs * g0.x; f[1] *= rs * g0.y; f[2] *= rs * g0.z; f[3] *= rs * g0.w; f[4] *= rs * g1.x; f[5] *= rs * g1.y; f[6] *= rs * g1.z; f[7] *= rs * g1.w;
        u32x4 w; w.x = cvt_pk_bf16(f[0], f[1]); w.y = cvt_pk_bf16(f[2], f[3]); w.z = cvt_pk_bf16(f[4], f[5]); w.w = cvt_pk_bf16(f[6], f[7]);
        *(u32x4*)(Ks + j * 72 + ch * 8) = w;
        if (qb == 31 && j >= 128) {
            float* o = p.out + O_PWK + ((size_t)(b * 128 + (j - 128)) * 4 + kvh) * 64 + ch * 8;
            *(f32x4*)o = (f32x4){f[0], f[1], f[2], f[3]}; *(f32x4*)(o + 4) = (f32x4){f[4], f[5], f[6], f[7]};
        }
    }
#pragma unroll
    for (int i = 0; i < 4; ++i) {
        const int ci = tid + 512 * i, j = ci & 255, ch = ci >> 8, pos = pos0 + j;
        u32x4 r = (u32x4){0u, 0u, 0u, 0u};
        if (pos >= 0) r = *(const u32x4*)(KVQ + (size_t)(b * 4096 + pos) * NKVQ + 256 + kvh * 64 + ch * 8);
        bf16_t* dst = VT + (ch * 8) * 264 + j;
        dst[0 * 264] = (bf16_t)(r.x & 0xffff); dst[1 * 264] = (bf16_t)(r.x >> 16); dst[2 * 264] = (bf16_t)(r.y & 0xffff); dst[3 * 264] = (bf16_t)(r.y >> 16);
        dst[4 * 264] = (bf16_t)(r.z & 0xffff); dst[5 * 264] = (bf16_t)(r.z >> 16); dst[6 * 264] = (bf16_t)(r.w & 0xffff); dst[7 * 264] = (bf16_t)(r.w >> 16);
        if (qb == 31 && j >= 128) {
            float* o = p.out + O_PWV + ((size_t)(b * 128 + (j - 128)) * 4 + kvh) * 64 + ch * 8;
            *(f32x4*)o = (f32x4){bflo(r.x), bfhi(r.x), bflo(r.y), bfhi(r.y)}; *(f32x4*)(o + 4) = (f32x4){bflo(r.z), bfhi(r.z), bflo(r.w), bfhi(r.w)};
        }
    }
    __syncthreads();
    const int g = wid >> 1, half = wid & 1, head = kvh * 4 + g;
    const float sink = p.att_sinks[head];
    const float* qg = p.q_norm_g;
#pragma unroll
    for (int m = 0; m < 4; ++m) {
        const int j0 = 64 * half + 16 * m;
        const size_t R = (size_t)b * 4096 + qb * 128 + j0 + fr;
        bf16x8 q0, q1; norm_frag(qr[m][0], qr[m][1], qg, 0.125f, fq, q0, q1);
        f32x4 s[9];
#pragma unroll
        for (int i = 0; i < 9; ++i) {
            s[i] = (f32x4){0.f, 0.f, 0.f, 0.f};
            const bf16_t* kr = Ks + (j0 + 16 * i + fr) * 72 + 8 * fq;
            s[i] = MFMA32(*(const bf16x8*)kr, q0, s[i]);
            s[i] = MFMA32(*(const bf16x8*)(kr + 32), q1, s[i]);
        }
        float mx = sink;
#pragma unroll
        for (int e = 0; e < 4; ++e) {
            s[0][e] = (4 * fq + e >= fr) ? s[0][e] : -INFINITY;
            s[8][e] = (4 * fq + e <= fr) ? s[8][e] : -INFINITY;
        }
        if (pos0 < 0) {
#pragma unroll
            for (int i = 0; i < 9; ++i)
#pragma unroll
                for (int e = 0; e < 4; ++e) s[i][e] = (pos0 + j0 + 16 * i + 4 * fq + e >= 0) ? s[i][e] : -INFINITY;
        }
#pragma unroll
        for (int i = 0; i < 9; ++i)
#pragma unroll
            for (int e = 0; e < 4; ++e) mx = fmaxf(mx, s[i][e]);
        mx = fmaxf(mx, __shfl_xor(mx, 16)); mx = fmaxf(mx, __shfl_xor(mx, 32));
        float l = 0.f;
        bf16x4 pf[9];
#pragma unroll
        for (int i = 0; i < 9; ++i) {
            float e0 = __expf(s[i][0] - mx), e1 = __expf(s[i][1] - mx), e2 = __expf(s[i][2] - mx), e3 = __expf(s[i][3] - mx);
            l += (e0 + e1) + (e2 + e3);
            u32x2 w; w.x = cvt_pk_bf16(e0, e1); w.y = cvt_pk_bf16(e2, e3);
            pf[i] = __builtin_bit_cast(bf16x4, w);
        }
        l += __shfl_xor(l, 16); l += __shfl_xor(l, 32);
        l += __expf(sink - mx);
        const float inv = 1.f / l;
        f32x4 o[4];
#pragma unroll
        for (int dt = 0; dt < 4; ++dt) {
            o[dt] = (f32x4){0.f, 0.f, 0.f, 0.f};
#pragma unroll
            for (int i = 0; i < 9; ++i) {
                const bf16x4 vf = *(const bf16x4*)(VT + (16 * dt + fr) * 264 + j0 + 16 * i + 4 * fq);
                o[dt] = MFMA16(vf, pf[i], o[dt]);
            }
        }
#pragma unroll
        for (int dt = 0; dt < 4; ++dt) {
            u32x2 w; w.x = cvt_pk_bf16(o[dt].x * inv, o[dt].y * inv); w.y = cvt_pk_bf16(o[dt].z * inv, o[dt].w * inv);
            *(u32x2*)(AO + R * D + head * 64 + 16 * dt + 4 * fq) = w;
        }
    }
    __syncthreads();
}

__device__ __forceinline__ void attn_sample_unit(const Params& p, int u, int lane) {
    const int fr = lane & 15, fq = lane >> 4;
    const int b = u >> 2, kvh = u & 3;
    unsigned char* ws = p.ws;
    const bf16_t* KVQ = (const bf16_t*)(ws + WS_KVQ);
    bf16_t* AO = (bf16_t*)(ws + WS_ATT);
    const float* ck = p.cache_k + (size_t)b * 128 * 256 + kvh * 64;
    const float* cv = p.cache_v + (size_t)b * 128 * 256 + kvh * 64;
    float* owk = p.out + O_SWK + (size_t)b * 128 * 256 + kvh * 64;
    float* owv = p.out + O_SWV + (size_t)b * 128 * 256 + kvh * 64;
    const size_t rbase = (size_t)TP + b * 4;
    for (int i = lane; i < 124 * 16; i += 64) {
        const int j = i >> 4, d4 = (i & 15) * 4;
        *(f32x4*)(owk + (size_t)j * 256 + d4) = *(const f32x4*)(ck + (size_t)(j + 4) * 256 + d4);
        *(f32x4*)(owv + (size_t)j * 256 + d4) = *(const f32x4*)(cv + (size_t)(j + 4) * 256 + d4);
    }
    {
        const int t = lane >> 4, d4 = (lane & 15) * 4;
        const u32x2 kr = *(const u32x2*)(KVQ + (rbase + t) * NKVQ + kvh * 64 + d4);
        const u32x2 vr = *(const u32x2*)(KVQ + (rbase + t) * NKVQ + 256 + kvh * 64 + d4);
        float f0 = bflo(kr.x), f1 = bfhi(kr.x), f2 = bflo(kr.y), f3 = bfhi(kr.y);
        float s = (f0 * f0 + f1 * f1) + (f2 * f2 + f3 * f3);
        s += __shfl_xor(s, 1); s += __shfl_xor(s, 2); s += __shfl_xor(s, 4); s += __shfl_xor(s, 8);
        const float rs = rsqrtf(s * (1.f / 64.f) + EPS);
        const f32x4 g = *(const f32x4*)(p.k_norm_g + d4);
        *(f32x4*)(owk + (size_t)(124 + t) * 256 + d4) = (f32x4){f0 * rs * g.x, f1 * rs * g.y, f2 * rs * g.z, f3 * rs * g.w};
        *(f32x4*)(owv + (size_t)(124 + t) * 256 + d4) = (f32x4){bflo(vr.x), bfhi(vr.x), bflo(vr.y), bfhi(vr.y)};
    }
    const int g = fr >> 2, t = fr & 3, head = kvh * 4 + g;
    const bf16_t* qp = KVQ + (rbase + t) * NKVQ + 512 + head * 64;
    const u32x4 r0 = *(const u32x4*)(qp + 8 * fq), r1 = *(const u32x4*)(qp + 32 + 8 * fq);
    bf16x8 q0, q1; norm_frag(r0, r1, p.q_norm_g, 0.125f, fq, q0, q1);
    const float sink = p.att_sinks[head];
    bf16x8 nk0, nk1;
    {
        const bf16_t* kp = KVQ + (rbase + (fr & 3)) * NKVQ + kvh * 64;
        const u32x4 a0 = *(const u32x4*)(kp + 8 * fq), a1 = *(const u32x4*)(kp + 32 + 8 * fq);
        norm_frag(a0, a1, p.k_norm_g, 1.f, fq, nk0, nk1);
        if (fr >= 4) { nk0 = (bf16x8){0, 0, 0, 0, 0, 0, 0, 0}; nk1 = nk0; }
    }
    f32x4 s[9];
#pragma unroll
    for (int i = 0; i < 8; ++i) {
        const float* kr = ck + (size_t)(16 * i + fr) * 256 + 8 * fq;
        const f32x4 a = *(const f32x4*)kr, b2 = *(const f32x4*)(kr + 4), c = *(const f32x4*)(kr + 32), d = *(const f32x4*)(kr + 36);
        u32x4 x0, x1;
        x0.x = cvt_pk_bf16(a.x, a.y); x0.y = cvt_pk_bf16(a.z, a.w); x0.z = cvt_pk_bf16(b2.x, b2.y); x0.w = cvt_pk_bf16(b2.z, b2.w);
        x1.x = cvt_pk_bf16(c.x, c.y); x1.y = cvt_pk_bf16(c.z, c.w); x1.z = cvt_pk_bf16(d.x, d.y); x1.w = cvt_pk_bf16(d.z, d.w);
        s[i] = (f32x4){0.f, 0.f, 0.f, 0.f};
        s[i] = MFMA32(__builtin_bit_cast(bf16x8, x0), q0, s[i]);
        s[i] = MFMA32(__builtin_bit_cast(bf16x8, x1), q1, s[i]);
    }
    s[8] = (f32x4){0.f, 0.f, 0.f, 0.f};
    s[8] = MFMA32(nk0, q0, s[8]); s[8] = MFMA32(nk1, q1, s[8]);
    float mx = sink;
#pragma unroll
    for (int i = 0; i < 9; ++i)
#pragma unroll
        for (int e = 0; e < 4; ++e) {
            const int j = 16 * i + 4 * fq + e;
            const bool ok = (j >= t) && (j <= t + 128);
            s[i][e] = ok ? s[i][e] : -INFINITY;
            mx = fmaxf(mx, s[i][e]);
        }
    mx = fmaxf(mx, __shfl_xor(mx, 16)); mx = fmaxf(mx, __shfl_xor(mx, 32));
    float l = 0.f; bf16x4 pf[9];
#pragma unroll
    for (int i = 0; i < 9; ++i) {
        float e0 = __expf(s[i][0] - mx), e1 = __expf(s[i][1] - mx), e2 = __expf(s[i][2] - mx), e3 = __expf(s[i][3] - mx);
        l += (e0 + e1) + (e2 + e3);
        u32x2 w; w.x = cvt_pk_bf16(e0, e1); w.y = cvt_pk_bf16(e2, e3);
        pf[i] = __builtin_bit_cast(bf16x4, w);
    }
    l += __shfl_xor(l, 16); l += __shfl_xor(l, 32);
    l += __expf(sink - mx);
    const float inv = 1.f / l;
#pragma unroll
    for (int dt = 0; dt < 4; ++dt) {
        f32x4 o = (f32x4){0.f, 0.f, 0.f, 0.f};
#pragma unroll
        for (int i = 0; i < 8; ++i) {
            const float* vr = cv + (size_t)(16 * i + 4 * fq) * 256 + 16 * dt + fr;
            u32x2 w; w.x = cvt_pk_bf16(vr[0], vr[256]); w.y = cvt_pk_bf16(vr[512], vr[768]);
            o = MFMA16(__builtin_bit_cast(bf16x4, w), pf[i], o);
        }
        {
            u32x2 w; w.x = 0u; w.y = 0u;
            const bf16_t* vp = KVQ + rbase * NKVQ + 256 + kvh * 64 + 16 * dt + fr;
            const unsigned v0 = vp[0], v1 = vp[NKVQ], v2 = vp[2 * NKVQ], v3 = vp[3 * NKVQ];
            if (fq == 0) { w.x = v0 | (v1 << 16); w.y = v2 | (v3 << 16); }
            o = MFMA16(__builtin_bit_cast(bf16x4, w), pf[8], o);
        }
        u32x2 w; w.x = cvt_pk_bf16(o.x * inv, o.y * inv); w.y = cvt_pk_bf16(o.z * inv, o.w * inv);
        *(u32x2*)(AO + (rbase + t) * D + head * 64 + 16 * dt + 4 * fq) = w;
    }
}


__device__ __forceinline__ void attn_sample_block(const Params& p, unsigned char* lds, int u) {
    const int tid = threadIdx.x, lane = tid & 63, wid = tid >> 6, fr = lane & 15, fq = lane >> 4;
    const int b = u >> 2, kvh = u & 3;
    unsigned char* ws = p.ws;
    const bf16_t* KVQ = (const bf16_t*)(ws + WS_KVQ);
    bf16_t* AO = (bf16_t*)(ws + WS_ATT);
    const float* ck = p.cache_k + (size_t)b * 128 * 256 + kvh * 64;
    const float* cv = p.cache_v + (size_t)b * 128 * 256 + kvh * 64;
    float* owk = p.out + O_SWK + (size_t)b * 128 * 256 + kvh * 64;
    float* owv = p.out + O_SWV + (size_t)b * 128 * 256 + kvh * 64;
    const size_t rbase = (size_t)TP + b * 4;
    bf16_t* Ks = (bf16_t*)lds;
    bf16_t* VT = Ks + 144 * 72;
    f32x4 kf[4], vf[4];
#pragma unroll
    for (int i = 0; i < 4; ++i) { const int idx = tid + 512 * i, j = idx >> 4, c4 = (idx & 15) * 4; kf[i] = *(const f32x4*)(ck + (size_t)j * 256 + c4); vf[i] = *(const f32x4*)(cv + (size_t)j * 256 + c4); }
#pragma unroll
    for (int i = 0; i < 4; ++i) {
        const int idx = tid + 512 * i, j = idx >> 4, c4 = (idx & 15) * 4;
        if (j >= 4) { *(f32x4*)(owk + (size_t)(j - 4) * 256 + c4) = kf[i]; *(f32x4*)(owv + (size_t)(j - 4) * 256 + c4) = vf[i]; }
        u32x2 w; w.x = cvt_pk_bf16(kf[i].x, kf[i].y); w.y = cvt_pk_bf16(kf[i].z, kf[i].w);
        *(u32x2*)(Ks + j * 72 + c4) = w;
        VT[(c4 + 0) * 152 + j] = f2bf(vf[i].x); VT[(c4 + 1) * 152 + j] = f2bf(vf[i].y); VT[(c4 + 2) * 152 + j] = f2bf(vf[i].z); VT[(c4 + 3) * 152 + j] = f2bf(vf[i].w);
    }
    if (tid < 64) {
        const int t = tid >> 4, d4 = (tid & 15) * 4;
        const u32x2 kr = *(const u32x2*)(KVQ + (rbase + t) * NKVQ + kvh * 64 + d4);
        const u32x2 vr = *(const u32x2*)(KVQ + (rbase + t) * NKVQ + 256 + kvh * 64 + d4);
        float f0 = bflo(kr.x), f1 = bfhi(kr.x), f2 = bflo(kr.y), f3 = bfhi(kr.y);
        float s = (f0 * f0 + f1 * f1) + (f2 * f2 + f3 * f3);
        s += __shfl_xor(s, 1); s += __shfl_xor(s, 2); s += __shfl_xor(s, 4); s += __shfl_xor(s, 8);
        const float rs = rsqrtf(s * (1.f / 64.f) + EPS);
        const f32x4 g = *(const f32x4*)(p.k_norm_g + d4);
        f0 *= rs * g.x; f1 *= rs * g.y; f2 *= rs * g.z; f3 *= rs * g.w;
        *(f32x4*)(owk + (size_t)(124 + t) * 256 + d4) = (f32x4){f0, f1, f2, f3};
        *(f32x4*)(owv + (size_t)(124 + t) * 256 + d4) = (f32x4){bflo(vr.x), bfhi(vr.x), bflo(vr.y), bfhi(vr.y)};
        u32x2 w; w.x = cvt_pk_bf16(f0, f1); w.y = cvt_pk_bf16(f2, f3);
        *(u32x2*)(Ks + (128 + t) * 72 + d4) = w;
        VT[(d4 + 0) * 152 + 128 + t] = (bf16_t)(vr.x & 0xffff); VT[(d4 + 1) * 152 + 128 + t] = (bf16_t)(vr.x >> 16);
        VT[(d4 + 2) * 152 + 128 + t] = (bf16_t)(vr.y & 0xffff); VT[(d4 + 3) * 152 + 128 + t] = (bf16_t)(vr.y >> 16);
    } else if (tid < 64 + 192) {
        const int i = tid - 64;
        if (i < 96) { const int r = 132 + (i >> 3), c8 = (i & 7) * 8; *(u32x4*)(Ks + r * 72 + c8) = (u32x4){0u, 0u, 0u, 0u}; }
        else { const int d = i - 96; if (d < 64) { bf16_t* z = VT + d * 152 + 132; for (int e = 0; e < 12; ++e) z[e] = 0; } }
    }
    __syncthreads();
    if (wid < 4) {
        const int dt = wid;
        const int g = fr >> 2, t = fr & 3, head = kvh * 4 + g;
        const bf16_t* qp = KVQ + (rbase + t) * NKVQ + 512 + head * 64;
        const u32x4 r0 = *(const u32x4*)(qp + 8 * fq), r1 = *(const u32x4*)(qp + 32 + 8 * fq);
        bf16x8 q0, q1; norm_frag(r0, r1, p.q_norm_g, 0.125f, fq, q0, q1);
        const float sink = p.att_sinks[head];
        f32x4 s[9];
#pragma unroll
        for (int i = 0; i < 9; ++i) {
            s[i] = (f32x4){0.f, 0.f, 0.f, 0.f};
            const bf16_t* kr = Ks + (16 * i + fr) * 72 + 8 * fq;
            s[i] = MFMA32(*(const bf16x8*)kr, q0, s[i]);
            s[i] = MFMA32(*(const bf16x8*)(kr + 32), q1, s[i]);
        }
        float mx = sink;
#pragma unroll
        for (int i = 0; i < 9; ++i)
#pragma unroll
            for (int e = 0; e < 4; ++e) {
                const int j = 16 * i + 4 * fq + e;
                const bool ok = (j >= t) && (j <= t + 128);
                s[i][e] = ok ? s[i][e] : -INFINITY;
                mx = fmaxf(mx, s[i][e]);
            }
        mx = fmaxf(mx, __shfl_xor(mx, 16)); mx = fmaxf(mx, __shfl_xor(mx, 32));
        float l = 0.f;
        f32x4 o = (f32x4){0.f, 0.f, 0.f, 0.f};
#pragma unroll
        for (int i = 0; i < 9; ++i) {
            const float e0 = __expf(s[i][0] - mx), e1 = __expf(s[i][1] - mx), e2 = __expf(s[i][2] - mx), e3 = __expf(s[i][3] - mx);
            l += (e0 + e1) + (e2 + e3);
            u32x2 w; w.x = cvt_pk_bf16(e0, e1); w.y = cvt_pk_bf16(e2, e3);
            const bf16x4 vfr = *(const bf16x4*)(VT + (16 * dt + fr) * 152 + 16 * i + 4 * fq);
            o = MFMA16(vfr, __builtin_bit_cast(bf16x4, w), o);
        }
        l += __shfl_xor(l, 16); l += __shfl_xor(l, 32);
        l += __expf(sink - mx);
        const float inv = 1.f / l;
        u32x2 w; w.x = cvt_pk_bf16(o.x * inv, o.y * inv); w.y = cvt_pk_bf16(o.z * inv, o.w * inv);
        *(u32x2*)(AO + (rbase + t) * D + head * 64 + 16 * dt + 4 * fq) = w;
    }
    __syncthreads();
}

#define LAS __attribute__((address_space(3)))
#define XB_TMO      128
#define XB_XCNT(j)  (256  + 64 * (j))
#define XB_XSUB(j)  (1280 + 64 * (j))
#define XB_XGEN(j)  (2304 + 64 * (j))
#define XB_TOP      3328
#define XB_TOPGEN   3392
#define XCD_BAR_WORDS 3456
#define XB_SPIN_CAP (1u << 18)

__device__ __forceinline__ unsigned xb_ld(unsigned* p)              { return __hip_atomic_load(p, __ATOMIC_RELAXED, __HIP_MEMORY_SCOPE_AGENT); }
__device__ __forceinline__ unsigned xb_add(unsigned* p, unsigned v) { return __hip_atomic_fetch_add(p, v, __ATOMIC_RELAXED, __HIP_MEMORY_SCOPE_AGENT); }
__device__ __forceinline__ unsigned xb_xcc_id() { return (unsigned)__builtin_amdgcn_s_getreg((3 << 11) | 20) & 0xFu; }
#define XB_SPIN(cond, bar) do { unsigned _sp = 0; while (cond) { __builtin_amdgcn_s_sleep(1); \
    if ((++_sp & 255u) == 0u) { if (xb_ld(&(bar)[XB_TMO])) break; if (_sp > XB_SPIN_CAP) { atomicAdd(&(bar)[XB_TMO], 1u); break; } } } } while (0)

struct XcdBarrier {
    unsigned* bar; unsigned x;
    volatile LAS unsigned* st;
};

__device__ __forceinline__ XcdBarrier xcd_barrier_post(unsigned* bar, volatile LAS unsigned* st) {
    XcdBarrier b; b.bar = bar; b.x = xb_xcc_id(); b.st = st;
    if (threadIdx.x == 0) (void)xb_add(&bar[XB_XCNT(b.x)], 1u);
    return b;
}
__device__ __forceinline__ void xcd_barrier_complete(unsigned* bar, unsigned x, unsigned& nloc, unsigned& nx) {
    const unsigned G = gridDim.x * gridDim.y * gridDim.z;
    unsigned sum, cnt, mine, sp = 0u;
    for (;;) {
        sum = 0u; cnt = 0u; mine = 0u;
#pragma unroll
        for (unsigned j = 0; j < 16; ++j) { const unsigned c = xb_ld(&bar[XB_XCNT(j)]); sum += c; cnt += (c > 0u) ? 1u : 0u; mine = (j == x) ? c : mine; }
        if (sum == G) break;
        __builtin_amdgcn_s_sleep(1);
        if ((++sp & 255u) == 0u) { if (xb_ld(&bar[XB_TMO])) break; if (sp > XB_SPIN_CAP) { atomicAdd(&bar[XB_TMO], 1u); break; } }
    }
    nloc = mine > 0u ? mine : 1u; nx = cnt > 0u ? cnt : 1u;
}

__device__ __forceinline__ void xcd_barrier(const XcdBarrier& b) {
    asm volatile("s_waitcnt vmcnt(0)" ::: "memory");
    __syncthreads();
    if (threadIdx.x == 0) {
        unsigned* bar = b.bar;
        __builtin_amdgcn_s_waitcnt(0);
        unsigned nloc = b.st[0], nx = b.st[1];
        if (nloc == 0u) { xcd_barrier_complete(bar, b.x, nloc, nx); b.st[0] = nloc; b.st[1] = nx; }
        const unsigned old = xb_add(&bar[XB_XSUB(b.x)], 1u);
        const unsigned gen = old / nloc;
        if (old + 1u == (gen + 1u) * nloc) {
            __builtin_amdgcn_fence(__ATOMIC_RELEASE, "agent");
            asm volatile("s_waitcnt vmcnt(0)" ::: "memory");
            const unsigned og = xb_add(&bar[XB_TOP], 1u);
            const unsigned tg = og / nx;
            if (og + 1u == (tg + 1u) * nx) xb_add(&bar[XB_TOPGEN], 1u);
            else XB_SPIN(xb_ld(&bar[XB_TOPGEN]) == tg, bar);
            __builtin_amdgcn_fence(__ATOMIC_ACQUIRE, "agent");
            xb_add(&bar[XB_XGEN(b.x)], 1u);
            asm volatile("s_waitcnt vmcnt(0)" ::: "memory");
        } else {
            XB_SPIN(xb_ld(&bar[XB_XGEN(b.x)]) == gen, bar);
            __builtin_amdgcn_fence(__ATOMIC_ACQUIRE, "agent");
            asm volatile("s_waitcnt vmcnt(0)" ::: "memory");
        }
    }
    __syncthreads();
}

__global__ void __launch_bounds__(NTHREADS) yoco_fwd(Params p) {
    extern __shared__ __attribute__((aligned(16))) unsigned char lds[];
    const int bid = blockIdx.x, G = gridDim.x;
    unsigned char* ws = p.ws;
    float* SS = (float*)(ws + WS_SS);
    float* Y = p.out + O_Y;
    bf16_t* XB = (bf16_t*)(ws + WS_XB);

#define IN(k) (p.ph_lo <= (k) && (k) < p.ph_hi)
    volatile LAS unsigned* bst = (volatile LAS unsigned*)((LAS unsigned char*)lds + 131072 + 64);
    XcdBarrier xbar; xbar.bar = (unsigned*)(ws + WS_BAR); xbar.x = 0; xbar.st = bst;
    int cv = bid;
    if (p.ph_hi - p.ph_lo > 1) {
        if (threadIdx.x < 8) bst[threadIdx.x] = 0u;
        __syncthreads();
        xbar.x = xb_xcc_id();
        if (threadIdx.x == 0) bst[2] = xb_add(&xbar.bar[XB_XCNT(xbar.x)], 1u);
    }
#define SEAM(k) do { if (IN(k) && IN((k) + 1)) xcd_barrier(xbar); } while (0)
    if (IN(0)) { for (int rep = 0; rep < REP_P0; ++rep) p0_prologue(p, lds, bid, G); }
    SEAM(0);
    if (p.ph_hi - p.ph_lo > 1 && IN(0) && IN(1)) {
        if (threadIdx.x == 0) {
            bool ok = (G % 8 == 0) && xbar.x < 8u;
            for (unsigned j = 0; j < 8; ++j) ok = ok && (xb_ld(&xbar.bar[XB_XCNT(j)]) == (unsigned)(G / 8));
            const unsigned rank = bst[2];
            bst[3] = (ok && rank < (unsigned)(G / 8)) ? (xbar.x + 8u * rank) : (unsigned)bid;
        }
        __syncthreads();
        cv = __builtin_amdgcn_readfirstlane((int)bst[3]);
    }
    PG8_LAS unsigned char* l3 = (PG8_LAS unsigned char*)lds;
    float* YS = Y;
#define PGEMM(Aptr, Bptr, Nn, Kk, EpiT, ...) do { pg8::Gemm g_{(const bf16_t*)(Aptr), (const bf16_t*)(Bptr), TP, (Nn), (Kk), ((Kk) == FF) ? 1 : 0}; pg8::StaticOrder S_; S_.init(TP, (Nn), G, cv); \
        Pg8Epi<EpiT> E_{EpiT{__VA_ARGS__}}; pg8::gemm_phase<Pg8Epi<EpiT>, pg8::StaticOrder, true, true>(l3, g_, S_, E_); } while (0)
    if (IN(1)) {
        for (int rep = 0; rep < REP_PG; ++rep) { PGEMM(XB, ws + WS_WIN, NIN, 1024, EpiBf16, (bf16_t*)(ws + WS_P), NIN, nullptr, 0); }
        { EpiBf16 E{(bf16_t*)(ws + WS_P), NIN, nullptr, 0}; for (int rep = 0; rep < REP_SG; ++rep) sgemm64<0>(lds, XB, 1024, (const bf16_t*)(ws + WS_WIN), TP, TS, NIN, 1024, 1, E, bid, G); }
    }
    SEAM(1);
    if (IN(2)) {
        for (int rep = 0; rep < REP_2AL; ++rep) for (int u = bid; u < 1024; u += G) mlstm_local_unit(p, lds, u);
        for (int rep = 0; rep < REP_2AS; ++rep) for (int u = bid; u < 512; u += G) mlstm_sample_unit(p, lds, u);
    }
    SEAM(2);
    if (IN(3)) mlstm_scan(p, lds, bid, G);
    SEAM(3);
    if (IN(4)) { for (int rep = 0; rep < REP_2C; ++rep) for (int u = bid; u < 1024; u += G) mlstm_out_unit(p, lds, u); }
    SEAM(4);
    if (IN(5)) {
        PGEMM(ws + WS_HG, ws + WS_WOUT, 1024, 1024, EpiResB, p.x_prompt, XB, nullptr, SS);
        { EpiAddF32 E{YS}; sgemm64<0>(lds, ws + WS_HG, 1024, (const bf16_t*)(ws + WS_WOUT), TP, TS, 1024, 1024, 1, E, bid, G); }
    }
    SEAM(5);
    if (IN(6)) {
        for (int rep = 0; rep < REP_PG; ++rep) { PGEMM(XB, ws + WS_W1A, FF, 1024, EpiBf16, (bf16_t*)(ws + WS_HID), FF, SS, 1); }
        { EpiBf16 E{(bf16_t*)(ws + WS_HID), FF, nullptr, 1}; for (int rep = 0; rep < REP_SG; ++rep) sgemm64<1>(lds, Y, 1024, (const bf16_t*)(ws + WS_W1A), TP, TS, FF, 1024, 1, E, bid, G); }
    }
    SEAM(6);
    if (IN(7)) {
        PGEMM(ws + WS_HID, ws + WS_W2A, 1024, FF, EpiResB, nullptr, XB, nullptr, SS + T);
        { EpiAtomic E{YS}; sgemm64<0>(lds, ws + WS_HID, FF, (const bf16_t*)(ws + WS_W2A), TP, TS, 1024, FF, 2, E, bid, G); }
    }
    SEAM(7);
    if (IN(8)) {
        for (int rep = 0; rep < REP_PG; ++rep) { PGEMM(XB, ws + WS_WKVQ, NKVQ, 1024, EpiBf16, (bf16_t*)(ws + WS_KVQ), NKVQ, SS + T, 0); }
        { EpiBf16 E{(bf16_t*)(ws + WS_KVQ), NKVQ, nullptr, 0}; for (int rep = 0; rep < REP_SG; ++rep) sgemm64<1>(lds, Y, 1024, (const bf16_t*)(ws + WS_WKVQ), TP, TS, NKVQ, 1024, 1, E, (cv + G / 2) % G, G); }
        __syncthreads();
        if (cv >= G / 2) late_weights(p, lds, cv - G / 2, G - G / 2);
    }
    SEAM(8);
    if (IN(9)) {
        { const int vb = (G % 8 == 0) ? (cv % 8) * (G / 8) + cv / 8 : cv;
          for (int rep = 0; rep < REP_7P; ++rep) for (int u = vb; u < 512; u += G) attn_prompt_unit(p, lds, u); }
        for (int rep = 0; rep < REP_7S; ++rep) for (int u = bid; u < 512; u += G) attn_sample_block(p, lds, u);
    }
    SEAM(9);
    if (IN(10)) {
        PGEMM(ws + WS_ATT, ws + WS_WO, 1024, 1024, EpiResB, nullptr, XB, nullptr, SS + 2 * T);
        { EpiAddF32 E{YS}; sgemm64<0>(lds, ws + WS_ATT, 1024, (const bf16_t*)(ws + WS_WO), TP, TS, 1024, 1024, 1, E, bid, G); }
    }
    SEAM(10);
    if (IN(11)) {
        for (int rep = 0; rep < REP_PG; ++rep) { PGEMM(XB, ws + WS_W1B, FF, 1024, EpiBf16, (bf16_t*)(ws + WS_HID), FF, SS + 2 * T, 1); }
        { EpiBf16 E{(bf16_t*)(ws + WS_HID), FF, nullptr, 1}; for (int rep = 0; rep < REP_SG; ++rep) sgemm64<1>(lds, Y, 1024, (const bf16_t*)(ws + WS_W1B), TP, TS, FF, 1024, 1, E, bid, G); }
    }
    SEAM(11);
    if (IN(12)) {
        PGEMM(ws + WS_HID, ws + WS_W2B, 1024, FF, EpiResB, nullptr, XB, Y, nullptr);
        { EpiAtomic E{YS}; sgemm64<0>(lds, ws + WS_HID, FF, (const bf16_t*)(ws + WS_W2B), TP, TS, 1024, FF, 2, E, bid, G); }
    }
#undef PGEMM
#undef IN
#undef SEAM
}

extern "C" void kernel_launch(void* const* d_in, const int* in_sizes, int n_in, void* d_out, int out_size, void* d_ws, size_t ws_size, hipStream_t stream) {
    static int grid_blocks = 0;
    if (!grid_blocks) {
        if (n_in != 24 || (size_t)out_size != O_END || ws_size < WS_END) { fprintf(stderr, "kernel_launch: unexpected shapes n_in=%d out=%d ws=%zu\n", n_in, out_size, ws_size); grid_blocks = -1; return; }
        int dev = 0, cus = 0, per_cu = 0;
        hipGetDevice(&dev);
        hipDeviceGetAttribute(&cus, hipDeviceAttributeMultiprocessorCount, dev);
        hipFuncSetAttribute((const void*)yoco_fwd, hipFuncAttributeMaxDynamicSharedMemorySize, LDS_BYTES);
        hipOccupancyMaxActiveBlocksPerMultiprocessor(&per_cu, (const void*)yoco_fwd, NTHREADS, LDS_BYTES);
        if (per_cu < 1) per_cu = 1;
        grid_blocks = cus * per_cu;
        (void)hipGetLastError();
    }
    if (grid_blocks < 0) return;
    Params p{};
    const float** pp = (const float**)&p;
    for (int i = 0; i < 24; ++i) pp[i] = (const float*)d_in[i];
    p.out = (float*)d_out; p.ws = (unsigned char*)d_ws;
#if N_LAUNCH_MODE == 1
    p.ph_lo = 0; p.ph_hi = 13;
    (void)hipMemsetAsync((char*)d_ws + WS_BAR, 0, BAR_BYTES, stream);
    void* args[] = {&p};
    hipError_t e = hipLaunchCooperativeKernel((const void*)yoco_fwd, dim3(grid_blocks), dim3(NTHREADS), args, LDS_BYTES, stream);
    if (e != hipSuccess) fprintf(stderr, "cooperative launch failed: %s (grid %d)\n", hipGetErrorString(e), grid_blocks);
#else
    for (int k = 0; k < MAX_PHASE; ++k) { p.ph_lo = k; p.ph_hi = k + 1; hipLaunchKernelGGL(yoco_fwd, dim3(grid_blocks), dim3(NTHREADS), LDS_BYTES, stream, p); }
#endif
}
```

```cpp
#include <hip/hip_runtime.h>
#include <hip/hip_cooperative_groups.h>
#include <cstdio>
#include <cstdint>
namespace cg = cooperative_groups;

typedef unsigned short bf16_t;
typedef short bf16x8 __attribute__((ext_vector_type(8)));
typedef short bf16x4 __attribute__((ext_vector_type(4)));
typedef float f32x4 __attribute__((ext_vector_type(4)));
typedef unsigned u32x4 __attribute__((ext_vector_type(4)));
typedef unsigned u32x2 __attribute__((ext_vector_type(2)));

constexpr int D = 1024, TP = 16384, TS = 512, T = TP + TS;
constexpr int NIN = 3072, LDW_IN = 3080, FF = 4096, NKVQ = 1536;
constexpr float EPS = 1e-6f;
constexpr int NTHREADS = 512;
constexpr int LDS_BYTES = 147456;
#ifndef REP_P0
#define REP_P0 1
#endif
#ifndef REP_2AL
#define REP_2AL 1
#endif
#ifndef REP_2AS
#define REP_2AS 1
#endif
#ifndef REP_2C
#define REP_2C 1
#endif
#ifndef REP_7P
#define REP_7P 1
#endif
#ifndef REP_7S
#define REP_7S 1
#endif
#ifndef REP_PG
#define REP_PG 1
#endif
#ifndef REP_SG
#define REP_SG 1
#endif
#ifndef MAX_PHASE
#define MAX_PHASE 13
#endif
#ifndef N_LAUNCH_MODE
#define N_LAUNCH_MODE 1
#endif

constexpr size_t MiB = 1u << 20;
constexpr size_t WS_SS = 0;
constexpr size_t WS_CHB = 256 * 1024, WS_CHM = WS_CHB + 4096, WS_MPREV = WS_CHM + 4096;
constexpr size_t WS_GATES = 1 * MiB;
constexpr size_t WS_GN = 2 * MiB;
constexpr size_t WS_BAR = 3 * MiB, BAR_BYTES = 16384;
constexpr size_t WS_WIN = 4 * MiB, WS_WOUT = 10 * MiB, WS_W1A = 12 * MiB, WS_W2A = 20 * MiB, WS_WKVQ = 28 * MiB, WS_WO = 31 * MiB, WS_W1B = 33 * MiB, WS_W2B = 41 * MiB;
constexpr size_t WS_XB = 49 * MiB;
constexpr size_t WS_P = 82 * MiB;
constexpr size_t WS_HG = 181 * MiB;
constexpr size_t WS_HID = 82 * MiB;
constexpr size_t WS_KVQ = 82 * MiB;
constexpr size_t WS_ATT = 132 * MiB;
constexpr size_t WS_END = 214 * MiB;

constexpr size_t O_Y = 0, O_PC = 17301504, O_PN = 17825792, O_PM = 17827840, O_PWK = 17827856, O_PWV = 17958928,
                 O_SC = 18090000, O_SN = 34867216, O_SM = 34932752, O_SWK = 34933264, O_SWV = 39127568, O_END = 43321872;

struct Params {
    const float *x_prompt, *x_sample, *st_C, *st_n, *st_m, *cache_k, *cache_v;
    const float *ml_norm_g, *ml_w_in, *ml_b_i, *ml_b_f, *ml_head_g, *ml_w_out;
    const float *kv_norm_g, *w_kv, *k_norm_g;
    const float *att_norm_g, *att_w_q, *q_norm_g, *att_sinks, *att_w_o;
    const float *mlp_norm_g, *mlp_w1, *mlp_w2;
    float* out; unsigned char* ws;
    int ph_lo, ph_hi;
};

typedef float f32x2 __attribute__((ext_vector_type(2)));
typedef __bf16 bf16x2n __attribute__((ext_vector_type(2)));
__device__ __forceinline__ unsigned cvt_pk_bf16(float lo, float hi) { const f32x2 v = {lo, hi}; const bf16x2n b = __builtin_convertvector(v, bf16x2n); return __builtin_bit_cast(unsigned, b); }
__device__ __forceinline__ bf16_t f2bf(float f) { return (bf16_t)(cvt_pk_bf16(f, 0.f) & 0xffffu); }
__device__ __forceinline__ float bf2f(bf16_t h) { return __uint_as_float(((unsigned)h) << 16); }
__device__ __forceinline__ float bflo(unsigned u) { return __uint_as_float(u << 16); }
__device__ __forceinline__ float bfhi(unsigned u) { return __uint_as_float(u & 0xffff0000u); }
__device__ __forceinline__ float wave_sum(float v) {
#pragma unroll
    for (int o = 1; o < 64; o <<= 1) v += __shfl_xor(v, o);
    return v;
}
__device__ __forceinline__ float wave_max(float v) {
#pragma unroll
    for (int o = 1; o < 64; o <<= 1) v = fmaxf(v, __shfl_xor(v, o));
    return v;
}
__device__ __forceinline__ float scan_sum(float x, int lane) {
#pragma unroll
    for (int o = 1; o < 64; o <<= 1) { float y = __shfl_up(x, o); if (lane >= o) x += y; }
    return x;
}
__device__ __forceinline__ float scan_max(float x, int lane) {
#pragma unroll
    for (int o = 1; o < 64; o <<= 1) { float y = __shfl_up(x, o); if (lane >= o) x = fmaxf(x, y); }
    return x;
}
__device__ __forceinline__ float softcap15(float x) { return 15.f * tanhf(x * (1.f / 15.f)); }
__device__ __forceinline__ float logsigmoid(float z) { return fminf(z, 0.f) - log1pf(__expf(-fabsf(z))); }
__device__ __forceinline__ float sigmoidf_(float z) { return 1.f / (1.f + __expf(-z)); }
#define LDS_WAIT() asm volatile("s_waitcnt lgkmcnt(0)" ::: "memory")
#define MFMA32(x, y, acc) __builtin_amdgcn_mfma_f32_16x16x32_bf16((x), (y), (acc), 0, 0, 0)
#define MFMA16(x, y, acc) __builtin_amdgcn_mfma_f32_16x16x16bf16_1k((x), (y), (acc), 0, 0, 0)

__device__ __forceinline__ void transpose_item(const float* __restrict__ W, int ldw, int K, const float* __restrict__ gk, float cs,
                                               bf16_t* WT, int row_off, int k0, int n0, float* scr, int lane) {
    {
        const int kr = lane >> 3, n4 = (lane & 7) * 4;
        f32x4 wv[8];
#pragma unroll
        for (int i = 0; i < 8; ++i) wv[i] = __builtin_nontemporal_load((const f32x4*)(W + (size_t)(k0 + kr + 8 * i) * ldw + n0 + n4));
#pragma unroll
        for (int i = 0; i < 8; ++i) {
            const int kk = kr + 8 * i;
            const float g = gk ? gk[k0 + kk] * cs : cs;
            float* d = scr + kk * 33 + n4;
            d[0] = wv[i].x * g; d[1] = wv[i].y * g; d[2] = wv[i].z * g; d[3] = wv[i].w * g;
        }
    }
    LDS_WAIT();
    const int c = lane & 7;
#pragma unroll
    for (int j = 0; j < 4; ++j) {
        const int n = (lane >> 3) + 8 * j; const float* s = scr + (8 * c) * 33 + n;
        u32x4 o; o.x = cvt_pk_bf16(s[0 * 33], s[1 * 33]); o.y = cvt_pk_bf16(s[2 * 33], s[3 * 33]); o.z = cvt_pk_bf16(s[4 * 33], s[5 * 33]); o.w = cvt_pk_bf16(s[6 * 33], s[7 * 33]);
        *(u32x4*)(WT + (size_t)(row_off + n0 + n) * K + k0 + 8 * c) = o;
    }
    LDS_WAIT();
}

__device__ __forceinline__ void p0_prologue(const Params& p, unsigned char* lds, int bid, int G) {
    const int tid = threadIdx.x, lane = tid & 63, wid = tid >> 6;
    unsigned char* ws = p.ws;
    float* scr = (float*)(lds + wid * 8448);
    float* wif = (float*)(lds + 73728);
    for (int k = tid; k < 1024; k += NTHREADS) {
        const float g = p.ml_norm_g[k];
        const f32x4 a = *(const f32x4*)(p.ml_w_in + (size_t)k * LDW_IN + 3072), b = *(const f32x4*)(p.ml_w_in + (size_t)k * LDW_IN + 3076);
        wif[0 * 1024 + k] = a.x * g; wif[1 * 1024 + k] = a.y * g; wif[2 * 1024 + k] = a.z * g; wif[3 * 1024 + k] = a.w * g;
        wif[4 * 1024 + k] = b.x * g; wif[5 * 1024 + k] = b.y * g; wif[6 * 1024 + k] = b.z * g; wif[7 * 1024 + k] = b.w * g;
    }
    { float* ss = (float*)(ws + WS_SS); for (int i = bid * NTHREADS + tid; i < 3 * T; i += G * NTHREADS) ss[i] = 0.f; }
    __syncthreads();
    const int gw = bid * 8 + wid, NGW = G * 8;
    constexpr int I_IN = 16 * 96, I_SQ = 16 * 32, I_1 = 16 * 128, I_2 = 64 * 32, I_KV = 16 * 16;
    constexpr int NITEMS = I_IN + I_SQ + I_1 + I_2 + I_KV + I_SQ;
    for (int it = gw; it < NITEMS; it += NGW) {
        int r = it;
        if (r < I_IN) { const int kb = r / 96, nb = r % 96, n0 = nb * 32; const float cs = (n0 >= 512 && n0 < 1024) ? 0.08838834764831845f : 1.f;
            transpose_item(p.ml_w_in, LDW_IN, 1024, p.ml_norm_g, cs, (bf16_t*)(ws + WS_WIN), 0, kb * 64, n0, scr, lane); continue; } r -= I_IN;
        if (r < I_SQ) { transpose_item(p.ml_w_out, 1024, 1024, nullptr, 1.f, (bf16_t*)(ws + WS_WOUT), 0, (r / 32) * 64, (r % 32) * 32, scr, lane); continue; } r -= I_SQ;
        if (r < I_1) { transpose_item(p.mlp_w1, 4096, 1024, p.mlp_norm_g, 1.f, (bf16_t*)(ws + WS_W1A), 0, (r / 128) * 64, (r % 128) * 32, scr, lane); continue; } r -= I_1;
        if (r < I_2) { transpose_item(p.mlp_w2, 1024, 4096, nullptr, 1.f, (bf16_t*)(ws + WS_W2A), 0, (r / 32) * 64, (r % 32) * 32, scr, lane); continue; } r -= I_2;
        if (r < I_KV) { transpose_item(p.w_kv, 512, 1024, p.kv_norm_g, 1.f, (bf16_t*)(ws + WS_WKVQ), 0, (r / 16) * 64, (r % 16) * 32, scr, lane); continue; } r -= I_KV;
        transpose_item(p.att_w_q, 1024, 1024, p.att_norm_g, 1.f, (bf16_t*)(ws + WS_WKVQ), 512, (r / 32) * 64, (r % 32) * 32, scr, lane);
    }
    bf16_t* XB = (bf16_t*)(ws + WS_XB); float* gates = (float*)(ws + WS_GATES);
    for (int m = gw; m < T; m += NGW) {
        const float* xrow = m < TP ? p.x_prompt + (size_t)m * D : p.x_sample + (size_t)(m - TP) * D;
        f32x4 v[4]; float s = 0.f;
#pragma unroll
        for (int j = 0; j < 4; ++j) { v[j] = __builtin_nontemporal_load((const f32x4*)(xrow + 4 * lane + 256 * j)); s += (v[j].x * v[j].x + v[j].y * v[j].y) + (v[j].z * v[j].z + v[j].w * v[j].w); }
        const float rstd = rsqrtf(wave_sum(s) * (1.f / D) + EPS);
        if (m >= TP) {
#pragma unroll
            for (int j = 0; j < 4; ++j) *(f32x4*)(p.out + O_Y + (size_t)m * D + 4 * lane + 256 * j) = v[j];
        }
#pragma unroll
        for (int j = 0; j < 4; ++j) { u32x2 w; w.x = cvt_pk_bf16(v[j].x * rstd, v[j].y * rstd); w.y = cvt_pk_bf16(v[j].z * rstd, v[j].w * rstd); *(u32x2*)(XB + (size_t)m * D + 4 * lane + 256 * j) = w; }
        float mine = 0.f;
#pragma unroll
        for (int g = 0; g < 8; ++g) {
            float a = 0.f;
#pragma unroll
            for (int j = 0; j < 4; ++j) { const f32x4 w = *(const f32x4*)(wif + g * 1024 + 4 * lane + 256 * j); a += (v[j].x * w.x + v[j].y * w.y) + (v[j].z * w.z + v[j].w * w.w); }
            a = wave_sum(a) * rstd;
            if (lane == g) mine = a;
        }
        if (lane < 4) gates[(size_t)m * 8 + lane] = softcap15(mine + p.ml_b_i[lane]);
        else if (lane < 8) gates[(size_t)m * 8 + lane] = logsigmoid(softcap15(mine + p.ml_b_f[lane - 4]));
    }
}

__device__ __forceinline__ void late_weights(const Params& p, unsigned char* lds, int slot, int nslots) {
    const int tid = threadIdx.x, lane = tid & 63, wid = tid >> 6;
    unsigned char* ws = p.ws;
    float* scr = (float*)(lds + wid * 8448);
    constexpr int I_SQ = 16 * 32, I_1 = 16 * 128, I_2 = 64 * 32, NIT = I_SQ + I_1 + I_2;
    for (int it = slot * 8 + wid; it < NIT; it += nslots * 8) {
        int r = it;
        if (r < I_SQ) { transpose_item(p.att_w_o, 1024, 1024, nullptr, 1.f, (bf16_t*)(ws + WS_WO), 0, (r / 32) * 64, (r % 32) * 32, scr, lane); continue; } r -= I_SQ;
        if (r < I_1) { transpose_item(p.mlp_w1 + (size_t)1024 * 4096, 4096, 1024, p.mlp_norm_g + 1024, 1.f, (bf16_t*)(ws + WS_W1B), 0, (r / 128) * 64, (r % 128) * 32, scr, lane); continue; } r -= I_1;
        transpose_item(p.mlp_w2 + (size_t)4096 * 1024, 1024, 4096, nullptr, 1.f, (bf16_t*)(ws + WS_W2B), 0, (r / 32) * 64, (r % 32) * 32, scr, lane);
    }
}

struct EpiBf16 {
    bf16_t* out; int ld; const float* ss; int act;
    template <int NQ, bool PAIRED> __device__ __forceinline__ void row(int r, const int (&c)[NQ], const f32x4 (&v)[NQ], int fq, float rscale) const {
        float sc = rscale; if (ss) sc = rsqrtf(ss[r] * (1.f / 1024.f) + EPS);
        u32x2 w[NQ];
#pragma unroll
        for (int q = 0; q < NQ; ++q) {
            f32x4 x = v[q] * sc;
            if (act) { x.x = fmaxf(x.x, 0.f); x.y = fmaxf(x.y, 0.f); x.z = fmaxf(x.z, 0.f); x.w = fmaxf(x.w, 0.f); x = x * x; }
            w[q].x = cvt_pk_bf16(x.x, x.y); w[q].y = cvt_pk_bf16(x.z, x.w);
        }
        if (PAIRED) {
#pragma unroll
            for (int q = 0; q < NQ; q += 2) { u32x4 o; o.x = w[q].x; o.y = w[q].y; o.z = w[q + 1].x; o.w = w[q + 1].y; *(u32x4*)(out + (size_t)r * ld + c[q]) = o; }
        } else {
#pragma unroll
            for (int q = 0; q < NQ; ++q) *(u32x2*)(out + (size_t)r * ld + c[q]) = w[q];
        }
    }
};
struct EpiRes {
    const float* srcp; const float* srcs; float* dst; bf16_t* xb; float* ss;
    template <int NQ, bool PAIRED> __device__ __forceinline__ void row(int r, const int (&c)[NQ], const f32x4 (&v)[NQ], int fq, float rscale) const {
        const float* s = r < TP ? srcp + (size_t)r * D : srcs + (size_t)(r - TP) * D;
        float a2 = 0.f;
        u32x2 w[NQ];
#pragma unroll
        for (int q = 0; q < NQ; ++q) {
            const f32x4 o = *(const f32x4*)(s + c[q]) + v[q];
            *(f32x4*)(dst + (size_t)r * D + c[q]) = o;
            w[q].x = cvt_pk_bf16(o.x, o.y); w[q].y = cvt_pk_bf16(o.z, o.w);
            a2 += (o.x * o.x + o.y * o.y) + (o.z * o.z + o.w * o.w);
        }
        if (xb) {
            if (PAIRED) {
#pragma unroll
                for (int q = 0; q < NQ; q += 2) { u32x4 o; o.x = w[q].x; o.y = w[q].y; o.z = w[q + 1].x; o.w = w[q + 1].y; *(u32x4*)(xb + (size_t)r * D + c[q]) = o; }
            } else {
#pragma unroll
                for (int q = 0; q < NQ; ++q) *(u32x2*)(xb + (size_t)r * D + c[q]) = w[q];
            }
        }
        if (ss) { a2 += __shfl_xor(a2, 16); a2 += __shfl_xor(a2, 32); if (fq == 0) atomicAdd(ss + r, a2); }
    }
};

namespace pg8 {
#define PG8_LAS __attribute__((address_space(3)))
typedef unsigned short bf16_t;
typedef short bf16x8 __attribute__((ext_vector_type(8)));
typedef float f32x4 __attribute__((ext_vector_type(4)));
typedef unsigned u32x4 __attribute__((ext_vector_type(4)));
constexpr int BM = 256, BK = 64, HALF = 128, HTB = HALF * BK * 2  , STAGE_BYTES = 8 * HTB, NXCD = 8, WGM = 8;

__host__ __device__ __forceinline__ int lds_byte(int r, int c) { const int st = (r >> 4) * 2 + (c >> 5), rr = r & 15, cc = c & 31, ob = rr * 64 + cc * 2; return st * 1024 + (ob ^ (((ob >> 9) & 1) << 5)); }
__host__ __device__ __forceinline__ void stage_rc(int b, int& R, int& C) { const int st = b / 1024, sb = b % 1024, swz = sb ^ (((sb >> 9) & 1) << 5); R = (st >> 1) * 16 + swz / 64; C = (st & 1) * 32 + (swz % 64) / 2; }
__host__ __device__ __forceinline__ int perm32(int rho) { const int n = rho >> 4, i = rho & 15; return 8 * (i >> 2) + 4 * n + (i & 3); }

struct Unit { int pm, pn; };
struct Gemm { const bf16_t* A; const bf16_t* Bt; int M, N, K; int revk; };

struct StaticOrder {
    int nM, nN, nwg, G, c;
    __host__ __device__ void init(int M, int N, int G_, int c_) { nM = M / BM; nN = N / BM; nwg = nM * nN; G = G_; c = c_; }
    __host__ __device__ bool next(int i, Unit& u) const {
        const long L = (long)i * G + c; if (L >= nwg) return false;
        int wgid = (int)L; { const int q = nwg / NXCD, r = nwg % NXCD, xcd = wgid % NXCD, off = wgid / NXCD; wgid = (xcd < r ? xcd * (q + 1) : r * (q + 1) + (xcd - r) * q) + off; }
        const int nig = WGM * nN, gid = wgid / nig, fm = gid * WGM, gsz = (nM - fm) < WGM ? (nM - fm) : WGM;
        u.pm = fm + ((wgid % nig) % gsz); u.pn = (wgid % nig) / gsz; return true;
    }
    __device__ __forceinline__ void a_ready(const Unit&) const {}
    __device__ __forceinline__ void done(const Unit&) const {}
};


template <class Epi, class Sched, bool ALIGN_EPI = false, bool SP2 = false>
__device__ __forceinline__ void gemm_phase(PG8_LAS unsigned char* lds, const Gemm g, const Sched& S, const Epi& E) {
    const int tid = threadIdx.x, wid = __builtin_amdgcn_readfirstlane(tid >> 6), lane = tid & 63, wr = wid >> 2, wc = wid & 3, fr = lane & 15, fq = lane >> 4;
    const int K = g.K, nt = K / BK;
    unsigned voffA[2], voffB[2];
#pragma unroll
    for (int i = 0; i < 2; ++i) { int R, C; stage_rc(tid * 16 + i * 8192, R, C); const int Rb = Epi::PERM ? ((R & ~31) + perm32(R & 31)) : R;
        voffA[i] = (unsigned)(R * K + C) * 2u; voffB[i] = (unsigned)(Rb * K + C) * 2u; }
    const size_t kstep = g.revk ? (size_t)0 - (size_t)(BK * 2) : (size_t)(BK * 2);
    const size_t koff = g.revk ? (size_t)(K - BK) * 2 : (size_t)0;
    const size_t hstep = (size_t)HALF * K * 2;
    const size_t tstep = 2 * hstep;
    const unsigned ldsw = (unsigned)wid * 1024u;
    const int aoff = lds_byte(wr * 64 + fr, fq * 8), boff = lds_byte(wc * 32 + fr, fq * 8);
#define PG8_SA(b, h) (((b) * 2 + (h)) * HTB)
#define PG8_SB(b, h) ((4 + (b) * 2 + (h)) * HTB)
#define PG8_STAGE(bufoff, gbase, voff) do { _Pragma("unroll") for (int _i = 0; _i < 2; ++_i) \
        __builtin_amdgcn_global_load_lds((const unsigned*)((const char*)(gbase) + (voff)[_i]), (PG8_LAS unsigned*)(lds + (bufoff) + ldsw + _i * 8192), 16, 0, 0); } while (0)
#define PG8_LDA(dst, b, h) do { _Pragma("unroll") for (int m = 0; m < 4; ++m) _Pragma("unroll") for (int k = 0; k < 2; ++k) dst[m][k] = *(const PG8_LAS bf16x8*)(lds + PG8_SA(b, h) + aoff + m * 2048 + k * 1024); } while (0)
#define PG8_LDB(dst, b, h) do { _Pragma("unroll") for (int n = 0; n < 2; ++n) _Pragma("unroll") for (int k = 0; k < 2; ++k) dst[n][k] = *(const PG8_LAS bf16x8*)(lds + PG8_SB(b, h) + boff + n * 2048 + k * 1024); } while (0)
#define PG8_MMA(ai, bj, At, Bt) do { __builtin_amdgcn_s_setprio(1); _Pragma("unroll") for (int m = 0; m < 4; ++m) _Pragma("unroll") for (int n = 0; n < 2; ++n) _Pragma("unroll") for (int k = 0; k < 2; ++k) \
        acc[ai][bj][m][n] = __builtin_amdgcn_mfma_f32_16x16x32_bf16(Bt[n][k], At[m][k], acc[ai][bj][m][n], 0, 0, 0); __builtin_amdgcn_s_setprio(0); } while (0)
#define PG8_WAIT_V(n) asm volatile("s_waitcnt vmcnt(" #n ")" ::: "memory")
#define PG8_WAIT_L(n) asm volatile("s_waitcnt lgkmcnt(" #n ")" ::: "memory")
#define PG8_BAR __builtin_amdgcn_s_barrier()
#define PG8_SCHED __builtin_amdgcn_sched_barrier(0)
    Unit cur, nxt; int ui = 0;
    if (!S.next(0, cur)) return;
    f32x4 acc[2][2][4][2];
#pragma unroll
    for (int a = 0; a < 2; ++a)
#pragma unroll
        for (int b = 0; b < 2; ++b)
#pragma unroll
            for (int m = 0; m < 4; ++m)
#pragma unroll
                for (int n = 0; n < 2; ++n) acc[a][b][m][n] = (f32x4){0.f, 0.f, 0.f, 0.f};
    bf16x8 At[4][2], B0[2][2], B1[2][2];
    const char* cA = (const char*)g.A + (size_t)cur.pm * tstep + koff; const char* cB = (const char*)g.Bt + (size_t)cur.pn * tstep + koff;
    S.a_ready(cur);
    if constexpr (SP2) {
        PG8_STAGE(PG8_SB(0, 0), cB, voffB); PG8_STAGE(PG8_SB(0, 1), cB + hstep, voffB); PG8_STAGE(PG8_SA(0, 0), cA, voffA); PG8_STAGE(PG8_SA(0, 1), cA + hstep, voffA);
        if (wr == 1) PG8_BAR;
        PG8_WAIT_V(2); PG8_BAR;
        PG8_STAGE(PG8_SB(1, 0), cB + kstep, voffB); PG8_STAGE(PG8_SA(1, 0), cA + kstep, voffA); PG8_STAGE(PG8_SB(1, 1), cB + hstep + kstep, voffB);
        PG8_WAIT_V(6); PG8_BAR;
    } else {
        PG8_STAGE(PG8_SB(0, 0), cB, voffB); PG8_STAGE(PG8_SA(0, 0), cA, voffA); PG8_STAGE(PG8_SB(0, 1), cB + hstep, voffB); PG8_STAGE(PG8_SA(0, 1), cA + hstep, voffA);
        if (wr == 1) PG8_BAR;
        PG8_WAIT_V(4); PG8_BAR;
        PG8_STAGE(PG8_SB(1, 0), cB + kstep, voffB); PG8_STAGE(PG8_SA(1, 0), cA + kstep, voffA); PG8_STAGE(PG8_SB(1, 1), cB + hstep + kstep, voffB);
        PG8_WAIT_V(6); PG8_BAR;
    }
    for (;;) {
        const bool has_next = S.next(ui + 1, nxt);
        const char* nA = has_next ? (const char*)g.A + (size_t)nxt.pm * tstep + koff : cA; const char* nB = has_next ? (const char*)g.Bt + (size_t)nxt.pn * tstep + koff : cB;
        for (int t = 0; t < nt; t += 2) {
            const bool last = (t == nt - 2);
            const char* a1 = cA + (size_t)(t + 1) * kstep;
            const char* a2 = last ? nA : cA + (size_t)(t + 2) * kstep; const char* b2 = last ? nB : cB + (size_t)(t + 2) * kstep;
            const char* a3 = a2 + kstep; const char* b3 = b2 + kstep;
            if (last && has_next) S.a_ready(nxt);
            if constexpr (SP2) {
            PG8_LDB(B0, 0, 0); PG8_LDB(B1, 0, 1); PG8_SCHED; PG8_LDA(At, 0, 0); PG8_STAGE(PG8_SA(1, 1), a1 + hstep, voffA);
            PG8_WAIT_V(8); PG8_WAIT_L(0); PG8_BAR; PG8_MMA(0, 0, At, B0); PG8_MMA(0, 1, At, B1); PG8_BAR; PG8_SCHED;
            PG8_LDA(At, 0, 1); PG8_STAGE(PG8_SB(0, 0), b2, voffB); PG8_STAGE(PG8_SB(0, 1), b2 + hstep, voffB); PG8_STAGE(PG8_SA(0, 0), a2, voffA);
            PG8_WAIT_V(8); PG8_WAIT_L(0); PG8_BAR; PG8_MMA(1, 0, At, B0); PG8_MMA(1, 1, At, B1); PG8_BAR; PG8_SCHED;
            PG8_LDB(B0, 1, 0); PG8_LDB(B1, 1, 1); PG8_SCHED; PG8_LDA(At, 1, 0); PG8_STAGE(PG8_SA(0, 1), a2 + hstep, voffA);
            PG8_WAIT_V(8); PG8_WAIT_L(0); PG8_BAR; PG8_MMA(0, 0, At, B0); PG8_MMA(0, 1, At, B1); PG8_BAR; PG8_SCHED;
            PG8_LDA(At, 1, 1); PG8_STAGE(PG8_SB(1, 0), b3, voffB); PG8_STAGE(PG8_SB(1, 1), b3 + hstep, voffB); PG8_STAGE(PG8_SA(1, 0), a3, voffA);
            PG8_WAIT_V(8); PG8_WAIT_L(0); PG8_BAR; PG8_MMA(1, 0, At, B0); PG8_MMA(1, 1, At, B1); PG8_BAR; PG8_SCHED;
            } else {
            PG8_LDB(B0, 0, 0); PG8_SCHED; PG8_LDA(At, 0, 0); PG8_STAGE(PG8_SA(1, 1), a1 + hstep, voffA);
            PG8_WAIT_L(8); PG8_BAR; PG8_WAIT_L(0); PG8_MMA(0, 0, At, B0); PG8_BAR; PG8_SCHED;
            PG8_LDB(B1, 0, 1); PG8_STAGE(PG8_SB(0, 0), b2, voffB);
            PG8_BAR; PG8_WAIT_L(0); PG8_MMA(0, 1, At, B1); PG8_BAR;
            PG8_LDA(At, 0, 1); PG8_STAGE(PG8_SA(0, 0), a2, voffA);
            PG8_BAR; PG8_WAIT_L(0); PG8_MMA(1, 0, At, B0); PG8_BAR; PG8_SCHED;
            PG8_STAGE(PG8_SB(0, 1), b2 + hstep, voffB);
            PG8_WAIT_V(6); PG8_BAR; PG8_MMA(1, 1, At, B1); PG8_BAR;
            PG8_LDB(B0, 1, 0); PG8_SCHED; PG8_LDA(At, 1, 0); PG8_STAGE(PG8_SA(0, 1), a2 + hstep, voffA);
            PG8_WAIT_L(8); PG8_BAR; PG8_WAIT_L(0); PG8_MMA(0, 0, At, B0); PG8_BAR; PG8_SCHED;
            PG8_LDB(B1, 1, 1); PG8_STAGE(PG8_SB(1, 0), b3, voffB);
            PG8_BAR; PG8_WAIT_L(0); PG8_MMA(0, 1, At, B1); PG8_BAR;
            PG8_LDA(At, 1, 1); PG8_STAGE(PG8_SA(1, 0), a3, voffA);
            PG8_BAR; PG8_WAIT_L(0); PG8_MMA(1, 0, At, B0); PG8_BAR; PG8_SCHED;
            PG8_STAGE(PG8_SB(1, 1), b3 + hstep, voffB);
            PG8_WAIT_V(6); PG8_BAR; PG8_MMA(1, 1, At, B1); PG8_BAR;
            }
        }
        if constexpr (ALIGN_EPI) { if (wr == 0) PG8_BAR; }
        if constexpr (!Epi::AFTER_DRAIN) { E(acc, cur, wr, wc, fr, fq); S.done(cur); }
        if (!has_next) break;
#pragma unroll
        for (int a = 0; a < 2; ++a)
#pragma unroll
            for (int b = 0; b < 2; ++b)
#pragma unroll
                for (int m = 0; m < 4; ++m)
#pragma unroll
                    for (int n = 0; n < 2; ++n) acc[a][b][m][n] = (f32x4){0.f, 0.f, 0.f, 0.f};
        cur = nxt; cA = nA; cB = nB; ++ui;
        if constexpr (ALIGN_EPI) { if (wr == 1) PG8_BAR; }
    }
    PG8_WAIT_V(0);
    if constexpr (!ALIGN_EPI) { if (wr == 0) PG8_BAR; }
    PG8_BAR;
    if constexpr (Epi::AFTER_DRAIN) { E.fused(acc, cur, wr, wc, fr, fq, lds, wid, lane); S.done(cur); }
#undef PG8_SA
#undef PG8_SB
#undef PG8_STAGE
#undef PG8_LDA
#undef PG8_LDB
#undef PG8_MMA
#undef PG8_WAIT_V
#undef PG8_WAIT_L
#undef PG8_BAR
#undef PG8_SCHED
}
}


template <class Inner> struct Pg8Epi {
    static constexpr bool PERM = true, AFTER_DRAIN = false;
    Inner in;
    __device__ __forceinline__ void operator()(const f32x4 (&acc)[2][2][4][2], const pg8::Unit& u, int wr, int wc, int fr, int fq) const {
#pragma unroll
        for (int ai = 0; ai < 2; ++ai)
#pragma unroll
            for (int m = 0; m < 4; ++m) {
                const int r = u.pm * 256 + ai * 128 + wr * 64 + m * 16 + fr;
                const int c0 = u.pn * 256 + wc * 32 + 8 * fq;
                const int cols[4] = {c0, c0 + 4, c0 + 128, c0 + 132};
                const f32x4 vv[4] = {acc[ai][0][m][0], acc[ai][0][m][1], acc[ai][1][m][0], acc[ai][1][m][1]};
                in.template row<4, true>(r, cols, vv, fq, 1.f);
            }
    }
};
struct EpiResB {
    const float* srcf; bf16_t* xb; float* dstf; float* ss;
    template <int NQ, bool PAIRED> __device__ __forceinline__ void row(int r, const int (&c)[NQ], const f32x4 (&v)[NQ], int fq, float rscale) const {
        static_assert(PAIRED && NQ % 2 == 0, "EpiResB: paired quads only");
        float a2 = 0.f;
#pragma unroll
        for (int q = 0; q < NQ; q += 2) {
            f32x4 s0, s1;
            if (srcf) { s0 = *(const f32x4*)(srcf + (size_t)r * D + c[q]); s1 = *(const f32x4*)(srcf + (size_t)r * D + c[q] + 4); }
            else { const u32x4 xr = *(const u32x4*)(xb + (size_t)r * D + c[q]); s0 = (f32x4){bflo(xr.x), bfhi(xr.x), bflo(xr.y), bfhi(xr.y)}; s1 = (f32x4){bflo(xr.z), bfhi(xr.z), bflo(xr.w), bfhi(xr.w)}; }
            const f32x4 o0 = s0 + v[q], o1 = s1 + v[q + 1];
            if (dstf) { *(f32x4*)(dstf + (size_t)r * D + c[q]) = o0; *(f32x4*)(dstf + (size_t)r * D + c[q] + 4) = o1; }
            else {
                u32x4 w; w.x = cvt_pk_bf16(o0.x, o0.y); w.y = cvt_pk_bf16(o0.z, o0.w); w.z = cvt_pk_bf16(o1.x, o1.y); w.w = cvt_pk_bf16(o1.z, o1.w);
                *(u32x4*)(xb + (size_t)r * D + c[q]) = w;
                a2 += (o0.x * o0.x + o0.y * o0.y) + (o0.z * o0.z + o0.w * o0.w) + (o1.x * o1.x + o1.y * o1.y) + (o1.z * o1.z + o1.w * o1.w);
            }
        }
        if (ss) { a2 += __shfl_xor(a2, 16); a2 += __shfl_xor(a2, 32); if (fq == 0) atomicAdd(ss + r, a2); }
    }
};
struct EpiAddF32 {
    float* dst;
    template <int NQ, bool PAIRED> __device__ __forceinline__ void row(int r, const int (&c)[NQ], const f32x4 (&v)[NQ], int fq, float rscale) const {
#pragma unroll
        for (int q = 0; q < NQ; ++q) { f32x4* d = (f32x4*)(dst + (size_t)r * D + c[q]); *d = *d + v[q]; }
    }
};
struct EpiAtomic {
    float* dst;
    template <int NQ, bool PAIRED> __device__ __forceinline__ void row(int r, const int (&c)[NQ], const f32x4 (&v)[NQ], int fq, float rscale) const {
#pragma unroll
        for (int q = 0; q < NQ; ++q) { float* d = dst + (size_t)r * D + c[q]; atomicAdd(d, v[q].x); atomicAdd(d + 1, v[q].y); atomicAdd(d + 2, v[q].z); atomicAdd(d + 3, v[q].w); }
    }
};

template <int AF32, class Epi>
__device__ __forceinline__ void sgemm64(unsigned char* lds, const void* Av, int lda, const bf16_t* __restrict__ Bt, int row0, int nrows, int N, int K, int ksplit,
                                        const Epi& E, int bid, int G) {
    const int tid = threadIdx.x, lane = tid & 63, wid = tid >> 6, wr = wid >> 2, wc = wid & 3, fr = lane & 15, fq = lane >> 4;
    const int nN = N / 128, nT = (nrows / 64) * nN, nU = nT * ksplit, Ksl = K / ksplit, nk = Ksl / 128;
    constexpr int LS = 136;
    bf16_t* As = (bf16_t*)lds;
    bf16_t* Bs = As + 2 * 64 * LS;
    float* rs = (float*)(Bs + 2 * 128 * LS);
    const int arow = tid >> 3, ak = (tid & 7) * 8;
    for (int u = bid; u < nU; u += G) {
        const int ks = u / nT, t = u % nT, pm = t / nN, pn = t % nN, k0 = ks * Ksl;
        const bf16_t* Ab = (const bf16_t*)Av + (size_t)(row0 + pm * 64 + arow) * lda + k0 + ak;
        const float* Af = (const float*)Av + (size_t)(row0 + pm * 64 + arow) * lda + k0 + ak;
        const bf16_t* Bg = Bt + (size_t)(pn * 128 + arow) * K + k0 + ak;
        f32x4 acc[2][2];
#pragma unroll
        for (int m = 0; m < 2; ++m)
#pragma unroll
            for (int n = 0; n < 2; ++n) acc[m][n] = (f32x4){0.f, 0.f, 0.f, 0.f};
        float ssq = 0.f;
        u32x4 ra[2], rb[2][2];
        auto loadAB = [&](int kt) {
#pragma unroll
            for (int h = 0; h < 2; ++h) {
                if (AF32) { const f32x4 a = *(const f32x4*)(Af + kt * 128 + 64 * h), b = *(const f32x4*)(Af + kt * 128 + 64 * h + 4);
                    ssq += (a.x * a.x + a.y * a.y) + (a.z * a.z + a.w * a.w) + (b.x * b.x + b.y * b.y) + (b.z * b.z + b.w * b.w);
                    ra[h].x = cvt_pk_bf16(a.x, a.y); ra[h].y = cvt_pk_bf16(a.z, a.w); ra[h].z = cvt_pk_bf16(b.x, b.y); ra[h].w = cvt_pk_bf16(b.z, b.w); }
                else ra[h] = *(const u32x4*)(Ab + kt * 128 + 64 * h);
#pragma unroll
                for (int i = 0; i < 2; ++i) rb[i][h] = *(const u32x4*)(Bg + (size_t)(64 * i) * K + kt * 128 + 64 * h);
            }
        };
        auto storeAB = [&](int buf) {
#pragma unroll
            for (int h = 0; h < 2; ++h) {
                *(u32x4*)(As + buf * 64 * LS + arow * LS + ak + 64 * h) = ra[h];
#pragma unroll
                for (int i = 0; i < 2; ++i) *(u32x4*)(Bs + buf * 128 * LS + (arow + 64 * i) * LS + ak + 64 * h) = rb[i][h];
            }
        };
        loadAB(0);
        storeAB(0);
        __syncthreads();
        for (int kt = 0; kt < nk; ++kt) {
            const int buf = kt & 1;
            if (kt + 1 < nk) loadAB(kt + 1);
            const bf16_t* as = As + buf * 64 * LS; const bf16_t* bs = Bs + buf * 128 * LS;
#pragma unroll
            for (int kk = 0; kk < 4; ++kk) {
                bf16x8 af[2], bfr[2];
#pragma unroll
                for (int m = 0; m < 2; ++m) af[m] = *(const bf16x8*)(as + (32 * wr + 16 * m + fr) * LS + 32 * kk + 8 * fq);
#pragma unroll
                for (int n = 0; n < 2; ++n) bfr[n] = *(const bf16x8*)(bs + (32 * wc + 16 * n + fr) * LS + 32 * kk + 8 * fq);
#pragma unroll
                for (int m = 0; m < 2; ++m)
#pragma unroll
                    for (int n = 0; n < 2; ++n) acc[m][n] = MFMA32(bfr[n], af[m], acc[m][n]);
            }
            if (kt + 1 < nk) storeAB(buf ^ 1);
            __syncthreads();
        }
        if (AF32) {
            ssq += __shfl_xor(ssq, 1); ssq += __shfl_xor(ssq, 2); ssq += __shfl_xor(ssq, 4);
            if ((tid & 7) == 0) rs[arow] = rsqrtf(ssq * (1.f / 1024.f) + EPS);
            __syncthreads();
        }
#pragma unroll
        for (int m = 0; m < 2; ++m) {
            const int lr = 32 * wr + 16 * m + fr, r = row0 + pm * 64 + lr;
            const int cols[2] = {pn * 128 + 32 * wc + 4 * fq, pn * 128 + 32 * wc + 16 + 4 * fq};
            const f32x4 vv[2] = {acc[m][0], acc[m][1]};
            E.template row<2, false>(r, cols, vv, fq, AF32 ? rs[lr] : 1.f);
        }
    }
}

template <class Epi>
__device__ __forceinline__ void sgemm_phase(unsigned char* lds, const bf16_t* __restrict__ A, const bf16_t* __restrict__ Bt, int row0, int nrows, int N, int K,
                                            const Epi& E, int bid, int G) {
    const int tid = threadIdx.x, lane = tid & 63, wid = tid >> 6, wr = wid >> 2, wc = wid & 3, fr = lane & 15, fq = lane >> 4;
    const int nN = N / 128, nU = (nrows / 128) * nN, nk = K / 64;
    bf16_t* As = (bf16_t*)lds;
    bf16_t* Bs = As + 2 * 128 * 72;
    const int ldrow = tid >> 3, ldk = (tid & 7) * 8;
    for (int u = bid; u < nU; u += G) {
        const int pm = u / nN, pn = u % nN;
        const bf16_t* Ag = A + (size_t)(row0 + pm * 128 + ldrow) * K + ldk;
        const bf16_t* Bg = Bt + (size_t)(pn * 128 + ldrow) * K + ldk;
        f32x4 acc[4][2];
#pragma unroll
        for (int m = 0; m < 4; ++m)
#pragma unroll
            for (int n = 0; n < 2; ++n) acc[m][n] = (f32x4){0.f, 0.f, 0.f, 0.f};
        u32x4 ra[2], rb[2];
#pragma unroll
        for (int i = 0; i < 2; ++i) { ra[i] = *(const u32x4*)(Ag + (size_t)(64 * i) * K); rb[i] = *(const u32x4*)(Bg + (size_t)(64 * i) * K); }
#pragma unroll
        for (int i = 0; i < 2; ++i) { *(u32x4*)(As + (ldrow + 64 * i) * 72 + ldk) = ra[i]; *(u32x4*)(Bs + (ldrow + 64 * i) * 72 + ldk) = rb[i]; }
        __syncthreads();
        for (int kt = 0; kt < nk; ++kt) {
            const int buf = kt & 1;
            if (kt + 1 < nk) {
#pragma unroll
                for (int i = 0; i < 2; ++i) { ra[i] = *(const u32x4*)(Ag + (size_t)(64 * i) * K + (kt + 1) * 64); rb[i] = *(const u32x4*)(Bg + (size_t)(64 * i) * K + (kt + 1) * 64); }
            }
            const bf16_t* as = As + buf * 128 * 72; const bf16_t* bs = Bs + buf * 128 * 72;
#pragma unroll
            for (int kk = 0; kk < 2; ++kk) {
                bf16x8 af[4], bfr[2];
#pragma unroll
                for (int m = 0; m < 4; ++m) af[m] = *(const bf16x8*)(as + (64 * wr + 16 * m + fr) * 72 + 32 * kk + 8 * fq);
#pragma unroll
                for (int n = 0; n < 2; ++n) bfr[n] = *(const bf16x8*)(bs + (32 * wc + 16 * n + fr) * 72 + 32 * kk + 8 * fq);
#pragma unroll
                for (int m = 0; m < 4; ++m)
#pragma unroll
                    for (int n = 0; n < 2; ++n) acc[m][n] = MFMA32(bfr[n], af[m], acc[m][n]);
            }
            if (kt + 1 < nk) {
                bf16_t* an = As + (buf ^ 1) * 128 * 72; bf16_t* bn = Bs + (buf ^ 1) * 128 * 72;
#pragma unroll
                for (int i = 0; i < 2; ++i) { *(u32x4*)(an + (ldrow + 64 * i) * 72 + ldk) = ra[i]; *(u32x4*)(bn + (ldrow + 64 * i) * 72 + ldk) = rb[i]; }
            }
            __syncthreads();
        }
#pragma unroll
        for (int m = 0; m < 4; ++m) {
            const int r = row0 + pm * 128 + 64 * wr + 16 * m + fr;
            const int cols[2] = {pn * 128 + 32 * wc + 4 * fq, pn * 128 + 32 * wc + 16 + 4 * fq};
            const f32x4 vv[2] = {acc[m][0], acc[m][1]};
            E.template row<2, false>(r, cols, vv, fq, 1.f);
        }
    }
}

__device__ __forceinline__ void mlstm_local_unit(const Params& p, unsigned char* lds, int u) {
    const int tid = threadIdx.x, lane = tid & 63, wid = tid >> 6, fr = lane & 15, fq = lane >> 4;
    const int bh = u >> 6, c = u & 63, b = bh >> 2, h = bh & 3, base = b * 4096 + c * 64;
    unsigned char* ws = p.ws;
    const bf16_t* P = (const bf16_t*)(ws + WS_P); const float* gates = (const float*)(ws + WS_GATES);
    bf16_t* GS = (bf16_t*)p.out;
    bf16_t* kT = (bf16_t*)lds;
    bf16_t* vT = kT + 128 * 72;
    float* wk = (float*)(vT + 256 * 72);
    if (wid == 0) {
        const float lf = gates[(size_t)(base + lane) * 8 + 4 + h], li = gates[(size_t)(base + lane) * 8 + h];
        const float bc = scan_sum(lf, lane);
        const float B = __shfl(bc, 63);
        const float val = B - bc + li;
        const float ml = wave_max(val);
        wk[lane] = __expf(val - ml);
        if (lane == 0) { ((float*)(ws + WS_CHB))[u] = B; ((float*)(ws + WS_CHM))[u] = ml; }
    }
    __syncthreads();
    {
        const bf16_t* Pk = P + (size_t)(base + lane) * NIN + 512 + h * 128;
#pragma unroll
        for (int i = 0; i < 2; ++i) {
            const int dch = wid * 2 + i; const u32x4 r = *(const u32x4*)(Pk + dch * 8);
            bf16_t* dst = kT + (dch * 8) * 72 + lane;
            dst[0 * 72] = (bf16_t)(r.x & 0xffff); dst[1 * 72] = (bf16_t)(r.x >> 16); dst[2 * 72] = (bf16_t)(r.y & 0xffff); dst[3 * 72] = (bf16_t)(r.y >> 16);
            dst[4 * 72] = (bf16_t)(r.z & 0xffff); dst[5 * 72] = (bf16_t)(r.z >> 16); dst[6 * 72] = (bf16_t)(r.w & 0xffff); dst[7 * 72] = (bf16_t)(r.w >> 16);
        }
        const bf16_t* Pv = P + (size_t)(base + lane) * NIN + 1024 + h * 256;
        const float w = wk[lane];
#pragma unroll
        for (int i = 0; i < 4; ++i) {
            const int vch = wid * 4 + i; const u32x4 r = *(const u32x4*)(Pv + vch * 8);
            bf16_t* dst = vT + (vch * 8) * 72 + lane;
            dst[0 * 72] = f2bf(bflo(r.x) * w); dst[1 * 72] = f2bf(bfhi(r.x) * w); dst[2 * 72] = f2bf(bflo(r.y) * w); dst[3 * 72] = f2bf(bfhi(r.y) * w);
            dst[4 * 72] = f2bf(bflo(r.z) * w); dst[5 * 72] = f2bf(bfhi(r.z) * w); dst[6 * 72] = f2bf(bflo(r.w) * w); dst[7 * 72] = f2bf(bfhi(r.w) * w);
        }
    }
    __syncthreads();
    {
        f32x4 acc[2][8];
#pragma unroll
        for (int a = 0; a < 2; ++a)
#pragma unroll
            for (int d = 0; d < 8; ++d) acc[a][d] = (f32x4){0.f, 0.f, 0.f, 0.f};
#pragma unroll
        for (int ks = 0; ks < 2; ++ks) {
            bf16x8 yf[2];
#pragma unroll
            for (int vt = 0; vt < 2; ++vt) yf[vt] = *(const bf16x8*)(vT + (32 * wid + 16 * vt + fr) * 72 + 32 * ks + 8 * fq);
#pragma unroll
            for (int dt = 0; dt < 8; ++dt) {
                const bf16x8 xf = *(const bf16x8*)(kT + (16 * dt + fr) * 72 + 32 * ks + 8 * fq);
#pragma unroll
                for (int vt = 0; vt < 2; ++vt) acc[vt][dt] = MFMA32(xf, yf[vt], acc[vt][dt]);
            }
        }
        bf16_t* G = GS + (size_t)u * 32768;
#pragma unroll
        for (int vt = 0; vt < 2; ++vt)
#pragma unroll
            for (int dt = 0; dt < 8; ++dt) {
                u32x2 w; w.x = cvt_pk_bf16(acc[vt][dt].x, acc[vt][dt].y); w.y = cvt_pk_bf16(acc[vt][dt].z, acc[vt][dt].w);
                *(u32x2*)(G + (32 * wid + 16 * vt + fr) * 128 + 16 * dt + 4 * fq) = w;
            }
    }
    if (tid < 128) {
        float s = 0.f;
#pragma unroll 8
        for (int ss = 0; ss < 64; ++ss) s += bf2f(kT[tid * 72 + ss]) * wk[ss];
        ((float*)(ws + WS_GN))[(size_t)u * 128 + tid] = s;
    }
    __syncthreads();
}

__device__ __forceinline__ void mlstm_sample_unit(const Params& p, unsigned char* lds, int u) {
    const int tid = threadIdx.x, lane = tid & 63, wid = tid >> 6;
    const int b = u >> 2, h = u & 3, base = TP + b * 4;
    unsigned char* ws = p.ws;
    const bf16_t* P = (const bf16_t*)(ws + WS_P); const float* gates = (const float*)(ws + WS_GATES);
    float* q = (float*)lds;
    float* k = q + 512;
    float* v = k + 512;
    float* n0 = v + 1024;
    float* sc = n0 + 128;
    float* red = sc + 64;
    const float* C0 = p.st_C + (size_t)u * 32768;
    float* Cout = p.out + O_SC + (size_t)u * 32768;
    {
        const int t = tid >> 7, d = tid & 127;
        q[tid] = bf2f(P[(size_t)(base + t) * NIN + h * 128 + d]);
        k[tid] = bf2f(P[(size_t)(base + t) * NIN + 512 + h * 128 + d]);
        const int t2 = tid >> 8, vv = tid & 255;
        v[tid] = bf2f(P[(size_t)(base + t2) * NIN + 1024 + h * 256 + vv]);
        v[512 + tid] = bf2f(P[(size_t)(base + 2 + t2) * NIN + 1024 + h * 256 + vv]);
        if (tid < 128) n0[tid] = p.st_n[(size_t)u * 128 + tid];
    }
    if (tid == 0) {
        float li[4], bc[4]; float run = 0.f;
#pragma unroll
        for (int t = 0; t < 4; ++t) { li[t] = gates[(size_t)(base + t) * 8 + h]; run += gates[(size_t)(base + t) * 8 + 4 + h]; bc[t] = run; }
        const float m0 = p.st_m[u]; float mt[4];
#pragma unroll
        for (int t = 0; t < 4; ++t) {
            const float inter = bc[t] + m0; float mx = inter;
#pragma unroll
            for (int s = 0; s < 4; ++s) if (s <= t) mx = fmaxf(mx, bc[t] - bc[s] + li[s]);
            mt[t] = mx; sc[16 + t] = __expf(inter - mx); sc[28 + t] = __expf(-mx);
#pragma unroll
            for (int s = 0; s < 4; ++s) sc[t * 4 + s] = (s <= t) ? __expf(bc[t] - bc[s] + li[s] - mx) : 0.f;
        }
        const float mn = mt[3];
        sc[24] = __expf(bc[3] + m0 - mn);
#pragma unroll
        for (int s = 0; s < 4; ++s) sc[20 + s] = __expf(bc[3] - bc[s] + li[s] - mn);
        p.out[O_SM + u] = mn;
    }
    __syncthreads();
#pragma unroll
    for (int i = 0; i < 2; ++i) {
        const int pr = wid * 2 + i, t = pr >> 2, s = pr & 3;
        float a = q[t * 128 + lane] * k[s * 128 + lane] + q[t * 128 + 64 + lane] * k[s * 128 + 64 + lane];
        a = wave_sum(a);
        if (lane == 0) sc[32 + pr] = a * sc[pr];
    }
    if (wid < 4) { float a = q[wid * 128 + lane] * n0[lane] + q[wid * 128 + 64 + lane] * n0[64 + lane]; a = wave_sum(a); if (lane == 0) sc[48 + wid] = a; }
    if (tid < 8) sc[52 + tid] = 0.f;
    {
        const int vq = lane, dg = wid;
        f32x4 qc[4];
#pragma unroll
        for (int t = 0; t < 4; ++t) qc[t] = (f32x4){0.f, 0.f, 0.f, 0.f};
        const float decay = sc[24];
        f32x4 vs[4];
#pragma unroll
        for (int s = 0; s < 4; ++s) vs[s] = *(const f32x4*)(v + s * 256 + 4 * vq) * sc[20 + s];
#pragma unroll 4
        for (int dd = 0; dd < 16; ++dd) {
            const int d = dg * 16 + dd;
            const f32x4 c0 = __builtin_nontemporal_load((const f32x4*)(C0 + (size_t)d * 256 + 4 * vq));
            f32x4 cn = c0 * decay;
#pragma unroll
            for (int s = 0; s < 4; ++s) cn += vs[s] * k[s * 128 + d];
            *(f32x4*)(Cout + (size_t)d * 256 + 4 * vq) = cn;
#pragma unroll
            for (int t = 0; t < 4; ++t) qc[t] += c0 * q[t * 128 + d];
        }
#pragma unroll
        for (int t = 0; t < 4; ++t) *(f32x4*)(red + (dg * 4 + t) * 256 + 4 * vq) = qc[t];
    }
    if (tid < 128) {
        float nn = sc[24] * n0[tid];
#pragma unroll
        for (int s = 0; s < 4; ++s) nn += sc[20 + s] * k[s * 128 + tid];
        p.out[O_SN + (size_t)u * 128 + tid] = nn;
    }
    __syncthreads();
    {
        const int t = tid >> 7, v0 = (tid & 127) * 2;
        float den = sc[16 + t] * sc[48 + t];
#pragma unroll
        for (int s = 0; s < 4; ++s) den += sc[32 + t * 4 + s];
        const float inv = 1.f / fmaxf(fabsf(den), sc[28 + t]);
        float hv[2]; float ssq = 0.f;
#pragma unroll
        for (int j = 0; j < 2; ++j) {
            float qC = 0.f;
#pragma unroll
            for (int g = 0; g < 8; ++g) qC += red[(g * 4 + t) * 256 + v0 + j];
            float num = sc[16 + t] * qC;
#pragma unroll
            for (int s = 0; s < 4; ++s) num += sc[32 + t * 4 + s] * v[s * 256 + v0 + j];
            hv[j] = num * inv; ssq += hv[j] * hv[j];
        }
        ssq = wave_sum(ssq);
        if (lane == 0) sc[52 + wid] = ssq;
        __syncthreads();
        const float tot = sc[52 + 2 * t] + sc[52 + 2 * t + 1];
        const float rstd = rsqrtf(tot * (1.f / 256.f) + EPS);
        const unsigned ob = *(const unsigned*)(P + (size_t)(base + t) * NIN + 2048 + h * 256 + v0);
        const float o0 = sigmoidf_(bflo(ob)), o1 = sigmoidf_(bfhi(ob));
        const float g0 = p.ml_head_g[h * 256 + v0], g1 = p.ml_head_g[h * 256 + v0 + 1];
        bf16_t* HG = (bf16_t*)(ws + WS_HG);
        *(unsigned*)(HG + (size_t)(base + t) * D + h * 256 + v0) = cvt_pk_bf16(hv[0] * rstd * g0 * o0, hv[1] * rstd * g1 * o1);
    }
    __syncthreads();
}

__device__ __forceinline__ void mlstm_scan(const Params& p, unsigned char* lds, int bid, int G) {
    unsigned char* ws = p.ws;
    bf16_t* GS = (bf16_t*)p.out;
    const float* CHB = (const float*)(ws + WS_CHB); const float* CHM = (const float*)(ws + WS_CHM);
    float* MPREV = (float*)(ws + WS_MPREV); float* GN = (float*)(ws + WS_GN);
    const int tid = threadIdx.x;
    float* decs = (float*)lds;
    float* scls = decs + 64;
    float* tile = scls + 64;
    for (int blk = bid; blk < 256; blk += G) {
        const int bh = blk >> 4;
        if (tid < 64) {
            const float B = CHB[bh * 64 + tid], ml = CHM[bh * 64 + tid];
            float a = B, b2 = ml;
#pragma unroll
            for (int o = 1; o < 64; o <<= 1) { const float ya = __shfl_up(a, o), yb = __shfl_up(b2, o); if (tid >= o) { b2 = fmaxf(yb + a, b2); a = ya + a; } }
            const float m = fmaxf(a, b2);
            float mp = __shfl_up(m, 1); if (tid == 0) mp = 0.f;
            decs[tid] = __expf(B + mp - m); scls[tid] = __expf(ml - m);
            if ((blk & 15) == 0) { MPREV[bh * 64 + tid] = mp; if (tid == 63) p.out[O_PM + bh] = m; }
        }
        float gnv[64]; float* gp = GN + (size_t)(bh * 64) * 128 + (blk & 15) * 8 + (tid & 7);
        if (tid < 8) {
#pragma unroll
            for (int c = 0; c < 64; ++c) gnv[c] = gp[(size_t)c * 128];
        }
        __syncthreads();
        const int e4 = blk * NTHREADS + tid;
        const int off = (e4 & 8191) * 4;
        bf16_t* ptr = GS + (size_t)bh * 64 * 32768 + off;
        float c0 = 0.f, c1 = 0.f, c2 = 0.f, c3 = 0.f;
#pragma unroll 1
        for (int cb = 0; cb < 64; cb += 16) {
            u32x2 g[16];
#pragma unroll
            for (int j = 0; j < 16; ++j) g[j] = *(const u32x2*)(ptr + (size_t)(cb + j) * 32768);
#pragma unroll
            for (int j = 0; j < 16; ++j) {
                const float dec = decs[cb + j], s = scls[cb + j];
                u32x2 w; w.x = cvt_pk_bf16(c0, c1); w.y = cvt_pk_bf16(c2, c3);
                *(u32x2*)(ptr + (size_t)(cb + j) * 32768) = w;
                c0 = dec * c0 + s * bflo(g[j].x); c1 = dec * c1 + s * bfhi(g[j].x); c2 = dec * c2 + s * bflo(g[j].y); c3 = dec * c3 + s * bfhi(g[j].y);
            }
        }
        {
            const int vl = (off >> 7) & 15, d = off & 127;
            tile[(d + 0) * 20 + vl] = c0; tile[(d + 1) * 20 + vl] = c1; tile[(d + 2) * 20 + vl] = c2; tile[(d + 3) * 20 + vl] = c3;
            __syncthreads();
            const int dd = tid >> 2, vq = tid & 3, v0 = (blk & 15) * 16;
            const f32x4 o = (f32x4){tile[dd * 20 + 4 * vq], tile[dd * 20 + 4 * vq + 1], tile[dd * 20 + 4 * vq + 2], tile[dd * 20 + 4 * vq + 3]};
            *(f32x4*)(p.out + O_PC + (size_t)bh * 32768 + (size_t)dd * 256 + v0 + 4 * vq) = o;
        }
        if (tid < 8) {
            float n = 0.f;
#pragma unroll
            for (int c = 0; c < 64; ++c) { gp[(size_t)c * 128] = n; n = decs[c] * n + scls[c] * gnv[c]; }
            p.out[O_PN + bh * 128 + (blk & 15) * 8 + tid] = n;
        }
        __syncthreads();
    }
}

__device__ __forceinline__ void mlstm_out_unit(const Params& p, unsigned char* lds, int u) {
    const int tid = threadIdx.x, lane = tid & 63, wid = tid >> 6, fr = lane & 15, fq = lane >> 4;
    const int bh = u >> 6, c = u & 63, b = bh >> 2, h = bh & 3, base = b * 4096 + c * 64;
    unsigned char* ws = p.ws;
    const bf16_t* P = (const bf16_t*)(ws + WS_P); const float* gates = (const float*)(ws + WS_GATES);
    const bf16_t* CT = (const bf16_t*)p.out + (size_t)u * 32768;
    bf16_t* Qs = (bf16_t*)lds;
    bf16_t* Ks = Qs + 64 * 136;
    bf16_t* Ac = Ks + 64 * 136;
    bf16_t* VT = Ac + 64 * 200;
    float* sm = (float*)(VT + 256 * 72);
    float *bt = sm, *lmb = sm + 64, *mt = sm + 128, *at = sm + 192, *den = sm + 256, *hss = sm + 320, *npv = sm + 384;
    bf16x8 cf[2][4];
#pragma unroll
    for (int vt = 0; vt < 2; ++vt)
#pragma unroll
        for (int kd = 0; kd < 4; ++kd) cf[vt][kd] = *(const bf16x8*)(CT + (32 * wid + 16 * vt + fr) * 128 + 32 * kd + 8 * fq);
    if (wid == 0) {
        const float lf = gates[(size_t)(base + lane) * 8 + 4 + h], li = gates[(size_t)(base + lane) * 8 + h];
        const float bc = scan_sum(lf, lane);
        const float lm = li - bc;
        const float pm = scan_max(lm, lane);
        const float mprev = ((const float*)(ws + WS_MPREV))[u];
        const float inter = bc + mprev;
        const float m_t = fmaxf(inter, bc + pm);
        bt[lane] = bc; lmb[lane] = lm; mt[lane] = m_t; at[lane] = __expf(inter - m_t); den[lane] = 0.f; hss[lane] = 0.f;
    }
    if (wid == 1) { const float* NP = (const float*)(ws + WS_GN) + (size_t)u * 128; npv[lane] = NP[lane]; npv[64 + lane] = NP[64 + lane]; }
    __syncthreads();
#pragma unroll
    for (int i = 0; i < 2; ++i) {
        const int ci = tid + 512 * i, t = ci >> 4, dch = ci & 15;
        const u32x4 qv = *(const u32x4*)(P + (size_t)(base + t) * NIN + h * 128 + dch * 8);
        const u32x4 kv = *(const u32x4*)(P + (size_t)(base + t) * NIN + 512 + h * 128 + dch * 8);
        *(u32x4*)(Qs + t * 136 + dch * 8) = qv;
        *(u32x4*)(Ks + t * 136 + dch * 8) = kv;
        const float a = at[t];
        u32x4 sq; sq.x = cvt_pk_bf16(bflo(qv.x) * a, bfhi(qv.x) * a); sq.y = cvt_pk_bf16(bflo(qv.y) * a, bfhi(qv.y) * a);
        sq.z = cvt_pk_bf16(bflo(qv.z) * a, bfhi(qv.z) * a); sq.w = cvt_pk_bf16(bflo(qv.w) * a, bfhi(qv.w) * a);
        *(u32x4*)(Ac + t * 200 + 64 + dch * 8) = sq;
    }
    {
        const bf16_t* Pv = P + (size_t)(base + lane) * NIN + 1024 + h * 256;
#pragma unroll
        for (int i = 0; i < 4; ++i) {
            const int vch = wid * 4 + i; const u32x4 r = *(const u32x4*)(Pv + vch * 8);
            bf16_t* dst = VT + (vch * 8) * 72 + lane;
            dst[0 * 72] = (bf16_t)(r.x & 0xffff); dst[1 * 72] = (bf16_t)(r.x >> 16); dst[2 * 72] = (bf16_t)(r.y & 0xffff); dst[3 * 72] = (bf16_t)(r.y >> 16);
            dst[4 * 72] = (bf16_t)(r.z & 0xffff); dst[5 * 72] = (bf16_t)(r.z >> 16); dst[6 * 72] = (bf16_t)(r.w & 0xffff); dst[7 * 72] = (bf16_t)(r.w >> 16);
        }
    }
    __syncthreads();
    {
        const int tt = wid >> 1;
#pragma unroll
        for (int j = 0; j < 2; ++j) {
            const int st = 2 * (wid & 1) + j;
            const int t = 16 * tt + fr, s0 = 16 * st + 4 * fq;
            u32x2 w; w.x = 0u; w.y = 0u;
            if (st <= tt) {
                f32x4 a = (f32x4){0.f, 0.f, 0.f, 0.f};
#pragma unroll
                for (int kd = 0; kd < 4; ++kd) {
                    const bf16x8 x = *(const bf16x8*)(Ks + (16 * st + fr) * 136 + 32 * kd + 8 * fq);
                    const bf16x8 y = *(const bf16x8*)(Qs + (16 * tt + fr) * 136 + 32 * kd + 8 * fq);
                    a = MFMA32(x, y, a);
                }
                const float e0 = bt[t] - mt[t];
                float vals[4];
#pragma unroll
                for (int i = 0; i < 4; ++i) { const int s = s0 + i; vals[i] = (s <= t) ? a[i] * __expf(e0 + lmb[s]) : 0.f; }
                float rs = (vals[0] + vals[1]) + (vals[2] + vals[3]);
                rs += __shfl_xor(rs, 16); rs += __shfl_xor(rs, 32);
                if (fq == 0) atomicAdd(&den[t], rs);
                w.x = cvt_pk_bf16(vals[0], vals[1]); w.y = cvt_pk_bf16(vals[2], vals[3]);
            }
            *(u32x2*)(Ac + t * 200 + s0) = w;
        }
#pragma unroll
        for (int i = 0; i < 8; ++i) {
            const int t = 8 * wid + i;
            float a = bf2f(Qs[t * 136 + lane]) * npv[lane] + bf2f(Qs[t * 136 + 64 + lane]) * npv[64 + lane];
            a = wave_sum(a);
            if (lane == 0) atomicAdd(&den[t], at[t] * a);
        }
    }
    __syncthreads();
    f32x4 acc[4][2];
#pragma unroll
    for (int a = 0; a < 4; ++a)
#pragma unroll
        for (int d = 0; d < 2; ++d) acc[a][d] = (f32x4){0.f, 0.f, 0.f, 0.f};
#pragma unroll
    for (int kk = 0; kk < 6; ++kk) {
        bf16x8 x[2];
#pragma unroll
        for (int vt = 0; vt < 2; ++vt) x[vt] = (kk < 2) ? *(const bf16x8*)(VT + (32 * wid + 16 * vt + fr) * 72 + 32 * kk + 8 * fq) : cf[vt][kk >= 2 ? kk - 2 : 0];
#pragma unroll
        for (int tt = 0; tt < 4; ++tt) {
            const bf16x8 y = *(const bf16x8*)(Ac + (16 * tt + fr) * 200 + 32 * kk + 8 * fq);
#pragma unroll
            for (int vt = 0; vt < 2; ++vt) acc[tt][vt] = MFMA32(x[vt], y, acc[tt][vt]);
        }
    }
#pragma unroll
    for (int tt = 0; tt < 4; ++tt) {
        const int t = 16 * tt + fr;
        const float inv = 1.f / fmaxf(fabsf(den[t]), __expf(-mt[t]));
        float ssq = 0.f;
#pragma unroll
        for (int vt = 0; vt < 2; ++vt) { acc[tt][vt] = acc[tt][vt] * inv; const f32x4 a = acc[tt][vt]; ssq += (a.x * a.x + a.y * a.y) + (a.z * a.z + a.w * a.w); }
        ssq += __shfl_xor(ssq, 16); ssq += __shfl_xor(ssq, 32);
        if (fq == 0) atomicAdd(&hss[t], ssq);
    }
    __syncthreads();
    {
        bf16_t* HG = (bf16_t*)(ws + WS_HG);
#pragma unroll
        for (int tt = 0; tt < 4; ++tt) {
            const int t = 16 * tt + fr;
            const float rstd = rsqrtf(hss[t] * (1.f / 256.f) + EPS);
#pragma unroll
            for (int vt = 0; vt < 2; ++vt) {
                const int v0 = 32 * wid + 16 * vt + 4 * fq;
                const u32x2 ob = *(const u32x2*)(P + (size_t)(base + t) * NIN + 2048 + h * 256 + v0);
                const f32x4 g = *(const f32x4*)(p.ml_head_g + h * 256 + v0);
                const f32x4 a = acc[tt][vt];
                u32x2 w;
                w.x = cvt_pk_bf16(a.x * rstd * g.x * sigmoidf_(bflo(ob.x)), a.y * rstd * g.y * sigmoidf_(bfhi(ob.x)));
                w.y = cvt_pk_bf16(a.z * rstd * g.z * sigmoidf_(bflo(ob.y)), a.w * rstd * g.w * sigmoidf_(bfhi(ob.y)));
                *(u32x2*)(HG + (size_t)(base + t) * D + h * 256 + v0) = w;
            }
        }
    }
    __syncthreads();
}

__device__ __forceinline__ void norm_frag(const u32x4 r0, const u32x4 r1, const float* __restrict__ g, float extra, int fq, bf16x8& o0, bf16x8& o1) {
    float f[16];
    f[0] = bflo(r0.x); f[1] = bfhi(r0.x); f[2] = bflo(r0.y); f[3] = bfhi(r0.y); f[4] = bflo(r0.z); f[5] = bfhi(r0.z); f[6] = bflo(r0.w); f[7] = bfhi(r0.w);
    f[8] = bflo(r1.x); f[9] = bfhi(r1.x); f[10] = bflo(r1.y); f[11] = bfhi(r1.y); f[12] = bflo(r1.z); f[13] = bfhi(r1.z); f[14] = bflo(r1.w); f[15] = bfhi(r1.w);
    float s = 0.f;
#pragma unroll
    for (int i = 0; i < 16; ++i) s += f[i] * f[i];
    s += __shfl_xor(s, 16); s += __shfl_xor(s, 32);
    const float rs = rsqrtf(s * (1.f / 64.f) + EPS) * extra;
    const f32x4 ga = *(const f32x4*)(g + 8 * fq), gb = *(const f32x4*)(g + 8 * fq + 4), gc = *(const f32x4*)(g + 32 + 8 * fq), gd = *(const f32x4*)(g + 32 + 8 * fq + 4);
    u32x4 a, b2;
    a.x = cvt_pk_bf16(f[0] * rs * ga.x, f[1] * rs * ga.y); a.y = cvt_pk_bf16(f[2] * rs * ga.z, f[3] * rs * ga.w);
    a.z = cvt_pk_bf16(f[4] * rs * gb.x, f[5] * rs * gb.y); a.w = cvt_pk_bf16(f[6] * rs * gb.z, f[7] * rs * gb.w);
    b2.x = cvt_pk_bf16(f[8] * rs * gc.x, f[9] * rs * gc.y); b2.y = cvt_pk_bf16(f[10] * rs * gc.z, f[11] * rs * gc.w);
    b2.z = cvt_pk_bf16(f[12] * rs * gd.x, f[13] * rs * gd.y); b2.w = cvt_pk_bf16(f[14] * rs * gd.z, f[15] * rs * gd.w);
    o0 = __builtin_bit_cast(bf16x8, a); o1 = __builtin_bit_cast(bf16x8, b2);
}

__device__ __forceinline__ void attn_prompt_unit(const Params& p, unsigned char* lds, int u) {
    const int tid = threadIdx.x, lane = tid & 63, wid = tid >> 6, fr = lane & 15, fq = lane >> 4;
    const int qb = u & 31, kvh = (u >> 5) & 3, b = u >> 7;
    unsigned char* ws = p.ws;
    const bf16_t* KVQ = (const bf16_t*)(ws + WS_KVQ);
    bf16_t* AO = (bf16_t*)(ws + WS_ATT);
    bf16_t* Ks = (bf16_t*)lds;
    bf16_t* VT = Ks + 256 * 72;
    const int pos0 = qb * 128 - 128;
    u32x4 qr[4][2];
    {
        const int g_ = wid >> 1, half_ = wid & 1, head_ = kvh * 4 + g_;
#pragma unroll
        for (int m = 0; m < 4; ++m) {
            const bf16_t* qp = KVQ + ((size_t)b * 4096 + qb * 128 + 64 * half_ + 16 * m + fr) * NKVQ + 512 + head_ * 64;
            qr[m][0] = *(const u32x4*)(qp + 8 * fq); qr[m][1] = *(const u32x4*)(qp + 32 + 8 * fq);
        }
    }
#pragma unroll
    for (int i = 0; i < 4; ++i) {
        const int ci = tid + 512 * i, j = ci >> 3, ch = ci & 7, pos = pos0 + j;
        u32x4 r = (u32x4){0u, 0u, 0u, 0u};
        if (pos >= 0) r = *(const u32x4*)(KVQ + (size_t)(b * 4096 + pos) * NKVQ + kvh * 64 + ch * 8);
        float f[8] = {bflo(r.x), bfhi(r.x), bflo(r.y), bfhi(r.y), bflo(r.z), bfhi(r.z), bflo(r.w), bfhi(r.w)};
        float s = 0.f;
#pragma unroll
        for (int e = 0; e < 8; ++e) s += f[e] * f[e];
        s += __shfl_xor(s, 1); s += __shfl_xor(s, 2); s += __shfl_xor(s, 4);
        const float rs = rsqrtf(s * (1.f / 64.f) + EPS);
        const f32x4 g0 = *(const f32x4*)(p.k_norm_g + ch * 8), g1 = *(const f32x4*)(p.k_norm_g + ch * 8 + 4);
        f[0] *= rs * g0.x; f[1] *= rs * g0.y; f[2] *= rs * g0.z; f[3] *= rs * g0.w; f[4] *= rs * g1.x; f[5] *= rs * g1.y; f[6] *= rs * g1.z; f[7] *= rs * g1.w;
        u32x4 w; w.x = cvt_pk_bf16(f[0], f[1]); w.y = cvt_pk_bf16(f[2], f[3]); w.z = cvt_pk_bf16(f[4], f[5]); w.w = cvt_pk_bf16(f[6], f[7]);
        *(u32x4*)(Ks + j * 72 + ch * 8) = w;
        if (qb == 31 && j >= 128) {
            float* o = p.out + O_PWK + ((size_t)(b * 128 + (j - 128)) * 4 + kvh) * 64 + ch * 8;
            *(f32x4*)o = (f32x4){f[0], f[1], f[2], f[3]}; *(f32x4*)(o + 4) = (f32x4){f[4], f[5], f[6], f[7]};
        }
    }
#pragma unroll
    for (int i = 0; i < 4; ++i) {
        const int ci = tid + 512 * i, j = ci & 255, ch = ci >> 8, pos = pos0 + j;
        u32x4 r = (u32x4){0u, 0u, 0u, 0u};
        if (pos >= 0) r = *(const u32x4*)(KVQ + (size_t)(b * 4096 + pos) * NKVQ + 256 + kvh * 64 + ch * 8);
        bf16_t* dst = VT + (ch * 8) * 264 + j;
        dst[0 * 264] = (bf16_t)(r.x & 0xffff); dst[1 * 264] = (bf16_t)(r.x >> 16); dst[2 * 264] = (bf16_t)(r.y & 0xffff); dst[3 * 264] = (bf16_t)(r.y >> 16);
        dst[4 * 264] = (bf16_t)(r.z & 0xffff); dst[5 * 264] = (bf16_t)(r.z >> 16); dst[6 * 264] = (bf16_t)(r.w & 0xffff); dst[7 * 264] = (bf16_t)(r.w >> 16);
        if (qb == 31 && j >= 128) {
            float* o = p.out + O_PWV + ((size_t)(b * 128 + (j - 128)) * 4 + kvh) * 64 + ch * 8;
            *(f32x4*)o = (f32x4){bflo(r.x), bfhi(r.x), bflo(r.y), bfhi(r.y)}; *(f32x4*)(o + 4) = (f32x4){bflo(r.z), bfhi(r.z), bflo(r.w), bfhi(r.w)};
        }
    }
    __syncthreads();
    const int g = wid >> 1, half = wid & 1, head = kvh * 4 + g;
    const float sink = p.att_sinks[head];
    const float* qg = p.q_norm_g;
#pragma unroll
    for (int m = 0; m < 4; ++m) {
        const int j0 = 64 * half + 16 * m;
        const size_t R = (size_t)b * 4096 + qb * 128 + j0 + fr;
        bf16x8 q0, q1; norm_frag(qr[m][0], qr[m][1], qg, 0.125f, fq, q0, q1);
        f32x4 s[9];
#pragma unroll
        for (int i = 0; i < 9; ++i) {
            s[i] = (f32x4){0.f, 0.f, 0.f, 0.f};
            const bf16_t* kr = Ks + (j0 + 16 * i + fr) * 72 + 8 * fq;
            s[i] = MFMA32(*(const bf16x8*)kr, q0, s[i]);
            s[i] = MFMA32(*(const bf16x8*)(kr + 32), q1, s[i]);
        }
        float mx = sink;
#pragma unroll
        for (int e = 0; e < 4; ++e) {
            s[0][e] = (4 * fq + e >= fr) ? s[0][e] : -INFINITY;
            s[8][e] = (4 * fq + e <= fr) ? s[8][e] : -INFINITY;
        }
        if (pos0 < 0) {
#pragma unroll
            for (int i = 0; i < 9; ++i)
#pragma unroll
                for (int e = 0; e < 4; ++e) s[i][e] = (pos0 + j0 + 16 * i + 4 * fq + e >= 0) ? s[i][e] : -INFINITY;
        }
#pragma unroll
        for (int i = 0; i < 9; ++i)
#pragma unroll
            for (int e = 0; e < 4; ++e) mx = fmaxf(mx, s[i][e]);
        mx = fmaxf(mx, __shfl_xor(mx, 16)); mx = fmaxf(mx, __shfl_xor(mx, 32));
        float l = 0.f;
        bf16x4 pf[9];
#pragma unroll
        for (int i = 0; i < 9; ++i) {
            float e0 = __expf(s[i][0] - mx), e1 = __expf(s[i][1] - mx), e2 = __expf(s[i][2] - mx), e3 = __expf(s[i][3] - mx);
            l += (e0 + e1) + (e2 + e3);
            u32x2 w; w.x = cvt_pk_bf16(e0, e1); w.y = cvt_pk_bf16(e2, e3);
            pf[i] = __builtin_bit_cast(bf16x4, w);
        }
        l += __shfl_xor(l, 16); l += __shfl_xor(l, 32);
        l += __expf(sink - mx);
        const float inv = 1.f / l;
        f32x4 o[4];
#pragma unroll
        for (int dt = 0; dt < 4; ++dt) {
            o[dt] = (f32x4){0.f, 0.f, 0.f, 0.f};
#pragma unroll
            for (int i = 0; i < 9; ++i) {
                const bf16x4 vf = *(const bf16x4*)(VT + (16 * dt + fr) * 264 + j0 + 16 * i + 4 * fq);
                o[dt] = MFMA16(vf, pf[i], o[dt]);
            }
        }
#pragma unroll
        for (int dt = 0; dt < 4; ++dt) {
            u32x2 w; w.x = cvt_pk_bf16(o[dt].x * inv, o[dt].y * inv); w.y = cvt_pk_bf16(o[dt].z * inv, o[dt].w * inv);
            *(u32x2*)(AO + R * D + head * 64 + 16 * dt + 4 * fq) = w;
        }
    }
    __syncthreads();
}

__device__ __forceinline__ void attn_sample_unit(const Params& p, int u, int lane) {
    const int fr = lane & 15, fq = lane >> 4;
    const int b = u >> 2, kvh = u & 3;
    unsigned char* ws = p.ws;
    const bf16_t* KVQ = (const bf16_t*)(ws + WS_KVQ);
    bf16_t* AO = (bf16_t*)(ws + WS_ATT);
    const float* ck = p.cache_k + (size_t)b * 128 * 256 + kvh * 64;
    const float* cv = p.cache_v + (size_t)b * 128 * 256 + kvh * 64;
    float* owk = p.out + O_SWK + (size_t)b * 128 * 256 + kvh * 64;
    float* owv = p.out + O_SWV + (size_t)b * 128 * 256 + kvh * 64;
    const size_t rbase = (size_t)TP + b * 4;
    for (int i = lane; i < 124 * 16; i += 64) {
        const int j = i >> 4, d4 = (i & 15) * 4;
        *(f32x4*)(owk + (size_t)j * 256 + d4) = *(const f32x4*)(ck + (size_t)(j + 4) * 256 + d4);
        *(f32x4*)(owv + (size_t)j * 256 + d4) = *(const f32x4*)(cv + (size_t)(j + 4) * 256 + d4);
    }
    {
        const int t = lane >> 4, d4 = (lane & 15) * 4;
        const u32x2 kr = *(const u32x2*)(KVQ + (rbase + t) * NKVQ + kvh * 64 + d4);
        const u32x2 vr = *(const u32x2*)(KVQ + (rbase + t) * NKVQ + 256 + kvh * 64 + d4);
        float f0 = bflo(kr.x), f1 = bfhi(kr.x), f2 = bflo(kr.y), f3 = bfhi(kr.y);
        float s = (f0 * f0 + f1 * f1) + (f2 * f2 + f3 * f3);
        s += __shfl_xor(s, 1); s += __shfl_xor(s, 2); s += __shfl_xor(s, 4); s += __shfl_xor(s, 8);
        const float rs = rsqrtf(s * (1.f / 64.f) + EPS);
        const f32x4 g = *(const f32x4*)(p.k_norm_g + d4);
        *(f32x4*)(owk + (size_t)(124 + t) * 256 + d4) = (f32x4){f0 * rs * g.x, f1 * rs * g.y, f2 * rs * g.z, f3 * rs * g.w};
        *(f32x4*)(owv + (size_t)(124 + t) * 256 + d4) = (f32x4){bflo(vr.x), bfhi(vr.x), bflo(vr.y), bfhi(vr.y)};
    }
    const int g = fr >> 2, t = fr & 3, head = kvh * 4 + g;
    const bf16_t* qp = KVQ + (rbase + t) * NKVQ + 512 + head * 64;
    const u32x4 r0 = *(const u32x4*)(qp + 8 * fq), r1 = *(const u32x4*)(qp + 32 + 8 * fq);
    bf16x8 q0, q1; norm_frag(r0, r1, p.q_norm_g, 0.125f, fq, q0, q1);
    const float sink = p.att_sinks[head];
    bf16x8 nk0, nk1;
    {
        const bf16_t* kp = KVQ + (rbase + (fr & 3)) * NKVQ + kvh * 64;
        const u32x4 a0 = *(const u32x4*)(kp + 8 * fq), a1 = *(const u32x4*)(kp + 32 + 8 * fq);
        norm_frag(a0, a1, p.k_norm_g, 1.f, fq, nk0, nk1);
        if (fr >= 4) { nk0 = (bf16x8){0, 0, 0, 0, 0, 0, 0, 0}; nk1 = nk0; }
    }
    f32x4 s[9];
#pragma unroll
    for (int i = 0; i < 8; ++i) {
        const float* kr = ck + (size_t)(16 * i + fr) * 256 + 8 * fq;
        const f32x4 a = *(const f32x4*)kr, b2 = *(const f32x4*)(kr + 4), c = *(const f32x4*)(kr + 32), d = *(const f32x4*)(kr + 36);
        u32x4 x0, x1;
        x0.x = cvt_pk_bf16(a.x, a.y); x0.y = cvt_pk_bf16(a.z, a.w); x0.z = cvt_pk_bf16(b2.x, b2.y); x0.w = cvt_pk_bf16(b2.z, b2.w);
        x1.x = cvt_pk_bf16(c.x, c.y); x1.y = cvt_pk_bf16(c.z, c.w); x1.z = cvt_pk_bf16(d.x, d.y); x1.w = cvt_pk_bf16(d.z, d.w);
        s[i] = (f32x4){0.f, 0.f, 0.f, 0.f};
        s[i] = MFMA32(__builtin_bit_cast(bf16x8, x0), q0, s[i]);
        s[i] = MFMA32(__builtin_bit_cast(bf16x8, x1), q1, s[i]);
    }
    s[8] = (f32x4){0.f, 0.f, 0.f, 0.f};
    s[8] = MFMA32(nk0, q0, s[8]); s[8] = MFMA32(nk1, q1, s[8]);
    float mx = sink;
#pragma unroll
    for (int i = 0; i < 9; ++i)
#pragma unroll
        for (int e = 0; e < 4; ++e) {
            const int j = 16 * i + 4 * fq + e;
            const bool ok = (j >= t) && (j <= t + 128);
            s[i][e] = ok ? s[i][e] : -INFINITY;
            mx = fmaxf(mx, s[i][e]);
        }
    mx = fmaxf(mx, __shfl_xor(mx, 16)); mx = fmaxf(mx, __shfl_xor(mx, 32));
    float l = 0.f; bf16x4 pf[9];
#pragma unroll
    for (int i = 0; i < 9; ++i) {
        float e0 = __expf(s[i][0] - mx), e1 = __expf(s[i][1] - mx), e2 = __expf(s[i][2] - mx), e3 = __expf(s[i][3] - mx);
        l += (e0 + e1) + (e2 + e3);
        u32x2 w; w.x = cvt_pk_bf16(e0, e1); w.y = cvt_pk_bf16(e2, e3);
        pf[i] = __builtin_bit_cast(bf16x4, w);
    }
    l += __shfl_xor(l, 16); l += __shfl_xor(l, 32);
    l += __expf(sink - mx);
    const float inv = 1.f / l;
#pragma unroll
    for (int dt = 0; dt < 4; ++dt) {
        f32x4 o = (f32x4){0.f, 0.f, 0.f, 0.f};
#pragma unroll
        for (int i = 0; i < 8; ++i) {
            const float* vr = cv + (size_t)(16 * i + 4 * fq) * 256 + 16 * dt + fr;
            u32x2 w; w.x = cvt_pk_bf16(vr[0], vr[256]); w.y = cvt_pk_bf16(vr[512], vr[768]);
            o = MFMA16(__builtin_bit_cast(bf16x4, w), pf[i], o);
        }
        {
            u32x2 w; w.x = 0u; w.y = 0u;
            const bf16_t* vp = KVQ + rbase * NKVQ + 256 + kvh * 64 + 16 * dt + fr;
            const unsigned v0 = vp[0], v1 = vp[NKVQ], v2 = vp[2 * NKVQ], v3 = vp[3 * NKVQ];
            if (fq == 0) { w.x = v0 | (v1 << 16); w.y = v2 | (v3 << 16); }
            o = MFMA16(__builtin_bit_cast(bf16x4, w), pf[8], o);
        }
        u32x2 w; w.x = cvt_pk_bf16(o.x * inv, o.y * inv); w.y = cvt_pk_bf16(o.z * inv, o.w * inv);
        *(u32x2*)(AO + (rbase + t) * D + head * 64 + 16 * dt + 4 * fq) = w;
    }
}


__device__ __forceinline__ void attn_sample_block(const Params& p, unsigned char* lds, int u) {
    const int tid = threadIdx.x, lane = tid & 63, wid = tid >> 6, fr = lane & 15, fq = lane >> 4;
    const int b = u >> 2, kvh = u & 3;
    unsigned char* ws = p.ws;
    const bf16_t* KVQ = (const bf16_t*)(ws + WS_KVQ);
    bf16_t* AO = (bf16_t*)(ws + WS_ATT);
    const float* ck = p.cache_k + (size_t)b * 128 * 256 + kvh * 64;
    const float* cv = p.cache_v + (size_t)b * 128 * 256 + kvh * 64;
    float* owk = p.out + O_SWK + (size_t)b * 128 * 256 + kvh * 64;
    float* owv = p.out + O_SWV + (size_t)b * 128 * 256 + kvh * 64;
    const size_t rbase = (size_t)TP + b * 4;
    bf16_t* Ks = (bf16_t*)lds;
    bf16_t* VT = Ks + 144 * 72;
    f32x4 kf[4], vf[4];
#pragma unroll
    for (int i = 0; i < 4; ++i) { const int idx = tid + 512 * i, j = idx >> 4, c4 = (idx & 15) * 4; kf[i] = __builtin_nontemporal_load((const f32x4*)(ck + (size_t)j * 256 + c4)); vf[i] = __builtin_nontemporal_load((const f32x4*)(cv + (size_t)j * 256 + c4)); }
#pragma unroll
    for (int i = 0; i < 4; ++i) {
        const int idx = tid + 512 * i, j = idx >> 4, c4 = (idx & 15) * 4;
        if (j >= 4) { *(f32x4*)(owk + (size_t)(j - 4) * 256 + c4) = kf[i]; *(f32x4*)(owv + (size_t)(j - 4) * 256 + c4) = vf[i]; }
        u32x2 w; w.x = cvt_pk_bf16(kf[i].x, kf[i].y); w.y = cvt_pk_bf16(kf[i].z, kf[i].w);
        *(u32x2*)(Ks + j * 72 + c4) = w;
        VT[(c4 + 0) * 152 + j] = f2bf(vf[i].x); VT[(c4 + 1) * 152 + j] = f2bf(vf[i].y); VT[(c4 + 2) * 152 + j] = f2bf(vf[i].z); VT[(c4 + 3) * 152 + j] = f2bf(vf[i].w);
    }
    if (tid < 64) {
        const int t = tid >> 4, d4 = (tid & 15) * 4;
        const u32x2 kr = *(const u32x2*)(KVQ + (rbase + t) * NKVQ + kvh * 64 + d4);
        const u32x2 vr = *(const u32x2*)(KVQ + (rbase + t) * NKVQ + 256 + kvh * 64 + d4);
        float f0 = bflo(kr.x), f1 = bfhi(kr.x), f2 = bflo(kr.y), f3 = bfhi(kr.y);
        float s = (f0 * f0 + f1 * f1) + (f2 * f2 + f3 * f3);
        s += __shfl_xor(s, 1); s += __shfl_xor(s, 2); s += __shfl_xor(s, 4); s += __shfl_xor(s, 8);
        const float rs = rsqrtf(s * (1.f / 64.f) + EPS);
        const f32x4 g = *(const f32x4*)(p.k_norm_g + d4);
        f0 *= rs * g.x; f1 *= rs * g.y; f2 *= rs * g.z; f3 *= rs * g.w;
        *(f32x4*)(owk + (size_t)(124 + t) * 256 + d4) = (f32x4){f0, f1, f2, f3};
        *(f32x4*)(owv + (size_t)(124 + t) * 256 + d4) = (f32x4){bflo(vr.x), bfhi(vr.x), bflo(vr.y), bfhi(vr.y)};
        u32x2 w; w.x = cvt_pk_bf16(f0, f1); w.y = cvt_pk_bf16(f2, f3);
        *(u32x2*)(Ks + (128 + t) * 72 + d4) = w;
        VT[(d4 + 0) * 152 + 128 + t] = (bf16_t)(vr.x & 0xffff); VT[(d4 + 1) * 152 + 128 + t] = (bf16_t)(vr.x >> 16);
        VT[(d4 + 2) * 152 + 128 + t] = (bf16_t)(vr.y & 0xffff); VT[(d4 + 3) * 152 + 128 + t] = (bf16_t)(vr.y >> 16);
    } else if (tid < 64 + 192) {
        const int i = tid - 64;
        if (i < 96) { const int r = 132 + (i >> 3), c8 = (i & 7) * 8; *(u32x4*)(Ks + r * 72 + c8) = (u32x4){0u, 0u, 0u, 0u}; }
        else { const int d = i - 96; if (d < 64) { bf16_t* z = VT + d * 152 + 132; for (int e = 0; e < 12; ++e) z[e] = 0; } }
    }
    __syncthreads();
    if (wid < 4) {
        const int dt = wid;
        const int g = fr >> 2, t = fr & 3, head = kvh * 4 + g;
        const bf16_t* qp = KVQ + (rbase + t) * NKVQ + 512 + head * 64;
        const u32x4 r0 = *(const u32x4*)(qp + 8 * fq), r1 = *(const u32x4*)(qp + 32 + 8 * fq);
        bf16x8 q0, q1; norm_frag(r0, r1, p.q_norm_g, 0.125f, fq, q0, q1);
        const float sink = p.att_sinks[head];
        f32x4 s[9];
#pragma unroll
        for (int i = 0; i < 9; ++i) {
            s[i] = (f32x4){0.f, 0.f, 0.f, 0.f};
            const bf16_t* kr = Ks + (16 * i + fr) * 72 + 8 * fq;
            s[i] = MFMA32(*(const bf16x8*)kr, q0, s[i]);
            s[i] = MFMA32(*(const bf16x8*)(kr + 32), q1, s[i]);
        }
        float mx = sink;
#pragma unroll
        for (int i = 0; i < 9; ++i)
#pragma unroll
            for (int e = 0; e < 4; ++e) {
                const int j = 16 * i + 4 * fq + e;
                const bool ok = (j >= t) && (j <= t + 128);
                s[i][e] = ok ? s[i][e] : -INFINITY;
                mx = fmaxf(mx, s[i][e]);
            }
        mx = fmaxf(mx, __shfl_xor(mx, 16)); mx = fmaxf(mx, __shfl_xor(mx, 32));
        float l = 0.f;
        f32x4 o = (f32x4){0.f, 0.f, 0.f, 0.f};
#pragma unroll
        for (int i = 0; i < 9; ++i) {
            const float e0 = __expf(s[i][0] - mx), e1 = __expf(s[i][1] - mx), e2 = __expf(s[i][2] - mx), e3 = __expf(s[i][3] - mx);
            l += (e0 + e1) + (e2 + e3);
            u32x2 w; w.x = cvt_pk_bf16(e0, e1); w.y = cvt_pk_bf16(e2, e3);
            const bf16x4 vfr = *(const bf16x4*)(VT + (16 * dt + fr) * 152 + 16 * i + 4 * fq);
            o = MFMA16(vfr, __builtin_bit_cast(bf16x4, w), o);
        }
        l += __shfl_xor(l, 16); l += __shfl_xor(l, 32);
        l += __expf(sink - mx);
        const float inv = 1.f / l;
        u32x2 w; w.x = cvt_pk_bf16(o.x * inv, o.y * inv); w.y = cvt_pk_bf16(o.z * inv, o.w * inv);
        *(u32x2*)(AO + (rbase + t) * D + head * 64 + 16 * dt + 4 * fq) = w;
    }
    __syncthreads();
}

#define LAS __attribute__((address_space(3)))
#define XB_TMO      128
#define XB_XCNT(j)  (256  + 64 * (j))
#define XB_XSUB(j)  (1280 + 64 * (j))
#define XB_XGEN(j)  (2304 + 64 * (j))
#define XB_TOP      3328
#define XB_TOPGEN   3392
#define XCD_BAR_WORDS 3456
#define XB_SPIN_CAP (1u << 18)

__device__ __forceinline__ unsigned xb_ld(unsigned* p)              { return __hip_atomic_load(p, __ATOMIC_RELAXED, __HIP_MEMORY_SCOPE_AGENT); }
__device__ __forceinline__ unsigned xb_add(unsigned* p, unsigned v) { return __hip_atomic_fetch_add(p, v, __ATOMIC_RELAXED, __HIP_MEMORY_SCOPE_AGENT); }
__device__ __forceinline__ unsigned xb_xcc_id() { return (unsigned)__builtin_amdgcn_s_getreg((3 << 11) | 20) & 0xFu; }
#define XB_SPIN(cond, bar) do { unsigned _sp = 0; while (cond) { __builtin_amdgcn_s_sleep(1); \
    if ((++_sp & 255u) == 0u) { if (xb_ld(&(bar)[XB_TMO])) break; if (_sp > XB_SPIN_CAP) { atomicAdd(&(bar)[XB_TMO], 1u); break; } } } } while (0)

struct XcdBarrier {
    unsigned* bar; unsigned x;
    volatile LAS unsigned* st;
};

__device__ __forceinline__ XcdBarrier xcd_barrier_post(unsigned* bar, volatile LAS unsigned* st) {
    XcdBarrier b; b.bar = bar; b.x = xb_xcc_id(); b.st = st;
    if (threadIdx.x == 0) (void)xb_add(&bar[XB_XCNT(b.x)], 1u);
    return b;
}
__device__ __forceinline__ void xcd_barrier_complete(unsigned* bar, unsigned x, unsigned& nloc, unsigned& nx) {
    const unsigned G = gridDim.x * gridDim.y * gridDim.z;
    unsigned sum, cnt, mine, sp = 0u;
    for (;;) {
        sum = 0u; cnt = 0u; mine = 0u;
#pragma unroll
        for (unsigned j = 0; j < 16; ++j) { const unsigned c = xb_ld(&bar[XB_XCNT(j)]); sum += c; cnt += (c > 0u) ? 1u : 0u; mine = (j == x) ? c : mine; }
        if (sum == G) break;
        __builtin_amdgcn_s_sleep(1);
        if ((++sp & 255u) == 0u) { if (xb_ld(&bar[XB_TMO])) break; if (sp > XB_SPIN_CAP) { atomicAdd(&bar[XB_TMO], 1u); break; } }
    }
    nloc = mine > 0u ? mine : 1u; nx = cnt > 0u ? cnt : 1u;
}

__device__ __forceinline__ void xcd_barrier(const XcdBarrier& b) {
    asm volatile("s_waitcnt vmcnt(0)" ::: "memory");
    __syncthreads();
    if (threadIdx.x == 0) {
        unsigned* bar = b.bar;
        __builtin_amdgcn_s_waitcnt(0);
        unsigned nloc = b.st[0], nx = b.st[1];
        if (nloc == 0u) { xcd_barrier_complete(bar, b.x, nloc, nx); b.st[0] = nloc; b.st[1] = nx; }
        const unsigned old = xb_add(&bar[XB_XSUB(b.x)], 1u);
        const unsigned gen = old / nloc;
        if (old + 1u == (gen + 1u) * nloc) {
            __builtin_amdgcn_fence(__ATOMIC_RELEASE, "agent");
            asm volatile("s_waitcnt vmcnt(0)" ::: "memory");
            const unsigned og = xb_add(&bar[XB_TOP], 1u);
            const unsigned tg = og / nx;
            if (og + 1u == (tg + 1u) * nx) xb_add(&bar[XB_TOPGEN], 1u);
            else XB_SPIN(xb_ld(&bar[XB_TOPGEN]) == tg, bar);
            __builtin_amdgcn_fence(__ATOMIC_ACQUIRE, "agent");
            xb_add(&bar[XB_XGEN(b.x)], 1u);
            asm volatile("s_waitcnt vmcnt(0)" ::: "memory");
        } else {
            XB_SPIN(xb_ld(&bar[XB_XGEN(b.x)]) == gen, bar);
            __builtin_amdgcn_fence(__ATOMIC_ACQUIRE, "agent");
            asm volatile("s_waitcnt vmcnt(0)" ::: "memory");
        }
    }
    __syncthreads();
}

__global__ void __launch_bounds__(NTHREADS) yoco_fwd(Params p) {
    extern __shared__ __attribute__((aligned(16))) unsigned char lds[];
    const int bid = blockIdx.x, G = gridDim.x;
    unsigned char* ws = p.ws;
    float* SS = (float*)(ws + WS_SS);
    float* Y = p.out + O_Y;
    bf16_t* XB = (bf16_t*)(ws + WS_XB);

#define IN(k) (p.ph_lo <= (k) && (k) < p.ph_hi)
    volatile LAS unsigned* bst = (volatile LAS unsigned*)((LAS unsigned char*)lds + 131072 + 64);
    XcdBarrier xbar; xbar.bar = (unsigned*)(ws + WS_BAR); xbar.x = 0; xbar.st = bst;
    int cv = bid;
    if (p.ph_hi - p.ph_lo > 1) {
        if (threadIdx.x < 8) bst[threadIdx.x] = 0u;
        __syncthreads();
        xbar.x = xb_xcc_id();
        if (threadIdx.x == 0) bst[2] = xb_add(&xbar.bar[XB_XCNT(xbar.x)], 1u);
    }
#define SEAM(k) do { if (IN(k) && IN((k) + 1)) xcd_barrier(xbar); } while (0)
    if (IN(0)) { for (int rep = 0; rep < REP_P0; ++rep) p0_prologue(p, lds, bid, G); }
    SEAM(0);
    if (p.ph_hi - p.ph_lo > 1 && IN(0) && IN(1)) {
        if (threadIdx.x == 0) {
            bool ok = (G % 8 == 0) && xbar.x < 8u;
            for (unsigned j = 0; j < 8; ++j) ok = ok && (xb_ld(&xbar.bar[XB_XCNT(j)]) == (unsigned)(G / 8));
            const unsigned rank = bst[2];
            bst[3] = (ok && rank < (unsigned)(G / 8)) ? (xbar.x + 8u * rank) : (unsigned)bid;
        }
        __syncthreads();
        cv = __builtin_amdgcn_readfirstlane((int)bst[3]);
    }
    PG8_LAS unsigned char* l3 = (PG8_LAS unsigned char*)lds;
    float* YS = Y;
#define PGEMM(Aptr, Bptr, Nn, Kk, EpiT, ...) do { pg8::Gemm g_{(const bf16_t*)(Aptr), (const bf16_t*)(Bptr), TP, (Nn), (Kk), ((Kk) == FF) ? 1 : 0}; pg8::StaticOrder S_; S_.init(TP, (Nn), G, cv); \
        Pg8Epi<EpiT> E_{EpiT{__VA_ARGS__}}; pg8::gemm_phase<Pg8Epi<EpiT>, pg8::StaticOrder, true, true>(l3, g_, S_, E_); } while (0)
    if (IN(1)) {
        for (int rep = 0; rep < REP_PG; ++rep) { PGEMM(XB, ws + WS_WIN, NIN, 1024, EpiBf16, (bf16_t*)(ws + WS_P), NIN, nullptr, 0); }
        { EpiBf16 E{(bf16_t*)(ws + WS_P), NIN, nullptr, 0}; for (int rep = 0; rep < REP_SG; ++rep) sgemm64<0>(lds, XB, 1024, (const bf16_t*)(ws + WS_WIN), TP, TS, NIN, 1024, 1, E, bid, G); }
    }
    SEAM(1);
    if (IN(2)) {
        for (int rep = 0; rep < REP_2AL; ++rep) for (int u = bid; u < 1024; u += G) mlstm_local_unit(p, lds, u);
        for (int rep = 0; rep < REP_2AS; ++rep) for (int u = bid; u < 512; u += G) mlstm_sample_unit(p, lds, u);
    }
    SEAM(2);
    if (IN(3)) mlstm_scan(p, lds, bid, G);
    SEAM(3);
    if (IN(4)) { for (int rep = 0; rep < REP_2C; ++rep) for (int u = bid; u < 1024; u += G) mlstm_out_unit(p, lds, u); }
    SEAM(4);
    if (IN(5)) {
        PGEMM(ws + WS_HG, ws + WS_WOUT, 1024, 1024, EpiResB, p.x_prompt, XB, nullptr, SS);
        { EpiAddF32 E{YS}; sgemm64<0>(lds, ws + WS_HG, 1024, (const bf16_t*)(ws + WS_WOUT), TP, TS, 1024, 1024, 1, E, bid, G); }
    }
    SEAM(5);
    if (IN(6)) {
        for (int rep = 0; rep < REP_PG; ++rep) { PGEMM(XB, ws + WS_W1A, FF, 1024, EpiBf16, (bf16_t*)(ws + WS_HID), FF, SS, 1); }
        { EpiBf16 E{(bf16_t*)(ws + WS_HID), FF, nullptr, 1}; for (int rep = 0; rep < REP_SG; ++rep) sgemm64<1>(lds, Y, 1024, (const bf16_t*)(ws + WS_W1A), TP, TS, FF, 1024, 1, E, bid, G); }
    }
    SEAM(6);
    if (IN(7)) {
        PGEMM(ws + WS_HID, ws + WS_W2A, 1024, FF, EpiResB, nullptr, XB, nullptr, SS + T);
        { EpiAtomic E{YS}; sgemm64<0>(lds, ws + WS_HID, FF, (const bf16_t*)(ws + WS_W2A), TP, TS, 1024, FF, 2, E, bid, G); }
    }
    SEAM(7);
    if (IN(8)) {
        for (int rep = 0; rep < REP_PG; ++rep) { PGEMM(XB, ws + WS_WKVQ, NKVQ, 1024, EpiBf16, (bf16_t*)(ws + WS_KVQ), NKVQ, SS + T, 0); }
        { EpiBf16 E{(bf16_t*)(ws + WS_KVQ), NKVQ, nullptr, 0}; for (int rep = 0; rep < REP_SG; ++rep) sgemm64<1>(lds, Y, 1024, (const bf16_t*)(ws + WS_WKVQ), TP, TS, NKVQ, 1024, 1, E, (cv + G / 2) % G, G); }
        __syncthreads();
        if (cv >= G / 2) late_weights(p, lds, cv - G / 2, G - G / 2);
    }
    SEAM(8);
    if (IN(9)) {
        { const int vb = (G % 8 == 0) ? (cv % 8) * (G / 8) + cv / 8 : cv;
          for (int rep = 0; rep < REP_7P; ++rep) for (int u = vb; u < 512; u += G) attn_prompt_unit(p, lds, u); }
        for (int rep = 0; rep < REP_7S; ++rep) for (int u = bid; u < 512; u += G) attn_sample_block(p, lds, u);
    }
    SEAM(9);
    if (IN(10)) {
        PGEMM(ws + WS_ATT, ws + WS_WO, 1024, 1024, EpiResB, nullptr, XB, nullptr, SS + 2 * T);
        { EpiAddF32 E{YS}; sgemm64<0>(lds, ws + WS_ATT, 1024, (const bf16_t*)(ws + WS_WO), TP, TS, 1024, 1024, 1, E, bid, G); }
    }
    SEAM(10);
    if (IN(11)) {
        for (int rep = 0; rep < REP_PG; ++rep) { PGEMM(XB, ws + WS_W1B, FF, 1024, EpiBf16, (bf16_t*)(ws + WS_HID), FF, SS + 2 * T, 1); }
        { EpiBf16 E{(bf16_t*)(ws + WS_HID), FF, nullptr, 1}; for (int rep = 0; rep < REP_SG; ++rep) sgemm64<1>(lds, Y, 1024, (const bf16_t*)(ws + WS_W1B), TP, TS, FF, 1024, 1, E, bid, G); }
    }
    SEAM(11);
    if (IN(12)) {
        PGEMM(ws + WS_HID, ws + WS_W2B, 1024, FF, EpiResB, nullptr, XB, Y, nullptr);
        { EpiAtomic E{YS}; sgemm64<0>(lds, ws + WS_HID, FF, (const bf16_t*)(ws + WS_W2B), TP, TS, 1024, FF, 2, E, bid, G); }
    }
#undef PGEMM
#undef IN
#undef SEAM
}

extern "C" void kernel_launch(void* const* d_in, const int* in_sizes, int n_in, void* d_out, int out_size, void* d_ws, size_t ws_size, hipStream_t stream) {
    static int grid_blocks = 0;
    if (!grid_blocks) {
        if (n_in != 24 || (size_t)out_size != O_END || ws_size < WS_END) { fprintf(stderr, "kernel_launch: unexpected shapes n_in=%d out=%d ws=%zu\n", n_in, out_size, ws_size); grid_blocks = -1; return; }
        int dev = 0, cus = 0, per_cu = 0;
        hipGetDevice(&dev);
        hipDeviceGetAttribute(&cus, hipDeviceAttributeMultiprocessorCount, dev);
        hipFuncSetAttribute((const void*)yoco_fwd, hipFuncAttributeMaxDynamicSharedMemorySize, LDS_BYTES);
        hipOccupancyMaxActiveBlocksPerMultiprocessor(&per_cu, (const void*)yoco_fwd, NTHREADS, LDS_BYTES);
        if (per_cu < 1) per_cu = 1;
        grid_blocks = cus * per_cu;
        (void)hipGetLastError();
    }
    if (grid_blocks < 0) return;
    Params p{};
    const float** pp = (const float**)&p;
    for (int i = 0; i < 24; ++i) pp[i] = (const float*)d_in[i];
    p.out = (float*)d_out; p.ws = (unsigned char*)d_ws;
#if N_LAUNCH_MODE == 1
    p.ph_lo = 0; p.ph_hi = 13;
    (void)hipMemsetAsync((char*)d_ws + WS_BAR, 0, BAR_BYTES, stream);
    void* args[] = {&p};
    hipError_t e = hipLaunchCooperativeKernel((const void*)yoco_fwd, dim3(grid_blocks), dim3(NTHREADS), args, LDS_BYTES, stream);
    if (e != hipSuccess) fprintf(stderr, "cooperative launch failed: %s (grid %d)\n", hipGetErrorString(e), grid_blocks);
#else
    for (int k = 0; k < MAX_PHASE; ++k) { p.ph_lo = k; p.ph_hi = k + 1; hipLaunchKernelGGL(yoco_fwd, dim3(grid_blocks), dim3(NTHREADS), LDS_BYTES, stream, p); }
#endif
}
```

```cpp
#include <hip/hip_runtime.h>
#include <hip/hip_cooperative_groups.h>
#include <cstdio>
#include <cstdint>
namespace cg = cooperative_groups;

typedef unsigned short bf16_t;
typedef short bf16x8 __attribute__((ext_vector_type(8)));
typedef short bf16x4 __attribute__((ext_vector_type(4)));
typedef float f32x4 __attribute__((ext_vector_type(4)));
typedef unsigned u32x4 __attribute__((ext_vector_type(4)));
typedef unsigned u32x2 __attribute__((ext_vector_type(2)));

constexpr int D = 1024, TP = 16384, TS = 512, T = TP + TS;
constexpr int NIN = 3072, LDW_IN = 3080, FF = 4096, NKVQ = 1536;
constexpr float EPS = 1e-6f;
constexpr int NTHREADS = 512;
constexpr int LDS_BYTES = 147456;
#ifndef REP_P0
#define REP_P0 1
#endif
#ifndef REP_2AL
#define REP_2AL 1
#endif
#ifndef REP_2AS
#define REP_2AS 1
#endif
#ifndef REP_2C
#define REP_2C 1
#endif
#ifndef REP_7P
#define REP_7P 1
#endif
#ifndef REP_7S
#define REP_7S 1
#endif
#ifndef REP_PG
#define REP_PG 1
#endif
#ifndef REP_SG
#define REP_SG 1
#endif
#ifndef MAX_PHASE
#define MAX_PHASE 13
#endif
#ifndef N_LAUNCH_MODE
#define N_LAUNCH_MODE 1
#endif

constexpr size_t MiB = 1u << 20;
constexpr size_t WS_SS = 0;
constexpr size_t WS_CHB = 256 * 1024, WS_CHM = WS_CHB + 4096, WS_MPREV = WS_CHM + 4096;
constexpr size_t WS_GATES = 1 * MiB;
constexpr size_t WS_GN = 2 * MiB;
constexpr size_t WS_BAR = 3 * MiB, BAR_BYTES = 16384;
constexpr size_t WS_WIN = 4 * MiB, WS_WOUT = 10 * MiB, WS_W1A = 12 * MiB, WS_W2A = 20 * MiB, WS_WKVQ = 28 * MiB, WS_WO = 31 * MiB, WS_W1B = 33 * MiB, WS_W2B = 41 * MiB;
constexpr size_t WS_XB = 49 * MiB;
constexpr size_t WS_P = 82 * MiB;
constexpr size_t WS_HG = 181 * MiB;
constexpr size_t WS_HID = 82 * MiB;
constexpr size_t WS_KVQ = 82 * MiB;
constexpr size_t WS_ATT = 132 * MiB;
constexpr size_t WS_END = 214 * MiB;

constexpr size_t O_Y = 0, O_PC = 17301504, O_PN = 17825792, O_PM = 17827840, O_PWK = 17827856, O_PWV = 17958928,
                 O_SC = 18090000, O_SN = 34867216, O_SM = 34932752, O_SWK = 34933264, O_SWV = 39127568, O_END = 43321872;

struct Params {
    const float *x_prompt, *x_sample, *st_C, *st_n, *st_m, *cache_k, *cache_v;
    const float *ml_norm_g, *ml_w_in, *ml_b_i, *ml_b_f, *ml_head_g, *ml_w_out;
    const float *kv_norm_g, *w_kv, *k_norm_g;
    const float *att_norm_g, *att_w_q, *q_norm_g, *att_sinks, *att_w_o;
    const float *mlp_norm_g, *mlp_w1, *mlp_w2;
    float* out; unsigned char* ws;
    int ph_lo, ph_hi;
};

typedef float f32x2 __attribute__((ext_vector_type(2)));
typedef __bf16 bf16x2n __attribute__((ext_vector_type(2)));
__device__ __forceinline__ unsigned cvt_pk_bf16(float lo, float hi) { const f32x2 v = {lo, hi}; const bf16x2n b = __builtin_convertvector(v, bf16x2n); return __builtin_bit_cast(unsigned, b); }
__device__ __forceinline__ bf16_t f2bf(float f) { return (bf16_t)(cvt_pk_bf16(f, 0.f) & 0xffffu); }
__device__ __forceinline__ float bf2f(bf16_t h) { return __uint_as_float(((unsigned)h) << 16); }
__device__ __forceinline__ float bflo(unsigned u) { return __uint_as_float(u << 16); }
__device__ __forceinline__ float bfhi(unsigned u) { return __uint_as_float(u & 0xffff0000u); }
__device__ __forceinline__ float wave_sum(float v) {
#pragma unroll
    for (int o = 1; o < 64; o <<= 1) v += __shfl_xor(v, o);
    return v;
}
__device__ __forceinline__ float wave_max(float v) {
#pragma unroll
    for (int o = 1; o < 64; o <<= 1) v = fmaxf(v, __shfl_xor(v, o));
    return v;
}
__device__ __forceinline__ float scan_sum(float x, int lane) {
#pragma unroll
    for (int o = 1; o < 64; o <<= 1) { float y = __shfl_up(x, o); if (lane >= o) x += y; }
    return x;
}
__device__ __forceinline__ float scan_max(float x, int lane) {
#pragma unroll
    for (int o = 1; o < 64; o <<= 1) { float y = __shfl_up(x, o); if (lane >= o) x = fmaxf(x, y); }
    return x;
}
__device__ __forceinline__ float softcap15(float x) { return 15.f * tanhf(x * (1.f / 15.f)); }
__device__ __forceinline__ float logsigmoid(float z) { return fminf(z, 0.f) - log1pf(__expf(-fabsf(z))); }
__device__ __forceinline__ float sigmoidf_(float z) { return 1.f / (1.f + __expf(-z)); }
#define LDS_WAIT() asm volatile("s_waitcnt lgkmcnt(0)" ::: "memory")
#define MFMA32(x, y, acc) __builtin_amdgcn_mfma_f32_16x16x32_bf16((x), (y), (acc), 0, 0, 0)
#define MFMA16(x, y, acc) __builtin_amdgcn_mfma_f32_16x16x16bf16_1k((x), (y), (acc), 0, 0, 0)

__device__ __forceinline__ void transpose_item(const float* __restrict__ W, int ldw, int K, const float* __restrict__ gk, float cs,
                                               bf16_t* WT, int row_off, int k0, int n0, float* scr, int lane) {
    {
        const int kr = lane >> 3, n4 = (lane & 7) * 4;
        f32x4 wv[8];
#pragma unroll
        for (int i = 0; i < 8; ++i) wv[i] = __builtin_nontemporal_load((const f32x4*)(W + (size_t)(k0 + kr + 8 * i) * ldw + n0 + n4));
#pragma unroll
        for (int i = 0; i < 8; ++i) {
            const int kk = kr + 8 * i;
            const float g = gk ? gk[k0 + kk] * cs : cs;
            float* d = scr + kk * 33 + n4;
            d[0] = wv[i].x * g; d[1] = wv[i].y * g; d[2] = wv[i].z * g; d[3] = wv[i].w * g;
        }
    }
    LDS_WAIT();
    const int c = lane & 7;
#pragma unroll
    for (int j = 0; j < 4; ++j) {
        const int n = (lane >> 3) + 8 * j; const float* s = scr + (8 * c) * 33 + n;
        u32x4 o; o.x = cvt_pk_bf16(s[0 * 33], s[1 * 33]); o.y = cvt_pk_bf16(s[2 * 33], s[3 * 33]); o.z = cvt_pk_bf16(s[4 * 33], s[5 * 33]); o.w = cvt_pk_bf16(s[6 * 33], s[7 * 33]);
        *(u32x4*)(WT + (size_t)(row_off + n0 + n) * K + k0 + 8 * c) = o;
    }
    LDS_WAIT();
}

__device__ __forceinline__ void p0_prologue(const Params& p, unsigned char* lds, int bid, int G) {
    const int tid = threadIdx.x, lane = tid & 63, wid = tid >> 6;
    unsigned char* ws = p.ws;
    float* scr = (float*)(lds + wid * 8448);
    float* wif = (float*)(lds + 73728);
    for (int k = tid; k < 1024; k += NTHREADS) {
        const float g = p.ml_norm_g[k];
        const f32x4 a = *(const f32x4*)(p.ml_w_in + (size_t)k * LDW_IN + 3072), b = *(const f32x4*)(p.ml_w_in + (size_t)k * LDW_IN + 3076);
        wif[0 * 1024 + k] = a.x * g; wif[1 * 1024 + k] = a.y * g; wif[2 * 1024 + k] = a.z * g; wif[3 * 1024 + k] = a.w * g;
        wif[4 * 1024 + k] = b.x * g; wif[5 * 1024 + k] = b.y * g; wif[6 * 1024 + k] = b.z * g; wif[7 * 1024 + k] = b.w * g;
    }
    { float* ss = (float*)(ws + WS_SS); for (int i = bid * NTHREADS + tid; i < 3 * T; i += G * NTHREADS) ss[i] = 0.f; }
    __syncthreads();
    const int gw = bid * 8 + wid, NGW = G * 8;
    constexpr int I_IN = 16 * 96, I_SQ = 16 * 32, I_1 = 16 * 128, I_2 = 64 * 32, I_KV = 16 * 16;
    constexpr int NITEMS = I_IN + I_SQ + I_1 + I_2 + I_KV + I_SQ;
    for (int it = gw; it < NITEMS; it += NGW) {
        int r = it;
        if (r < I_IN) { const int kb = r / 96, nb = r % 96, n0 = nb * 32; const float cs = (n0 >= 512 && n0 < 1024) ? 0.08838834764831845f : 1.f;
            transpose_item(p.ml_w_in, LDW_IN, 1024, p.ml_norm_g, cs, (bf16_t*)(ws + WS_WIN), 0, kb * 64, n0, scr, lane); continue; } r -= I_IN;
        if (r < I_SQ) { transpose_item(p.ml_w_out, 1024, 1024, nullptr, 1.f, (bf16_t*)(ws + WS_WOUT), 0, (r / 32) * 64, (r % 32) * 32, scr, lane); continue; } r -= I_SQ;
        if (r < I_1) { transpose_item(p.mlp_w1, 4096, 1024, p.mlp_norm_g, 1.f, (bf16_t*)(ws + WS_W1A), 0, (r / 128) * 64, (r % 128) * 32, scr, lane); continue; } r -= I_1;
        if (r < I_2) { transpose_item(p.mlp_w2, 1024, 4096, nullptr, 1.f, (bf16_t*)(ws + WS_W2A), 0, (r / 32) * 64, (r % 32) * 32, scr, lane); continue; } r -= I_2;
        if (r < I_KV) { transpose_item(p.w_kv, 512, 1024, p.kv_norm_g, 1.f, (bf16_t*)(ws + WS_WKVQ), 0, (r / 16) * 64, (r % 16) * 32, scr, lane); continue; } r -= I_KV;
        transpose_item(p.att_w_q, 1024, 1024, p.att_norm_g, 1.f, (bf16_t*)(ws + WS_WKVQ), 512, (r / 32) * 64, (r % 32) * 32, scr, lane);
    }
    bf16_t* XB = (bf16_t*)(ws + WS_XB); float* gates = (float*)(ws + WS_GATES);
    for (int m = gw; m < T; m += NGW) {
        const float* xrow = m < TP ? p.x_prompt + (size_t)m * D : p.x_sample + (size_t)(m - TP) * D;
        f32x4 v[4]; float s = 0.f;
#pragma unroll
        for (int j = 0; j < 4; ++j) { v[j] = __builtin_nontemporal_load((const f32x4*)(xrow + 4 * lane + 256 * j)); s += (v[j].x * v[j].x + v[j].y * v[j].y) + (v[j].z * v[j].z + v[j].w * v[j].w); }
        const float rstd = rsqrtf(wave_sum(s) * (1.f / D) + EPS);
        if (m >= TP) {
#pragma unroll
            for (int j = 0; j < 4; ++j) *(f32x4*)(p.out + O_Y + (size_t)m * D + 4 * lane + 256 * j) = v[j];
        }
#pragma unroll
        for (int j = 0; j < 4; ++j) { u32x2 w; w.x = cvt_pk_bf16(v[j].x * rstd, v[j].y * rstd); w.y = cvt_pk_bf16(v[j].z * rstd, v[j].w * rstd); *(u32x2*)(XB + (size_t)m * D + 4 * lane + 256 * j) = w; }
        float mine = 0.f;
#pragma unroll
        for (int g = 0; g < 8; ++g) {
            float a = 0.f;
#pragma unroll
            for (int j = 0; j < 4; ++j) { const f32x4 w = *(const f32x4*)(wif + g * 1024 + 4 * lane + 256 * j); a += (v[j].x * w.x + v[j].y * w.y) + (v[j].z * w.z + v[j].w * w.w); }
            a = wave_sum(a) * rstd;
            if (lane == g) mine = a;
        }
        if (lane < 4) gates[(size_t)m * 8 + lane] = softcap15(mine + p.ml_b_i[lane]);
        else if (lane < 8) gates[(size_t)m * 8 + lane] = logsigmoid(softcap15(mine + p.ml_b_f[lane - 4]));
    }
}

__device__ __forceinline__ void late_weights(const Params& p, unsigned char* lds, int slot, int nslots) {
    const int tid = threadIdx.x, lane = tid & 63, wid = tid >> 6;
    unsigned char* ws = p.ws;
    float* scr = (float*)(lds + wid * 8448);
    constexpr int I_SQ = 16 * 32, I_1 = 16 * 128, I_2 = 64 * 32, NIT = I_SQ + I_1 + I_2;
    for (int it = slot * 8 + wid; it < NIT; it += nslots * 8) {
        int r = it;
        if (r < I_SQ) { transpose_item(p.att_w_o, 1024, 1024, nullptr, 1.f, (bf16_t*)(ws + WS_WO), 0, (r / 32) * 64, (r % 32) * 32, scr, lane); continue; } r -= I_SQ;
        if (r < I_1) { transpose_item(p.mlp_w1 + (size_t)1024 * 4096, 4096, 1024, p.mlp_norm_g + 1024, 1.f, (bf16_t*)(ws + WS_W1B), 0, (r / 128) * 64, (r % 128) * 32, scr, lane); continue; } r -= I_1;
        transpose_item(p.mlp_w2 + (size_t)4096 * 1024, 1024, 4096, nullptr, 1.f, (bf16_t*)(ws + WS_W2B), 0, (r / 32) * 64, (r % 32) * 32, scr, lane);
    }
}

struct EpiBf16 {
    bf16_t* out; int ld; const float* ss; int act;
    template <int NQ, bool PAIRED> __device__ __forceinline__ void row(int r, const int (&c)[NQ], const f32x4 (&v)[NQ], int fq, float rscale) const {
        float sc = rscale; if (ss) sc = rsqrtf(ss[r] * (1.f / 1024.f) + EPS);
        u32x2 w[NQ];
#pragma unroll
        for (int q = 0; q < NQ; ++q) {
            f32x4 x = v[q] * sc;
            if (act) { x.x = fmaxf(x.x, 0.f); x.y = fmaxf(x.y, 0.f); x.z = fmaxf(x.z, 0.f); x.w = fmaxf(x.w, 0.f); x = x * x; }
            w[q].x = cvt_pk_bf16(x.x, x.y); w[q].y = cvt_pk_bf16(x.z, x.w);
        }
        if (PAIRED) {
#pragma unroll
            for (int q = 0; q < NQ; q += 2) { u32x4 o; o.x = w[q].x; o.y = w[q].y; o.z = w[q + 1].x; o.w = w[q + 1].y; *(u32x4*)(out + (size_t)r * ld + c[q]) = o; }
        } else {
#pragma unroll
            for (int q = 0; q < NQ; ++q) *(u32x2*)(out + (size_t)r * ld + c[q]) = w[q];
        }
    }
};
struct EpiRes {
    const float* srcp; const float* srcs; float* dst; bf16_t* xb; float* ss;
    template <int NQ, bool PAIRED> __device__ __forceinline__ void row(int r, const int (&c)[NQ], const f32x4 (&v)[NQ], int fq, float rscale) const {
        const float* s = r < TP ? srcp + (size_t)r * D : srcs + (size_t)(r - TP) * D;
        float a2 = 0.f;
        u32x2 w[NQ];
#pragma unroll
        for (int q = 0; q < NQ; ++q) {
            const f32x4 o = *(const f32x4*)(s + c[q]) + v[q];
            *(f32x4*)(dst + (size_t)r * D + c[q]) = o;
            w[q].x = cvt_pk_bf16(o.x, o.y); w[q].y = cvt_pk_bf16(o.z, o.w);
            a2 += (o.x * o.x + o.y * o.y) + (o.z * o.z + o.w * o.w);
        }
        if (xb) {
            if (PAIRED) {
#pragma unroll
                for (int q = 0; q < NQ; q += 2) { u32x4 o; o.x = w[q].x; o.y = w[q].y; o.z = w[q + 1].x; o.w = w[q + 1].y; *(u32x4*)(xb + (size_t)r * D + c[q]) = o; }
            } else {
#pragma unroll
                for (int q = 0; q < NQ; ++q) *(u32x2*)(xb + (size_t)r * D + c[q]) = w[q];
            }
        }
        if (ss) { a2 += __shfl_xor(a2, 16); a2 += __shfl_xor(a2, 32); if (fq == 0) atomicAdd(ss + r, a2); }
    }
};

namespace pg8 {
#define PG8_LAS __attribute__((address_space(3)))
typedef unsigned short bf16_t;
typedef short bf16x8 __attribute__((ext_vector_type(8)));
typedef float f32x4 __attribute__((ext_vector_type(4)));
typedef unsigned u32x4 __attribute__((ext_vector_type(4)));
constexpr int BM = 256, BK = 64, HALF = 128, HTB = HALF * BK * 2  , STAGE_BYTES = 8 * HTB, NXCD = 8, WGM = 8;

__host__ __device__ __forceinline__ int lds_byte(int r, int c) { const int st = (r >> 4) * 2 + (c >> 5), rr = r & 15, cc = c & 31, ob = rr * 64 + cc * 2; return st * 1024 + (ob ^ (((ob >> 9) & 1) << 5)); }
__host__ __device__ __forceinline__ void stage_rc(int b, int& R, int& C) { const int st = b / 1024, sb = b % 1024, swz = sb ^ (((sb >> 9) & 1) << 5); R = (st >> 1) * 16 + swz / 64; C = (st & 1) * 32 + (swz % 64) / 2; }
__host__ __device__ __forceinline__ int perm32(int rho) { const int n = rho >> 4, i = rho & 15; return 8 * (i >> 2) + 4 * n + (i & 3); }

struct Unit { int pm, pn; };
struct Gemm { const bf16_t* A; const bf16_t* Bt; int M, N, K; int revk; };

struct StaticOrder {
    int nM, nN, nwg, G, c;
    __host__ __device__ void init(int M, int N, int G_, int c_) { nM = M / BM; nN = N / BM; nwg = nM * nN; G = G_; c = c_; }
    __host__ __device__ bool next(int i, Unit& u) const {
        const long L = (long)i * G + c; if (L >= nwg) return false;
        int wgid = (int)L; { const int q = nwg / NXCD, r = nwg % NXCD, xcd = wgid % NXCD, off = wgid / NXCD; wgid = (xcd < r ? xcd * (q + 1) : r * (q + 1) + (xcd - r) * q) + off; }
        const int nig = WGM * nN, gid = wgid / nig, fm = gid * WGM, gsz = (nM - fm) < WGM ? (nM - fm) : WGM;
        u.pm = fm + ((wgid % nig) % gsz); u.pn = (wgid % nig) / gsz; return true;
    }
    __device__ __forceinline__ void a_ready(const Unit&) const {}
    __device__ __forceinline__ void done(const Unit&) const {}
};


template <class Epi, class Sched, bool ALIGN_EPI = false, bool SP2 = false>
__device__ __forceinline__ void gemm_phase(PG8_LAS unsigned char* lds, const Gemm g, const Sched& S, const Epi& E) {
    const int tid = threadIdx.x, wid = __builtin_amdgcn_readfirstlane(tid >> 6), lane = tid & 63, wr = wid >> 2, wc = wid & 3, fr = lane & 15, fq = lane >> 4;
    const int K = g.K, nt = K / BK;
    unsigned voffA[2], voffB[2];
#pragma unroll
    for (int i = 0; i < 2; ++i) { int R, C; stage_rc(tid * 16 + i * 8192, R, C); const int Rb = Epi::PERM ? ((R & ~31) + perm32(R & 31)) : R;
        voffA[i] = (unsigned)(R * K + C) * 2u; voffB[i] = (unsigned)(Rb * K + C) * 2u; }
    const size_t kstep = g.revk ? (size_t)0 - (size_t)(BK * 2) : (size_t)(BK * 2);
    const size_t koff = g.revk ? (size_t)(K - BK) * 2 : (size_t)0;
    const size_t hstep = (size_t)HALF * K * 2;
    const size_t tstep = 2 * hstep;
    const unsigned ldsw = (unsigned)wid * 1024u;
    const int aoff = lds_byte(wr * 64 + fr, fq * 8), boff = lds_byte(wc * 32 + fr, fq * 8);
#define PG8_SA(b, h) (((b) * 2 + (h)) * HTB)
#define PG8_SB(b, h) ((4 + (b) * 2 + (h)) * HTB)
#define PG8_STAGE(bufoff, gbase, voff) do { _Pragma("unroll") for (int _i = 0; _i < 2; ++_i) \
        __builtin_amdgcn_global_load_lds((const unsigned*)((const char*)(gbase) + (voff)[_i]), (PG8_LAS unsigned*)(lds + (bufoff) + ldsw + _i * 8192), 16, 0, 0); } while (0)
#define PG8_LDA(dst, b, h) do { _Pragma("unroll") for (int m = 0; m < 4; ++m) _Pragma("unroll") for (int k = 0; k < 2; ++k) dst[m][k] = *(const PG8_LAS bf16x8*)(lds + PG8_SA(b, h) + aoff + m * 2048 + k * 1024); } while (0)
#define PG8_LDB(dst, b, h) do { _Pragma("unroll") for (int n = 0; n < 2; ++n) _Pragma("unroll") for (int k = 0; k < 2; ++k) dst[n][k] = *(const PG8_LAS bf16x8*)(lds + PG8_SB(b, h) + boff + n * 2048 + k * 1024); } while (0)
#define PG8_MMA(ai, bj, At, Bt) do { __builtin_amdgcn_s_setprio(1); _Pragma("unroll") for (int m = 0; m < 4; ++m) _Pragma("unroll") for (int n = 0; n < 2; ++n) _Pragma("unroll") for (int k = 0; k < 2; ++k) \
        acc[ai][bj][m][n] = __builtin_amdgcn_mfma_f32_16x16x32_bf16(Bt[n][k], At[m][k], acc[ai][bj][m][n], 0, 0, 0); __builtin_amdgcn_s_setprio(0); } while (0)
#define PG8_WAIT_V(n) asm volatile("s_waitcnt vmcnt(" #n ")" ::: "memory")
#define PG8_WAIT_L(n) asm volatile("s_waitcnt lgkmcnt(" #n ")" ::: "memory")
#define PG8_BAR __builtin_amdgcn_s_barrier()
#define PG8_SCHED __builtin_amdgcn_sched_barrier(0)
    Unit cur, nxt; int ui = 0;
    if (!S.next(0, cur)) return;
    f32x4 acc[2][2][4][2];
#pragma unroll
    for (int a = 0; a < 2; ++a)
#pragma unroll
        for (int b = 0; b < 2; ++b)
#pragma unroll
            for (int m = 0; m < 4; ++m)
#pragma unroll
                for (int n = 0; n < 2; ++n) acc[a][b][m][n] = (f32x4){0.f, 0.f, 0.f, 0.f};
    bf16x8 At[4][2], B0[2][2], B1[2][2];
    const char* cA = (const char*)g.A + (size_t)cur.pm * tstep + koff; const char* cB = (const char*)g.Bt + (size_t)cur.pn * tstep + koff;
    S.a_ready(cur);
    if constexpr (SP2) {
        PG8_STAGE(PG8_SB(0, 0), cB, voffB); PG8_STAGE(PG8_SB(0, 1), cB + hstep, voffB); PG8_STAGE(PG8_SA(0, 0), cA, voffA); PG8_STAGE(PG8_SA(0, 1), cA + hstep, voffA);
        if (wr == 1) PG8_BAR;
        PG8_WAIT_V(2); PG8_BAR;
        PG8_STAGE(PG8_SB(1, 0), cB + kstep, voffB); PG8_STAGE(PG8_SA(1, 0), cA + kstep, voffA); PG8_STAGE(PG8_SB(1, 1), cB + hstep + kstep, voffB);
        PG8_WAIT_V(6); PG8_BAR;
    } else {
        PG8_STAGE(PG8_SB(0, 0), cB, voffB); PG8_STAGE(PG8_SA(0, 0), cA, voffA); PG8_STAGE(PG8_SB(0, 1), cB + hstep, voffB); PG8_STAGE(PG8_SA(0, 1), cA + hstep, voffA);
        if (wr == 1) PG8_BAR;
        PG8_WAIT_V(4); PG8_BAR;
        PG8_STAGE(PG8_SB(1, 0), cB + kstep, voffB); PG8_STAGE(PG8_SA(1, 0), cA + kstep, voffA); PG8_STAGE(PG8_SB(1, 1), cB + hstep + kstep, voffB);
        PG8_WAIT_V(6); PG8_BAR;
    }
    for (;;) {
        const bool has_next = S.next(ui + 1, nxt);
        const char* nA = has_next ? (const char*)g.A + (size_t)nxt.pm * tstep + koff : cA; const char* nB = has_next ? (const char*)g.Bt + (size_t)nxt.pn * tstep + koff : cB;
        for (int t = 0; t < nt; t += 2) {
            const bool last = (t == nt - 2);
            const char* a1 = cA + (size_t)(t + 1) * kstep;
            const char* a2 = last ? nA : cA + (size_t)(t + 2) * kstep; const char* b2 = last ? nB : cB + (size_t)(t + 2) * kstep;
            const char* a3 = a2 + kstep; const char* b3 = b2 + kstep;
            if (last && has_next) S.a_ready(nxt);
            if constexpr (SP2) {
            PG8_LDB(B0, 0, 0); PG8_LDB(B1, 0, 1); PG8_SCHED; PG8_LDA(At, 0, 0); PG8_STAGE(PG8_SA(1, 1), a1 + hstep, voffA);
            PG8_WAIT_V(8); PG8_WAIT_L(0); PG8_BAR; PG8_MMA(0, 0, At, B0); PG8_MMA(0, 1, At, B1); PG8_BAR; PG8_SCHED;
            PG8_LDA(At, 0, 1); PG8_STAGE(PG8_SB(0, 0), b2, voffB); PG8_STAGE(PG8_SB(0, 1), b2 + hstep, voffB); PG8_STAGE(PG8_SA(0, 0), a2, voffA);
            PG8_WAIT_V(8); PG8_WAIT_L(0); PG8_BAR; PG8_MMA(1, 0, At, B0); PG8_MMA(1, 1, At, B1); PG8_BAR; PG8_SCHED;
            PG8_LDB(B0, 1, 0); PG8_LDB(B1, 1, 1); PG8_SCHED; PG8_LDA(At, 1, 0); PG8_STAGE(PG8_SA(0, 1), a2 + hstep, voffA);
            PG8_WAIT_V(8); PG8_WAIT_L(0); PG8_BAR; PG8_MMA(0, 0, At, B0); PG8_MMA(0, 1, At, B1); PG8_BAR; PG8_SCHED;
            PG8_LDA(At, 1, 1); PG8_STAGE(PG8_SB(1, 0), b3, voffB); PG8_STAGE(PG8_SB(1, 1), b3 + hstep, voffB); PG8_STAGE(PG8_SA(1, 0), a3, voffA);
            PG8_WAIT_V(8); PG8_WAIT_L(0); PG8_BAR; PG8_MMA(1, 0, At, B0); PG8_MMA(1, 1, At, B1); PG8_BAR; PG8_SCHED;
            } else {
            PG8_LDB(B0, 0, 0); PG8_SCHED; PG8_LDA(At, 0, 0); PG8_STAGE(PG8_SA(1, 1), a1 + hstep, voffA);
            PG8_WAIT_L(8); PG8_BAR; PG8_WAIT_L(0); PG8_MMA(0, 0, At, B0); PG8_BAR; PG8_SCHED;
            PG8_LDB(B1, 0, 1); PG8_STAGE(PG8_SB(0, 0), b2, voffB);
            PG8_BAR; PG8_WAIT_L(0); PG8_MMA(0, 1, At, B1); PG8_BAR;
            PG8_LDA(At, 0, 1); PG8_STAGE(PG8_SA(0, 0), a2, voffA);
            PG8_BAR; PG8_WAIT_L(0); PG8_MMA(1, 0, At, B0); PG8_BAR; PG8_SCHED;
            PG8_STAGE(PG8_SB(0, 1), b2 + hstep, voffB);
            PG8_WAIT_V(6); PG8_BAR; PG8_MMA(1, 1, At, B1); PG8_BAR;
            PG8_LDB(B0, 1, 0); PG8_SCHED; PG8_LDA(At, 1, 0); PG8_STAGE(PG8_SA(0, 1), a2 + hstep, voffA);
            PG8_WAIT_L(8); PG8_BAR; PG8_WAIT_L(0); PG8_MMA(0, 0, At, B0); PG8_BAR; PG8_SCHED;
            PG8_LDB(B1, 1, 1); PG8_STAGE(PG8_SB(1, 0), b3, voffB);
            PG8_BAR; PG8_WAIT_L(0); PG8_MMA(0, 1, At, B1); PG8_BAR;
            PG8_LDA(At, 1, 1); PG8_STAGE(PG8_SA(1, 0), a3, voffA);
            PG8_BAR; PG8_WAIT_L(0); PG8_MMA(1, 0, At, B0); PG8_BAR; PG8_SCHED;
            PG8_STAGE(PG8_SB(1, 1), b3 + hstep, voffB);
            PG8_WAIT_V(6); PG8_BAR; PG8_MMA(1, 1, At, B1); PG8_BAR;
            }
        }
        if constexpr (ALIGN_EPI) { if (wr == 0) PG8_BAR; }
        if constexpr (!Epi::AFTER_DRAIN) { E(acc, cur, wr, wc, fr, fq); S.done(cur); }
        if (!has_next) break;
#pragma unroll
        for (int a = 0; a < 2; ++a)
#pragma unroll
            for (int b = 0; b < 2; ++b)
#pragma unroll
                for (int m = 0; m < 4; ++m)
#pragma unroll
                    for (int n = 0; n < 2; ++n) acc[a][b][m][n] = (f32x4){0.f, 0.f, 0.f, 0.f};
        cur = nxt; cA = nA; cB = nB; ++ui;
        if constexpr (ALIGN_EPI) { if (wr == 1) PG8_BAR; }
    }
    PG8_WAIT_V(0);
    if constexpr (!ALIGN_EPI) { if (wr == 0) PG8_BAR; }
    PG8_BAR;
    if constexpr (Epi::AFTER_DRAIN) { E.fused(acc, cur, wr, wc, fr, fq, lds, wid, lane); S.done(cur); }
#undef PG8_SA
#undef PG8_SB
#undef PG8_STAGE
#undef PG8_LDA
#undef PG8_LDB
#undef PG8_MMA
#undef PG8_WAIT_V
#undef PG8_WAIT_L
#undef PG8_BAR
#undef PG8_SCHED
}
}


template <class Inner> struct Pg8Epi {
    static constexpr bool PERM = true, AFTER_DRAIN = false;
    Inner in;
    __device__ __forceinline__ void operator()(const f32x4 (&acc)[2][2][4][2], const pg8::Unit& u, int wr, int wc, int fr, int fq) const {
#pragma unroll
        for (int ai = 0; ai < 2; ++ai)
#pragma unroll
            for (int m = 0; m < 4; ++m) {
                const int r = u.pm * 256 + ai * 128 + wr * 64 + m * 16 + fr;
                const int c0 = u.pn * 256 + wc * 32 + 8 * fq;
                const int cols[4] = {c0, c0 + 4, c0 + 128, c0 + 132};
                const f32x4 vv[4] = {acc[ai][0][m][0], acc[ai][0][m][1], acc[ai][1][m][0], acc[ai][1][m][1]};
                in.template row<4, true>(r, cols, vv, fq, 1.f);
            }
    }
};
struct EpiResB {
    const float* srcf; bf16_t* xb; float* dstf; float* ss;
    template <int NQ, bool PAIRED> __device__ __forceinline__ void row(int r, const int (&c)[NQ], const f32x4 (&v)[NQ], int fq, float rscale) const {
        static_assert(PAIRED && NQ % 2 == 0, "EpiResB: paired quads only");
        float a2 = 0.f;
#pragma unroll
        for (int q = 0; q < NQ; q += 2) {
            f32x4 s0, s1;
            if (srcf) { s0 = *(const f32x4*)(srcf + (size_t)r * D + c[q]); s1 = *(const f32x4*)(srcf + (size_t)r * D + c[q] + 4); }
            else { const u32x4 xr = *(const u32x4*)(xb + (size_t)r * D + c[q]); s0 = (f32x4){bflo(xr.x), bfhi(xr.x), bflo(xr.y), bfhi(xr.y)}; s1 = (f32x4){bflo(xr.z), bfhi(xr.z), bflo(xr.w), bfhi(xr.w)}; }
            const f32x4 o0 = s0 + v[q], o1 = s1 + v[q + 1];
            if (dstf) { __builtin_nontemporal_store(o0, (f32x4*)(dstf + (size_t)r * D + c[q])); __builtin_nontemporal_store(o1, (f32x4*)(dstf + (size_t)r * D + c[q] + 4)); }
            else {
                u32x4 w; w.x = cvt_pk_bf16(o0.x, o0.y); w.y = cvt_pk_bf16(o0.z, o0.w); w.z = cvt_pk_bf16(o1.x, o1.y); w.w = cvt_pk_bf16(o1.z, o1.w);
                *(u32x4*)(xb + (size_t)r * D + c[q]) = w;
                a2 += (o0.x * o0.x + o0.y * o0.y) + (o0.z * o0.z + o0.w * o0.w) + (o1.x * o1.x + o1.y * o1.y) + (o1.z * o1.z + o1.w * o1.w);
            }
        }
        if (ss) { a2 += __shfl_xor(a2, 16); a2 += __shfl_xor(a2, 32); if (fq == 0) atomicAdd(ss + r, a2); }
    }
};
struct EpiAddF32 {
    float* dst;
    template <int NQ, bool PAIRED> __device__ __forceinline__ void row(int r, const int (&c)[NQ], const f32x4 (&v)[NQ], int fq, float rscale) const {
#pragma unroll
        for (int q = 0; q < NQ; ++q) { f32x4* d = (f32x4*)(dst + (size_t)r * D + c[q]); *d = *d + v[q]; }
    }
};
struct EpiAtomic {
    float* dst;
    template <int NQ, bool PAIRED> __device__ __forceinline__ void row(int r, const int (&c)[NQ], const f32x4 (&v)[NQ], int fq, float rscale) const {
#pragma unroll
        for (int q = 0; q < NQ; ++q) { float* d = dst + (size_t)r * D + c[q]; atomicAdd(d, v[q].x); atomicAdd(d + 1, v[q].y); atomicAdd(d + 2, v[q].z); atomicAdd(d + 3, v[q].w); }
    }
};

template <int AF32, class Epi>
__device__ __forceinline__ void sgemm64(unsigned char* lds, const void* Av, int lda, const bf16_t* __restrict__ Bt, int row0, int nrows, int N, int K, int ksplit,
                                        const Epi& E, int bid, int G) {
    const int tid = threadIdx.x, lane = tid & 63, wid = tid >> 6, wr = wid >> 2, wc = wid & 3, fr = lane & 15, fq = lane >> 4;
    const int nN = N / 128, nT = (nrows / 64) * nN, nU = nT * ksplit, Ksl = K / ksplit, nk = Ksl / 128;
    constexpr int LS = 136;
    bf16_t* As = (bf16_t*)lds;
    bf16_t* Bs = As + 2 * 64 * LS;
    float* rs = (float*)(Bs + 2 * 128 * LS);
    const int arow = tid >> 3, ak = (tid & 7) * 8;
    for (int u = bid; u < nU; u += G) {
        const int ks = u / nT, t = u % nT, pm = t / nN, pn = t % nN, k0 = ks * Ksl;
        const bf16_t* Ab = (const bf16_t*)Av + (size_t)(row0 + pm * 64 + arow) * lda + k0 + ak;
        const float* Af = (const float*)Av + (size_t)(row0 + pm * 64 + arow) * lda + k0 + ak;
        const bf16_t* Bg = Bt + (size_t)(pn * 128 + arow) * K + k0 + ak;
        f32x4 acc[2][2];
#pragma unroll
        for (int m = 0; m < 2; ++m)
#pragma unroll
            for (int n = 0; n < 2; ++n) acc[m][n] = (f32x4){0.f, 0.f, 0.f, 0.f};
        float ssq = 0.f;
        u32x4 ra[2], rb[2][2];
        auto loadAB = [&](int kt) {
#pragma unroll
            for (int h = 0; h < 2; ++h) {
                if (AF32) { const f32x4 a = *(const f32x4*)(Af + kt * 128 + 64 * h), b = *(const f32x4*)(Af + kt * 128 + 64 * h + 4);
                    ssq += (a.x * a.x + a.y * a.y) + (a.z * a.z + a.w * a.w) + (b.x * b.x + b.y * b.y) + (b.z * b.z + b.w * b.w);
                    ra[h].x = cvt_pk_bf16(a.x, a.y); ra[h].y = cvt_pk_bf16(a.z, a.w); ra[h].z = cvt_pk_bf16(b.x, b.y); ra[h].w = cvt_pk_bf16(b.z, b.w); }
                else ra[h] = *(const u32x4*)(Ab + kt * 128 + 64 * h);
#pragma unroll
                for (int i = 0; i < 2; ++i) rb[i][h] = *(const u32x4*)(Bg + (size_t)(64 * i) * K + kt * 128 + 64 * h);
            }
        };
        auto storeAB = [&](int buf) {
#pragma unroll
            for (int h = 0; h < 2; ++h) {
                *(u32x4*)(As + buf * 64 * LS + arow * LS + ak + 64 * h) = ra[h];
#pragma unroll
                for (int i = 0; i < 2; ++i) *(u32x4*)(Bs + buf * 128 * LS + (arow + 64 * i) * LS + ak + 64 * h) = rb[i][h];
            }
        };
        loadAB(0);
        storeAB(0);
        __syncthreads();
        for (int kt = 0; kt < nk; ++kt) {
            const int buf = kt & 1;
            if (kt + 1 < nk) loadAB(kt + 1);
            const bf16_t* as = As + buf * 64 * LS; const bf16_t* bs = Bs + buf * 128 * LS;
#pragma unroll
            for (int kk = 0; kk < 4; ++kk) {
                bf16x8 af[2], bfr[2];
#pragma unroll
                for (int m = 0; m < 2; ++m) af[m] = *(const bf16x8*)(as + (32 * wr + 16 * m + fr) * LS + 32 * kk + 8 * fq);
#pragma unroll
                for (int n = 0; n < 2; ++n) bfr[n] = *(const bf16x8*)(bs + (32 * wc + 16 * n + fr) * LS + 32 * kk + 8 * fq);
#pragma unroll
                for (int m = 0; m < 2; ++m)
#pragma unroll
                    for (int n = 0; n < 2; ++n) acc[m][n] = MFMA32(bfr[n], af[m], acc[m][n]);
            }
            if (kt + 1 < nk) storeAB(buf ^ 1);
            __syncthreads();
        }
        if (AF32) {
            ssq += __shfl_xor(ssq, 1); ssq += __shfl_xor(ssq, 2); ssq += __shfl_xor(ssq, 4);
            if ((tid & 7) == 0) rs[arow] = rsqrtf(ssq * (1.f / 1024.f) + EPS);
            __syncthreads();
        }
#pragma unroll
        for (int m = 0; m < 2; ++m) {
            const int lr = 32 * wr + 16 * m + fr, r = row0 + pm * 64 + lr;
            const int cols[2] = {pn * 128 + 32 * wc + 4 * fq, pn * 128 + 32 * wc + 16 + 4 * fq};
            const f32x4 vv[2] = {acc[m][0], acc[m][1]};
            E.template row<2, false>(r, cols, vv, fq, AF32 ? rs[lr] : 1.f);
        }
    }
}

template <class Epi>
__device__ __forceinline__ void sgemm_phase(unsigned char* lds, const bf16_t* __restrict__ A, const bf16_t* __restrict__ Bt, int row0, int nrows, int N, int K,
                                            const Epi& E, int bid, int G) {
    const int tid = threadIdx.x, lane = tid & 63, wid = tid >> 6, wr = wid >> 2, wc = wid & 3, fr = lane & 15, fq = lane >> 4;
    const int nN = N / 128, nU = (nrows / 128) * nN, nk = K / 64;
    bf16_t* As = (bf16_t*)lds;
    bf16_t* Bs = As + 2 * 128 * 72;
    const int ldrow = tid >> 3, ldk = (tid & 7) * 8;
    for (int u = bid; u < nU; u += G) {
        const int pm = u / nN, pn = u % nN;
        const bf16_t* Ag = A + (size_t)(row0 + pm * 128 + ldrow) * K + ldk;
        const bf16_t* Bg = Bt + (size_t)(pn * 128 + ldrow) * K + ldk;
        f32x4 acc[4][2];
#pragma unroll
        for (int m = 0; m < 4; ++m)
#pragma unroll
            for (int n = 0; n < 2; ++n) acc[m][n] = (f32x4){0.f, 0.f, 0.f, 0.f};
        u32x4 ra[2], rb[2];
#pragma unroll
        for (int i = 0; i < 2; ++i) { ra[i] = *(const u32x4*)(Ag + (size_t)(64 * i) * K); rb[i] = *(const u32x4*)(Bg + (size_t)(64 * i) * K); }
#pragma unroll
        for (int i = 0; i < 2; ++i) { *(u32x4*)(As + (ldrow + 64 * i) * 72 + ldk) = ra[i]; *(u32x4*)(Bs + (ldrow + 64 * i) * 72 + ldk) = rb[i]; }
        __syncthreads();
        for (int kt = 0; kt < nk; ++kt) {
            const int buf = kt & 1;
            if (kt + 1 < nk) {
#pragma unroll
                for (int i = 0; i < 2; ++i) { ra[i] = *(const u32x4*)(Ag + (size_t)(64 * i) * K + (kt + 1) * 64); rb[i] = *(const u32x4*)(Bg + (size_t)(64 * i) * K + (kt + 1) * 64); }
            }
            const bf16_t* as = As + buf * 128 * 72; const bf16_t* bs = Bs + buf * 128 * 72;
#pragma unroll
            for (int kk = 0; kk < 2; ++kk) {
                bf16x8 af[4], bfr[2];
#pragma unroll
                for (int m = 0; m < 4; ++m) af[m] = *(const bf16x8*)(as + (64 * wr + 16 * m + fr) * 72 + 32 * kk + 8 * fq);
#pragma unroll
                for (int n = 0; n < 2; ++n) bfr[n] = *(const bf16x8*)(bs + (32 * wc + 16 * n + fr) * 72 + 32 * kk + 8 * fq);
#pragma unroll
                for (int m = 0; m < 4; ++m)
#pragma unroll
                    for (int n = 0; n < 2; ++n) acc[m][n] = MFMA32(bfr[n], af[m], acc[m][n]);
            }
            if (kt + 1 < nk) {
                bf16_t* an = As + (buf ^ 1) * 128 * 72; bf16_t* bn = Bs + (buf ^ 1) * 128 * 72;
#pragma unroll
                for (int i = 0; i < 2; ++i) { *(u32x4*)(an + (ldrow + 64 * i) * 72 + ldk) = ra[i]; *(u32x4*)(bn + (ldrow + 64 * i) * 72 + ldk) = rb[i]; }
            }
            __syncthreads();
        }
#pragma unroll
        for (int m = 0; m < 4; ++m) {
            const int r = row0 + pm * 128 + 64 * wr + 16 * m + fr;
            const int cols[2] = {pn * 128 + 32 * wc + 4 * fq, pn * 128 + 32 * wc + 16 + 4 * fq};
            const f32x4 vv[2] = {acc[m][0], acc[m][1]};
            E.template row<2, false>(r, cols, vv, fq, 1.f);
        }
    }
}

__device__ __forceinline__ void mlstm_local_unit(const Params& p, unsigned char* lds, int u) {
    const int tid = threadIdx.x, lane = tid & 63, wid = tid >> 6, fr = lane & 15, fq = lane >> 4;
    const int bh = u >> 6, c = u & 63, b = bh >> 2, h = bh & 3, base = b * 4096 + c * 64;
    unsigned char* ws = p.ws;
    const bf16_t* P = (const bf16_t*)(ws + WS_P); const float* gates = (const float*)(ws + WS_GATES);
    bf16_t* GS = (bf16_t*)p.out;
    bf16_t* kT = (bf16_t*)lds;
    bf16_t* vT = kT + 128 * 72;
    float* wk = (float*)(vT + 256 * 72);
    if (wid == 0) {
        const float lf = gates[(size_t)(base + lane) * 8 + 4 + h], li = gates[(size_t)(base + lane) * 8 + h];
        const float bc = scan_sum(lf, lane);
        const float B = __shfl(bc, 63);
        const float val = B - bc + li;
        const float ml = wave_max(val);
        wk[lane] = __expf(val - ml);
        if (lane == 0) { ((float*)(ws + WS_CHB))[u] = B; ((float*)(ws + WS_CHM))[u] = ml; }
    }
    __syncthreads();
    {
        const bf16_t* Pk = P + (size_t)(base + lane) * NIN + 512 + h * 128;
#pragma unroll
        for (int i = 0; i < 2; ++i) {
            const int dch = wid * 2 + i; const u32x4 r = *(const u32x4*)(Pk + dch * 8);
            bf16_t* dst = kT + (dch * 8) * 72 + lane;
            dst[0 * 72] = (bf16_t)(r.x & 0xffff); dst[1 * 72] = (bf16_t)(r.x >> 16); dst[2 * 72] = (bf16_t)(r.y & 0xffff); dst[3 * 72] = (bf16_t)(r.y >> 16);
            dst[4 * 72] = (bf16_t)(r.z & 0xffff); dst[5 * 72] = (bf16_t)(r.z >> 16); dst[6 * 72] = (bf16_t)(r.w & 0xffff); dst[7 * 72] = (bf16_t)(r.w >> 16);
        }
        const bf16_t* Pv = P + (size_t)(base + lane) * NIN + 1024 + h * 256;
        const float w = wk[lane];
#pragma unroll
        for (int i = 0; i < 4; ++i) {
            const int vch = wid * 4 + i; const u32x4 r = *(const u32x4*)(Pv + vch * 8);
            bf16_t* dst = vT + (vch * 8) * 72 + lane;
            dst[0 * 72] = f2bf(bflo(r.x) * w); dst[1 * 72] = f2bf(bfhi(r.x) * w); dst[2 * 72] = f2bf(bflo(r.y) * w); dst[3 * 72] = f2bf(bfhi(r.y) * w);
            dst[4 * 72] = f2bf(bflo(r.z) * w); dst[5 * 72] = f2bf(bfhi(r.z) * w); dst[6 * 72] = f2bf(bflo(r.w) * w); dst[7 * 72] = f2bf(bfhi(r.w) * w);
        }
    }
    __syncthreads();
    {
        f32x4 acc[2][8];
#pragma unroll
        for (int a = 0; a < 2; ++a)
#pragma unroll
            for (int d = 0; d < 8; ++d) acc[a][d] = (f32x4){0.f, 0.f, 0.f, 0.f};
#pragma unroll
        for (int ks = 0; ks < 2; ++ks) {
            bf16x8 yf[2];
#pragma unroll
            for (int vt = 0; vt < 2; ++vt) yf[vt] = *(const bf16x8*)(vT + (32 * wid + 16 * vt + fr) * 72 + 32 * ks + 8 * fq);
#pragma unroll
            for (int dt = 0; dt < 8; ++dt) {
                const bf16x8 xf = *(const bf16x8*)(kT + (16 * dt + fr) * 72 + 32 * ks + 8 * fq);
#pragma unroll
                for (int vt = 0; vt < 2; ++vt) acc[vt][dt] = MFMA32(xf, yf[vt], acc[vt][dt]);
            }
        }
        bf16_t* G = GS + (size_t)u * 32768;
#pragma unroll
        for (int vt = 0; vt < 2; ++vt)
#pragma unroll
            for (int dt = 0; dt < 8; ++dt) {
                u32x2 w; w.x = cvt_pk_bf16(acc[vt][dt].x, acc[vt][dt].y); w.y = cvt_pk_bf16(acc[vt][dt].z, acc[vt][dt].w);
                *(u32x2*)(G + (32 * wid + 16 * vt + fr) * 128 + 16 * dt + 4 * fq) = w;
            }
    }
    if (tid < 128) {
        float s = 0.f;
#pragma unroll 8
        for (int ss = 0; ss < 64; ++ss) s += bf2f(kT[tid * 72 + ss]) * wk[ss];
        ((float*)(ws + WS_GN))[(size_t)u * 128 + tid] = s;
    }
    __syncthreads();
}

__device__ __forceinline__ void mlstm_sample_unit(const Params& p, unsigned char* lds, int u) {
    const int tid = threadIdx.x, lane = tid & 63, wid = tid >> 6;
    const int b = u >> 2, h = u & 3, base = TP + b * 4;
    unsigned char* ws = p.ws;
    const bf16_t* P = (const bf16_t*)(ws + WS_P); const float* gates = (const float*)(ws + WS_GATES);
    float* q = (float*)lds;
    float* k = q + 512;
    float* v = k + 512;
    float* n0 = v + 1024;
    float* sc = n0 + 128;
    float* red = sc + 64;
    const float* C0 = p.st_C + (size_t)u * 32768;
    float* Cout = p.out + O_SC + (size_t)u * 32768;
    {
        const int t = tid >> 7, d = tid & 127;
        q[tid] = bf2f(P[(size_t)(base + t) * NIN + h * 128 + d]);
        k[tid] = bf2f(P[(size_t)(base + t) * NIN + 512 + h * 128 + d]);
        const int t2 = tid >> 8, vv = tid & 255;
        v[tid] = bf2f(P[(size_t)(base + t2) * NIN + 1024 + h * 256 + vv]);
        v[512 + tid] = bf2f(P[(size_t)(base + 2 + t2) * NIN + 1024 + h * 256 + vv]);
        if (tid < 128) n0[tid] = p.st_n[(size_t)u * 128 + tid];
    }
    if (tid == 0) {
        float li[4], bc[4]; float run = 0.f;
#pragma unroll
        for (int t = 0; t < 4; ++t) { li[t] = gates[(size_t)(base + t) * 8 + h]; run += gates[(size_t)(base + t) * 8 + 4 + h]; bc[t] = run; }
        const float m0 = p.st_m[u]; float mt[4];
#pragma unroll
        for (int t = 0; t < 4; ++t) {
            const float inter = bc[t] + m0; float mx = inter;
#pragma unroll
            for (int s = 0; s < 4; ++s) if (s <= t) mx = fmaxf(mx, bc[t] - bc[s] + li[s]);
            mt[t] = mx; sc[16 + t] = __expf(inter - mx); sc[28 + t] = __expf(-mx);
#pragma unroll
            for (int s = 0; s < 4; ++s) sc[t * 4 + s] = (s <= t) ? __expf(bc[t] - bc[s] + li[s] - mx) : 0.f;
        }
        const float mn = mt[3];
        sc[24] = __expf(bc[3] + m0 - mn);
#pragma unroll
        for (int s = 0; s < 4; ++s) sc[20 + s] = __expf(bc[3] - bc[s] + li[s] - mn);
        p.out[O_SM + u] = mn;
    }
    __syncthreads();
#pragma unroll
    for (int i = 0; i < 2; ++i) {
        const int pr = wid * 2 + i, t = pr >> 2, s = pr & 3;
        float a = q[t * 128 + lane] * k[s * 128 + lane] + q[t * 128 + 64 + lane] * k[s * 128 + 64 + lane];
        a = wave_sum(a);
        if (lane == 0) sc[32 + pr] = a * sc[pr];
    }
    if (wid < 4) { float a = q[wid * 128 + lane] * n0[lane] + q[wid * 128 + 64 + lane] * n0[64 + lane]; a = wave_sum(a); if (lane == 0) sc[48 + wid] = a; }
    if (tid < 8) sc[52 + tid] = 0.f;
    {
        const int vq = lane, dg = wid;
        f32x4 qc[4];
#pragma unroll
        for (int t = 0; t < 4; ++t) qc[t] = (f32x4){0.f, 0.f, 0.f, 0.f};
        const float decay = sc[24];
        f32x4 vs[4];
#pragma unroll
        for (int s = 0; s < 4; ++s) vs[s] = *(const f32x4*)(v + s * 256 + 4 * vq) * sc[20 + s];
#pragma unroll 4
        for (int dd = 0; dd < 16; ++dd) {
            const int d = dg * 16 + dd;
            const f32x4 c0 = __builtin_nontemporal_load((const f32x4*)(C0 + (size_t)d * 256 + 4 * vq));
            f32x4 cn = c0 * decay;
#pragma unroll
            for (int s = 0; s < 4; ++s) cn += vs[s] * k[s * 128 + d];
            __builtin_nontemporal_store(cn, (f32x4*)(Cout + (size_t)d * 256 + 4 * vq));
#pragma unroll
            for (int t = 0; t < 4; ++t) qc[t] += c0 * q[t * 128 + d];
        }
#pragma unroll
        for (int t = 0; t < 4; ++t) *(f32x4*)(red + (dg * 4 + t) * 256 + 4 * vq) = qc[t];
    }
    if (tid < 128) {
        float nn = sc[24] * n0[tid];
#pragma unroll
        for (int s = 0; s < 4; ++s) nn += sc[20 + s] * k[s * 128 + tid];
        p.out[O_SN + (size_t)u * 128 + tid] = nn;
    }
    __syncthreads();
    {
        const int t = tid >> 7, v0 = (tid & 127) * 2;
        float den = sc[16 + t] * sc[48 + t];
#pragma unroll
        for (int s = 0; s < 4; ++s) den += sc[32 + t * 4 + s];
        const float inv = 1.f / fmaxf(fabsf(den), sc[28 + t]);
        float hv[2]; float ssq = 0.f;
#pragma unroll
        for (int j = 0; j < 2; ++j) {
            float qC = 0.f;
#pragma unroll
            for (int g = 0; g < 8; ++g) qC += red[(g * 4 + t) * 256 + v0 + j];
            float num = sc[16 + t] * qC;
#pragma unroll
            for (int s = 0; s < 4; ++s) num += sc[32 + t * 4 + s] * v[s * 256 + v0 + j];
            hv[j] = num * inv; ssq += hv[j] * hv[j];
        }
        ssq = wave_sum(ssq);
        if (lane == 0) sc[52 + wid] = ssq;
        __syncthreads();
        const float tot = sc[52 + 2 * t] + sc[52 + 2 * t + 1];
        const float rstd = rsqrtf(tot * (1.f / 256.f) + EPS);
        const unsigned ob = *(const unsigned*)(P + (size_t)(base + t) * NIN + 2048 + h * 256 + v0);
        const float o0 = sigmoidf_(bflo(ob)), o1 = sigmoidf_(bfhi(ob));
        const float g0 = p.ml_head_g[h * 256 + v0], g1 = p.ml_head_g[h * 256 + v0 + 1];
        bf16_t* HG = (bf16_t*)(ws + WS_HG);
        *(unsigned*)(HG + (size_t)(base + t) * D + h * 256 + v0) = cvt_pk_bf16(hv[0] * rstd * g0 * o0, hv[1] * rstd * g1 * o1);
    }
    __syncthreads();
}

__device__ __forceinline__ void mlstm_scan(const Params& p, unsigned char* lds, int bid, int G) {
    unsigned char* ws = p.ws;
    bf16_t* GS = (bf16_t*)p.out;
    const float* CHB = (const float*)(ws + WS_CHB); const float* CHM = (const float*)(ws + WS_CHM);
    float* MPREV = (float*)(ws + WS_MPREV); float* GN = (float*)(ws + WS_GN);
    const int tid = threadIdx.x;
    float* decs = (float*)lds;
    float* scls = decs + 64;
    float* tile = scls + 64;
    for (int blk = bid; blk < 256; blk += G) {
        const int bh = blk >> 4;
        if (tid < 64) {
            const float B = CHB[bh * 64 + tid], ml = CHM[bh * 64 + tid];
            float a = B, b2 = ml;
#pragma unroll
            for (int o = 1; o < 64; o <<= 1) { const float ya = __shfl_up(a, o), yb = __shfl_up(b2, o); if (tid >= o) { b2 = fmaxf(yb + a, b2); a = ya + a; } }
            const float m = fmaxf(a, b2);
            float mp = __shfl_up(m, 1); if (tid == 0) mp = 0.f;
            decs[tid] = __expf(B + mp - m); scls[tid] = __expf(ml - m);
            if ((blk & 15) == 0) { MPREV[bh * 64 + tid] = mp; if (tid == 63) p.out[O_PM + bh] = m; }
        }
        float gnv[64]; float* gp = GN + (size_t)(bh * 64) * 128 + (blk & 15) * 8 + (tid & 7);
        if (tid < 8) {
#pragma unroll
            for (int c = 0; c < 64; ++c) gnv[c] = gp[(size_t)c * 128];
        }
        __syncthreads();
        const int e4 = blk * NTHREADS + tid;
        const int off = (e4 & 8191) * 4;
        bf16_t* ptr = GS + (size_t)bh * 64 * 32768 + off;
        float c0 = 0.f, c1 = 0.f, c2 = 0.f, c3 = 0.f;
#pragma unroll 1
        for (int cb = 0; cb < 64; cb += 16) {
            u32x2 g[16];
#pragma unroll
            for (int j = 0; j < 16; ++j) g[j] = *(const u32x2*)(ptr + (size_t)(cb + j) * 32768);
#pragma unroll
            for (int j = 0; j < 16; ++j) {
                const float dec = decs[cb + j], s = scls[cb + j];
                u32x2 w; w.x = cvt_pk_bf16(c0, c1); w.y = cvt_pk_bf16(c2, c3);
                *(u32x2*)(ptr + (size_t)(cb + j) * 32768) = w;
                c0 = dec * c0 + s * bflo(g[j].x); c1 = dec * c1 + s * bfhi(g[j].x); c2 = dec * c2 + s * bflo(g[j].y); c3 = dec * c3 + s * bfhi(g[j].y);
            }
        }
        {
            const int vl = (off >> 7) & 15, d = off & 127;
            tile[(d + 0) * 20 + vl] = c0; tile[(d + 1) * 20 + vl] = c1; tile[(d + 2) * 20 + vl] = c2; tile[(d + 3) * 20 + vl] = c3;
            __syncthreads();
            const int dd = tid >> 2, vq = tid & 3, v0 = (blk & 15) * 16;
            const f32x4 o = (f32x4){tile[dd * 20 + 4 * vq], tile[dd * 20 + 4 * vq + 1], tile[dd * 20 + 4 * vq + 2], tile[dd * 20 + 4 * vq + 3]};
            *(f32x4*)(p.out + O_PC + (size_t)bh * 32768 + (size_t)dd * 256 + v0 + 4 * vq) = o;
        }
        if (tid < 8) {
            float n = 0.f;
#pragma unroll
            for (int c = 0; c < 64; ++c) { gp[(size_t)c * 128] = n; n = decs[c] * n + scls[c] * gnv[c]; }
            p.out[O_PN + bh * 128 + (blk & 15) * 8 + tid] = n;
        }
        __syncthreads();
    }
}

__device__ __forceinline__ void mlstm_out_unit(const Params& p, unsigned char* lds, int u) {
    const int tid = threadIdx.x, lane = tid & 63, wid = tid >> 6, fr = lane & 15, fq = lane >> 4;
    const int bh = u >> 6, c = u & 63, b = bh >> 2, h = bh & 3, base = b * 4096 + c * 64;
    unsigned char* ws = p.ws;
    const bf16_t* P = (const bf16_t*)(ws + WS_P); const float* gates = (const float*)(ws + WS_GATES);
    const bf16_t* CT = (const bf16_t*)p.out + (size_t)u * 32768;
    bf16_t* Qs = (bf16_t*)lds;
    bf16_t* Ks = Qs + 64 * 136;
    bf16_t* Ac = Ks + 64 * 136;
    bf16_t* VT = Ac + 64 * 200;
    float* sm = (float*)(VT + 256 * 72);
    float *bt = sm, *lmb = sm + 64, *mt = sm + 128, *at = sm + 192, *den = sm + 256, *hss = sm + 320, *npv = sm + 384;
    bf16x8 cf[2][4];
#pragma unroll
    for (int vt = 0; vt < 2; ++vt)
#pragma unroll
        for (int kd = 0; kd < 4; ++kd) cf[vt][kd] = *(const bf16x8*)(CT + (32 * wid + 16 * vt + fr) * 128 + 32 * kd + 8 * fq);
    if (wid == 0) {
        const float lf = gates[(size_t)(base + lane) * 8 + 4 + h], li = gates[(size_t)(base + lane) * 8 + h];
        const float bc = scan_sum(lf, lane);
        const float lm = li - bc;
        const float pm = scan_max(lm, lane);
        const float mprev = ((const float*)(ws + WS_MPREV))[u];
        const float inter = bc + mprev;
        const float m_t = fmaxf(inter, bc + pm);
        bt[lane] = bc; lmb[lane] = lm; mt[lane] = m_t; at[lane] = __expf(inter - m_t); den[lane] = 0.f; hss[lane] = 0.f;
    }
    if (wid == 1) { const float* NP = (const float*)(ws + WS_GN) + (size_t)u * 128; npv[lane] = NP[lane]; npv[64 + lane] = NP[64 + lane]; }
    __syncthreads();
#pragma unroll
    for (int i = 0; i < 2; ++i) {
        const int ci = tid + 512 * i, t = ci >> 4, dch = ci & 15;
        const u32x4 qv = *(const u32x4*)(P + (size_t)(base + t) * NIN + h * 128 + dch * 8);
        const u32x4 kv = *(const u32x4*)(P + (size_t)(base + t) * NIN + 512 + h * 128 + dch * 8);
        *(u32x4*)(Qs + t * 136 + dch * 8) = qv;
        *(u32x4*)(Ks + t * 136 + dch * 8) = kv;
        const float a = at[t];
        u32x4 sq; sq.x = cvt_pk_bf16(bflo(qv.x) * a, bfhi(qv.x) * a); sq.y = cvt_pk_bf16(bflo(qv.y) * a, bfhi(qv.y) * a);
        sq.z = cvt_pk_bf16(bflo(qv.z) * a, bfhi(qv.z) * a); sq.w = cvt_pk_bf16(bflo(qv.w) * a, bfhi(qv.w) * a);
        *(u32x4*)(Ac + t * 200 + 64 + dch * 8) = sq;
    }
    {
        const bf16_t* Pv = P + (size_t)(base + lane) * NIN + 1024 + h * 256;
#pragma unroll
        for (int i = 0; i < 4; ++i) {
            const int vch = wid * 4 + i; const u32x4 r = *(const u32x4*)(Pv + vch * 8);
            bf16_t* dst = VT + (vch * 8) * 72 + lane;
            dst[0 * 72] = (bf16_t)(r.x & 0xffff); dst[1 * 72] = (bf16_t)(r.x >> 16); dst[2 * 72] = (bf16_t)(r.y & 0xffff); dst[3 * 72] = (bf16_t)(r.y >> 16);
            dst[4 * 72] = (bf16_t)(r.z & 0xffff); dst[5 * 72] = (bf16_t)(r.z >> 16); dst[6 * 72] = (bf16_t)(r.w & 0xffff); dst[7 * 72] = (bf16_t)(r.w >> 16);
        }
    }
    __syncthreads();
    {
        const int tt = wid >> 1;
#pragma unroll
        for (int j = 0; j < 2; ++j) {
            const int st = 2 * (wid & 1) + j;
            const int t = 16 * tt + fr, s0 = 16 * st + 4 * fq;
            u32x2 w; w.x = 0u; w.y = 0u;
            if (st <= tt) {
                f32x4 a = (f32x4){0.f, 0.f, 0.f, 0.f};
#pragma unroll
                for (int kd = 0; kd < 4; ++kd) {
                    const bf16x8 x = *(const bf16x8*)(Ks + (16 * st + fr) * 136 + 32 * kd + 8 * fq);
                    const bf16x8 y = *(const bf16x8*)(Qs + (16 * tt + fr) * 136 + 32 * kd + 8 * fq);
                    a = MFMA32(x, y, a);
                }
                const float e0 = bt[t] - mt[t];
                float vals[4];
#pragma unroll
                for (int i = 0; i < 4; ++i) { const int s = s0 + i; vals[i] = (s <= t) ? a[i] * __expf(e0 + lmb[s]) : 0.f; }
                float rs = (vals[0] + vals[1]) + (vals[2] + vals[3]);
                rs += __shfl_xor(rs, 16); rs += __shfl_xor(rs, 32);
                if (fq == 0) atomicAdd(&den[t], rs);
                w.x = cvt_pk_bf16(vals[0], vals[1]); w.y = cvt_pk_bf16(vals[2], vals[3]);
            }
            *(u32x2*)(Ac + t * 200 + s0) = w;
        }
#pragma unroll
        for (int i = 0; i < 8; ++i) {
            const int t = 8 * wid + i;
            float a = bf2f(Qs[t * 136 + lane]) * npv[lane] + bf2f(Qs[t * 136 + 64 + lane]) * npv[64 + lane];
            a = wave_sum(a);
            if (lane == 0) atomicAdd(&den[t], at[t] * a);
        }
    }
    __syncthreads();
    f32x4 acc[4][2];
#pragma unroll
    for (int a = 0; a < 4; ++a)
#pragma unroll
        for (int d = 0; d < 2; ++d) acc[a][d] = (f32x4){0.f, 0.f, 0.f, 0.f};
#pragma unroll
    for (int kk = 0; kk < 6; ++kk) {
        bf16x8 x[2];
#pragma unroll
        for (int vt = 0; vt < 2; ++vt) x[vt] = (kk < 2) ? *(const bf16x8*)(VT + (32 * wid + 16 * vt + fr) * 72 + 32 * kk + 8 * fq) : cf[vt][kk >= 2 ? kk - 2 : 0];
#pragma unroll
        for (int tt = 0; tt < 4; ++tt) {
            const bf16x8 y = *(const bf16x8*)(Ac + (16 * tt + fr) * 200 + 32 * kk + 8 * fq);
#pragma unroll
            for (int vt = 0; vt < 2; ++vt) acc[tt][vt] = MFMA32(x[vt], y, acc[tt][vt]);
        }
    }
#pragma unroll
    for (int tt = 0; tt < 4; ++tt) {
        const int t = 16 * tt + fr;
        const float inv = 1.f / fmaxf(fabsf(den[t]), __expf(-mt[t]));
        float ssq = 0.f;
#pragma unroll
        for (int vt = 0; vt < 2; ++vt) { acc[tt][vt] = acc[tt][vt] * inv; const f32x4 a = acc[tt][vt]; ssq += (a.x * a.x + a.y * a.y) + (a.z * a.z + a.w * a.w); }
        ssq += __shfl_xor(ssq, 16); ssq += __shfl_xor(ssq, 32);
        if (fq == 0) atomicAdd(&hss[t], ssq);
    }
    __syncthreads();
    {
        bf16_t* HG = (bf16_t*)(ws + WS_HG);
#pragma unroll
        for (int tt = 0; tt < 4; ++tt) {
            const int t = 16 * tt + fr;
            const float rstd = rsqrtf(hss[t] * (1.f / 256.f) + EPS);
#pragma unroll
            for (int vt = 0; vt < 2; ++vt) {
                const int v0 = 32 * wid + 16 * vt + 4 * fq;
                const u32x2 ob = *(const u32x2*)(P + (size_t)(base + t) * NIN + 2048 + h * 256 + v0);
                const f32x4 g = *(const f32x4*)(p.ml_head_g + h * 256 + v0);
                const f32x4 a = acc[tt][vt];
                u32x2 w;
                w.x = cvt_pk_bf16(a.x * rstd * g.x * sigmoidf_(bflo(ob.x)), a.y * rstd * g.y * sigmoidf_(bfhi(ob.x)));
                w.y = cvt_pk_bf16(a.z * rstd * g.z * sigmoidf_(bflo(ob.y)), a.w * rstd * g.w * sigmoidf_(bfhi(ob.y)));
                *(u32x2*)(HG + (size_t)(base + t) * D + h * 256 + v0) = w;
            }
        }
    }
    __syncthreads();
}

__device__ __forceinline__ void norm_frag(const u32x4 r0, const u32x4 r1, const float* __restrict__ g, float extra, int fq, bf16x8& o0, bf16x8& o1) {
    float f[16];
    f[0] = bflo(r0.x); f[1] = bfhi(r0.x); f[2] = bflo(r0.y); f[3] = bfhi(r0.y); f[4] = bflo(r0.z); f[5] = bfhi(r0.z); f[6] = bflo(r0.w); f[7] = bfhi(r0.w);
    f[8] = bflo(r1.x); f[9] = bfhi(r1.x); f[10] = bflo(r1.y); f[11] = bfhi(r1.y); f[12] = bflo(r1.z); f[13] = bfhi(r1.z); f[14] = bflo(r1.w); f[15] = bfhi(r1.w);
    float s = 0.f;
#pragma unroll
    for (int i = 0; i < 16; ++i) s += f[i] * f[i];
    s += __shfl_xor(s, 16); s += __shfl_xor(s, 32);
    const float rs = rsqrtf(s * (1.f / 64.f) + EPS) * extra;
    const f32x4 ga = *(const f32x4*)(g + 8 * fq), gb = *(const f32x4*)(g + 8 * fq + 4), gc = *(const f32x4*)(g + 32 + 8 * fq), gd = *(const f32x4*)(g + 32 + 8 * fq + 4);
    u32x4 a, b2;
    a.x = cvt_pk_bf16(f[0] * rs * ga.x, f[1] * rs * ga.y); a.y = cvt_pk_bf16(f[2] * rs * ga.z, f[3] * rs * ga.w);
    a.z = cvt_pk_bf16(f[4] * rs * gb.x, f[5] * rs * gb.y); a.w = cvt_pk_bf16(f[6] * rs * gb.z, f[7] * rs * gb.w);
    b2.x = cvt_pk_bf16(f[8] * rs * gc.x, f[9] * rs * gc.y); b2.y = cvt_pk_bf16(f[10] * rs * gc.z, f[11] * rs * gc.w);
    b2.z = cvt_pk_bf16(f[12] * rs * gd.x, f[13] * rs * gd.y); b2.w = cvt_pk_bf16(f[14] * rs * gd.z, f[15] * rs * gd.w);
    o0 = __builtin_bit_cast(bf16x8, a); o1 = __builtin_bit_cast(bf16x8, b2);
}

__device__ __forceinline__ void attn_prompt_unit(const Params& p, unsigned char* lds, int u) {
    const int tid = threadIdx.x, lane = tid & 63, wid = tid >> 6, fr = lane & 15, fq = lane >> 4;
    const int qb = u & 31, kvh = (u >> 5) & 3, b = u >> 7;
    unsigned char* ws = p.ws;
    const bf16_t* KVQ = (const bf16_t*)(ws + WS_KVQ);
    bf16_t* AO = (bf16_t*)(ws + WS_ATT);
    bf16_t* Ks = (bf16_t*)lds;
    bf16_t* VT = Ks + 256 * 72;
    const int pos0 = qb * 128 - 128;
    u32x4 qr[4][2];
    {
        const int g_ = wid >> 1, half_ = wid & 1, head_ = kvh * 4 + g_;
#pragma unroll
        for (int m = 0; m < 4; ++m) {
            const bf16_t* qp = KVQ + ((size_t)b * 4096 + qb * 128 + 64 * half_ + 16 * m + fr) * NKVQ + 512 + head_ * 64;
            qr[m][0] = *(const u32x4*)(qp + 8 * fq); qr[m][1] = *(const u32x4*)(qp + 32 + 8 * fq);
        }
    }
#pragma unroll
    for (int i = 0; i < 4; ++i) {
        const int ci = tid + 512 * i, j = ci >> 3, ch = ci & 7, pos = pos0 + j;
        u32x4 r = (u32x4){0u, 0u, 0u, 0u};
        if (pos >= 0) r = *(const u32x4*)(KVQ + (size_t)(b * 4096 + pos) * NKVQ + kvh * 64 + ch * 8);
        float f[8] = {bflo(r.x), bfhi(r.x), bflo(r.y), bfhi(r.y), bflo(r.z), bfhi(r.z), bflo(r.w), bfhi(r.w)};
        float s = 0.f;
#pragma unroll
        for (int e = 0; e < 8; ++e) s += f[e] * f[e];
        s += __shfl_xor(s, 1); s += __shfl_xor(s, 2); s += __shfl_xor(s, 4);
        const float rs = rsqrtf(s * (1.f / 64.f) + EPS);
        const f32x4 g0 = *(const f32x4*)(p.k_norm_g + ch * 8), g1 = *(const f32x4*)(p.k_norm_g + ch * 8 + 4);
        f[0] *= rs * g0.x; f[1] *= rs * g0.y; f[2] *= rs * g0.z; f[3] *= rs * g0.w; f[4] *= rs * g1.x; f[5] *= rs * g1.y; f[6] *= rs * g1.z; f[7] *= rs * g1.w;
        u32x4 w; w.x = cvt_pk_bf16(f[0], f[1]); w.y = cvt_pk_bf16(f[2], f[3]); w.z = cvt_pk_bf16(f[4], f[5]); w.w = cvt_pk_bf16(f[6], f[7]);
        *(u32x4*)(Ks + j * 72 + ch * 8) = w;
        if (qb == 31 && j >= 128) {
            float* o = p.out + O_PWK + ((size_t)(b * 128 + (j - 128)) * 4 + kvh) * 64 + ch * 8;
            *(f32x4*)o = (f32x4){f[0], f[1], f[2], f[3]}; *(f32x4*)(o + 4) = (f32x4){f[4], f[5], f[6], f[7]};
        }
    }
#pragma unroll
    for (int i = 0; i < 4; ++i) {
        const int ci = tid + 512 * i, j = ci & 255, ch = ci >> 8, pos = pos0 + j;
        u32x4 r = (u32x4){0u, 0u, 0u, 0u};
        if (pos >= 0) r = *(const u32x4*)(KVQ + (size_t)(b * 4096 + pos) * NKVQ + 256 + kvh * 64 + ch * 8);
        bf16_t* dst = VT + (ch * 8) * 264 + j;
        dst[0 * 264] = (bf16_t)(r.x & 0xffff); dst[1 * 264] = (bf16_t)(r.x >> 16); dst[2 * 264] = (bf16_t)(r.y & 0xffff); dst[3 * 264] = (bf16_t)(r.y >> 16);
        dst[4 * 264] = (bf16_t)(r.z & 0xffff); dst[5 * 264] = (bf16_t)(r.z >> 16); dst[6 * 264] = (bf16_t)(r.w & 0xffff); dst[7 * 264] = (bf16_t)(r.w >> 16);
        if (qb == 31 && j >= 128) {
            float* o = p.out + O_PWV + ((size_t)(b * 128 + (j - 128)) * 4 + kvh) * 64 + ch * 8;
            *(f32x4*)o = (f32x4){bflo(r.x), bfhi(r.x), bflo(r.y), bfhi(r.y)}; *(f32x4*)(o + 4) = (f32x4){bflo(r.z), bfhi(r.z), bflo(r.w), bfhi(r.w)};
        }
    }
    __syncthreads();
    const int g = wid >> 1, half = wid & 1, head = kvh * 4 + g;
    const float sink = p.att_sinks[head];
    const float* qg = p.q_norm_g;
#pragma unroll
    for (int m = 0; m < 4; ++m) {
        const int j0 = 64 * half + 16 * m;
        const size_t R = (size_t)b * 4096 + qb * 128 + j0 + fr;
        bf16x8 q0, q1; norm_frag(qr[m][0], qr[m][1], qg, 0.125f, fq, q0, q1);
        f32x4 s[9];
#pragma unroll
        for (int i = 0; i < 9; ++i) {
            s[i] = (f32x4){0.f, 0.f, 0.f, 0.f};
            const bf16_t* kr = Ks + (j0 + 16 * i + fr) * 72 + 8 * fq;
            s[i] = MFMA32(*(const bf16x8*)kr, q0, s[i]);
            s[i] = MFMA32(*(const bf16x8*)(kr + 32), q1, s[i]);
        }
        float mx = sink;
#pragma unroll
        for (int e = 0; e < 4; ++e) {
            s[0][e] = (4 * fq + e >= fr) ? s[0][e] : -INFINITY;
            s[8][e] = (4 * fq + e <= fr) ? s[8][e] : -INFINITY;
        }
        if (pos0 < 0) {
#pragma unroll
            for (int i = 0; i < 9; ++i)
#pragma unroll
                for (int e = 0; e < 4; ++e) s[i][e] = (pos0 + j0 + 16 * i + 4 * fq + e >= 0) ? s[i][e] : -INFINITY;
        }
#pragma unroll
        for (int i = 0; i < 9; ++i)
#pragma unroll
            for (int e = 0; e < 4; ++e) mx = fmaxf(mx, s[i][e]);
        mx = fmaxf(mx, __shfl_xor(mx, 16)); mx = fmaxf(mx, __shfl_xor(mx, 32));
        float l = 0.f;
        bf16x4 pf[9];
#pragma unroll
        for (int i = 0; i < 9; ++i) {
            float e0 = __expf(s[i][0] - mx), e1 = __expf(s[i][1] - mx), e2 = __expf(s[i][2] - mx), e3 = __expf(s[i][3] - mx);
            l += (e0 + e1) + (e2 + e3);
            u32x2 w; w.x = cvt_pk_bf16(e0, e1); w.y = cvt_pk_bf16(e2, e3);
            pf[i] = __builtin_bit_cast(bf16x4, w);
        }
        l += __shfl_xor(l, 16); l += __shfl_xor(l, 32);
        l += __expf(sink - mx);
        const float inv = 1.f / l;
        f32x4 o[4];
#pragma unroll
        for (int dt = 0; dt < 4; ++dt) {
            o[dt] = (f32x4){0.f, 0.f, 0.f, 0.f};
#pragma unroll
            for (int i = 0; i < 9; ++i) {
                const bf16x4 vf = *(const bf16x4*)(VT + (16 * dt + fr) * 264 + j0 + 16 * i + 4 * fq);
                o[dt] = MFMA16(vf, pf[i], o[dt]);
            }
        }
#pragma unroll
        for (int dt = 0; dt < 4; ++dt) {
            u32x2 w; w.x = cvt_pk_bf16(o[dt].x * inv, o[dt].y * inv); w.y = cvt_pk_bf16(o[dt].z * inv, o[dt].w * inv);
            *(u32x2*)(AO + R * D + head * 64 + 16 * dt + 4 * fq) = w;
        }
    }
    __syncthreads();
}

__device__ __forceinline__ void attn_sample_unit(const Params& p, int u, int lane) {
    const int fr = lane & 15, fq = lane >> 4;
    const int b = u >> 2, kvh = u & 3;
    unsigned char* ws = p.ws;
    const bf16_t* KVQ = (const bf16_t*)(ws + WS_KVQ);
    bf16_t* AO = (bf16_t*)(ws + WS_ATT);
    const float* ck = p.cache_k + (size_t)b * 128 * 256 + kvh * 64;
    const float* cv = p.cache_v + (size_t)b * 128 * 256 + kvh * 64;
    float* owk = p.out + O_SWK + (size_t)b * 128 * 256 + kvh * 64;
    float* owv = p.out + O_SWV + (size_t)b * 128 * 256 + kvh * 64;
    const size_t rbase = (size_t)TP + b * 4;
    for (int i = lane; i < 124 * 16; i += 64) {
        const int j = i >> 4, d4 = (i & 15) * 4;
        *(f32x4*)(owk + (size_t)j * 256 + d4) = *(const f32x4*)(ck + (size_t)(j + 4) * 256 + d4);
        *(f32x4*)(owv + (size_t)j * 256 + d4) = *(const f32x4*)(cv + (size_t)(j + 4) * 256 + d4);
    }
    {
        const int t = lane >> 4, d4 = (lane & 15) * 4;
        const u32x2 kr = *(const u32x2*)(KVQ + (rbase + t) * NKVQ + kvh * 64 + d4);
        const u32x2 vr = *(const u32x2*)(KVQ + (rbase + t) * NKVQ + 256 + kvh * 64 + d4);
        float f0 = bflo(kr.x), f1 = bfhi(kr.x), f2 = bflo(kr.y), f3 = bfhi(kr.y);
        float s = (f0 * f0 + f1 * f1) + (f2 * f2 + f3 * f3);
        s += __shfl_xor(s, 1); s += __shfl_xor(s, 2); s += __shfl_xor(s, 4); s += __shfl_xor(s, 8);
        const float rs = rsqrtf(s * (1.f / 64.f) + EPS);
        const f32x4 g = *(const f32x4*)(p.k_norm_g + d4);
        *(f32x4*)(owk + (size_t)(124 + t) * 256 + d4) = (f32x4){f0 * rs * g.x, f1 * rs * g.y, f2 * rs * g.z, f3 * rs * g.w};
        *(f32x4*)(owv + (size_t)(124 + t) * 256 + d4) = (f32x4){bflo(vr.x), bfhi(vr.x), bflo(vr.y), bfhi(vr.y)};
    }
    const int g = fr >> 2, t = fr & 3, head = kvh * 4 + g;
    const bf16_t* qp = KVQ + (rbase + t) * NKVQ + 512 + head * 64;
    const u32x4 r0 = *(const u32x4*)(qp + 8 * fq), r1 = *(const u32x4*)(qp + 32 + 8 * fq);
    bf16x8 q0, q1; norm_frag(r0, r1, p.q_norm_g, 0.125f, fq, q0, q1);
    const float sink = p.att_sinks[head];
    bf16x8 nk0, nk1;
    {
        const bf16_t* kp = KVQ + (rbase + (fr & 3)) * NKVQ + kvh * 64;
        const u32x4 a0 = *(const u32x4*)(kp + 8 * fq), a1 = *(const u32x4*)(kp + 32 + 8 * fq);
        norm_frag(a0, a1, p.k_norm_g, 1.f, fq, nk0, nk1);
        if (fr >= 4) { nk0 = (bf16x8){0, 0, 0, 0, 0, 0, 0, 0}; nk1 = nk0; }
    }
    f32x4 s[9];
#pragma unroll
    for (int i = 0; i < 8; ++i) {
        const float* kr = ck + (size_t)(16 * i + fr) * 256 + 8 * fq;
        const f32x4 a = *(const f32x4*)kr, b2 = *(const f32x4*)(kr + 4), c = *(const f32x4*)(kr + 32), d = *(const f32x4*)(kr + 36);
        u32x4 x0, x1;
        x0.x = cvt_pk_bf16(a.x, a.y); x0.y = cvt_pk_bf16(a.z, a.w); x0.z = cvt_pk_bf16(b2.x, b2.y); x0.w = cvt_pk_bf16(b2.z, b2.w);
        x1.x = cvt_pk_bf16(c.x, c.y); x1.y = cvt_pk_bf16(c.z, c.w); x1.z = cvt_pk_bf16(d.x, d.y); x1.w = cvt_pk_bf16(d.z, d.w);
        s[i] = (f32x4){0.f, 0.f, 0.f, 0.f};
        s[i] = MFMA32(__builtin_bit_cast(bf16x8, x0), q0, s[i]);
        s[i] = MFMA32(__builtin_bit_cast(bf16x8, x1), q1, s[i]);
    }
    s[8] = (f32x4){0.f, 0.f, 0.f, 0.f};
    s[8] = MFMA32(nk0, q0, s[8]); s[8] = MFMA32(nk1, q1, s[8]);
    float mx = sink;
#pragma unroll
    for (int i = 0; i < 9; ++i)
#pragma unroll
        for (int e = 0; e < 4; ++e) {
            const int j = 16 * i + 4 * fq + e;
            const bool ok = (j >= t) && (j <= t + 128);
            s[i][e] = ok ? s[i][e] : -INFINITY;
            mx = fmaxf(mx, s[i][e]);
        }
    mx = fmaxf(mx, __shfl_xor(mx, 16)); mx = fmaxf(mx, __shfl_xor(mx, 32));
    float l = 0.f; bf16x4 pf[9];
#pragma unroll
    for (int i = 0; i < 9; ++i) {
        float e0 = __expf(s[i][0] - mx), e1 = __expf(s[i][1] - mx), e2 = __expf(s[i][2] - mx), e3 = __expf(s[i][3] - mx);
        l += (e0 + e1) + (e2 + e3);
        u32x2 w; w.x = cvt_pk_bf16(e0, e1); w.y = cvt_pk_bf16(e2, e3);
        pf[i] = __builtin_bit_cast(bf16x4, w);
    }
    l += __shfl_xor(l, 16); l += __shfl_xor(l, 32);
    l += __expf(sink - mx);
    const float inv = 1.f / l;
#pragma unroll
    for (int dt = 0; dt < 4; ++dt) {
        f32x4 o = (f32x4){0.f, 0.f, 0.f, 0.f};
#pragma unroll
        for (int i = 0; i < 8; ++i) {
            const float* vr = cv + (size_t)(16 * i + 4 * fq) * 256 + 16 * dt + fr;
            u32x2 w; w.x = cvt_pk_bf16(vr[0], vr[256]); w.y = cvt_pk_bf16(vr[512], vr[768]);
            o = MFMA16(__builtin_bit_cast(bf16x4, w), pf[i], o);
        }
        {
            u32x2 w; w.x = 0u; w.y = 0u;
            const bf16_t* vp = KVQ + rbase * NKVQ + 256 + kvh * 64 + 16 * dt + fr;
            const unsigned v0 = vp[0], v1 = vp[NKVQ], v2 = vp[2 * NKVQ], v3 = vp[3 * NKVQ];
            if (fq == 0) { w.x = v0 | (v1 << 16); w.y = v2 | (v3 << 16); }
            o = MFMA16(__builtin_bit_cast(bf16x4, w), pf[8], o);
        }
        u32x2 w; w.x = cvt_pk_bf16(o.x * inv, o.y * inv); w.y = cvt_pk_bf16(o.z * inv, o.w * inv);
        *(u32x2*)(AO + (rbase + t) * D + head * 64 + 16 * dt + 4 * fq) = w;
    }
}


__device__ __forceinline__ void attn_sample_block(const Params& p, unsigned char* lds, int u) {
    const int tid = threadIdx.x, lane = tid & 63, wid = tid >> 6, fr = lane & 15, fq = lane >> 4;
    const int b = u >> 2, kvh = u & 3;
    unsigned char* ws = p.ws;
    const bf16_t* KVQ = (const bf16_t*)(ws + WS_KVQ);
    bf16_t* AO = (bf16_t*)(ws + WS_ATT);
    const float* ck = p.cache_k + (size_t)b * 128 * 256 + kvh * 64;
    const float* cv = p.cache_v + (size_t)b * 128 * 256 + kvh * 64;
    float* owk = p.out + O_SWK + (size_t)b * 128 * 256 + kvh * 64;
    float* owv = p.out + O_SWV + (size_t)b * 128 * 256 + kvh * 64;
    const size_t rbase = (size_t)TP + b * 4;
    bf16_t* Ks = (bf16_t*)lds;
    bf16_t* VT = Ks + 144 * 72;
    f32x4 kf[4], vf[4];
#pragma unroll
    for (int i = 0; i < 4; ++i) { const int idx = tid + 512 * i, j = idx >> 4, c4 = (idx & 15) * 4; kf[i] = __builtin_nontemporal_load((const f32x4*)(ck + (size_t)j * 256 + c4)); vf[i] = __builtin_nontemporal_load((const f32x4*)(cv + (size_t)j * 256 + c4)); }
#pragma unroll
    for (int i = 0; i < 4; ++i) {
        const int idx = tid + 512 * i, j = idx >> 4, c4 = (idx & 15) * 4;
        if (j >= 4) { __builtin_nontemporal_store(kf[i], (f32x4*)(owk + (size_t)(j - 4) * 256 + c4)); __builtin_nontemporal_store(vf[i], (f32x4*)(owv + (size_t)(j - 4) * 256 + c4)); }
        u32x2 w; w.x = cvt_pk_bf16(kf[i].x, kf[i].y); w.y = cvt_pk_bf16(kf[i].z, kf[i].w);
        *(u32x2*)(Ks + j * 72 + c4) = w;
        VT[(c4 + 0) * 152 + j] = f2bf(vf[i].x); VT[(c4 + 1) * 152 + j] = f2bf(vf[i].y); VT[(c4 + 2) * 152 + j] = f2bf(vf[i].z); VT[(c4 + 3) * 152 + j] = f2bf(vf[i].w);
    }
    if (tid < 64) {
        const int t = tid >> 4, d4 = (tid & 15) * 4;
        const u32x2 kr = *(const u32x2*)(KVQ + (rbase + t) * NKVQ + kvh * 64 + d4);
        const u32x2 vr = *(const u32x2*)(KVQ + (rbase + t) * NKVQ + 256 + kvh * 64 + d4);
        float f0 = bflo(kr.x), f1 = bfhi(kr.x), f2 = bflo(kr.y), f3 = bfhi(kr.y);
        float s = (f0 * f0 + f1 * f1) + (f2 * f2 + f3 * f3);
        s += __shfl_xor(s, 1); s += __shfl_xor(s, 2); s += __shfl_xor(s, 4); s += __shfl_xor(s, 8);
        const float rs = rsqrtf(s * (1.f / 64.f) + EPS);
        const f32x4 g = *(const f32x4*)(p.k_norm_g + d4);
        f0 *= rs * g.x; f1 *= rs * g.y; f2 *= rs * g.z; f3 *= rs * g.w;
        *(f32x4*)(owk + (size_t)(124 + t) * 256 + d4) = (f32x4){f0, f1, f2, f3};
        *(f32x4*)(owv + (size_t)(124 + t) * 256 + d4) = (f32x4){bflo(vr.x), bfhi(vr.x), bflo(vr.y), bfhi(vr.y)};
        u32x2 w; w.x = cvt_pk_bf16(f0, f1); w.y = cvt_pk_bf16(f2, f3);
        *(u32x2*)(Ks + (128 + t) * 72 + d4) = w;
        VT[(d4 + 0) * 152 + 128 + t] = (bf16_t)(vr.x & 0xffff); VT[(d4 + 1) * 152 + 128 + t] = (bf16_t)(vr.x >> 16);
        VT[(d4 + 2) * 152 + 128 + t] = (bf16_t)(vr.y & 0xffff); VT[(d4 + 3) * 152 + 128 + t] = (bf16_t)(vr.y >> 16);
    } else if (tid < 64 + 192) {
        const int i = tid - 64;
        if (i < 96) { const int r = 132 + (i >> 3), c8 = (i & 7) * 8; *(u32x4*)(Ks + r * 72 + c8) = (u32x4){0u, 0u, 0u, 0u}; }
        else { const int d = i - 96; if (d < 64) { bf16_t* z = VT + d * 152 + 132; for (int e = 0; e < 12; ++e) z[e] = 0; } }
    }
    __syncthreads();
    if (wid < 4) {
        const int dt = wid;
        const int g = fr >> 2, t = fr & 3, head = kvh * 4 + g;
        const bf16_t* qp = KVQ + (rbase + t) * NKVQ + 512 + head * 64;
        const u32x4 r0 = *(const u32x4*)(qp + 8 * fq), r1 = *(const u32x4*)(qp + 32 + 8 * fq);
        bf16x8 q0, q1; norm_frag(r0, r1, p.q_norm_g, 0.125f, fq, q0, q1);
        const float sink = p.att_sinks[head];
        f32x4 s[9];
#pragma unroll
        for (int i = 0; i < 9; ++i) {
            s[i] = (f32x4){0.f, 0.f, 0.f, 0.f};
            const bf16_t* kr = Ks + (16 * i + fr) * 72 + 8 * fq;
            s[i] = MFMA32(*(const bf16x8*)kr, q0, s[i]);
            s[i] = MFMA32(*(const bf16x8*)(kr + 32), q1, s[i]);
        }
        float mx = sink;
#pragma unroll
        for (int i = 0; i < 9; ++i)
#pragma unroll
            for (int e = 0; e < 4; ++e) {
                const int j = 16 * i + 4 * fq + e;
                const bool ok = (j >= t) && (j <= t + 128);
                s[i][e] = ok ? s[i][e] : -INFINITY;
                mx = fmaxf(mx, s[i][e]);
            }
        mx = fmaxf(mx, __shfl_xor(mx, 16)); mx = fmaxf(mx, __shfl_xor(mx, 32));
        float l = 0.f;
        f32x4 o = (f32x4){0.f, 0.f, 0.f, 0.f};
#pragma unroll
        for (int i = 0; i < 9; ++i) {
            const float e0 = __expf(s[i][0] - mx), e1 = __expf(s[i][1] - mx), e2 = __expf(s[i][2] - mx), e3 = __expf(s[i][3] - mx);
            l += (e0 + e1) + (e2 + e3);
            u32x2 w; w.x = cvt_pk_bf16(e0, e1); w.y = cvt_pk_bf16(e2, e3);
            const bf16x4 vfr = *(const bf16x4*)(VT + (16 * dt + fr) * 152 + 16 * i + 4 * fq);
            o = MFMA16(vfr, __builtin_bit_cast(bf16x4, w), o);
        }
        l += __shfl_xor(l, 16); l += __shfl_xor(l, 32);
        l += __expf(sink - mx);
        const float inv = 1.f / l;
        u32x2 w; w.x = cvt_pk_bf16(o.x * inv, o.y * inv); w.y = cvt_pk_bf16(o.z * inv, o.w * inv);
        *(u32x2*)(AO + (rbase + t) * D + head * 64 + 16 * dt + 4 * fq) = w;
    }
    __syncthreads();
}

#define LAS __attribute__((address_space(3)))
#define XB_TMO      128
#define XB_XCNT(j)  (256  + 64 * (j))
#define XB_XSUB(j)  (1280 + 64 * (j))
#define XB_XGEN(j)  (2304 + 64 * (j))
#define XB_TOP      3328
#define XB_TOPGEN   3392
#define XCD_BAR_WORDS 3456
#define XB_SPIN_CAP (1u << 18)

__device__ __forceinline__ unsigned xb_ld(unsigned* p)              { return __hip_atomic_load(p, __ATOMIC_RELAXED, __HIP_MEMORY_SCOPE_AGENT); }
__device__ __forceinline__ unsigned xb_add(unsigned* p, unsigned v) { return __hip_atomic_fetch_add(p, v, __ATOMIC_RELAXED, __HIP_MEMORY_SCOPE_AGENT); }
__device__ __forceinline__ unsigned xb_xcc_id() { return (unsigned)__builtin_amdgcn_s_getreg((3 << 11) | 20) & 0xFu; }
#define XB_SPIN(cond, bar) do { unsigned _sp = 0; while (cond) { __builtin_amdgcn_s_sleep(1); \
    if ((++_sp & 255u) == 0u) { if (xb_ld(&(bar)[XB_TMO])) break; if (_sp > XB_SPIN_CAP) { atomicAdd(&(bar)[XB_TMO], 1u); break; } } } } while (0)

struct XcdBarrier {
    unsigned* bar; unsigned x;
    volatile LAS unsigned* st;
};

__device__ __forceinline__ XcdBarrier xcd_barrier_post(unsigned* bar, volatile LAS unsigned* st) {
    XcdBarrier b; b.bar = bar; b.x = xb_xcc_id(); b.st = st;
    if (threadIdx.x == 0) (void)xb_add(&bar[XB_XCNT(b.x)], 1u);
    return b;
}
__device__ __forceinline__ void xcd_barrier_complete(unsigned* bar, unsigned x, unsigned& nloc, unsigned& nx) {
    const unsigned G = gridDim.x * gridDim.y * gridDim.z;
    unsigned sum, cnt, mine, sp = 0u;
    for (;;) {
        sum = 0u; cnt = 0u; mine = 0u;
#pragma unroll
        for (unsigned j = 0; j < 16; ++j) { const unsigned c = xb_ld(&bar[XB_XCNT(j)]); sum += c; cnt += (c > 0u) ? 1u : 0u; mine = (j == x) ? c : mine; }
        if (sum == G) break;
        __builtin_amdgcn_s_sleep(1);
        if ((++sp & 255u) == 0u) { if (xb_ld(&bar[XB_TMO])) break; if (sp > XB_SPIN_CAP) { atomicAdd(&bar[XB_TMO], 1u); break; } }
    }
    nloc = mine > 0u ? mine : 1u; nx = cnt > 0u ? cnt : 1u;
}

__device__ __forceinline__ void xcd_barrier(const XcdBarrier& b) {
    asm volatile("s_waitcnt vmcnt(0)" ::: "memory");
    __syncthreads();
    if (threadIdx.x == 0) {
        unsigned* bar = b.bar;
        __builtin_amdgcn_s_waitcnt(0);
        unsigned nloc = b.st[0], nx = b.st[1];
        if (nloc == 0u) { xcd_barrier_complete(bar, b.x, nloc, nx); b.st[0] = nloc; b.st[1] = nx; }
        const unsigned old = xb_add(&bar[XB_XSUB(b.x)], 1u);
        const unsigned gen = old / nloc;
        if (old + 1u == (gen + 1u) * nloc) {
            __builtin_amdgcn_fence(__ATOMIC_RELEASE, "agent");
            asm volatile("s_waitcnt vmcnt(0)" ::: "memory");
            const unsigned og = xb_add(&bar[XB_TOP], 1u);
            const unsigned tg = og / nx;
            if (og + 1u == (tg + 1u) * nx) xb_add(&bar[XB_TOPGEN], 1u);
            else XB_SPIN(xb_ld(&bar[XB_TOPGEN]) == tg, bar);
            __builtin_amdgcn_fence(__ATOMIC_ACQUIRE, "agent");
            xb_add(&bar[XB_XGEN(b.x)], 1u);
            asm volatile("s_waitcnt vmcnt(0)" ::: "memory");
        } else {
            XB_SPIN(xb_ld(&bar[XB_XGEN(b.x)]) == gen, bar);
            __builtin_amdgcn_fence(__ATOMIC_ACQUIRE, "agent");
            asm volatile("s_waitcnt vmcnt(0)" ::: "memory");
        }
    }
    __syncthreads();
}

__global__ void __launch_bounds__(NTHREADS) yoco_fwd(Params p) {
    extern __shared__ __attribute__((aligned(16))) unsigned char lds[];
    const int bid = blockIdx.x, G = gridDim.x;
    unsigned char* ws = p.ws;
    float* SS = (float*)(ws + WS_SS);
    float* Y = p.out + O_Y;
    bf16_t* XB = (bf16_t*)(ws + WS_XB);

#define IN(k) (p.ph_lo <= (k) && (k) < p.ph_hi)
    volatile LAS unsigned* bst = (volatile LAS unsigned*)((LAS unsigned char*)lds + 131072 + 64);
    XcdBarrier xbar; xbar.bar = (unsigned*)(ws + WS_BAR); xbar.x = 0; xbar.st = bst;
    int cv = bid;
    if (p.ph_hi - p.ph_lo > 1) {
        if (threadIdx.x < 8) bst[threadIdx.x] = 0u;
        __syncthreads();
        xbar.x = xb_xcc_id();
        if (threadIdx.x == 0) bst[2] = xb_add(&xbar.bar[XB_XCNT(xbar.x)], 1u);
    }
#define SEAM(k) do { if (IN(k) && IN((k) + 1)) xcd_barrier(xbar); } while (0)
    if (IN(0)) { for (int rep = 0; rep < REP_P0; ++rep) p0_prologue(p, lds, bid, G); }
    SEAM(0);
    if (p.ph_hi - p.ph_lo > 1 && IN(0) && IN(1)) {
        if (threadIdx.x == 0) {
            bool ok = (G % 8 == 0) && xbar.x < 8u;
            for (unsigned j = 0; j < 8; ++j) ok = ok && (xb_ld(&xbar.bar[XB_XCNT(j)]) == (unsigned)(G / 8));
            const unsigned rank = bst[2];
            bst[3] = (ok && rank < (unsigned)(G / 8)) ? (xbar.x + 8u * rank) : (unsigned)bid;
        }
        __syncthreads();
        cv = __builtin_amdgcn_readfirstlane((int)bst[3]);
    }
    PG8_LAS unsigned char* l3 = (PG8_LAS unsigned char*)lds;
    float* YS = Y;
#define PGEMM(Aptr, Bptr, Nn, Kk, EpiT, ...) do { pg8::Gemm g_{(const bf16_t*)(Aptr), (const bf16_t*)(Bptr), TP, (Nn), (Kk), ((Kk) == FF) ? 1 : 0}; pg8::StaticOrder S_; S_.init(TP, (Nn), G, cv); \
        Pg8Epi<EpiT> E_{EpiT{__VA_ARGS__}}; pg8::gemm_phase<Pg8Epi<EpiT>, pg8::StaticOrder, true, true>(l3, g_, S_, E_); } while (0)
    if (IN(1)) {
        for (int rep = 0; rep < REP_PG; ++rep) { PGEMM(XB, ws + WS_WIN, NIN, 1024, EpiBf16, (bf16_t*)(ws + WS_P), NIN, nullptr, 0); }
        { EpiBf16 E{(bf16_t*)(ws + WS_P), NIN, nullptr, 0}; for (int rep = 0; rep < REP_SG; ++rep) sgemm64<0>(lds, XB, 1024, (const bf16_t*)(ws + WS_WIN), TP, TS, NIN, 1024, 1, E, bid, G); }
    }
    SEAM(1);
    if (IN(2)) {
        for (int rep = 0; rep < REP_2AL; ++rep) for (int u = bid; u < 1024; u += G) mlstm_local_unit(p, lds, u);
        for (int rep = 0; rep < REP_2AS; ++rep) for (int u = bid; u < 512; u += G) mlstm_sample_unit(p, lds, u);
    }
    SEAM(2);
    if (IN(3)) mlstm_scan(p, lds, bid, G);
    SEAM(3);
    if (IN(4)) { for (int rep = 0; rep < REP_2C; ++rep) for (int u = bid; u < 1024; u += G) mlstm_out_unit(p, lds, u); }
    SEAM(4);
    if (IN(5)) {
        PGEMM(ws + WS_HG, ws + WS_WOUT, 1024, 1024, EpiResB, p.x_prompt, XB, nullptr, SS);
        { EpiAddF32 E{YS}; sgemm64<0>(lds, ws + WS_HG, 1024, (const bf16_t*)(ws + WS_WOUT), TP, TS, 1024, 1024, 1, E, bid, G); }
    }
    SEAM(5);
    if (IN(6)) {
        for (int rep = 0; rep < REP_PG; ++rep) { PGEMM(XB, ws + WS_W1A, FF, 1024, EpiBf16, (bf16_t*)(ws + WS_HID), FF, SS, 1); }
        { EpiBf16 E{(bf16_t*)(ws + WS_HID), FF, nullptr, 1}; for (int rep = 0; rep < REP_SG; ++rep) sgemm64<1>(lds, Y, 1024, (const bf16_t*)(ws + WS_W1A), TP, TS, FF, 1024, 1, E, bid, G); }
    }
    SEAM(6);
    if (IN(7)) {
        PGEMM(ws + WS_HID, ws + WS_W2A, 1024, FF, EpiResB, nullptr, XB, nullptr, SS + T);
        { EpiAtomic E{YS}; sgemm64<0>(lds, ws + WS_HID, FF, (const bf16_t*)(ws + WS_W2A), TP, TS, 1024, FF, 2, E, bid, G); }
    }
    SEAM(7);
    if (IN(8)) {
        for (int rep = 0; rep < REP_PG; ++rep) { PGEMM(XB, ws + WS_WKVQ, NKVQ, 1024, EpiBf16, (bf16_t*)(ws + WS_KVQ), NKVQ, SS + T, 0); }
        { EpiBf16 E{(bf16_t*)(ws + WS_KVQ), NKVQ, nullptr, 0}; for (int rep = 0; rep < REP_SG; ++rep) sgemm64<1>(lds, Y, 1024, (const bf16_t*)(ws + WS_WKVQ), TP, TS, NKVQ, 1024, 1, E, (cv + G / 2) % G, G); }
        __syncthreads();
        if (cv >= G / 2) late_weights(p, lds, cv - G / 2, G - G / 2);
    }
    SEAM(8);
    if (IN(9)) {
        { const int vb = (G % 8 == 0) ? (cv % 8) * (G / 8) + cv / 8 : cv;
          for (int rep = 0; rep < REP_7P; ++rep) for (int u = vb; u < 512; u += G) attn_prompt_unit(p, lds, u); }
        for (int rep = 0; rep < REP_7S; ++rep) for (int u = bid; u < 512; u += G) attn_sample_block(p, lds, u);
    }
    SEAM(9);
    if (IN(10)) {
        PGEMM(ws + WS_ATT, ws + WS_WO, 1024, 1024, EpiResB, nullptr, XB, nullptr, SS + 2 * T);
        { EpiAddF32 E{YS}; sgemm64<0>(lds, ws + WS_ATT, 1024, (const bf16_t*)(ws + WS_WO), TP, TS, 1024, 1024, 1, E, bid, G); }
    }
    SEAM(10);
    if (IN(11)) {
        for (int rep = 0; rep < REP_PG; ++rep) { PGEMM(XB, ws + WS_W1B, FF, 1024, EpiBf16, (bf16_t*)(ws + WS_HID), FF, SS + 2 * T, 1); }
        { EpiBf16 E{(bf16_t*)(ws + WS_HID), FF, nullptr, 1}; for (int rep = 0; rep < REP_SG; ++rep) sgemm64<1>(lds, Y, 1024, (const bf16_t*)(ws + WS_W1B), TP, TS, FF, 1024, 1, E, bid, G); }
    }
    SEAM(11);
    if (IN(12)) {
        PGEMM(ws + WS_HID, ws + WS_W2B, 1024, FF, EpiResB, nullptr, XB, Y, nullptr);
        { EpiAtomic E{YS}; sgemm64<0>(lds, ws + WS_HID, FF, (const bf16_t*)(ws + WS_W2B), TP, TS, 1024, FF, 2, E, bid, G); }
    }
#undef PGEMM
#undef IN
#undef SEAM
}

extern "C" void kernel_launch(void* const* d_in, const int* in_sizes, int n_in, void* d_out, int out_size, void* d_ws, size_t ws_size, hipStream_t stream) {
    static int grid_blocks = 0;
    if (!grid_blocks) {
        if (n_in != 24 || (size_t)out_size != O_END || ws_size < WS_END) { fprintf(stderr, "kernel_launch: unexpected shapes n_in=%d out=%d ws=%zu\n", n_in, out_size, ws_size); grid_blocks = -1; return; }
        int dev = 0, cus = 0, per_cu = 0;
        hipGetDevice(&dev);
        hipDeviceGetAttribute(&cus, hipDeviceAttributeMultiprocessorCount, dev);
        hipFuncSetAttribute((const void*)yoco_fwd, hipFuncAttributeMaxDynamicSharedMemorySize, LDS_BYTES);
        hipOccupancyMaxActiveBlocksPerMultiprocessor(&per_cu, (const void*)yoco_fwd, NTHREADS, LDS_BYTES);
        if (per_cu < 1) per_cu = 1;
        grid_blocks = cus * per_cu;
        (void)hipGetLastError();
    }
    if (grid_blocks < 0) return;
    Params p{};
    const float** pp = (const float**)&p;
    for (int i = 0; i < 24; ++i) pp[i] = (const float*)d_in[i];
    p.out = (float*)d_out; p.ws = (unsigned char*)d_ws;
#if N_LAUNCH_MODE == 1
    p.ph_lo = 0; p.ph_hi = 13;
    (void)hipMemsetAsync((char*)d_ws + WS_BAR, 0, BAR_BYTES, stream);
    void* args[] = {&p};
    hipError_t e = hipLaunchCooperativeKernel((const void*)yoco_fwd, dim3(grid_blocks), dim3(NTHREADS), args, LDS_BYTES, stream);
    if (e != hipSuccess) fprintf(stderr, "cooperative launch failed: %s (grid %d)\n", hipGetErrorString(e), grid_blocks);
#else
    for (int k = 0; k < MAX_PHASE; ++k) { p.ph_lo = k; p.ph_hi = k + 1; hipLaunchKernelGGL(yoco_fwd, dim3(grid_blocks), dim3(NTHREADS), LDS_BYTES, stream, p); }
#endif
}
```

```cpp
#include <hip/hip_runtime.h>
#include <hip/hip_cooperative_groups.h>
#include <cstdio>
#include <cstdint>
namespace cg = cooperative_groups;

typedef unsigned short bf16_t;
typedef short bf16x8 __attribute__((ext_vector_type(8)));
typedef short bf16x4 __attribute__((ext_vector_type(4)));
typedef float f32x4 __attribute__((ext_vector_type(4)));
typedef unsigned u32x4 __attribute__((ext_vector_type(4)));
typedef unsigned u32x2 __attribute__((ext_vector_type(2)));

constexpr int D = 1024, TP = 16384, TS = 512, T = TP + TS;
constexpr int NIN = 3072, LDW_IN = 3080, FF = 4096, NKVQ = 1536;
constexpr float EPS = 1e-6f;
constexpr int NTHREADS = 512;
constexpr int LDS_BYTES = 147456;
#ifndef REP_P0
#define REP_P0 1
#endif
#ifndef REP_2AL
#define REP_2AL 1
#endif
#ifndef REP_2AS
#define REP_2AS 1
#endif
#ifndef REP_2C
#define REP_2C 1
#endif
#ifndef REP_7P
#define REP_7P 1
#endif
#ifndef REP_7S
#define REP_7S 1
#endif
#ifndef REP_PG
#define REP_PG 1
#endif
#ifndef REP_SG
#define REP_SG 1
#endif
#ifndef MAX_PHASE
#define MAX_PHASE 13
#endif
#ifndef N_LAUNCH_MODE
#define N_LAUNCH_MODE 1
#endif

constexpr size_t MiB = 1u << 20;
constexpr size_t WS_SS = 0;
constexpr size_t WS_CHB = 256 * 1024, WS_CHM = WS_CHB + 4096, WS_MPREV = WS_CHM + 4096;
constexpr size_t WS_GATES = 1 * MiB;
constexpr size_t WS_GN = 2 * MiB;
constexpr size_t WS_BAR = 3 * MiB, BAR_BYTES = 16384;
constexpr size_t WS_WIN = 4 * MiB, WS_WOUT = 10 * MiB, WS_W1A = 12 * MiB, WS_W2A = 20 * MiB, WS_WKVQ = 28 * MiB, WS_WO = 31 * MiB, WS_W1B = 33 * MiB, WS_W2B = 41 * MiB;
constexpr size_t WS_XB = 49 * MiB;
constexpr size_t WS_P = 82 * MiB;
constexpr size_t WS_HG = 181 * MiB;
constexpr size_t WS_HID = 82 * MiB;
constexpr size_t WS_KVQ = 82 * MiB;
constexpr size_t WS_ATT = 132 * MiB;
constexpr size_t WS_END = 214 * MiB;

constexpr size_t O_Y = 0, O_PC = 17301504, O_PN = 17825792, O_PM = 17827840, O_PWK = 17827856, O_PWV = 17958928,
                 O_SC = 18090000, O_SN = 34867216, O_SM = 34932752, O_SWK = 34933264, O_SWV = 39127568, O_END = 43321872;

struct Params {
    const float *x_prompt, *x_sample, *st_C, *st_n, *st_m, *cache_k, *cache_v;
    const float *ml_norm_g, *ml_w_in, *ml_b_i, *ml_b_f, *ml_head_g, *ml_w_out;
    const float *kv_norm_g, *w_kv, *k_norm_g;
    const float *att_norm_g, *att_w_q, *q_norm_g, *att_sinks, *att_w_o;
    const float *mlp_norm_g, *mlp_w1, *mlp_w2;
    float* out; unsigned char* ws;
    int ph_lo, ph_hi;
};

typedef float f32x2 __attribute__((ext_vector_type(2)));
typedef __bf16 bf16x2n __attribute__((ext_vector_type(2)));
__device__ __forceinline__ unsigned cvt_pk_bf16(float lo, float hi) { const f32x2 v = {lo, hi}; const bf16x2n b = __builtin_convertvector(v, bf16x2n); return __builtin_bit_cast(unsigned, b); }
__device__ __forceinline__ bf16_t f2bf(float f) { return (bf16_t)(cvt_pk_bf16(f, 0.f) & 0xffffu); }
__device__ __forceinline__ float bf2f(bf16_t h) { return __uint_as_float(((unsigned)h) << 16); }
__device__ __forceinline__ float bflo(unsigned u) { return __uint_as_float(u << 16); }
__device__ __forceinline__ float bfhi(unsigned u) { return __uint_as_float(u & 0xffff0000u); }
__device__ __forceinline__ float wave_sum(float v) {
#pragma unroll
    for (int o = 1; o < 64; o <<= 1) v += __shfl_xor(v, o);
    return v;
}
__device__ __forceinline__ float wave_max(float v) {
#pragma unroll
    for (int o = 1; o < 64; o <<= 1) v = fmaxf(v, __shfl_xor(v, o));
    return v;
}
__device__ __forceinline__ float scan_sum(float x, int lane) {
#pragma unroll
    for (int o = 1; o < 64; o <<= 1) { float y = __shfl_up(x, o); if (lane >= o) x += y; }
    return x;
}
__device__ __forceinline__ float scan_max(float x, int lane) {
#pragma unroll
    for (int o = 1; o < 64; o <<= 1) { float y = __shfl_up(x, o); if (lane >= o) x = fmaxf(x, y); }
    return x;
}
__device__ __forceinline__ float softcap15(float x) { return 15.f * tanhf(x * (1.f / 15.f)); }
__device__ __forceinline__ float logsigmoid(float z) { return fminf(z, 0.f) - log1pf(__expf(-fabsf(z))); }
__device__ __forceinline__ float sigmoidf_(float z) { return 1.f / (1.f + __expf(-z)); }
#define LDS_WAIT() asm volatile("s_waitcnt lgkmcnt(0)" ::: "memory")
#define MFMA32(x, y, acc) __builtin_amdgcn_mfma_f32_16x16x32_bf16((x), (y), (acc), 0, 0, 0)
#define MFMA16(x, y, acc) __builtin_amdgcn_mfma_f32_16x16x16bf16_1k((x), (y), (acc), 0, 0, 0)

__device__ __forceinline__ void transpose_item(const float* __restrict__ W, int ldw, int K, const float* __restrict__ gk, float cs,
                                               bf16_t* WT, int row_off, int k0, int n0, float* scr, int lane) {
    {
        const int kr = lane >> 3, n4 = (lane & 7) * 4;
        f32x4 wv[8];
#pragma unroll
        for (int i = 0; i < 8; ++i) wv[i] = __builtin_nontemporal_load((const f32x4*)(W + (size_t)(k0 + kr + 8 * i) * ldw + n0 + n4));
#pragma unroll
        for (int i = 0; i < 8; ++i) {
            const int kk = kr + 8 * i;
            const float g = gk ? gk[k0 + kk] * cs : cs;
            float* d = scr + kk * 33 + n4;
            d[0] = wv[i].x * g; d[1] = wv[i].y * g; d[2] = wv[i].z * g; d[3] = wv[i].w * g;
        }
    }
    LDS_WAIT();
    const int c = lane & 7;
#pragma unroll
    for (int j = 0; j < 4; ++j) {
        const int n = (lane >> 3) + 8 * j; const float* s = scr + (8 * c) * 33 + n;
        u32x4 o; o.x = cvt_pk_bf16(s[0 * 33], s[1 * 33]); o.y = cvt_pk_bf16(s[2 * 33], s[3 * 33]); o.z = cvt_pk_bf16(s[4 * 33], s[5 * 33]); o.w = cvt_pk_bf16(s[6 * 33], s[7 * 33]);
        *(u32x4*)(WT + (size_t)(row_off + n0 + n) * K + k0 + 8 * c) = o;
    }
    LDS_WAIT();
}

__device__ __forceinline__ void p0_prologue(const Params& p, unsigned char* lds, int bid, int G) {
    const int tid = threadIdx.x, lane = tid & 63, wid = tid >> 6;
    unsigned char* ws = p.ws;
    float* scr = (float*)(lds + wid * 8448);
    float* wif = (float*)(lds + 73728);
    for (int k = tid; k < 1024; k += NTHREADS) {
        const float g = p.ml_norm_g[k];
        const f32x4 a = *(const f32x4*)(p.ml_w_in + (size_t)k * LDW_IN + 3072), b = *(const f32x4*)(p.ml_w_in + (size_t)k * LDW_IN + 3076);
        wif[0 * 1024 + k] = a.x * g; wif[1 * 1024 + k] = a.y * g; wif[2 * 1024 + k] = a.z * g; wif[3 * 1024 + k] = a.w * g;
        wif[4 * 1024 + k] = b.x * g; wif[5 * 1024 + k] = b.y * g; wif[6 * 1024 + k] = b.z * g; wif[7 * 1024 + k] = b.w * g;
    }
    { float* ss = (float*)(ws + WS_SS); for (int i = bid * NTHREADS + tid; i < 3 * T; i += G * NTHREADS) ss[i] = 0.f; }
    __syncthreads();
    const int gw = bid * 8 + wid, NGW = G * 8;
    constexpr int I_IN = 16 * 96, I_SQ = 16 * 32, I_1 = 16 * 128, I_2 = 64 * 32, I_KV = 16 * 16;
    constexpr int NITEMS = I_IN + I_SQ + I_1 + I_2 + I_KV + I_SQ;
    for (int it = gw; it < NITEMS; it += NGW) {
        int r = it;
        if (r < I_IN) { const int kb = r / 96, nb = r % 96, n0 = nb * 32; const float cs = (n0 >= 512 && n0 < 1024) ? 0.08838834764831845f : 1.f;
            transpose_item(p.ml_w_in, LDW_IN, 1024, p.ml_norm_g, cs, (bf16_t*)(ws + WS_WIN), 0, kb * 64, n0, scr, lane); continue; } r -= I_IN;
        if (r < I_SQ) { transpose_item(p.ml_w_out, 1024, 1024, nullptr, 1.f, (bf16_t*)(ws + WS_WOUT), 0, (r / 32) * 64, (r % 32) * 32, scr, lane); continue; } r -= I_SQ;
        if (r < I_1) { transpose_item(p.mlp_w1, 4096, 1024, p.mlp_norm_g, 1.f, (bf16_t*)(ws + WS_W1A), 0, (r / 128) * 64, (r % 128) * 32, scr, lane); continue; } r -= I_1;
        if (r < I_2) { transpose_item(p.mlp_w2, 1024, 4096, nullptr, 1.f, (bf16_t*)(ws + WS_W2A), 0, (r / 32) * 64, (r % 32) * 32, scr, lane); continue; } r -= I_2;
        if (r < I_KV) { transpose_item(p.w_kv, 512, 1024, p.kv_norm_g, 1.f, (bf16_t*)(ws + WS_WKVQ), 0, (r / 16) * 64, (r % 16) * 32, scr, lane); continue; } r -= I_KV;
        transpose_item(p.att_w_q, 1024, 1024, p.att_norm_g, 1.f, (bf16_t*)(ws + WS_WKVQ), 512, (r / 32) * 64, (r % 32) * 32, scr, lane);
    }
    bf16_t* XB = (bf16_t*)(ws + WS_XB); float* gates = (float*)(ws + WS_GATES);
    for (int m = gw; m < T; m += NGW) {
        const float* xrow = m < TP ? p.x_prompt + (size_t)m * D : p.x_sample + (size_t)(m - TP) * D;
        f32x4 v[4]; float s = 0.f;
#pragma unroll
        for (int j = 0; j < 4; ++j) { v[j] = __builtin_nontemporal_load((const f32x4*)(xrow + 4 * lane + 256 * j)); s += (v[j].x * v[j].x + v[j].y * v[j].y) + (v[j].z * v[j].z + v[j].w * v[j].w); }
        const float rstd = rsqrtf(wave_sum(s) * (1.f / D) + EPS);
        if (m >= TP) {
#pragma unroll
            for (int j = 0; j < 4; ++j) *(f32x4*)(p.out + O_Y + (size_t)m * D + 4 * lane + 256 * j) = v[j];
        }
#pragma unroll
        for (int j = 0; j < 4; ++j) { u32x2 w; w.x = cvt_pk_bf16(v[j].x * rstd, v[j].y * rstd); w.y = cvt_pk_bf16(v[j].z * rstd, v[j].w * rstd); *(u32x2*)(XB + (size_t)m * D + 4 * lane + 256 * j) = w; }
        float mine = 0.f;
#pragma unroll
        for (int g = 0; g < 8; ++g) {
            float a = 0.f;
#pragma unroll
            for (int j = 0; j < 4; ++j) { const f32x4 w = *(const f32x4*)(wif + g * 1024 + 4 * lane + 256 * j); a += (v[j].x * w.x + v[j].y * w.y) + (v[j].z * w.z + v[j].w * w.w); }
            a = wave_sum(a) * rstd;
            if (lane == g) mine = a;
        }
        if (lane < 4) gates[(size_t)m * 8 + lane] = softcap15(mine + p.ml_b_i[lane]);
        else if (lane < 8) gates[(size_t)m * 8 + lane] = logsigmoid(softcap15(mine + p.ml_b_f[lane - 4]));
    }
}

__device__ __forceinline__ void late_weights(const Params& p, unsigned char* lds, int slot, int nslots) {
    const int tid = threadIdx.x, lane = tid & 63, wid = tid >> 6;
    unsigned char* ws = p.ws;
    float* scr = (float*)(lds + wid * 8448);
    constexpr int I_SQ = 16 * 32, I_1 = 16 * 128, I_2 = 64 * 32, NIT = I_SQ + I_1 + I_2;
    for (int it = slot * 8 + wid; it < NIT; it += nslots * 8) {
        int r = it;
        if (r < I_SQ) { transpose_item(p.att_w_o, 1024, 1024, nullptr, 1.f, (bf16_t*)(ws + WS_WO), 0, (r / 32) * 64, (r % 32) * 32, scr, lane); continue; } r -= I_SQ;
        if (r < I_1) { transpose_item(p.mlp_w1 + (size_t)1024 * 4096, 4096, 1024, p.mlp_norm_g + 1024, 1.f, (bf16_t*)(ws + WS_W1B), 0, (r / 128) * 64, (r % 128) * 32, scr, lane); continue; } r -= I_1;
        transpose_item(p.mlp_w2 + (size_t)4096 * 1024, 1024, 4096, nullptr, 1.f, (bf16_t*)(ws + WS_W2B), 0, (r / 32) * 64, (r % 32) * 32, scr, lane);
    }
}

struct EpiBf16 {
    bf16_t* out; int ld; const float* ss; int act;
    template <int NQ, bool PAIRED> __device__ __forceinline__ void row(int r, const int (&c)[NQ], const f32x4 (&v)[NQ], int fq, float rscale) const {
        float sc = rscale; if (ss) sc = rsqrtf(ss[r] * (1.f / 1024.f) + EPS);
        u32x2 w[NQ];
#pragma unroll
        for (int q = 0; q < NQ; ++q) {
            f32x4 x = v[q] * sc;
            if (act) { x.x = fmaxf(x.x, 0.f); x.y = fmaxf(x.y, 0.f); x.z = fmaxf(x.z, 0.f); x.w = fmaxf(x.w, 0.f); x = x * x; }
            w[q].x = cvt_pk_bf16(x.x, x.y); w[q].y = cvt_pk_bf16(x.z, x.w);
        }
        if (PAIRED) {
#pragma unroll
            for (int q = 0; q < NQ; q += 2) { u32x4 o; o.x = w[q].x; o.y = w[q].y; o.z = w[q + 1].x; o.w = w[q + 1].y; *(u32x4*)(out + (size_t)r * ld + c[q]) = o; }
        } else {
#pragma unroll
            for (int q = 0; q < NQ; ++q) *(u32x2*)(out + (size_t)r * ld + c[q]) = w[q];
        }
    }
};
struct EpiRes {
    const float* srcp; const float* srcs; float* dst; bf16_t* xb; float* ss;
    template <int NQ, bool PAIRED> __device__ __forceinline__ void row(int r, const int (&c)[NQ], const f32x4 (&v)[NQ], int fq, float rscale) const {
        const float* s = r < TP ? srcp + (size_t)r * D : srcs + (size_t)(r - TP) * D;
        float a2 = 0.f;
        u32x2 w[NQ];
#pragma unroll
        for (int q = 0; q < NQ; ++q) {
            const f32x4 o = *(const f32x4*)(s + c[q]) + v[q];
            *(f32x4*)(dst + (size_t)r * D + c[q]) = o;
            w[q].x = cvt_pk_bf16(o.x, o.y); w[q].y = cvt_pk_bf16(o.z, o.w);
            a2 += (o.x * o.x + o.y * o.y) + (o.z * o.z + o.w * o.w);
        }
        if (xb) {
            if (PAIRED) {
#pragma unroll
                for (int q = 0; q < NQ; q += 2) { u32x4 o; o.x = w[q].x; o.y = w[q].y; o.z = w[q + 1].x; o.w = w[q + 1].y; *(u32x4*)(xb + (size_t)r * D + c[q]) = o; }
            } else {
#pragma unroll
                for (int q = 0; q < NQ; ++q) *(u32x2*)(xb + (size_t)r * D + c[q]) = w[q];
            }
        }
        if (ss) { a2 += __shfl_xor(a2, 16); a2 += __shfl_xor(a2, 32); if (fq == 0) atomicAdd(ss + r, a2); }
    }
};

namespace pg8 {
#define PG8_LAS __attribute__((address_space(3)))
typedef unsigned short bf16_t;
typedef short bf16x8 __attribute__((ext_vector_type(8)));
typedef float f32x4 __attribute__((ext_vector_type(4)));
typedef unsigned u32x4 __attribute__((ext_vector_type(4)));
constexpr int BM = 256, BK = 64, HALF = 128, HTB = HALF * BK * 2  , STAGE_BYTES = 8 * HTB, NXCD = 8, WGM = 8;

__host__ __device__ __forceinline__ int lds_byte(int r, int c) { const int st = (r >> 4) * 2 + (c >> 5), rr = r & 15, cc = c & 31, ob = rr * 64 + cc * 2; return st * 1024 + (ob ^ (((ob >> 9) & 1) << 5)); }
__host__ __device__ __forceinline__ void stage_rc(int b, int& R, int& C) { const int st = b / 1024, sb = b % 1024, swz = sb ^ (((sb >> 9) & 1) << 5); R = (st >> 1) * 16 + swz / 64; C = (st & 1) * 32 + (swz % 64) / 2; }
__host__ __device__ __forceinline__ int perm32(int rho) { const int n = rho >> 4, i = rho & 15; return 8 * (i >> 2) + 4 * n + (i & 3); }

struct Unit { int pm, pn; };
struct Gemm { const bf16_t* A; const bf16_t* Bt; int M, N, K; int revk; };

struct StaticOrder {
    int nM, nN, nwg, G, c;
    __host__ __device__ void init(int M, int N, int G_, int c_) { nM = M / BM; nN = N / BM; nwg = nM * nN; G = G_; c = c_; }
    __host__ __device__ bool next(int i, Unit& u) const {
        const long L = (long)i * G + c; if (L >= nwg) return false;
        int wgid = (int)L; { const int q = nwg / NXCD, r = nwg % NXCD, xcd = wgid % NXCD, off = wgid / NXCD; wgid = (xcd < r ? xcd * (q + 1) : r * (q + 1) + (xcd - r) * q) + off; }
        const int nig = WGM * nN, gid = wgid / nig, fm = gid * WGM, gsz = (nM - fm) < WGM ? (nM - fm) : WGM;
        u.pm = fm + ((wgid % nig) % gsz); u.pn = (wgid % nig) / gsz; return true;
    }
    __device__ __forceinline__ void a_ready(const Unit&) const {}
    __device__ __forceinline__ void done(const Unit&) const {}
};


template <class Epi, class Sched, bool ALIGN_EPI = false, bool SP2 = false>
__device__ __forceinline__ void gemm_phase(PG8_LAS unsigned char* lds, const Gemm g, const Sched& S, const Epi& E) {
    const int tid = threadIdx.x, wid = __builtin_amdgcn_readfirstlane(tid >> 6), lane = tid & 63, wr = wid >> 2, wc = wid & 3, fr = lane & 15, fq = lane >> 4;
    const int K = g.K, nt = K / BK;
    unsigned voffA[2], voffB[2];
#pragma unroll
    for (int i = 0; i < 2; ++i) { int R, C; stage_rc(tid * 16 + i * 8192, R, C); const int Rb = Epi::PERM ? ((R & ~31) + perm32(R & 31)) : R;
        voffA[i] = (unsigned)(R * K + C) * 2u; voffB[i] = (unsigned)(Rb * K + C) * 2u; }
    const size_t kstep = g.revk ? (size_t)0 - (size_t)(BK * 2) : (size_t)(BK * 2);
    const size_t koff = g.revk ? (size_t)(K - BK) * 2 : (size_t)0;
    const size_t hstep = (size_t)HALF * K * 2;
    const size_t tstep = 2 * hstep;
    const unsigned ldsw = (unsigned)wid * 1024u;
    const int aoff = lds_byte(wr * 64 + fr, fq * 8), boff = lds_byte(wc * 32 + fr, fq * 8);
#define PG8_SA(b, h) (((b) * 2 + (h)) * HTB)
#define PG8_SB(b, h) ((4 + (b) * 2 + (h)) * HTB)
#define PG8_STAGE(bufoff, gbase, voff) do { _Pragma("unroll") for (int _i = 0; _i < 2; ++_i) \
        __builtin_amdgcn_global_load_lds((const unsigned*)((const char*)(gbase) + (voff)[_i]), (PG8_LAS unsigned*)(lds + (bufoff) + ldsw + _i * 8192), 16, 0, 0); } while (0)
#define PG8_LDA(dst, b, h) do { _Pragma("unroll") for (int m = 0; m < 4; ++m) _Pragma("unroll") for (int k = 0; k < 2; ++k) dst[m][k] = *(const PG8_LAS bf16x8*)(lds + PG8_SA(b, h) + aoff + m * 2048 + k * 1024); } while (0)
#define PG8_LDB(dst, b, h) do { _Pragma("unroll") for (int n = 0; n < 2; ++n) _Pragma("unroll") for (int k = 0; k < 2; ++k) dst[n][k] = *(const PG8_LAS bf16x8*)(lds + PG8_SB(b, h) + boff + n * 2048 + k * 1024); } while (0)
#define PG8_MMA(ai, bj, At, Bt) do { __builtin_amdgcn_s_setprio(1); _Pragma("unroll") for (int m = 0; m < 4; ++m) _Pragma("unroll") for (int n = 0; n < 2; ++n) _Pragma("unroll") for (int k = 0; k < 2; ++k) \
        acc[ai][bj][m][n] = __builtin_amdgcn_mfma_f32_16x16x32_bf16(Bt[n][k], At[m][k], acc[ai][bj][m][n], 0, 0, 0); __builtin_amdgcn_s_setprio(0); } while (0)
#define PG8_WAIT_V(n) asm volatile("s_waitcnt vmcnt(" #n ")" ::: "memory")
#define PG8_WAIT_L(n) asm volatile("s_waitcnt lgkmcnt(" #n ")" ::: "memory")
#define PG8_BAR __builtin_amdgcn_s_barrier()
#define PG8_SCHED __builtin_amdgcn_sched_barrier(0)
    Unit cur, nxt; int ui = 0;
    if (!S.next(0, cur)) return;
    f32x4 acc[2][2][4][2];
#pragma unroll
    for (int a = 0; a < 2; ++a)
#pragma unroll
        for (int b = 0; b < 2; ++b)
#pragma unroll
            for (int m = 0; m < 4; ++m)
#pragma unroll
                for (int n = 0; n < 2; ++n) acc[a][b][m][n] = (f32x4){0.f, 0.f, 0.f, 0.f};
    bf16x8 At[4][2], B0[2][2], B1[2][2];
    const char* cA = (const char*)g.A + (size_t)cur.pm * tstep + koff; const char* cB = (const char*)g.Bt + (size_t)cur.pn * tstep + koff;
    S.a_ready(cur);
    if constexpr (SP2) {
        PG8_STAGE(PG8_SB(0, 0), cB, voffB); PG8_STAGE(PG8_SB(0, 1), cB + hstep, voffB); PG8_STAGE(PG8_SA(0, 0), cA, voffA); PG8_STAGE(PG8_SA(0, 1), cA + hstep, voffA);
        if (wr == 1) PG8_BAR;
        PG8_WAIT_V(2); PG8_BAR;
        PG8_STAGE(PG8_SB(1, 0), cB + kstep, voffB); PG8_STAGE(PG8_SA(1, 0), cA + kstep, voffA); PG8_STAGE(PG8_SB(1, 1), cB + hstep + kstep, voffB);
        PG8_WAIT_V(6); PG8_BAR;
    } else {
        PG8_STAGE(PG8_SB(0, 0), cB, voffB); PG8_STAGE(PG8_SA(0, 0), cA, voffA); PG8_STAGE(PG8_SB(0, 1), cB + hstep, voffB); PG8_STAGE(PG8_SA(0, 1), cA + hstep, voffA);
        if (wr == 1) PG8_BAR;
        PG8_WAIT_V(4); PG8_BAR;
        PG8_STAGE(PG8_SB(1, 0), cB + kstep, voffB); PG8_STAGE(PG8_SA(1, 0), cA + kstep, voffA); PG8_STAGE(PG8_SB(1, 1), cB + hstep + kstep, voffB);
        PG8_WAIT_V(6); PG8_BAR;
    }
    for (;;) {
        const bool has_next = S.next(ui + 1, nxt);
        const char* nA = has_next ? (const char*)g.A + (size_t)nxt.pm * tstep + koff : cA; const char* nB = has_next ? (const char*)g.Bt + (size_t)nxt.pn * tstep + koff : cB;
        for (int t = 0; t < nt; t += 2) {
            const bool last = (t == nt - 2);
            const char* a1 = cA + (size_t)(t + 1) * kstep;
            const char* a2 = last ? nA : cA + (size_t)(t + 2) * kstep; const char* b2 = last ? nB : cB + (size_t)(t + 2) * kstep;
            const char* a3 = a2 + kstep; const char* b3 = b2 + kstep;
            if (last && has_next) S.a_ready(nxt);
            if constexpr (SP2) {
            PG8_LDB(B0, 0, 0); PG8_LDB(B1, 0, 1); PG8_SCHED; PG8_LDA(At, 0, 0); PG8_STAGE(PG8_SA(1, 1), a1 + hstep, voffA);
            PG8_WAIT_V(8); PG8_WAIT_L(0); PG8_BAR; PG8_MMA(0, 0, At, B0); PG8_MMA(0, 1, At, B1); PG8_BAR; PG8_SCHED;
            PG8_LDA(At, 0, 1); PG8_STAGE(PG8_SB(0, 0), b2, voffB); PG8_STAGE(PG8_SB(0, 1), b2 + hstep, voffB); PG8_STAGE(PG8_SA(0, 0), a2, voffA);
            PG8_WAIT_V(8); PG8_WAIT_L(0); PG8_BAR; PG8_MMA(1, 0, At, B0); PG8_MMA(1, 1, At, B1); PG8_BAR; PG8_SCHED;
            PG8_LDB(B0, 1, 0); PG8_LDB(B1, 1, 1); PG8_SCHED; PG8_LDA(At, 1, 0); PG8_STAGE(PG8_SA(0, 1), a2 + hstep, voffA);
            PG8_WAIT_V(8); PG8_WAIT_L(0); PG8_BAR; PG8_MMA(0, 0, At, B0); PG8_MMA(0, 1, At, B1); PG8_BAR; PG8_SCHED;
            PG8_LDA(At, 1, 1); PG8_STAGE(PG8_SB(1, 0), b3, voffB); PG8_STAGE(PG8_SB(1, 1), b3 + hstep, voffB); PG8_STAGE(PG8_SA(1, 0), a3, voffA);
            PG8_WAIT_V(8); PG8_WAIT_L(0); PG8_BAR; PG8_MMA(1, 0, At, B0); PG8_MMA(1, 1, At, B1); PG8_BAR; PG8_SCHED;
            } else {
            PG8_LDB(B0, 0, 0); PG8_SCHED; PG8_LDA(At, 0, 0); PG8_STAGE(PG8_SA(1, 1), a1 + hstep, voffA);
            PG8_WAIT_L(8); PG8_BAR; PG8_WAIT_L(0); PG8_MMA(0, 0, At, B0); PG8_BAR; PG8_SCHED;
            PG8_LDB(B1, 0, 1); PG8_STAGE(PG8_SB(0, 0), b2, voffB);
            PG8_BAR; PG8_WAIT_L(0); PG8_MMA(0, 1, At, B1); PG8_BAR;
            PG8_LDA(At, 0, 1); PG8_STAGE(PG8_SA(0, 0), a2, voffA);
            PG8_BAR; PG8_WAIT_L(0); PG8_MMA(1, 0, At, B0); PG8_BAR; PG8_SCHED;
            PG8_STAGE(PG8_SB(0, 1), b2 + hstep, voffB);
            PG8_WAIT_V(6); PG8_BAR; PG8_MMA(1, 1, At, B1); PG8_BAR;
            PG8_LDB(B0, 1, 0); PG8_SCHED; PG8_LDA(At, 1, 0); PG8_STAGE(PG8_SA(0, 1), a2 + hstep, voffA);
            PG8_WAIT_L(8); PG8_BAR; PG8_WAIT_L(0); PG8_MMA(0, 0, At, B0); PG8_BAR; PG8_SCHED;
            PG8_LDB(B1, 1, 1); PG8_STAGE(PG8_SB(1, 0), b3, voffB);
            PG8_BAR; PG8_WAIT_L(0); PG8_MMA(0, 1, At, B1); PG8_BAR;
            PG8_LDA(At, 1, 1); PG8_STAGE(PG8_SA(1, 0), a3, voffA);
            PG8_BAR; PG8_WAIT_L(0); PG8_MMA(1, 0, At, B0); PG8_BAR; PG8_SCHED;
            PG8_STAGE(PG8_SB(1, 1), b3 + hstep, voffB);
            PG8_WAIT_V(6); PG8_BAR; PG8_MMA(1, 1, At, B1); PG8_BAR;
            }
        }
        if constexpr (ALIGN_EPI) { if (wr == 0) PG8_BAR; }
        if constexpr (!Epi::AFTER_DRAIN) { E(acc, cur, wr, wc, fr, fq); S.done(cur); }
        if (!has_next) break;
#pragma unroll
        for (int a = 0; a < 2; ++a)
#pragma unroll
            for (int b = 0; b < 2; ++b)
#pragma unroll
                for (int m = 0; m < 4; ++m)
#pragma unroll
                    for (int n = 0; n < 2; ++n) acc[a][b][m][n] = (f32x4){0.f, 0.f, 0.f, 0.f};
        cur = nxt; cA = nA; cB = nB; ++ui;
        if constexpr (ALIGN_EPI) { if (wr == 1) PG8_BAR; }
    }
    PG8_WAIT_V(0);
    if constexpr (!ALIGN_EPI) { if (wr == 0) PG8_BAR; }
    PG8_BAR;
    if constexpr (Epi::AFTER_DRAIN) { E.fused(acc, cur, wr, wc, fr, fq, lds, wid, lane); S.done(cur); }
#undef PG8_SA
#undef PG8_SB
#undef PG8_STAGE
#undef PG8_LDA
#undef PG8_LDB
#undef PG8_MMA
#undef PG8_WAIT_V
#undef PG8_WAIT_L
#undef PG8_BAR
#undef PG8_SCHED
}
}


template <class Inner> struct Pg8Epi {
    static constexpr bool PERM = true, AFTER_DRAIN = false;
    Inner in;
    __device__ __forceinline__ void operator()(const f32x4 (&acc)[2][2][4][2], const pg8::Unit& u, int wr, int wc, int fr, int fq) const {
#pragma unroll
        for (int ai = 0; ai < 2; ++ai)
#pragma unroll
            for (int m = 0; m < 4; ++m) {
                const int r = u.pm * 256 + ai * 128 + wr * 64 + m * 16 + fr;
                const int c0 = u.pn * 256 + wc * 32 + 8 * fq;
                const int cols[4] = {c0, c0 + 4, c0 + 128, c0 + 132};
                const f32x4 vv[4] = {acc[ai][0][m][0], acc[ai][0][m][1], acc[ai][1][m][0], acc[ai][1][m][1]};
                in.template row<4, true>(r, cols, vv, fq, 1.f);
            }
    }
};
struct EpiResB {
    const float* srcf; bf16_t* xb; float* dstf; float* ss;
    template <int NQ, bool PAIRED> __device__ __forceinline__ void row(int r, const int (&c)[NQ], const f32x4 (&v)[NQ], int fq, float rscale) const {
        static_assert(PAIRED && NQ % 2 == 0, "EpiResB: paired quads only");
        float a2 = 0.f;
#pragma unroll
        for (int q = 0; q < NQ; q += 2) {
            f32x4 s0, s1;
            if (srcf) { s0 = __builtin_nontemporal_load((const f32x4*)(srcf + (size_t)r * D + c[q])); s1 = __builtin_nontemporal_load((const f32x4*)(srcf + (size_t)r * D + c[q] + 4)); }
            else { const u32x4 xr = *(const u32x4*)(xb + (size_t)r * D + c[q]); s0 = (f32x4){bflo(xr.x), bfhi(xr.x), bflo(xr.y), bfhi(xr.y)}; s1 = (f32x4){bflo(xr.z), bfhi(xr.z), bflo(xr.w), bfhi(xr.w)}; }
            const f32x4 o0 = s0 + v[q], o1 = s1 + v[q + 1];
            if (dstf) { __builtin_nontemporal_store(o0, (f32x4*)(dstf + (size_t)r * D + c[q])); __builtin_nontemporal_store(o1, (f32x4*)(dstf + (size_t)r * D + c[q] + 4)); }
            else {
                u32x4 w; w.x = cvt_pk_bf16(o0.x, o0.y); w.y = cvt_pk_bf16(o0.z, o0.w); w.z = cvt_pk_bf16(o1.x, o1.y); w.w = cvt_pk_bf16(o1.z, o1.w);
                *(u32x4*)(xb + (size_t)r * D + c[q]) = w;
                a2 += (o0.x * o0.x + o0.y * o0.y) + (o0.z * o0.z + o0.w * o0.w) + (o1.x * o1.x + o1.y * o1.y) + (o1.z * o1.z + o1.w * o1.w);
            }
        }
        if (ss) { a2 += __shfl_xor(a2, 16); a2 += __shfl_xor(a2, 32); if (fq == 0) atomicAdd(ss + r, a2); }
    }
};
struct EpiAddF32 {
    float* dst;
    template <int NQ, bool PAIRED> __device__ __forceinline__ void row(int r, const int (&c)[NQ], const f32x4 (&v)[NQ], int fq, float rscale) const {
#pragma unroll
        for (int q = 0; q < NQ; ++q) { f32x4* d = (f32x4*)(dst + (size_t)r * D + c[q]); *d = *d + v[q]; }
    }
};
struct EpiAtomic {
    float* dst;
    template <int NQ, bool PAIRED> __device__ __forceinline__ void row(int r, const int (&c)[NQ], const f32x4 (&v)[NQ], int fq, float rscale) const {
#pragma unroll
        for (int q = 0; q < NQ; ++q) { float* d = dst + (size_t)r * D + c[q]; atomicAdd(d, v[q].x); atomicAdd(d + 1, v[q].y); atomicAdd(d + 2, v[q].z); atomicAdd(d + 3, v[q].w); }
    }
};

template <int AF32, class Epi>
__device__ __forceinline__ void sgemm64(unsigned char* lds, const void* Av, int lda, const bf16_t* __restrict__ Bt, int row0, int nrows, int N, int K, int ksplit,
                                        const Epi& E, int bid, int G) {
    const int tid = threadIdx.x, lane = tid & 63, wid = tid >> 6, wr = wid >> 2, wc = wid & 3, fr = lane & 15, fq = lane >> 4;
    const int nN = N / 128, nT = (nrows / 64) * nN, nU = nT * ksplit, Ksl = K / ksplit, nk = Ksl / 128;
    constexpr int LS = 136;
    bf16_t* As = (bf16_t*)lds;
    bf16_t* Bs = As + 2 * 64 * LS;
    float* rs = (float*)(Bs + 2 * 128 * LS);
    const int arow = tid >> 3, ak = (tid & 7) * 8;
    for (int u = bid; u < nU; u += G) {
        const int ks = u / nT, t = u % nT, pm = t / nN, pn = t % nN, k0 = ks * Ksl;
        const bf16_t* Ab = (const bf16_t*)Av + (size_t)(row0 + pm * 64 + arow) * lda + k0 + ak;
        const float* Af = (const float*)Av + (size_t)(row0 + pm * 64 + arow) * lda + k0 + ak;
        const bf16_t* Bg = Bt + (size_t)(pn * 128 + arow) * K + k0 + ak;
        f32x4 acc[2][2];
#pragma unroll
        for (int m = 0; m < 2; ++m)
#pragma unroll
            for (int n = 0; n < 2; ++n) acc[m][n] = (f32x4){0.f, 0.f, 0.f, 0.f};
        float ssq = 0.f;
        u32x4 ra[2], rb[2][2];
        auto loadAB = [&](int kt) {
#pragma unroll
            for (int h = 0; h < 2; ++h) {
                if (AF32) { const f32x4 a = *(const f32x4*)(Af + kt * 128 + 64 * h), b = *(const f32x4*)(Af + kt * 128 + 64 * h + 4);
                    ssq += (a.x * a.x + a.y * a.y) + (a.z * a.z + a.w * a.w) + (b.x * b.x + b.y * b.y) + (b.z * b.z + b.w * b.w);
                    ra[h].x = cvt_pk_bf16(a.x, a.y); ra[h].y = cvt_pk_bf16(a.z, a.w); ra[h].z = cvt_pk_bf16(b.x, b.y); ra[h].w = cvt_pk_bf16(b.z, b.w); }
                else ra[h] = *(const u32x4*)(Ab + kt * 128 + 64 * h);
#pragma unroll
                for (int i = 0; i < 2; ++i) rb[i][h] = *(const u32x4*)(Bg + (size_t)(64 * i) * K + kt * 128 + 64 * h);
            }
        };
        auto storeAB = [&](int buf) {
#pragma unroll
            for (int h = 0; h < 2; ++h) {
                *(u32x4*)(As + buf * 64 * LS + arow * LS + ak + 64 * h) = ra[h];
#pragma unroll
                for (int i = 0; i < 2; ++i) *(u32x4*)(Bs + buf * 128 * LS + (arow + 64 * i) * LS + ak + 64 * h) = rb[i][h];
            }
        };
        loadAB(0);
        storeAB(0);
        __syncthreads();
        for (int kt = 0; kt < nk; ++kt) {
            const int buf = kt & 1;
            if (kt + 1 < nk) loadAB(kt + 1);
            const bf16_t* as = As + buf * 64 * LS; const bf16_t* bs = Bs + buf * 128 * LS;
#pragma unroll
            for (int kk = 0; kk < 4; ++kk) {
                bf16x8 af[2], bfr[2];
#pragma unroll
                for (int m = 0; m < 2; ++m) af[m] = *(const bf16x8*)(as + (32 * wr + 16 * m + fr) * LS + 32 * kk + 8 * fq);
#pragma unroll
                for (int n = 0; n < 2; ++n) bfr[n] = *(const bf16x8*)(bs + (32 * wc + 16 * n + fr) * LS + 32 * kk + 8 * fq);
#pragma unroll
                for (int m = 0; m < 2; ++m)
#pragma unroll
                    for (int n = 0; n < 2; ++n) acc[m][n] = MFMA32(bfr[n], af[m], acc[m][n]);
            }
            if (kt + 1 < nk) storeAB(buf ^ 1);
            __syncthreads();
        }
        if (AF32) {
            ssq += __shfl_xor(ssq, 1); ssq += __shfl_xor(ssq, 2); ssq += __shfl_xor(ssq, 4);
            if ((tid & 7) == 0) rs[arow] = rsqrtf(ssq * (1.f / 1024.f) + EPS);
            __syncthreads();
        }
#pragma unroll
        for (int m = 0; m < 2; ++m) {
            const int lr = 32 * wr + 16 * m + fr, r = row0 + pm * 64 + lr;
            const int cols[2] = {pn * 128 + 32 * wc + 4 * fq, pn * 128 + 32 * wc + 16 + 4 * fq};
            const f32x4 vv[2] = {acc[m][0], acc[m][1]};
            E.template row<2, false>(r, cols, vv, fq, AF32 ? rs[lr] : 1.f);
        }
    }
}

template <class Epi>
__device__ __forceinline__ void sgemm_phase(unsigned char* lds, const bf16_t* __restrict__ A, const bf16_t* __restrict__ Bt, int row0, int nrows, int N, int K,
                                            const Epi& E, int bid, int G) {
    const int tid = threadIdx.x, lane = tid & 63, wid = tid >> 6, wr = wid >> 2, wc = wid & 3, fr = lane & 15, fq = lane >> 4;
    const int nN = N / 128, nU = (nrows / 128) * nN, nk = K / 64;
    bf16_t* As = (bf16_t*)lds;
    bf16_t* Bs = As + 2 * 128 * 72;
    const int ldrow = tid >> 3, ldk = (tid & 7) * 8;
    for (int u = bid; u < nU; u += G) {
        const int pm = u / nN, pn = u % nN;
        const bf16_t* Ag = A + (size_t)(row0 + pm * 128 + ldrow) * K + ldk;
        const bf16_t* Bg = Bt + (size_t)(pn * 128 + ldrow) * K + ldk;
        f32x4 acc[4][2];
#pragma unroll
        for (int m = 0; m < 4; ++m)
#pragma unroll
            for (int n = 0; n < 2; ++n) acc[m][n] = (f32x4){0.f, 0.f, 0.f, 0.f};
        u32x4 ra[2], rb[2];
#pragma unroll
        for (int i = 0; i < 2; ++i) { ra[i] = *(const u32x4*)(Ag + (size_t)(64 * i) * K); rb[i] = *(const u32x4*)(Bg + (size_t)(64 * i) * K); }
#pragma unroll
        for (int i = 0; i < 2; ++i) { *(u32x4*)(As + (ldrow + 64 * i) * 72 + ldk) = ra[i]; *(u32x4*)(Bs + (ldrow + 64 * i) * 72 + ldk) = rb[i]; }
        __syncthreads();
        for (int kt = 0; kt < nk; ++kt) {
            const int buf = kt & 1;
            if (kt + 1 < nk) {
#pragma unroll
                for (int i = 0; i < 2; ++i) { ra[i] = *(const u32x4*)(Ag + (size_t)(64 * i) * K + (kt + 1) * 64); rb[i] = *(const u32x4*)(Bg + (size_t)(64 * i) * K + (kt + 1) * 64); }
            }
            const bf16_t* as = As + buf * 128 * 72; const bf16_t* bs = Bs + buf * 128 * 72;
#pragma unroll
            for (int kk = 0; kk < 2; ++kk) {
                bf16x8 af[4], bfr[2];
#pragma unroll
                for (int m = 0; m < 4; ++m) af[m] = *(const bf16x8*)(as + (64 * wr + 16 * m + fr) * 72 + 32 * kk + 8 * fq);
#pragma unroll
                for (int n = 0; n < 2; ++n) bfr[n] = *(const bf16x8*)(bs + (32 * wc + 16 * n + fr) * 72 + 32 * kk + 8 * fq);
#pragma unroll
                for (int m = 0; m < 4; ++m)
#pragma unroll
                    for (int n = 0; n < 2; ++n) acc[m][n] = MFMA32(bfr[n], af[m], acc[m][n]);
            }
            if (kt + 1 < nk) {
                bf16_t* an = As + (buf ^ 1) * 128 * 72; bf16_t* bn = Bs + (buf ^ 1) * 128 * 72;
#pragma unroll
                for (int i = 0; i < 2; ++i) { *(u32x4*)(an + (ldrow + 64 * i) * 72 + ldk) = ra[i]; *(u32x4*)(bn + (ldrow + 64 * i) * 72 + ldk) = rb[i]; }
            }
            __syncthreads();
        }
#pragma unroll
        for (int m = 0; m < 4; ++m) {
            const int r = row0 + pm * 128 + 64 * wr + 16 * m + fr;
            const int cols[2] = {pn * 128 + 32 * wc + 4 * fq, pn * 128 + 32 * wc + 16 + 4 * fq};
            const f32x4 vv[2] = {acc[m][0], acc[m][1]};
            E.template row<2, false>(r, cols, vv, fq, 1.f);
        }
    }
}

__device__ __forceinline__ void mlstm_local_unit(const Params& p, unsigned char* lds, int u) {
    const int tid = threadIdx.x, lane = tid & 63, wid = tid >> 6, fr = lane & 15, fq = lane >> 4;
    const int bh = u >> 6, c = u & 63, b = bh >> 2, h = bh & 3, base = b * 4096 + c * 64;
    unsigned char* ws = p.ws;
    const bf16_t* P = (const bf16_t*)(ws + WS_P); const float* gates = (const float*)(ws + WS_GATES);
    bf16_t* GS = (bf16_t*)p.out;
    bf16_t* kT = (bf16_t*)lds;
    bf16_t* vT = kT + 128 * 72;
    float* wk = (float*)(vT + 256 * 72);
    if (wid == 0) {
        const float lf = gates[(size_t)(base + lane) * 8 + 4 + h], li = gates[(size_t)(base + lane) * 8 + h];
        const float bc = scan_sum(lf, lane);
        const float B = __shfl(bc, 63);
        const float val = B - bc + li;
        const float ml = wave_max(val);
        wk[lane] = __expf(val - ml);
        if (lane == 0) { ((float*)(ws + WS_CHB))[u] = B; ((float*)(ws + WS_CHM))[u] = ml; }
    }
    __syncthreads();
    {
        const bf16_t* Pk = P + (size_t)(base + lane) * NIN + 512 + h * 128;
#pragma unroll
        for (int i = 0; i < 2; ++i) {
            const int dch = wid * 2 + i; const u32x4 r = *(const u32x4*)(Pk + dch * 8);
            bf16_t* dst = kT + (dch * 8) * 72 + lane;
            dst[0 * 72] = (bf16_t)(r.x & 0xffff); dst[1 * 72] = (bf16_t)(r.x >> 16); dst[2 * 72] = (bf16_t)(r.y & 0xffff); dst[3 * 72] = (bf16_t)(r.y >> 16);
            dst[4 * 72] = (bf16_t)(r.z & 0xffff); dst[5 * 72] = (bf16_t)(r.z >> 16); dst[6 * 72] = (bf16_t)(r.w & 0xffff); dst[7 * 72] = (bf16_t)(r.w >> 16);
        }
        const bf16_t* Pv = P + (size_t)(base + lane) * NIN + 1024 + h * 256;
        const float w = wk[lane];
#pragma unroll
        for (int i = 0; i < 4; ++i) {
            const int vch = wid * 4 + i; const u32x4 r = *(const u32x4*)(Pv + vch * 8);
            bf16_t* dst = vT + (vch * 8) * 72 + lane;
            dst[0 * 72] = f2bf(bflo(r.x) * w); dst[1 * 72] = f2bf(bfhi(r.x) * w); dst[2 * 72] = f2bf(bflo(r.y) * w); dst[3 * 72] = f2bf(bfhi(r.y) * w);
            dst[4 * 72] = f2bf(bflo(r.z) * w); dst[5 * 72] = f2bf(bfhi(r.z) * w); dst[6 * 72] = f2bf(bflo(r.w) * w); dst[7 * 72] = f2bf(bfhi(r.w) * w);
        }
    }
    __syncthreads();
    {
        f32x4 acc[2][8];
#pragma unroll
        for (int a = 0; a < 2; ++a)
#pragma unroll
            for (int d = 0; d < 8; ++d) acc[a][d] = (f32x4){0.f, 0.f, 0.f, 0.f};
#pragma unroll
        for (int ks = 0; ks < 2; ++ks) {
            bf16x8 yf[2];
#pragma unroll
            for (int vt = 0; vt < 2; ++vt) yf[vt] = *(const bf16x8*)(vT + (32 * wid + 16 * vt + fr) * 72 + 32 * ks + 8 * fq);
#pragma unroll
            for (int dt = 0; dt < 8; ++dt) {
                const bf16x8 xf = *(const bf16x8*)(kT + (16 * dt + fr) * 72 + 32 * ks + 8 * fq);
#pragma unroll
                for (int vt = 0; vt < 2; ++vt) acc[vt][dt] = MFMA32(xf, yf[vt], acc[vt][dt]);
            }
        }
        bf16_t* G = GS + (size_t)u * 32768;
#pragma unroll
        for (int vt = 0; vt < 2; ++vt)
#pragma unroll
            for (int dt = 0; dt < 8; ++dt) {
                u32x2 w; w.x = cvt_pk_bf16(acc[vt][dt].x, acc[vt][dt].y); w.y = cvt_pk_bf16(acc[vt][dt].z, acc[vt][dt].w);
                *(u32x2*)(G + (32 * wid + 16 * vt + fr) * 128 + 16 * dt + 4 * fq) = w;
            }
    }
    if (tid < 128) {
        float s = 0.f;
#pragma unroll 8
        for (int ss = 0; ss < 64; ++ss) s += bf2f(kT[tid * 72 + ss]) * wk[ss];
        ((float*)(ws + WS_GN))[(size_t)u * 128 + tid] = s;
    }
    __syncthreads();
}

__device__ __forceinline__ void mlstm_sample_unit(const Params& p, unsigned char* lds, int u) {
    const int tid = threadIdx.x, lane = tid & 63, wid = tid >> 6;
    const int b = u >> 2, h = u & 3, base = TP + b * 4;
    unsigned char* ws = p.ws;
    const bf16_t* P = (const bf16_t*)(ws + WS_P); const float* gates = (const float*)(ws + WS_GATES);
    float* q = (float*)lds;
    float* k = q + 512;
    float* v = k + 512;
    float* n0 = v + 1024;
    float* sc = n0 + 128;
    float* red = sc + 64;
    const float* C0 = p.st_C + (size_t)u * 32768;
    float* Cout = p.out + O_SC + (size_t)u * 32768;
    {
        const int t = tid >> 7, d = tid & 127;
        q[tid] = bf2f(P[(size_t)(base + t) * NIN + h * 128 + d]);
        k[tid] = bf2f(P[(size_t)(base + t) * NIN + 512 + h * 128 + d]);
        const int t2 = tid >> 8, vv = tid & 255;
        v[tid] = bf2f(P[(size_t)(base + t2) * NIN + 1024 + h * 256 + vv]);
        v[512 + tid] = bf2f(P[(size_t)(base + 2 + t2) * NIN + 1024 + h * 256 + vv]);
        if (tid < 128) n0[tid] = p.st_n[(size_t)u * 128 + tid];
    }
    if (tid == 0) {
        float li[4], bc[4]; float run = 0.f;
#pragma unroll
        for (int t = 0; t < 4; ++t) { li[t] = gates[(size_t)(base + t) * 8 + h]; run += gates[(size_t)(base + t) * 8 + 4 + h]; bc[t] = run; }
        const float m0 = p.st_m[u]; float mt[4];
#pragma unroll
        for (int t = 0; t < 4; ++t) {
            const float inter = bc[t] + m0; float mx = inter;
#pragma unroll
            for (int s = 0; s < 4; ++s) if (s <= t) mx = fmaxf(mx, bc[t] - bc[s] + li[s]);
            mt[t] = mx; sc[16 + t] = __expf(inter - mx); sc[28 + t] = __expf(-mx);
#pragma unroll
            for (int s = 0; s < 4; ++s) sc[t * 4 + s] = (s <= t) ? __expf(bc[t] - bc[s] + li[s] - mx) : 0.f;
        }
        const float mn = mt[3];
        sc[24] = __expf(bc[3] + m0 - mn);
#pragma unroll
        for (int s = 0; s < 4; ++s) sc[20 + s] = __expf(bc[3] - bc[s] + li[s] - mn);
        p.out[O_SM + u] = mn;
    }
    __syncthreads();
#pragma unroll
    for (int i = 0; i < 2; ++i) {
        const int pr = wid * 2 + i, t = pr >> 2, s = pr & 3;
        float a = q[t * 128 + lane] * k[s * 128 + lane] + q[t * 128 + 64 + lane] * k[s * 128 + 64 + lane];
        a = wave_sum(a);
        if (lane == 0) sc[32 + pr] = a * sc[pr];
    }
    if (wid < 4) { float a = q[wid * 128 + lane] * n0[lane] + q[wid * 128 + 64 + lane] * n0[64 + lane]; a = wave_sum(a); if (lane == 0) sc[48 + wid] = a; }
    if (tid < 8) sc[52 + tid] = 0.f;
    {
        const int vq = lane, dg = wid;
        f32x4 qc[4];
#pragma unroll
        for (int t = 0; t < 4; ++t) qc[t] = (f32x4){0.f, 0.f, 0.f, 0.f};
        const float decay = sc[24];
        f32x4 vs[4];
#pragma unroll
        for (int s = 0; s < 4; ++s) vs[s] = *(const f32x4*)(v + s * 256 + 4 * vq) * sc[20 + s];
#pragma unroll 4
        for (int dd = 0; dd < 16; ++dd) {
            const int d = dg * 16 + dd;
            const f32x4 c0 = __builtin_nontemporal_load((const f32x4*)(C0 + (size_t)d * 256 + 4 * vq));
            f32x4 cn = c0 * decay;
#pragma unroll
            for (int s = 0; s < 4; ++s) cn += vs[s] * k[s * 128 + d];
            __builtin_nontemporal_store(cn, (f32x4*)(Cout + (size_t)d * 256 + 4 * vq));
#pragma unroll
            for (int t = 0; t < 4; ++t) qc[t] += c0 * q[t * 128 + d];
        }
#pragma unroll
        for (int t = 0; t < 4; ++t) *(f32x4*)(red + (dg * 4 + t) * 256 + 4 * vq) = qc[t];
    }
    if (tid < 128) {
        float nn = sc[24] * n0[tid];
#pragma unroll
        for (int s = 0; s < 4; ++s) nn += sc[20 + s] * k[s * 128 + tid];
        p.out[O_SN + (size_t)u * 128 + tid] = nn;
    }
    __syncthreads();
    {
        const int t = tid >> 7, v0 = (tid & 127) * 2;
        float den = sc[16 + t] * sc[48 + t];
#pragma unroll
        for (int s = 0; s < 4; ++s) den += sc[32 + t * 4 + s];
        const float inv = 1.f / fmaxf(fabsf(den), sc[28 + t]);
        float hv[2]; float ssq = 0.f;
#pragma unroll
        for (int j = 0; j < 2; ++j) {
            float qC = 0.f;
#pragma unroll
            for (int g = 0; g < 8; ++g) qC += red[(g * 4 + t) * 256 + v0 + j];
            float num = sc[16 + t] * qC;
#pragma unroll
            for (int s = 0; s < 4; ++s) num += sc[32 + t * 4 + s] * v[s * 256 + v0 + j];
            hv[j] = num * inv; ssq += hv[j] * hv[j];
        }
        ssq = wave_sum(ssq);
        if (lane == 0) sc[52 + wid] = ssq;
        __syncthreads();
        const float tot = sc[52 + 2 * t] + sc[52 + 2 * t + 1];
        const float rstd = rsqrtf(tot * (1.f / 256.f) + EPS);
        const unsigned ob = *(const unsigned*)(P + (size_t)(base + t) * NIN + 2048 + h * 256 + v0);
        const float o0 = sigmoidf_(bflo(ob)), o1 = sigmoidf_(bfhi(ob));
        const float g0 = p.ml_head_g[h * 256 + v0], g1 = p.ml_head_g[h * 256 + v0 + 1];
        bf16_t* HG = (bf16_t*)(ws + WS_HG);
        *(unsigned*)(HG + (size_t)(base + t) * D + h * 256 + v0) = cvt_pk_bf16(hv[0] * rstd * g0 * o0, hv[1] * rstd * g1 * o1);
    }
    __syncthreads();
}

__device__ __forceinline__ void mlstm_scan(const Params& p, unsigned char* lds, int bid, int G) {
    unsigned char* ws = p.ws;
    bf16_t* GS = (bf16_t*)p.out;
    const float* CHB = (const float*)(ws + WS_CHB); const float* CHM = (const float*)(ws + WS_CHM);
    float* MPREV = (float*)(ws + WS_MPREV); float* GN = (float*)(ws + WS_GN);
    const int tid = threadIdx.x;
    float* decs = (float*)lds;
    float* scls = decs + 64;
    float* tile = scls + 64;
    for (int blk = bid; blk < 256; blk += G) {
        const int bh = blk >> 4;
        if (tid < 64) {
            const float B = CHB[bh * 64 + tid], ml = CHM[bh * 64 + tid];
            float a = B, b2 = ml;
#pragma unroll
            for (int o = 1; o < 64; o <<= 1) { const float ya = __shfl_up(a, o), yb = __shfl_up(b2, o); if (tid >= o) { b2 = fmaxf(yb + a, b2); a = ya + a; } }
            const float m = fmaxf(a, b2);
            float mp = __shfl_up(m, 1); if (tid == 0) mp = 0.f;
            decs[tid] = __expf(B + mp - m); scls[tid] = __expf(ml - m);
            if ((blk & 15) == 0) { MPREV[bh * 64 + tid] = mp; if (tid == 63) p.out[O_PM + bh] = m; }
        }
        float gnv[64]; float* gp = GN + (size_t)(bh * 64) * 128 + (blk & 15) * 8 + (tid & 7);
        if (tid < 8) {
#pragma unroll
            for (int c = 0; c < 64; ++c) gnv[c] = gp[(size_t)c * 128];
        }
        __syncthreads();
        const int e4 = blk * NTHREADS + tid;
        const int off = (e4 & 8191) * 4;
        bf16_t* ptr = GS + (size_t)bh * 64 * 32768 + off;
        float c0 = 0.f, c1 = 0.f, c2 = 0.f, c3 = 0.f;
#pragma unroll 1
        for (int cb = 0; cb < 64; cb += 16) {
            u32x2 g[16];
#pragma unroll
            for (int j = 0; j < 16; ++j) g[j] = __builtin_nontemporal_load((const u32x2*)(ptr + (size_t)(cb + j) * 32768));
#pragma unroll
            for (int j = 0; j < 16; ++j) {
                const float dec = decs[cb + j], s = scls[cb + j];
                u32x2 w; w.x = cvt_pk_bf16(c0, c1); w.y = cvt_pk_bf16(c2, c3);
                *(u32x2*)(ptr + (size_t)(cb + j) * 32768) = w;
                c0 = dec * c0 + s * bflo(g[j].x); c1 = dec * c1 + s * bfhi(g[j].x); c2 = dec * c2 + s * bflo(g[j].y); c3 = dec * c3 + s * bfhi(g[j].y);
            }
        }
        {
            const int vl = (off >> 7) & 15, d = off & 127;
            tile[(d + 0) * 20 + vl] = c0; tile[(d + 1) * 20 + vl] = c1; tile[(d + 2) * 20 + vl] = c2; tile[(d + 3) * 20 + vl] = c3;
            __syncthreads();
            const int dd = tid >> 2, vq = tid & 3, v0 = (blk & 15) * 16;
            const f32x4 o = (f32x4){tile[dd * 20 + 4 * vq], tile[dd * 20 + 4 * vq + 1], tile[dd * 20 + 4 * vq + 2], tile[dd * 20 + 4 * vq + 3]};
            *(f32x4*)(p.out + O_PC + (size_t)bh * 32768 + (size_t)dd * 256 + v0 + 4 * vq) = o;
        }
        if (tid < 8) {
            float n = 0.f;
#pragma unroll
            for (int c = 0; c < 64; ++c) { gp[(size_t)c * 128] = n; n = decs[c] * n + scls[c] * gnv[c]; }
            p.out[O_PN + bh * 128 + (blk & 15) * 8 + tid] = n;
        }
        __syncthreads();
    }
}

__device__ __forceinline__ void mlstm_out_unit(const Params& p, unsigned char* lds, int u) {
    const int tid = threadIdx.x, lane = tid & 63, wid = tid >> 6, fr = lane & 15, fq = lane >> 4;
    const int bh = u >> 6, c = u & 63, b = bh >> 2, h = bh & 3, base = b * 4096 + c * 64;
    unsigned char* ws = p.ws;
    const bf16_t* P = (const bf16_t*)(ws + WS_P); const float* gates = (const float*)(ws + WS_GATES);
    const bf16_t* CT = (const bf16_t*)p.out + (size_t)u * 32768;
    bf16_t* Qs = (bf16_t*)lds;
    bf16_t* Ks = Qs + 64 * 136;
    bf16_t* Ac = Ks + 64 * 136;
    bf16_t* VT = Ac + 64 * 200;
    float* sm = (float*)(VT + 256 * 72);
    float *bt = sm, *lmb = sm + 64, *mt = sm + 128, *at = sm + 192, *den = sm + 256, *hss = sm + 320, *npv = sm + 384;
    bf16x8 cf[2][4];
#pragma unroll
    for (int vt = 0; vt < 2; ++vt)
#pragma unroll
        for (int kd = 0; kd < 4; ++kd) cf[vt][kd] = *(const bf16x8*)(CT + (32 * wid + 16 * vt + fr) * 128 + 32 * kd + 8 * fq);
    if (wid == 0) {
        const float lf = gates[(size_t)(base + lane) * 8 + 4 + h], li = gates[(size_t)(base + lane) * 8 + h];
        const float bc = scan_sum(lf, lane);
        const float lm = li - bc;
        const float pm = scan_max(lm, lane);
        const float mprev = ((const float*)(ws + WS_MPREV))[u];
        const float inter = bc + mprev;
        const float m_t = fmaxf(inter, bc + pm);
        bt[lane] = bc; lmb[lane] = lm; mt[lane] = m_t; at[lane] = __expf(inter - m_t); den[lane] = 0.f; hss[lane] = 0.f;
    }
    if (wid == 1) { const float* NP = (const float*)(ws + WS_GN) + (size_t)u * 128; npv[lane] = NP[lane]; npv[64 + lane] = NP[64 + lane]; }
    __syncthreads();
#pragma unroll
    for (int i = 0; i < 2; ++i) {
        const int ci = tid + 512 * i, t = ci >> 4, dch = ci & 15;
        const u32x4 qv = *(const u32x4*)(P + (size_t)(base + t) * NIN + h * 128 + dch * 8);
        const u32x4 kv = *(const u32x4*)(P + (size_t)(base + t) * NIN + 512 + h * 128 + dch * 8);
        *(u32x4*)(Qs + t * 136 + dch * 8) = qv;
        *(u32x4*)(Ks + t * 136 + dch * 8) = kv;
        const float a = at[t];
        u32x4 sq; sq.x = cvt_pk_bf16(bflo(qv.x) * a, bfhi(qv.x) * a); sq.y = cvt_pk_bf16(bflo(qv.y) * a, bfhi(qv.y) * a);
        sq.z = cvt_pk_bf16(bflo(qv.z) * a, bfhi(qv.z) * a); sq.w = cvt_pk_bf16(bflo(qv.w) * a, bfhi(qv.w) * a);
        *(u32x4*)(Ac + t * 200 + 64 + dch * 8) = sq;
    }
    {
        const bf16_t* Pv = P + (size_t)(base + lane) * NIN + 1024 + h * 256;
#pragma unroll
        for (int i = 0; i < 4; ++i) {
            const int vch = wid * 4 + i; const u32x4 r = *(const u32x4*)(Pv + vch * 8);
            bf16_t* dst = VT + (vch * 8) * 72 + lane;
            dst[0 * 72] = (bf16_t)(r.x & 0xffff); dst[1 * 72] = (bf16_t)(r.x >> 16); dst[2 * 72] = (bf16_t)(r.y & 0xffff); dst[3 * 72] = (bf16_t)(r.y >> 16);
            dst[4 * 72] = (bf16_t)(r.z & 0xffff); dst[5 * 72] = (bf16_t)(r.z >> 16); dst[6 * 72] = (bf16_t)(r.w & 0xffff); dst[7 * 72] = (bf16_t)(r.w >> 16);
        }
    }
    __syncthreads();
    {
        const int tt = wid >> 1;
#pragma unroll
        for (int j = 0; j < 2; ++j) {
            const int st = 2 * (wid & 1) + j;
            const int t = 16 * tt + fr, s0 = 16 * st + 4 * fq;
            u32x2 w; w.x = 0u; w.y = 0u;
            if (st <= tt) {
                f32x4 a = (f32x4){0.f, 0.f, 0.f, 0.f};
#pragma unroll
                for (int kd = 0; kd < 4; ++kd) {
                    const bf16x8 x = *(const bf16x8*)(Ks + (16 * st + fr) * 136 + 32 * kd + 8 * fq);
                    const bf16x8 y = *(const bf16x8*)(Qs + (16 * tt + fr) * 136 + 32 * kd + 8 * fq);
                    a = MFMA32(x, y, a);
                }
                const float e0 = bt[t] - mt[t];
                float vals[4];
#pragma unroll
                for (int i = 0; i < 4; ++i) { const int s = s0 + i; vals[i] = (s <= t) ? a[i] * __expf(e0 + lmb[s]) : 0.f; }
                float rs = (vals[0] + vals[1]) + (vals[2] + vals[3]);
                rs += __shfl_xor(rs, 16); rs += __shfl_xor(rs, 32);
                if (fq == 0) atomicAdd(&den[t], rs);
                w.x = cvt_pk_bf16(vals[0], vals[1]); w.y = cvt_pk_bf16(vals[2], vals[3]);
            }
            *(u32x2*)(Ac + t * 200 + s0) = w;
        }
#pragma unroll
        for (int i = 0; i < 8; ++i) {
            const int t = 8 * wid + i;
            float a = bf2f(Qs[t * 136 + lane]) * npv[lane] + bf2f(Qs[t * 136 + 64 + lane]) * npv[64 + lane];
            a = wave_sum(a);
            if (lane == 0) atomicAdd(&den[t], at[t] * a);
        }
    }
    __syncthreads();
    f32x4 acc[4][2];
#pragma unroll
    for (int a = 0; a < 4; ++a)
#pragma unroll
        for (int d = 0; d < 2; ++d) acc[a][d] = (f32x4){0.f, 0.f, 0.f, 0.f};
#pragma unroll
    for (int kk = 0; kk < 6; ++kk) {
        bf16x8 x[2];
#pragma unroll
        for (int vt = 0; vt < 2; ++vt) x[vt] = (kk < 2) ? *(const bf16x8*)(VT + (32 * wid + 16 * vt + fr) * 72 + 32 * kk + 8 * fq) : cf[vt][kk >= 2 ? kk - 2 : 0];
#pragma unroll
        for (int tt = 0; tt < 4; ++tt) {
            const bf16x8 y = *(const bf16x8*)(Ac + (16 * tt + fr) * 200 + 32 * kk + 8 * fq);
#pragma unroll
            for (int vt = 0; vt < 2; ++vt) acc[tt][vt] = MFMA32(x[vt], y, acc[tt][vt]);
        }
    }
#pragma unroll
    for (int tt = 0; tt < 4; ++tt) {
        const int t = 16 * tt + fr;
        const float inv = 1.f / fmaxf(fabsf(den[t]), __expf(-mt[t]));
        float ssq = 0.f;
#pragma unroll
        for (int vt = 0; vt < 2; ++vt) { acc[tt][vt] = acc[tt][vt] * inv; const f32x4 a = acc[tt][vt]; ssq += (a.x * a.x + a.y * a.y) + (a.z * a.z + a.w * a.w); }
        ssq += __shfl_xor(ssq, 16); ssq += __shfl_xor(ssq, 32);
        if (fq == 0) atomicAdd(&hss[t], ssq);
    }
    __syncthreads();
    {
        bf16_t* HG = (bf16_t*)(ws + WS_HG);
#pragma unroll
        for (int tt = 0; tt < 4; ++tt) {
            const int t = 16 * tt + fr;
            const float rstd = rsqrtf(hss[t] * (1.f / 256.f) + EPS);
#pragma unroll
            for (int vt = 0; vt < 2; ++vt) {
                const int v0 = 32 * wid + 16 * vt + 4 * fq;
                const u32x2 ob = *(const u32x2*)(P + (size_t)(base + t) * NIN + 2048 + h * 256 + v0);
                const f32x4 g = *(const f32x4*)(p.ml_head_g + h * 256 + v0);
                const f32x4 a = acc[tt][vt];
                u32x2 w;
                w.x = cvt_pk_bf16(a.x * rstd * g.x * sigmoidf_(bflo(ob.x)), a.y * rstd * g.y * sigmoidf_(bfhi(ob.x)));
                w.y = cvt_pk_bf16(a.z * rstd * g.z * sigmoidf_(bflo(ob.y)), a.w * rstd * g.w * sigmoidf_(bfhi(ob.y)));
                *(u32x2*)(HG + (size_t)(base + t) * D + h * 256 + v0) = w;
            }
        }
    }
    __syncthreads();
}

__device__ __forceinline__ void norm_frag(const u32x4 r0, const u32x4 r1, const float* __restrict__ g, float extra, int fq, bf16x8& o0, bf16x8& o1) {
    float f[16];
    f[0] = bflo(r0.x); f[1] = bfhi(r0.x); f[2] = bflo(r0.y); f[3] = bfhi(r0.y); f[4] = bflo(r0.z); f[5] = bfhi(r0.z); f[6] = bflo(r0.w); f[7] = bfhi(r0.w);
    f[8] = bflo(r1.x); f[9] = bfhi(r1.x); f[10] = bflo(r1.y); f[11] = bfhi(r1.y); f[12] = bflo(r1.z); f[13] = bfhi(r1.z); f[14] = bflo(r1.w); f[15] = bfhi(r1.w);
    float s = 0.f;
#pragma unroll
    for (int i = 0; i < 16; ++i) s += f[i] * f[i];
    s += __shfl_xor(s, 16); s += __shfl_xor(s, 32);
    const float rs = rsqrtf(s * (1.f / 64.f) + EPS) * extra;
    const f32x4 ga = *(const f32x4*)(g + 8 * fq), gb = *(const f32x4*)(g + 8 * fq + 4), gc = *(const f32x4*)(g + 32 + 8 * fq), gd = *(const f32x4*)(g + 32 + 8 * fq + 4);
    u32x4 a, b2;
    a.x = cvt_pk_bf16(f[0] * rs * ga.x, f[1] * rs * ga.y); a.y = cvt_pk_bf16(f[2] * rs * ga.z, f[3] * rs * ga.w);
    a.z = cvt_pk_bf16(f[4] * rs * gb.x, f[5] * rs * gb.y); a.w = cvt_pk_bf16(f[6] * rs * gb.z, f[7] * rs * gb.w);
    b2.x = cvt_pk_bf16(f[8] * rs * gc.x, f[9] * rs * gc.y); b2.y = cvt_pk_bf16(f[10] * rs * gc.z, f[11] * rs * gc.w);
    b2.z = cvt_pk_bf16(f[12] * rs * gd.x, f[13] * rs * gd.y); b2.w = cvt_pk_bf16(f[14] * rs * gd.z, f[15] * rs * gd.w);
    o0 = __builtin_bit_cast(bf16x8, a); o1 = __builtin_bit_cast(bf16x8, b2);
}

__device__ __forceinline__ void attn_prompt_unit(const Params& p, unsigned char* lds, int u) {
    const int tid = threadIdx.x, lane = tid & 63, wid = tid >> 6, fr = lane & 15, fq = lane >> 4;
    const int qb = u & 31, kvh = (u >> 5) & 3, b = u >> 7;
    unsigned char* ws = p.ws;
    const bf16_t* KVQ = (const bf16_t*)(ws + WS_KVQ);
    bf16_t* AO = (bf16_t*)(ws + WS_ATT);
    bf16_t* Ks = (bf16_t*)lds;
    bf16_t* VT = Ks + 256 * 72;
    const int pos0 = qb * 128 - 128;
    u32x4 qr[4][2];
    {
        const int g_ = wid >> 1, half_ = wid & 1, head_ = kvh * 4 + g_;
#pragma unroll
        for (int m = 0; m < 4; ++m) {
            const bf16_t* qp = KVQ + ((size_t)b * 4096 + qb * 128 + 64 * half_ + 16 * m + fr) * NKVQ + 512 + head_ * 64;
            qr[m][0] = *(const u32x4*)(qp + 8 * fq); qr[m][1] = *(const u32x4*)(qp + 32 + 8 * fq);
        }
    }
#pragma unroll
    for (int i = 0; i < 4; ++i) {
        const int ci = tid + 512 * i, j = ci >> 3, ch = ci & 7, pos = pos0 + j;
        u32x4 r = (u32x4){0u, 0u, 0u, 0u};
        if (pos >= 0) r = *(const u32x4*)(KVQ + (size_t)(b * 4096 + pos) * NKVQ + kvh * 64 + ch * 8);
        float f[8] = {bflo(r.x), bfhi(r.x), bflo(r.y), bfhi(r.y), bflo(r.z), bfhi(r.z), bflo(r.w), bfhi(r.w)};
        float s = 0.f;
#pragma unroll
        for (int e = 0; e < 8; ++e) s += f[e] * f[e];
        s += __shfl_xor(s, 1); s += __shfl_xor(s, 2); s += __shfl_xor(s, 4);
        const float rs = rsqrtf(s * (1.f / 64.f) + EPS);
        const f32x4 g0 = *(const f32x4*)(p.k_norm_g + ch * 8), g1 = *(const f32x4*)(p.k_norm_g + ch * 8 + 4);
        f[0] *= rs * g0.x; f[1] *= rs * g0.y; f[2] *= rs * g0.z; f[3] *= rs * g0.w; f[4] *= rs * g1.x; f[5] *= rs * g1.y; f[6] *= rs * g1.z; f[7] *= rs * g1.w;
        u32x4 w; w.x = cvt_pk_bf16(f[0], f[1]); w.y = cvt_pk_bf16(f[2], f[3]); w.z = cvt_pk_bf16(f[4], f[5]); w.w = cvt_pk_bf16(f[6], f[7]);
        *(u32x4*)(Ks + j * 72 + ch * 8) = w;
        if (qb == 31 && j >= 128) {
            float* o = p.out + O_PWK + ((size_t)(b * 128 + (j - 128)) * 4 + kvh) * 64 + ch * 8;
            *(f32x4*)o = (f32x4){f[0], f[1], f[2], f[3]}; *(f32x4*)(o + 4) = (f32x4){f[4], f[5], f[6], f[7]};
        }
    }
#pragma unroll
    for (int i = 0; i < 4; ++i) {
        const int ci = tid + 512 * i, j = ci & 255, ch = ci >> 8, pos = pos0 + j;
        u32x4 r = (u32x4){0u, 0u, 0u, 0u};
        if (pos >= 0) r = *(const u32x4*)(KVQ + (size_t)(b * 4096 + pos) * NKVQ + 256 + kvh * 64 + ch * 8);
        bf16_t* dst = VT + (ch * 8) * 264 + j;
        dst[0 * 264] = (bf16_t)(r.x & 0xffff); dst[1 * 264] = (bf16_t)(r.x >> 16); dst[2 * 264] = (bf16_t)(r.y & 0xffff); dst[3 * 264] = (bf16_t)(r.y >> 16);
        dst[4 * 264] = (bf16_t)(r.z & 0xffff); dst[5 * 264] = (bf16_t)(r.z >> 16); dst[6 * 264] = (bf16_t)(r.w & 0xffff); dst[7 * 264] = (bf16_t)(r.w >> 16);
        if (qb == 31 && j >= 128) {
            float* o = p.out + O_PWV + ((size_t)(b * 128 + (j - 128)) * 4 + kvh) * 64 + ch * 8;
            *(f32x4*)o = (f32x4){bflo(r.x), bfhi(r.x), bflo(r.y), bfhi(r.y)}; *(f32x4*)(o + 4) = (f32x4){bflo(r.z), bfhi(r.z), bflo(r.w), bfhi(r.w)};
        }
    }
    __syncthreads();
    const int g = wid >> 1, half = wid & 1, head = kvh * 4 + g;
    const float sink = p.att_sinks[head];
    const float* qg = p.q_norm_g;
#pragma unroll
    for (int m = 0; m < 4; ++m) {
        const int j0 = 64 * half + 16 * m;
        const size_t R = (size_t)b * 4096 + qb * 128 + j0 + fr;
        bf16x8 q0, q1; norm_frag(qr[m][0], qr[m][1], qg, 0.125f, fq, q0, q1);
        f32x4 s[9];
#pragma unroll
        for (int i = 0; i < 9; ++i) {
            s[i] = (f32x4){0.f, 0.f, 0.f, 0.f};
            const bf16_t* kr = Ks + (j0 + 16 * i + fr) * 72 + 8 * fq;
            s[i] = MFMA32(*(const bf16x8*)kr, q0, s[i]);
            s[i] = MFMA32(*(const bf16x8*)(kr + 32), q1, s[i]);
        }
        float mx = sink;
#pragma unroll
        for (int e = 0; e < 4; ++e) {
            s[0][e] = (4 * fq + e >= fr) ? s[0][e] : -INFINITY;
            s[8][e] = (4 * fq + e <= fr) ? s[8][e] : -INFINITY;
        }
        if (pos0 < 0) {
#pragma unroll
            for (int i = 0; i < 9; ++i)
#pragma unroll
                for (int e = 0; e < 4; ++e) s[i][e] = (pos0 + j0 + 16 * i + 4 * fq + e >= 0) ? s[i][e] : -INFINITY;
        }
#pragma unroll
        for (int i = 0; i < 9; ++i)
#pragma unroll
            for (int e = 0; e < 4; ++e) mx = fmaxf(mx, s[i][e]);
        mx = fmaxf(mx, __shfl_xor(mx, 16)); mx = fmaxf(mx, __shfl_xor(mx, 32));
        float l = 0.f;
        bf16x4 pf[9];
#pragma unroll
        for (int i = 0; i < 9; ++i) {
            float e0 = __expf(s[i][0] - mx), e1 = __expf(s[i][1] - mx), e2 = __expf(s[i][2] - mx), e3 = __expf(s[i][3] - mx);
            l += (e0 + e1) + (e2 + e3);
            u32x2 w; w.x = cvt_pk_bf16(e0, e1); w.y = cvt_pk_bf16(e2, e3);
            pf[i] = __builtin_bit_cast(bf16x4, w);
        }
        l += __shfl_xor(l, 16); l += __shfl_xor(l, 32);
        l += __expf(sink - mx);
        const float inv = 1.f / l;
        f32x4 o[4];
#pragma unroll
        for (int dt = 0; dt < 4; ++dt) {
            o[dt] = (f32x4){0.f, 0.f, 0.f, 0.f};
#pragma unroll
            for (int i = 0; i < 9; ++i) {
                const bf16x4 vf = *(const bf16x4*)(VT + (16 * dt + fr) * 264 + j0 + 16 * i + 4 * fq);
                o[dt] = MFMA16(vf, pf[i], o[dt]);
            }
        }
#pragma unroll
        for (int dt = 0; dt < 4; ++dt) {
            u32x2 w; w.x = cvt_pk_bf16(o[dt].x * inv, o[dt].y * inv); w.y = cvt_pk_bf16(o[dt].z * inv, o[dt].w * inv);
            *(u32x2*)(AO + R * D + head * 64 + 16 * dt + 4 * fq) = w;
        }
    }
    __syncthreads();
}

__device__ __forceinline__ void attn_sample_unit(const Params& p, int u, int lane) {
    const int fr = lane & 15, fq = lane >> 4;
    const int b = u >> 2, kvh = u & 3;
    unsigned char* ws = p.ws;
    const bf16_t* KVQ = (const bf16_t*)(ws + WS_KVQ);
    bf16_t* AO = (bf16_t*)(ws + WS_ATT);
    const float* ck = p.cache_k + (size_t)b * 128 * 256 + kvh * 64;
    const float* cv = p.cache_v + (size_t)b * 128 * 256 + kvh * 64;
    float* owk = p.out + O_SWK + (size_t)b * 128 * 256 + kvh * 64;
    float* owv = p.out + O_SWV + (size_t)b * 128 * 256 + kvh * 64;
    const size_t rbase = (size_t)TP + b * 4;
    for (int i = lane; i < 124 * 16; i += 64) {
        const int j = i >> 4, d4 = (i & 15) * 4;
        *(f32x4*)(owk + (size_t)j * 256 + d4) = *(const f32x4*)(ck + (size_t)(j + 4) * 256 + d4);
        *(f32x4*)(owv + (size_t)j * 256 + d4) = *(const f32x4*)(cv + (size_t)(j + 4) * 256 + d4);
    }
    {
        const int t = lane >> 4, d4 = (lane & 15) * 4;
        const u32x2 kr = *(const u32x2*)(KVQ + (rbase + t) * NKVQ + kvh * 64 + d4);
        const u32x2 vr = *(const u32x2*)(KVQ + (rbase + t) * NKVQ + 256 + kvh * 64 + d4);
        float f0 = bflo(kr.x), f1 = bfhi(kr.x), f2 = bflo(kr.y), f3 = bfhi(kr.y);
        float s = (f0 * f0 + f1 * f1) + (f2 * f2 + f3 * f3);
        s += __shfl_xor(s, 1); s += __shfl_xor(s, 2); s += __shfl_xor(s, 4); s += __shfl_xor(s, 8);
        const float rs = rsqrtf(s * (1.f / 64.f) + EPS);
        const f32x4 g = *(const f32x4*)(p.k_norm_g + d4);
        *(f32x4*)(owk + (size_t)(124 + t) * 256 + d4) = (f32x4){f0 * rs * g.x, f1 * rs * g.y, f2 * rs * g.z, f3 * rs * g.w};
        *(f32x4*)(owv + (size_t)(124 + t) * 256 + d4) = (f32x4){bflo(vr.x), bfhi(vr.x), bflo(vr.y), bfhi(vr.y)};
    }
    const int g = fr >> 2, t = fr & 3, head = kvh * 4 + g;
    const bf16_t* qp = KVQ + (rbase + t) * NKVQ + 512 + head * 64;
    const u32x4 r0 = *(const u32x4*)(qp + 8 * fq), r1 = *(const u32x4*)(qp + 32 + 8 * fq);
    bf16x8 q0, q1; norm_frag(r0, r1, p.q_norm_g, 0.125f, fq, q0, q1);
    const float sink = p.att_sinks[head];
    bf16x8 nk0, nk1;
    {
        const bf16_t* kp = KVQ + (rbase + (fr & 3)) * NKVQ + kvh * 64;
        const u32x4 a0 = *(const u32x4*)(kp + 8 * fq), a1 = *(const u32x4*)(kp + 32 + 8 * fq);
        norm_frag(a0, a1, p.k_norm_g, 1.f, fq, nk0, nk1);
        if (fr >= 4) { nk0 = (bf16x8){0, 0, 0, 0, 0, 0, 0, 0}; nk1 = nk0; }
    }
    f32x4 s[9];
#pragma unroll
    for (int i = 0; i < 8; ++i) {
        const float* kr = ck + (size_t)(16 * i + fr) * 256 + 8 * fq;
        const f32x4 a = *(const f32x4*)kr, b2 = *(const f32x4*)(kr + 4), c = *(const f32x4*)(kr + 32), d = *(const f32x4*)(kr + 36);
        u32x4 x0, x1;
        x0.x = cvt_pk_bf16(a.x, a.y); x0.y = cvt_pk_bf16(a.z, a.w); x0.z = cvt_pk_bf16(b2.x, b2.y); x0.w = cvt_pk_bf16(b2.z, b2.w);
        x1.x = cvt_pk_bf16(c.x, c.y); x1.y = cvt_pk_bf16(c.z, c.w); x1.z = cvt_pk_bf16(d.x, d.y); x1.w = cvt_pk_bf16(d.z, d.w);
        s[i] = (f32x4){0.f, 0.f, 0.f, 0.f};
        s[i] = MFMA32(__builtin_bit_cast(bf16x8, x0), q0, s[i]);
        s[i] = MFMA32(__builtin_bit_cast(bf16x8, x1), q1, s[i]);
    }
    s[8] = (f32x4){0.f, 0.f, 0.f, 0.f};
    s[8] = MFMA32(nk0, q0, s[8]); s[8] = MFMA32(nk1, q1, s[8]);
    float mx = sink;
#pragma unroll
    for (int i = 0; i < 9; ++i)
#pragma unroll
        for (int e = 0; e < 4; ++e) {
            const int j = 16 * i + 4 * fq + e;
            const bool ok = (j >= t) && (j <= t + 128);
            s[i][e] = ok ? s[i][e] : -INFINITY;
            mx = fmaxf(mx, s[i][e]);
        }
    mx = fmaxf(mx, __shfl_xor(mx, 16)); mx = fmaxf(mx, __shfl_xor(mx, 32));
    float l = 0.f; bf16x4 pf[9];
#pragma unroll
    for (int i = 0; i < 9; ++i) {
        float e0 = __expf(s[i][0] - mx), e1 = __expf(s[i][1] - mx), e2 = __expf(s[i][2] - mx), e3 = __expf(s[i][3] - mx);
        l += (e0 + e1) + (e2 + e3);
        u32x2 w; w.x = cvt_pk_bf16(e0, e1); w.y = cvt_pk_bf16(e2, e3);
        pf[i] = __builtin_bit_cast(bf16x4, w);
    }
    l += __shfl_xor(l, 16); l += __shfl_xor(l, 32);
    l += __expf(sink - mx);
    const float inv = 1.f / l;
#pragma unroll
    for (int dt = 0; dt < 4; ++dt) {
        f32x4 o = (f32x4){0.f, 0.f, 0.f, 0.f};
#pragma unroll
        for (int i = 0; i < 8; ++i) {
            const float* vr = cv + (size_t)(16 * i + 4 * fq) * 256 + 16 * dt + fr;
            u32x2 w; w.x = cvt_pk_bf16(vr[0], vr[256]); w.y = cvt_pk_bf16(vr[512], vr[768]);
            o = MFMA16(__builtin_bit_cast(bf16x4, w), pf[i], o);
        }
        {
            u32x2 w; w.x = 0u; w.y = 0u;
            const bf16_t* vp = KVQ + rbase * NKVQ + 256 + kvh * 64 + 16 * dt + fr;
            const unsigned v0 = vp[0], v1 = vp[NKVQ], v2 = vp[2 * NKVQ], v3 = vp[3 * NKVQ];
            if (fq == 0) { w.x = v0 | (v1 << 16); w.y = v2 | (v3 << 16); }
            o = MFMA16(__builtin_bit_cast(bf16x4, w), pf[8], o);
        }
        u32x2 w; w.x = cvt_pk_bf16(o.x * inv, o.y * inv); w.y = cvt_pk_bf16(o.z * inv, o.w * inv);
        *(u32x2*)(AO + (rbase + t) * D + head * 64 + 16 * dt + 4 * fq) = w;
    }
}


__device__ __forceinline__ void attn_sample_block(const Params& p, unsigned char* lds, int u) {
    const int tid = threadIdx.x, lane = tid & 63, wid = tid >> 6, fr = lane & 15, fq = lane >> 4;
    const int b = u >> 2, kvh = u & 3;
    unsigned char* ws = p.ws;
    const bf16_t* KVQ = (const bf16_t*)(ws + WS_KVQ);
    bf16_t* AO = (bf16_t*)(ws + WS_ATT);
    const float* ck = p.cache_k + (size_t)b * 128 * 256 + kvh * 64;
    const float* cv = p.cache_v + (size_t)b * 128 * 256 + kvh * 64;
    float* owk = p.out + O_SWK + (size_t)b * 128 * 256 + kvh * 64;
    float* owv = p.out + O_SWV + (size_t)b * 128 * 256 + kvh * 64;
    const size_t rbase = (size_t)TP + b * 4;
    bf16_t* Ks = (bf16_t*)lds;
    bf16_t* VT = Ks + 144 * 72;
    f32x4 kf[4], vf[4];
#pragma unroll
    for (int i = 0; i < 4; ++i) { const int idx = tid + 512 * i, j = idx >> 4, c4 = (idx & 15) * 4; kf[i] = __builtin_nontemporal_load((const f32x4*)(ck + (size_t)j * 256 + c4)); vf[i] = __builtin_nontemporal_load((const f32x4*)(cv + (size_t)j * 256 + c4)); }
#pragma unroll
    for (int i = 0; i < 4; ++i) {
        const int idx = tid + 512 * i, j = idx >> 4, c4 = (idx & 15) * 4;
        if (j >= 4) { __builtin_nontemporal_store(kf[i], (f32x4*)(owk + (size_t)(j - 4) * 256 + c4)); __builtin_nontemporal_store(vf[i], (f32x4*)(owv + (size_t)(j - 4) * 256 + c4)); }
        u32x2 w; w.x = cvt_pk_bf16(kf[i].x, kf[i].y); w.y = cvt_pk_bf16(kf[i].z, kf[i].w);
        *(u32x2*)(Ks + j * 72 + c4) = w;
        VT[(c4 + 0) * 152 + j] = f2bf(vf[i].x); VT[(c4 + 1) * 152 + j] = f2bf(vf[i].y); VT[(c4 + 2) * 152 + j] = f2bf(vf[i].z); VT[(c4 + 3) * 152 + j] = f2bf(vf[i].w);
    }
    if (tid < 64) {
        const int t = tid >> 4, d4 = (tid & 15) * 4;
        const u32x2 kr = *(const u32x2*)(KVQ + (rbase + t) * NKVQ + kvh * 64 + d4);
        const u32x2 vr = *(const u32x2*)(KVQ + (rbase + t) * NKVQ + 256 + kvh * 64 + d4);
        float f0 = bflo(kr.x), f1 = bfhi(kr.x), f2 = bflo(kr.y), f3 = bfhi(kr.y);
        float s = (f0 * f0 + f1 * f1) + (f2 * f2 + f3 * f3);
        s += __shfl_xor(s, 1); s += __shfl_xor(s, 2); s += __shfl_xor(s, 4); s += __shfl_xor(s, 8);
        const float rs = rsqrtf(s * (1.f / 64.f) + EPS);
        const f32x4 g = *(const f32x4*)(p.k_norm_g + d4);
        f0 *= rs * g.x; f1 *= rs * g.y; f2 *= rs * g.z; f3 *= rs * g.w;
        *(f32x4*)(owk + (size_t)(124 + t) * 256 + d4) = (f32x4){f0, f1, f2, f3};
        *(f32x4*)(owv + (size_t)(124 + t) * 256 + d4) = (f32x4){bflo(vr.x), bfhi(vr.x), bflo(vr.y), bfhi(vr.y)};
        u32x2 w; w.x = cvt_pk_bf16(f0, f1); w.y = cvt_pk_bf16(f2, f3);
        *(u32x2*)(Ks + (128 + t) * 72 + d4) = w;
        VT[(d4 + 0) * 152 + 128 + t] = (bf16_t)(vr.x & 0xffff); VT[(d4 + 1) * 152 + 128 + t] = (bf16_t)(vr.x >> 16);
        VT[(d4 + 2) * 152 + 128 + t] = (bf16_t)(vr.y & 0xffff); VT[(d4 + 3) * 152 + 128 + t] = (bf16_t)(vr.y >> 16);
    } else if (tid < 64 + 192) {
        const int i = tid - 64;
        if (i < 96) { const int r = 132 + (i >> 3), c8 = (i & 7) * 8; *(u32x4*)(Ks + r * 72 + c8) = (u32x4){0u, 0u, 0u, 0u}; }
        else { const int d = i - 96; if (d < 64) { bf16_t* z = VT + d * 152 + 132; for (int e = 0; e < 12; ++e) z[e] = 0; } }
    }
    __syncthreads();
    if (wid < 4) {
        const int dt = wid;
        const int g = fr >> 2, t = fr & 3, head = kvh * 4 + g;
        const bf16_t* qp = KVQ + (rbase + t) * NKVQ + 512 + head * 64;
        const u32x4 r0 = *(const u32x4*)(qp + 8 * fq), r1 = *(const u32x4*)(qp + 32 + 8 * fq);
        bf16x8 q0, q1; norm_frag(r0, r1, p.q_norm_g, 0.125f, fq, q0, q1);
        const float sink = p.att_sinks[head];
        f32x4 s[9];
#pragma unroll
        for (int i = 0; i < 9; ++i) {
            s[i] = (f32x4){0.f, 0.f, 0.f, 0.f};
            const bf16_t* kr = Ks + (16 * i + fr) * 72 + 8 * fq;
            s[i] = MFMA32(*(const bf16x8*)kr, q0, s[i]);
            s[i] = MFMA32(*(const bf16x8*)(kr + 32), q1, s[i]);
        }
        float mx = sink;
#pragma unroll
        for (int i = 0; i < 9; ++i)
#pragma unroll
            for (int e = 0; e < 4; ++e) {
                const int j = 16 * i + 4 * fq + e;
                const bool ok = (j >= t) && (j <= t + 128);
                s[i][e] = ok ? s[i][e] : -INFINITY;
                mx = fmaxf(mx, s[i][e]);
            }
        mx = fmaxf(mx, __shfl_xor(mx, 16)); mx = fmaxf(mx, __shfl_xor(mx, 32));
        float l = 0.f;
        f32x4 o = (f32x4){0.f, 0.f, 0.f, 0.f};
#pragma unroll
        for (int i = 0; i < 9; ++i) {
            const float e0 = __expf(s[i][0] - mx), e1 = __expf(s[i][1] - mx), e2 = __expf(s[i][2] - mx), e3 = __expf(s[i][3] - mx);
            l += (e0 + e1) + (e2 + e3);
            u32x2 w; w.x = cvt_pk_bf16(e0, e1); w.y = cvt_pk_bf16(e2, e3);
            const bf16x4 vfr = *(const bf16x4*)(VT + (16 * dt + fr) * 152 + 16 * i + 4 * fq);
            o = MFMA16(vfr, __builtin_bit_cast(bf16x4, w), o);
        }
        l += __shfl_xor(l, 16); l += __shfl_xor(l, 32);
        l += __expf(sink - mx);
        const float inv = 1.f / l;
        u32x2 w; w.x = cvt_pk_bf16(o.x * inv, o.y * inv); w.y = cvt_pk_bf16(o.z * inv, o.w * inv);
        *(u32x2*)(AO + (rbase + t) * D + head * 64 + 16 * dt + 4 * fq) = w;
    }
    __syncthreads();
}

#define LAS __attribute__((address_space(3)))
#define XB_TMO      128
#define XB_XCNT(j)  (256  + 64 * (j))
#define XB_XSUB(j)  (1280 + 64 * (j))
#define XB_XGEN(j)  (2304 + 64 * (j))
#define XB_TOP      3328
#define XB_TOPGEN   3392
#define XCD_BAR_WORDS 3456
#define XB_SPIN_CAP (1u << 18)

__device__ __forceinline__ unsigned xb_ld(unsigned* p)              { return __hip_atomic_load(p, __ATOMIC_RELAXED, __HIP_MEMORY_SCOPE_AGENT); }
__device__ __forceinline__ unsigned xb_add(unsigned* p, unsigned v) { return __hip_atomic_fetch_add(p, v, __ATOMIC_RELAXED, __HIP_MEMORY_SCOPE_AGENT); }
__device__ __forceinline__ unsigned xb_xcc_id() { return (unsigned)__builtin_amdgcn_s_getreg((3 << 11) | 20) & 0xFu; }
#define XB_SPIN(cond, bar) do { unsigned _sp = 0; while (cond) { __builtin_amdgcn_s_sleep(1); \
    if ((++_sp & 255u) == 0u) { if (xb_ld(&(bar)[XB_TMO])) break; if (_sp > XB_SPIN_CAP) { atomicAdd(&(bar)[XB_TMO], 1u); break; } } } } while (0)

struct XcdBarrier {
    unsigned* bar; unsigned x;
    volatile LAS unsigned* st;
};

__device__ __forceinline__ XcdBarrier xcd_barrier_post(unsigned* bar, volatile LAS unsigned* st) {
    XcdBarrier b; b.bar = bar; b.x = xb_xcc_id(); b.st = st;
    if (threadIdx.x == 0) (void)xb_add(&bar[XB_XCNT(b.x)], 1u);
    return b;
}
__device__ __forceinline__ void xcd_barrier_complete(unsigned* bar, unsigned x, unsigned& nloc, unsigned& nx) {
    const unsigned G = gridDim.x * gridDim.y * gridDim.z;
    unsigned sum, cnt, mine, sp = 0u;
    for (;;) {
        sum = 0u; cnt = 0u; mine = 0u;
#pragma unroll
        for (unsigned j = 0; j < 16; ++j) { const unsigned c = xb_ld(&bar[XB_XCNT(j)]); sum += c; cnt += (c > 0u) ? 1u : 0u; mine = (j == x) ? c : mine; }
        if (sum == G) break;
        __builtin_amdgcn_s_sleep(1);
        if ((++sp & 255u) == 0u) { if (xb_ld(&bar[XB_TMO])) break; if (sp > XB_SPIN_CAP) { atomicAdd(&bar[XB_TMO], 1u); break; } }
    }
    nloc = mine > 0u ? mine : 1u; nx = cnt > 0u ? cnt : 1u;
}

__device__ __forceinline__ void xcd_barrier(const XcdBarrier& b) {
    asm volatile("s_waitcnt vmcnt(0)" ::: "memory");
    __syncthreads();
    if (threadIdx.x == 0) {
        unsigned* bar = b.bar;
        __builtin_amdgcn_s_waitcnt(0);
        unsigned nloc = b.st[0], nx = b.st[1];
        if (nloc == 0u) { xcd_barrier_complete(bar, b.x, nloc, nx); b.st[0] = nloc; b.st[1] = nx; }
        const unsigned old = xb_add(&bar[XB_XSUB(b.x)], 1u);
        const unsigned gen = old / nloc;
        if (old + 1u == (gen + 1u) * nloc) {
            __builtin_amdgcn_fence(__ATOMIC_RELEASE, "agent");
            asm volatile("s_waitcnt vmcnt(0)" ::: "memory");
            const unsigned og = xb_add(&bar[XB_TOP], 1u);
            const unsigned tg = og / nx;
            if (og + 1u == (tg + 1u) * nx) xb_add(&bar[XB_TOPGEN], 1u);
            else XB_SPIN(xb_ld(&bar[XB_TOPGEN]) == tg, bar);
            __builtin_amdgcn_fence(__ATOMIC_ACQUIRE, "agent");
            xb_add(&bar[XB_XGEN(b.x)], 1u);
            asm volatile("s_waitcnt vmcnt(0)" ::: "memory");
        } else {
            XB_SPIN(xb_ld(&bar[XB_XGEN(b.x)]) == gen, bar);
            __builtin_amdgcn_fence(__ATOMIC_ACQUIRE, "agent");
            asm volatile("s_waitcnt vmcnt(0)" ::: "memory");
        }
    }
    __syncthreads();
}

__global__ void __launch_bounds__(NTHREADS) yoco_fwd(Params p) {
    extern __shared__ __attribute__((aligned(16))) unsigned char lds[];
    const int bid = blockIdx.x, G = gridDim.x;
    unsigned char* ws = p.ws;
    float* SS = (float*)(ws + WS_SS);
    float* Y = p.out + O_Y;
    bf16_t* XB = (bf16_t*)(ws + WS_XB);

#define IN(k) (p.ph_lo <= (k) && (k) < p.ph_hi)
    volatile LAS unsigned* bst = (volatile LAS unsigned*)((LAS unsigned char*)lds + 131072 + 64);
    XcdBarrier xbar; xbar.bar = (unsigned*)(ws + WS_BAR); xbar.x = 0; xbar.st = bst;
    int cv = bid;
    if (p.ph_hi - p.ph_lo > 1) {
        if (threadIdx.x < 8) bst[threadIdx.x] = 0u;
        __syncthreads();
        xbar.x = xb_xcc_id();
        if (threadIdx.x == 0) bst[2] = xb_add(&xbar.bar[XB_XCNT(xbar.x)], 1u);
    }
#define SEAM(k) do { if (IN(k) && IN((k) + 1)) xcd_barrier(xbar); } while (0)
    if (IN(0)) { for (int rep = 0; rep < REP_P0; ++rep) p0_prologue(p, lds, bid, G); }
    SEAM(0);
    if (p.ph_hi - p.ph_lo > 1 && IN(0) && IN(1)) {
        if (threadIdx.x == 0) {
            bool ok = (G % 8 == 0) && xbar.x < 8u;
            for (unsigned j = 0; j < 8; ++j) ok = ok && (xb_ld(&xbar.bar[XB_XCNT(j)]) == (unsigned)(G / 8));
            const unsigned rank = bst[2];
            bst[3] = (ok && rank < (unsigned)(G / 8)) ? (xbar.x + 8u * rank) : (unsigned)bid;
        }
        __syncthreads();
        cv = __builtin_amdgcn_readfirstlane((int)bst[3]);
    }
    PG8_LAS unsigned char* l3 = (PG8_LAS unsigned char*)lds;
    float* YS = Y;
#define PGEMM(Aptr, Bptr, Nn, Kk, EpiT, ...) do { pg8::Gemm g_{(const bf16_t*)(Aptr), (const bf16_t*)(Bptr), TP, (Nn), (Kk), ((Kk) == FF) ? 1 : 0}; pg8::StaticOrder S_; S_.init(TP, (Nn), G, cv); \
        Pg8Epi<EpiT> E_{EpiT{__VA_ARGS__}}; pg8::gemm_phase<Pg8Epi<EpiT>, pg8::StaticOrder, true, true>(l3, g_, S_, E_); } while (0)
    if (IN(1)) {
        for (int rep = 0; rep < REP_PG; ++rep) { PGEMM(XB, ws + WS_WIN, NIN, 1024, EpiBf16, (bf16_t*)(ws + WS_P), NIN, nullptr, 0); }
        { EpiBf16 E{(bf16_t*)(ws + WS_P), NIN, nullptr, 0}; for (int rep = 0; rep < REP_SG; ++rep) sgemm64<0>(lds, XB, 1024, (const bf16_t*)(ws + WS_WIN), TP, TS, NIN, 1024, 1, E, bid, G); }
    }
    SEAM(1);
    if (IN(2)) {
        for (int rep = 0; rep < REP_2AL; ++rep) for (int u = bid; u < 1024; u += G) mlstm_local_unit(p, lds, u);
        for (int rep = 0; rep < REP_2AS; ++rep) for (int u = bid; u < 512; u += G) mlstm_sample_unit(p, lds, u);
    }
    SEAM(2);
    if (IN(3)) mlstm_scan(p, lds, bid, G);
    SEAM(3);
    if (IN(4)) { for (int rep = 0; rep < REP_2C; ++rep) for (int u = bid; u < 1024; u += G) mlstm_out_unit(p, lds, u); }
    SEAM(4);
    if (IN(5)) {
        PGEMM(ws + WS_HG, ws + WS_WOUT, 1024, 1024, EpiResB, p.x_prompt, XB, nullptr, SS);
        { EpiAddF32 E{YS}; sgemm64<0>(lds, ws + WS_HG, 1024, (const bf16_t*)(ws + WS_WOUT), TP, TS, 1024, 1024, 1, E, bid, G); }
    }
    SEAM(5);
    if (IN(6)) {
        for (int rep = 0; rep < REP_PG; ++rep) { PGEMM(XB, ws + WS_W1A, FF, 1024, EpiBf16, (bf16_t*)(ws + WS_HID), FF, SS, 1); }
        { EpiBf16 E{(bf16_t*)(ws + WS_HID), FF, nullptr, 1}; for (int rep = 0; rep < REP_SG; ++rep) sgemm64<1>(lds, Y, 1024, (const bf16_t*)(ws + WS_W1A), TP, TS, FF, 1024, 1, E, bid, G); }
    }
    SEAM(6);
    if (IN(7)) {
        PGEMM(ws + WS_HID, ws + WS_W2A, 1024, FF, EpiResB, nullptr, XB, nullptr, SS + T);
        { EpiAtomic E{YS}; sgemm64<0>(lds, ws + WS_HID, FF, (const bf16_t*)(ws + WS_W2A), TP, TS, 1024, FF, 2, E, bid, G); }
    }
    SEAM(7);
    if (IN(8)) {
        for (int rep = 0; rep < REP_PG; ++rep) { PGEMM(XB, ws + WS_WKVQ, NKVQ, 1024, EpiBf16, (bf16_t*)(ws + WS_KVQ), NKVQ, SS + T, 0); }
        { EpiBf16 E{(bf16_t*)(ws + WS_KVQ), NKVQ, nullptr, 0}; for (int rep = 0; rep < REP_SG; ++rep) sgemm64<1>(lds, Y, 1024, (const bf16_t*)(ws + WS_WKVQ), TP, TS, NKVQ, 1024, 1, E, (cv + G / 2) % G, G); }
        __syncthreads();
        if (cv >= G / 2) late_weights(p, lds, cv - G / 2, G - G / 2);
    }
    SEAM(8);
    if (IN(9)) {
        { const int vb = (G % 8 == 0) ? (cv % 8) * (G / 8) + cv / 8 : cv;
          for (int rep = 0; rep < REP_7P; ++rep) for (int u = vb; u < 512; u += G) attn_prompt_unit(p, lds, u); }
        for (int rep = 0; rep < REP_7S; ++rep) for (int u = bid; u < 512; u += G) attn_sample_block(p, lds, u);
    }
    SEAM(9);
    if (IN(10)) {
        PGEMM(ws + WS_ATT, ws + WS_WO, 1024, 1024, EpiResB, nullptr, XB, nullptr, SS + 2 * T);
        { EpiAddF32 E{YS}; sgemm64<0>(lds, ws + WS_ATT, 1024, (const bf16_t*)(ws + WS_WO), TP, TS, 1024, 1024, 1, E, bid, G); }
    }
    SEAM(10);
    if (IN(11)) {
        for (int rep = 0; rep < REP_PG; ++rep) { PGEMM(XB, ws + WS_W1B, FF, 1024, EpiBf16, (bf16_t*)(ws + WS_HID), FF, SS + 2 * T, 1); }
        { EpiBf16 E{(bf16_t*)(ws + WS_HID), FF, nullptr, 1}; for (int rep = 0; rep < REP_SG; ++rep) sgemm64<1>(lds, Y, 1024, (const bf16_t*)(ws + WS_W1B), TP, TS, FF, 1024, 1, E, bid, G); }
    }
    SEAM(11);
    if (IN(12)) {
        PGEMM(ws + WS_HID, ws + WS_W2B, 1024, FF, EpiResB, nullptr, XB, Y, nullptr);
        { EpiAtomic E{YS}; sgemm64<0>(lds, ws + WS_HID, FF, (const bf16_t*)(ws + WS_W2B), TP, TS, 1024, FF, 2, E, bid, G); }
    }
#undef PGEMM
#undef IN
#undef SEAM
}

extern "C" void kernel_launch(void* const* d_in, const int* in_sizes, int n_in, void* d_out, int out_size, void* d_ws, size_t ws_size, hipStream_t stream) {
    static int grid_blocks = 0;
    if (!grid_blocks) {
        if (n_in != 24 || (size_t)out_size != O_END || ws_size < WS_END) { fprintf(stderr, "kernel_launch: unexpected shapes n_in=%d out=%d ws=%zu\n", n_in, out_size, ws_size); grid_blocks = -1; return; }
        int dev = 0, cus = 0, per_cu = 0;
        hipGetDevice(&dev);
        hipDeviceGetAttribute(&cus, hipDeviceAttributeMultiprocessorCount, dev);
        hipFuncSetAttribute((const void*)yoco_fwd, hipFuncAttributeMaxDynamicSharedMemorySize, LDS_BYTES);
        hipOccupancyMaxActiveBlocksPerMultiprocessor(&per_cu, (const void*)yoco_fwd, NTHREADS, LDS_BYTES);
        if (per_cu < 1) per_cu = 1;
        grid_blocks = cus * per_cu;
        (void)hipGetLastError();
    }
    if (grid_blocks < 0) return;
    Params p{};
    const float** pp = (const float**)&p;
    for (int i = 0; i < 24; ++i) pp[i] = (const float*)d_in[i];
    p.out = (float*)d_out; p.ws = (unsigned char*)d_ws;
#if N_LAUNCH_MODE == 1
    p.ph_lo = 0; p.ph_hi = 13;
    (void)hipMemsetAsync((char*)d_ws + WS_BAR, 0, BAR_BYTES, stream);
    void* args[] = {&p};
    hipError_t e = hipLaunchCooperativeKernel((const void*)yoco_fwd, dim3(grid_blocks), dim3(NTHREADS), args, LDS_BYTES, stream);
    if (e != hipSuccess) fprintf(stderr, "cooperative launch failed: %s (grid %d)\n", hipGetErrorString(e), grid_blocks);
#else
    for (int k = 0; k < MAX_PHASE; ++k) { p.ph_lo = k; p.ph_hi = k + 1; hipLaunchKernelGGL(yoco_fwd, dim3(grid_blocks), dim3(NTHREADS), LDS_BYTES, stream, p); }
#endif
}
```

```cpp
#include <hip/hip_runtime.h>
#include <hip/hip_cooperative_groups.h>
#include <cstdio>
#include <cstdint>
namespace cg = cooperative_groups;

typedef unsigned short bf16_t;
typedef short bf16x8 __attribute__((ext_vector_type(8)));
typedef short bf16x4 __attribute__((ext_vector_type(4)));
typedef float f32x4 __attribute__((ext_vector_type(4)));
typedef unsigned u32x4 __attribute__((ext_vector_type(4)));
typedef unsigned u32x2 __attribute__((ext_vector_type(2)));

constexpr int D = 1024, TP = 16384, TS = 512, T = TP + TS;
constexpr int NIN = 3072, LDW_IN = 3080, FF = 4096, NKVQ = 1536;
constexpr float EPS = 1e-6f;
constexpr int NTHREADS = 512;
constexpr int LDS_BYTES = 147456;
#ifndef REP_P0
#define REP_P0 1
#endif
#ifndef REP_2AL
#define REP_2AL 1
#endif
#ifndef REP_2AS
#define REP_2AS 1
#endif
#ifndef REP_2C
#define REP_2C 1
#endif
#ifndef REP_7P
#define REP_7P 1
#endif
#ifndef REP_7S
#define REP_7S 1
#endif
#ifndef REP_PG
#define REP_PG 1
#endif
#ifndef REP_SG
#define REP_SG 1
#endif
#ifndef MAX_PHASE
#define MAX_PHASE 13
#endif
#ifndef N_LAUNCH_MODE
#define N_LAUNCH_MODE 1
#endif

constexpr size_t MiB = 1u << 20;
constexpr size_t WS_SS = 0;
constexpr size_t WS_CHB = 256 * 1024, WS_CHM = WS_CHB + 4096, WS_MPREV = WS_CHM + 4096;
constexpr size_t WS_GATES = 1 * MiB;
constexpr size_t WS_GN = 2 * MiB;
constexpr size_t WS_BAR = 3 * MiB, BAR_BYTES = 16384;
constexpr size_t WS_WIN = 4 * MiB, WS_WOUT = 10 * MiB, WS_W1A = 12 * MiB, WS_W2A = 20 * MiB, WS_WKVQ = 28 * MiB, WS_WO = 31 * MiB, WS_W1B = 33 * MiB, WS_W2B = 41 * MiB;
constexpr size_t WS_XB = 49 * MiB;
constexpr size_t WS_P = 82 * MiB;
constexpr size_t WS_HG = 181 * MiB;
constexpr size_t WS_HID = 82 * MiB;
constexpr size_t WS_KVQ = 82 * MiB;
constexpr size_t WS_ATT = 132 * MiB;
constexpr size_t WS_END = 214 * MiB;

constexpr size_t O_Y = 0, O_PC = 17301504, O_PN = 17825792, O_PM = 17827840, O_PWK = 17827856, O_PWV = 17958928,
                 O_SC = 18090000, O_SN = 34867216, O_SM = 34932752, O_SWK = 34933264, O_SWV = 39127568, O_END = 43321872;

struct Params {
    const float *x_prompt, *x_sample, *st_C, *st_n, *st_m, *cache_k, *cache_v;
    const float *ml_norm_g, *ml_w_in, *ml_b_i, *ml_b_f, *ml_head_g, *ml_w_out;
    const float *kv_norm_g, *w_kv, *k_norm_g;
    const float *att_norm_g, *att_w_q, *q_norm_g, *att_sinks, *att_w_o;
    const float *mlp_norm_g, *mlp_w1, *mlp_w2;
    float* out; unsigned char* ws;
    int ph_lo, ph_hi;
};

typedef float f32x2 __attribute__((ext_vector_type(2)));
typedef __bf16 bf16x2n __attribute__((ext_vector_type(2)));
__device__ __forceinline__ unsigned cvt_pk_bf16(float lo, float hi) { const f32x2 v = {lo, hi}; const bf16x2n b = __builtin_convertvector(v, bf16x2n); return __builtin_bit_cast(unsigned, b); }
__device__ __forceinline__ bf16_t f2bf(float f) { return (bf16_t)(cvt_pk_bf16(f, 0.f) & 0xffffu); }
__device__ __forceinline__ float bf2f(bf16_t h) { return __uint_as_float(((unsigned)h) << 16); }
__device__ __forceinline__ float bflo(unsigned u) { return __uint_as_float(u << 16); }
__device__ __forceinline__ float bfhi(unsigned u) { return __uint_as_float(u & 0xffff0000u); }
__device__ __forceinline__ float wave_sum(float v) {
#pragma unroll
    for (int o = 1; o < 64; o <<= 1) v += __shfl_xor(v, o);
    return v;
}
__device__ __forceinline__ float wave_max(float v) {
#pragma unroll
    for (int o = 1; o < 64; o <<= 1) v = fmaxf(v, __shfl_xor(v, o));
    return v;
}
__device__ __forceinline__ float scan_sum(float x, int lane) {
#pragma unroll
    for (int o = 1; o < 64; o <<= 1) { float y = __shfl_up(x, o); if (lane >= o) x += y; }
    return x;
}
__device__ __forceinline__ float scan_max(float x, int lane) {
#pragma unroll
    for (int o = 1; o < 64; o <<= 1) { float y = __shfl_up(x, o); if (lane >= o) x = fmaxf(x, y); }
    return x;
}
__device__ __forceinline__ float softcap15(float x) { return 15.f * tanhf(x * (1.f / 15.f)); }
__device__ __forceinline__ float logsigmoid(float z) { return fminf(z, 0.f) - log1pf(__expf(-fabsf(z))); }
__device__ __forceinline__ float sigmoidf_(float z) { return 1.f / (1.f + __expf(-z)); }
#define LDS_WAIT() asm volatile("s_waitcnt lgkmcnt(0)" ::: "memory")
#define MFMA32(x, y, acc) __builtin_amdgcn_mfma_f32_16x16x32_bf16((x), (y), (acc), 0, 0, 0)
#define MFMA16(x, y, acc) __builtin_amdgcn_mfma_f32_16x16x16bf16_1k((x), (y), (acc), 0, 0, 0)

__device__ __forceinline__ void transpose_item(const float* __restrict__ W, int ldw, int K, const float* __restrict__ gk, float cs,
                                               bf16_t* WT, int row_off, int k0, int n0, float* scr, int lane) {
    {
        const int kr = lane >> 3, n4 = (lane & 7) * 4;
        f32x4 wv[8];
#pragma unroll
        for (int i = 0; i < 8; ++i) wv[i] = __builtin_nontemporal_load((const f32x4*)(W + (size_t)(k0 + kr + 8 * i) * ldw + n0 + n4));
#pragma unroll
        for (int i = 0; i < 8; ++i) {
            const int kk = kr + 8 * i;
            const float g = gk ? gk[k0 + kk] * cs : cs;
            float* d = scr + kk * 33 + n4;
            d[0] = wv[i].x * g; d[1] = wv[i].y * g; d[2] = wv[i].z * g; d[3] = wv[i].w * g;
        }
    }
    LDS_WAIT();
    const int c = lane & 7;
#pragma unroll
    for (int j = 0; j < 4; ++j) {
        const int n = (lane >> 3) + 8 * j; const float* s = scr + (8 * c) * 33 + n;
        u32x4 o; o.x = cvt_pk_bf16(s[0 * 33], s[1 * 33]); o.y = cvt_pk_bf16(s[2 * 33], s[3 * 33]); o.z = cvt_pk_bf16(s[4 * 33], s[5 * 33]); o.w = cvt_pk_bf16(s[6 * 33], s[7 * 33]);
        *(u32x4*)(WT + (size_t)(row_off + n0 + n) * K + k0 + 8 * c) = o;
    }
    LDS_WAIT();
}

__device__ __forceinline__ void p0_prologue(const Params& p, unsigned char* lds, int bid, int G) {
    const int tid = threadIdx.x, lane = tid & 63, wid = tid >> 6;
    unsigned char* ws = p.ws;
    float* scr = (float*)(lds + wid * 8448);
    float* wif = (float*)(lds + 73728);
    for (int k = tid; k < 1024; k += NTHREADS) {
        const float g = p.ml_norm_g[k];
        const f32x4 a = *(const f32x4*)(p.ml_w_in + (size_t)k * LDW_IN + 3072), b = *(const f32x4*)(p.ml_w_in + (size_t)k * LDW_IN + 3076);
        wif[0 * 1024 + k] = a.x * g; wif[1 * 1024 + k] = a.y * g; wif[2 * 1024 + k] = a.z * g; wif[3 * 1024 + k] = a.w * g;
        wif[4 * 1024 + k] = b.x * g; wif[5 * 1024 + k] = b.y * g; wif[6 * 1024 + k] = b.z * g; wif[7 * 1024 + k] = b.w * g;
    }
    { float* ss = (float*)(ws + WS_SS); for (int i = bid * NTHREADS + tid; i < 3 * T; i += G * NTHREADS) ss[i] = 0.f; }
    __syncthreads();
    const int gw = bid * 8 + wid, NGW = G * 8;
    constexpr int I_IN = 16 * 96, I_SQ = 16 * 32, I_1 = 16 * 128, I_2 = 64 * 32, I_KV = 16 * 16;
    constexpr int NITEMS = I_IN + I_SQ + I_1 + I_2 + I_KV + I_SQ;
    for (int it = gw; it < NITEMS; it += NGW) {
        int r = it;
        if (r < I_IN) { const int kb = r / 96, nb = r % 96, n0 = nb * 32; const float cs = (n0 >= 512 && n0 < 1024) ? 0.08838834764831845f : 1.f;
            transpose_item(p.ml_w_in, LDW_IN, 1024, p.ml_norm_g, cs, (bf16_t*)(ws + WS_WIN), 0, kb * 64, n0, scr, lane); continue; } r -= I_IN;
        if (r < I_SQ) { transpose_item(p.ml_w_out, 1024, 1024, nullptr, 1.f, (bf16_t*)(ws + WS_WOUT), 0, (r / 32) * 64, (r % 32) * 32, scr, lane); continue; } r -= I_SQ;
        if (r < I_1) { transpose_item(p.mlp_w1, 4096, 1024, p.mlp_norm_g, 1.f, (bf16_t*)(ws + WS_W1A), 0, (r / 128) * 64, (r % 128) * 32, scr, lane); continue; } r -= I_1;
        if (r < I_2) { transpose_item(p.mlp_w2, 1024, 4096, nullptr, 1.f, (bf16_t*)(ws + WS_W2A), 0, (r / 32) * 64, (r % 32) * 32, scr, lane); continue; } r -= I_2;
        if (r < I_KV) { transpose_item(p.w_kv, 512, 1024, p.kv_norm_g, 1.f, (bf16_t*)(ws + WS_WKVQ), 0, (r / 16) * 64, (r % 16) * 32, scr, lane); continue; } r -= I_KV;
        transpose_item(p.att_w_q, 1024, 1024, p.att_norm_g, 1.f, (bf16_t*)(ws + WS_WKVQ), 512, (r / 32) * 64, (r % 32) * 32, scr, lane);
    }
    bf16_t* XB = (bf16_t*)(ws + WS_XB); float* gates = (float*)(ws + WS_GATES);
    for (int m = gw; m < T; m += NGW) {
        const float* xrow = m < TP ? p.x_prompt + (size_t)m * D : p.x_sample + (size_t)(m - TP) * D;
        f32x4 v[4]; float s = 0.f;
#pragma unroll
        for (int j = 0; j < 4; ++j) { v[j] = __builtin_nontemporal_load((const f32x4*)(xrow + 4 * lane + 256 * j)); s += (v[j].x * v[j].x + v[j].y * v[j].y) + (v[j].z * v[j].z + v[j].w * v[j].w); }
        const float rstd = rsqrtf(wave_sum(s) * (1.f / D) + EPS);
        if (m >= TP) {
#pragma unroll
            for (int j = 0; j < 4; ++j) *(f32x4*)(p.out + O_Y + (size_t)m * D + 4 * lane + 256 * j) = v[j];
        }
#pragma unroll
        for (int j = 0; j < 4; ++j) { u32x2 w; w.x = cvt_pk_bf16(v[j].x * rstd, v[j].y * rstd); w.y = cvt_pk_bf16(v[j].z * rstd, v[j].w * rstd); *(u32x2*)(XB + (size_t)m * D + 4 * lane + 256 * j) = w; }
        float mine = 0.f;
#pragma unroll
        for (int g = 0; g < 8; ++g) {
            float a = 0.f;
#pragma unroll
            for (int j = 0; j < 4; ++j) { const f32x4 w = *(const f32x4*)(wif + g * 1024 + 4 * lane + 256 * j); a += (v[j].x * w.x + v[j].y * w.y) + (v[j].z * w.z + v[j].w * w.w); }
            a = wave_sum(a) * rstd;
            if (lane == g) mine = a;
        }
        if (lane < 4) gates[(size_t)m * 8 + lane] = softcap15(mine + p.ml_b_i[lane]);
        else if (lane < 8) gates[(size_t)m * 8 + lane] = logsigmoid(softcap15(mine + p.ml_b_f[lane - 4]));
    }
}

__device__ __forceinline__ void late_weights(const Params& p, unsigned char* lds, int slot, int nslots) {
    const int tid = threadIdx.x, lane = tid & 63, wid = tid >> 6;
    unsigned char* ws = p.ws;
    float* scr = (float*)(lds + wid * 8448);
    constexpr int I_SQ = 16 * 32, I_1 = 16 * 128, I_2 = 64 * 32, NIT = I_SQ + I_1 + I_2;
    for (int it = slot * 8 + wid; it < NIT; it += nslots * 8) {
        int r = it;
        if (r < I_SQ) { transpose_item(p.att_w_o, 1024, 1024, nullptr, 1.f, (bf16_t*)(ws + WS_WO), 0, (r / 32) * 64, (r % 32) * 32, scr, lane); continue; } r -= I_SQ;
        if (r < I_1) { transpose_item(p.mlp_w1 + (size_t)1024 * 4096, 4096, 1024, p.mlp_norm_g + 1024, 1.f, (bf16_t*)(ws + WS_W1B), 0, (r / 128) * 64, (r % 128) * 32, scr, lane); continue; } r -= I_1;
        transpose_item(p.mlp_w2 + (size_t)4096 * 1024, 1024, 4096, nullptr, 1.f, (bf16_t*)(ws + WS_W2B), 0, (r / 32) * 64, (r % 32) * 32, scr, lane);
    }
}

struct EpiBf16 {
    bf16_t* out; int ld; const float* ss; int act;
    template <int NQ, bool PAIRED> __device__ __forceinline__ void row(int r, const int (&c)[NQ], const f32x4 (&v)[NQ], int fq, float rscale) const {
        float sc = rscale; if (ss) sc = rsqrtf(ss[r] * (1.f / 1024.f) + EPS);
        u32x2 w[NQ];
#pragma unroll
        for (int q = 0; q < NQ; ++q) {
            f32x4 x = v[q] * sc;
            if (act) { x.x = fmaxf(x.x, 0.f); x.y = fmaxf(x.y, 0.f); x.z = fmaxf(x.z, 0.f); x.w = fmaxf(x.w, 0.f); x = x * x; }
            w[q].x = cvt_pk_bf16(x.x, x.y); w[q].y = cvt_pk_bf16(x.z, x.w);
        }
        if (PAIRED) {
#pragma unroll
            for (int q = 0; q < NQ; q += 2) { u32x4 o; o.x = w[q].x; o.y = w[q].y; o.z = w[q + 1].x; o.w = w[q + 1].y; *(u32x4*)(out + (size_t)r * ld + c[q]) = o; }
        } else {
#pragma unroll
            for (int q = 0; q < NQ; ++q) *(u32x2*)(out + (size_t)r * ld + c[q]) = w[q];
        }
    }
};
struct EpiRes {
    const float* srcp; const float* srcs; float* dst; bf16_t* xb; float* ss;
    template <int NQ, bool PAIRED> __device__ __forceinline__ void row(int r, const int (&c)[NQ], const f32x4 (&v)[NQ], int fq, float rscale) const {
        const float* s = r < TP ? srcp + (size_t)r * D : srcs + (size_t)(r - TP) * D;
        float a2 = 0.f;
        u32x2 w[NQ];
#pragma unroll
        for (int q = 0; q < NQ; ++q) {
            const f32x4 o = *(const f32x4*)(s + c[q]) + v[q];
            *(f32x4*)(dst + (size_t)r * D + c[q]) = o;
            w[q].x = cvt_pk_bf16(o.x, o.y); w[q].y = cvt_pk_bf16(o.z, o.w);
            a2 += (o.x * o.x + o.y * o.y) + (o.z * o.z + o.w * o.w);
        }
        if (xb) {
            if (PAIRED) {
#pragma unroll
                for (int q = 0; q < NQ; q += 2) { u32x4 o; o.x = w[q].x; o.y = w[q].y; o.z = w[q + 1].x; o.w = w[q + 1].y; *(u32x4*)(xb + (size_t)r * D + c[q]) = o; }
            } else {
#pragma unroll
                for (int q = 0; q < NQ; ++q) *(u32x2*)(xb + (size_t)r * D + c[q]) = w[q];
            }
        }
        if (ss) { a2 += __shfl_xor(a2, 16); a2 += __shfl_xor(a2, 32); if (fq == 0) atomicAdd(ss + r, a2); }
    }
};

namespace pg8 {
#define PG8_LAS __attribute__((address_space(3)))
typedef unsigned short bf16_t;
typedef short bf16x8 __attribute__((ext_vector_type(8)));
typedef float f32x4 __attribute__((ext_vector_type(4)));
typedef unsigned u32x4 __attribute__((ext_vector_type(4)));
constexpr int BM = 256, BK = 64, HALF = 128, HTB = HALF * BK * 2  , STAGE_BYTES = 8 * HTB, NXCD = 8, WGM = 8;

__host__ __device__ __forceinline__ int lds_byte(int r, int c) { const int st = (r >> 4) * 2 + (c >> 5), rr = r & 15, cc = c & 31, ob = rr * 64 + cc * 2; return st * 1024 + (ob ^ (((ob >> 9) & 1) << 5)); }
__host__ __device__ __forceinline__ void stage_rc(int b, int& R, int& C) { const int st = b / 1024, sb = b % 1024, swz = sb ^ (((sb >> 9) & 1) << 5); R = (st >> 1) * 16 + swz / 64; C = (st & 1) * 32 + (swz % 64) / 2; }
__host__ __device__ __forceinline__ int perm32(int rho) { const int n = rho >> 4, i = rho & 15; return 8 * (i >> 2) + 4 * n + (i & 3); }

struct Unit { int pm, pn; };
struct Gemm { const bf16_t* A; const bf16_t* Bt; int M, N, K; int revk; };

struct StaticOrder {
    int nM, nN, nwg, G, c;
    __host__ __device__ void init(int M, int N, int G_, int c_) { nM = M / BM; nN = N / BM; nwg = nM * nN; G = G_; c = c_; }
    __host__ __device__ bool next(int i, Unit& u) const {
        const long L = (long)i * G + c; if (L >= nwg) return false;
        int wgid = (int)L; { const int q = nwg / NXCD, r = nwg % NXCD, xcd = wgid % NXCD, off = wgid / NXCD; wgid = (xcd < r ? xcd * (q + 1) : r * (q + 1) + (xcd - r) * q) + off; }
        const int nig = WGM * nN, gid = wgid / nig, fm = gid * WGM, gsz = (nM - fm) < WGM ? (nM - fm) : WGM;
        u.pm = fm + ((wgid % nig) % gsz); u.pn = (wgid % nig) / gsz; return true;
    }
    __device__ __forceinline__ void a_ready(const Unit&) const {}
    __device__ __forceinline__ void done(const Unit&) const {}
};


template <class Epi, class Sched, bool ALIGN_EPI = false, bool SP2 = false>
__device__ __forceinline__ void gemm_phase(PG8_LAS unsigned char* lds, const Gemm g, const Sched& S, const Epi& E) {
    const int tid = threadIdx.x, wid = __builtin_amdgcn_readfirstlane(tid >> 6), lane = tid & 63, wr = wid >> 2, wc = wid & 3, fr = lane & 15, fq = lane >> 4;
    const int K = g.K, nt = K / BK;
    unsigned voffA[2], voffB[2];
#pragma unroll
    for (int i = 0; i < 2; ++i) { int R, C; stage_rc(tid * 16 + i * 8192, R, C); const int Rb = Epi::PERM ? ((R & ~31) + perm32(R & 31)) : R;
        voffA[i] = (unsigned)(R * K + C) * 2u; voffB[i] = (unsigned)(Rb * K + C) * 2u; }
    const size_t kstep = g.revk ? (size_t)0 - (size_t)(BK * 2) : (size_t)(BK * 2);
    const size_t koff = g.revk ? (size_t)(K - BK) * 2 : (size_t)0;
    const size_t hstep = (size_t)HALF * K * 2;
    const size_t tstep = 2 * hstep;
    const unsigned ldsw = (unsigned)wid * 1024u;
    const int aoff = lds_byte(wr * 64 + fr, fq * 8), boff = lds_byte(wc * 32 + fr, fq * 8);
#define PG8_SA(b, h) (((b) * 2 + (h)) * HTB)
#define PG8_SB(b, h) ((4 + (b) * 2 + (h)) * HTB)
#define PG8_STAGE(bufoff, gbase, voff) do { _Pragma("unroll") for (int _i = 0; _i < 2; ++_i) \
        __builtin_amdgcn_global_load_lds((const unsigned*)((const char*)(gbase) + (voff)[_i]), (PG8_LAS unsigned*)(lds + (bufoff) + ldsw + _i * 8192), 16, 0, 0); } while (0)
#define PG8_LDA(dst, b, h) do { _Pragma("unroll") for (int m = 0; m < 4; ++m) _Pragma("unroll") for (int k = 0; k < 2; ++k) dst[m][k] = *(const PG8_LAS bf16x8*)(lds + PG8_SA(b, h) + aoff + m * 2048 + k * 1024); } while (0)
#define PG8_LDB(dst, b, h) do { _Pragma("unroll") for (int n = 0; n < 2; ++n) _Pragma("unroll") for (int k = 0; k < 2; ++k) dst[n][k] = *(const PG8_LAS bf16x8*)(lds + PG8_SB(b, h) + boff + n * 2048 + k * 1024); } while (0)
#define PG8_MMA(ai, bj, At, Bt) do { __builtin_amdgcn_s_setprio(1); _Pragma("unroll") for (int m = 0; m < 4; ++m) _Pragma("unroll") for (int n = 0; n < 2; ++n) _Pragma("unroll") for (int k = 0; k < 2; ++k) \
        acc[ai][bj][m][n] = __builtin_amdgcn_mfma_f32_16x16x32_bf16(Bt[n][k], At[m][k], acc[ai][bj][m][n], 0, 0, 0); __builtin_amdgcn_s_setprio(0); } while (0)
#define PG8_WAIT_V(n) asm volatile("s_waitcnt vmcnt(" #n ")" ::: "memory")
#define PG8_WAIT_L(n) asm volatile("s_waitcnt lgkmcnt(" #n ")" ::: "memory")
#define PG8_BAR __builtin_amdgcn_s_barrier()
#define PG8_SCHED __builtin_amdgcn_sched_barrier(0)
    Unit cur, nxt; int ui = 0;
    if (!S.next(0, cur)) return;
    f32x4 acc[2][2][4][2];
#pragma unroll
    for (int a = 0; a < 2; ++a)
#pragma unroll
        for (int b = 0; b < 2; ++b)
#pragma unroll
            for (int m = 0; m < 4; ++m)
#pragma unroll
                for (int n = 0; n < 2; ++n) acc[a][b][m][n] = (f32x4){0.f, 0.f, 0.f, 0.f};
    bf16x8 At[4][2], B0[2][2], B1[2][2];
    const char* cA = (const char*)g.A + (size_t)cur.pm * tstep + koff; const char* cB = (const char*)g.Bt + (size_t)cur.pn * tstep + koff;
    S.a_ready(cur);
    if constexpr (SP2) {
        PG8_STAGE(PG8_SB(0, 0), cB, voffB); PG8_STAGE(PG8_SB(0, 1), cB + hstep, voffB); PG8_STAGE(PG8_SA(0, 0), cA, voffA); PG8_STAGE(PG8_SA(0, 1), cA + hstep, voffA);
        if (wr == 1) PG8_BAR;
        PG8_WAIT_V(2); PG8_BAR;
        PG8_STAGE(PG8_SB(1, 0), cB + kstep, voffB); PG8_STAGE(PG8_SA(1, 0), cA + kstep, voffA); PG8_STAGE(PG8_SB(1, 1), cB + hstep + kstep, voffB);
        PG8_WAIT_V(6); PG8_BAR;
    } else {
        PG8_STAGE(PG8_SB(0, 0), cB, voffB); PG8_STAGE(PG8_SA(0, 0), cA, voffA); PG8_STAGE(PG8_SB(0, 1), cB + hstep, voffB); PG8_STAGE(PG8_SA(0, 1), cA + hstep, voffA);
        if (wr == 1) PG8_BAR;
        PG8_WAIT_V(4); PG8_BAR;
        PG8_STAGE(PG8_SB(1, 0), cB + kstep, voffB); PG8_STAGE(PG8_SA(1, 0), cA + kstep, voffA); PG8_STAGE(PG8_SB(1, 1), cB + hstep + kstep, voffB);
        PG8_WAIT_V(6); PG8_BAR;
    }
    for (;;) {
        const bool has_next = S.next(ui + 1, nxt);
        const char* nA = has_next ? (const char*)g.A + (size_t)nxt.pm * tstep + koff : cA; const char* nB = has_next ? (const char*)g.Bt + (size_t)nxt.pn * tstep + koff : cB;
        for (int t = 0; t < nt; t += 2) {
            const bool last = (t == nt - 2);
            const char* a1 = cA + (size_t)(t + 1) * kstep;
            const char* a2 = last ? nA : cA + (size_t)(t + 2) * kstep; const char* b2 = last ? nB : cB + (size_t)(t + 2) * kstep;
            const char* a3 = a2 + kstep; const char* b3 = b2 + kstep;
            if (last && has_next) S.a_ready(nxt);
            if constexpr (SP2) {
            PG8_LDB(B0, 0, 0); PG8_LDB(B1, 0, 1); PG8_SCHED; PG8_LDA(At, 0, 0); PG8_STAGE(PG8_SA(1, 1), a1 + hstep, voffA);
            PG8_WAIT_V(8); PG8_WAIT_L(0); PG8_BAR; PG8_MMA(0, 0, At, B0); PG8_MMA(0, 1, At, B1); PG8_BAR; PG8_SCHED;
            PG8_LDA(At, 0, 1); PG8_STAGE(PG8_SB(0, 0), b2, voffB); PG8_STAGE(PG8_SB(0, 1), b2 + hstep, voffB); PG8_STAGE(PG8_SA(0, 0), a2, voffA);
            PG8_WAIT_V(8); PG8_WAIT_L(0); PG8_BAR; PG8_MMA(1, 0, At, B0); PG8_MMA(1, 1, At, B1); PG8_BAR; PG8_SCHED;
            PG8_LDB(B0, 1, 0); PG8_LDB(B1, 1, 1); PG8_SCHED; PG8_LDA(At, 1, 0); PG8_STAGE(PG8_SA(0, 1), a2 + hstep, voffA);
            PG8_WAIT_V(8); PG8_WAIT_L(0); PG8_BAR; PG8_MMA(0, 0, At, B0); PG8_MMA(0, 1, At, B1); PG8_BAR; PG8_SCHED;
            PG8_LDA(At, 1, 1); PG8_STAGE(PG8_SB(1, 0), b3, voffB); PG8_STAGE(PG8_SB(1, 1), b3 + hstep, voffB); PG8_STAGE(PG8_SA(1, 0), a3, voffA);
            PG8_WAIT_V(8); PG8_WAIT_L(0); PG8_BAR; PG8_MMA(1, 0, At, B0); PG8_MMA(1, 1, At, B1); PG8_BAR; PG8_SCHED;
            } else {
            PG8_LDB(B0, 0, 0); PG8_SCHED; PG8_LDA(At, 0, 0); PG8_STAGE(PG8_SA(1, 1), a1 + hstep, voffA);
            PG8_WAIT_L(8); PG8_BAR; PG8_WAIT_L(0); PG8_MMA(0, 0, At, B0); PG8_BAR; PG8_SCHED;
            PG8_LDB(B1, 0, 1); PG8_STAGE(PG8_SB(0, 0), b2, voffB);
            PG8_BAR; PG8_WAIT_L(0); PG8_MMA(0, 1, At, B1); PG8_BAR;
            PG8_LDA(At, 0, 1); PG8_STAGE(PG8_SA(0, 0), a2, voffA);
            PG8_BAR; PG8_WAIT_L(0); PG8_MMA(1, 0, At, B0); PG8_BAR; PG8_SCHED;
            PG8_STAGE(PG8_SB(0, 1), b2 + hstep, voffB);
            PG8_WAIT_V(6); PG8_BAR; PG8_MMA(1, 1, At, B1); PG8_BAR;
            PG8_LDB(B0, 1, 0); PG8_SCHED; PG8_LDA(At, 1, 0); PG8_STAGE(PG8_SA(0, 1), a2 + hstep, voffA);
            PG8_WAIT_L(8); PG8_BAR; PG8_WAIT_L(0); PG8_MMA(0, 0, At, B0); PG8_BAR; PG8_SCHED;
            PG8_LDB(B1, 1, 1); PG8_STAGE(PG8_SB(1, 0), b3, voffB);
            PG8_BAR; PG8_WAIT_L(0); PG8_MMA(0, 1, At, B1); PG8_BAR;
            PG8_LDA(At, 1, 1); PG8_STAGE(PG8_SA(1, 0), a3, voffA);
            PG8_BAR; PG8_WAIT_L(0); PG8_MMA(1, 0, At, B0); PG8_BAR; PG8_SCHED;
            PG8_STAGE(PG8_SB(1, 1), b3 + hstep, voffB);
            PG8_WAIT_V(6); PG8_BAR; PG8_MMA(1, 1, At, B1); PG8_BAR;
            }
        }
        if constexpr (ALIGN_EPI) { if (wr == 0) PG8_BAR; }
        if constexpr (!Epi::AFTER_DRAIN) { E(acc, cur, wr, wc, fr, fq); S.done(cur); }
        if (!has_next) break;
#pragma unroll
        for (int a = 0; a < 2; ++a)
#pragma unroll
            for (int b = 0; b < 2; ++b)
#pragma unroll
                for (int m = 0; m < 4; ++m)
#pragma unroll
                    for (int n = 0; n < 2; ++n) acc[a][b][m][n] = (f32x4){0.f, 0.f, 0.f, 0.f};
        cur = nxt; cA = nA; cB = nB; ++ui;
        if constexpr (ALIGN_EPI) { if (wr == 1) PG8_BAR; }
    }
    PG8_WAIT_V(0);
    if constexpr (!ALIGN_EPI) { if (wr == 0) PG8_BAR; }
    PG8_BAR;
    if constexpr (Epi::AFTER_DRAIN) { E.fused(acc, cur, wr, wc, fr, fq, lds, wid, lane); S.done(cur); }
#undef PG8_SA
#undef PG8_SB
#undef PG8_STAGE
#undef PG8_LDA
#undef PG8_LDB
#undef PG8_MMA
#undef PG8_WAIT_V
#undef PG8_WAIT_L
#undef PG8_BAR
#undef PG8_SCHED
}
}


template <class Inner> struct Pg8Epi {
    static constexpr bool PERM = true, AFTER_DRAIN = false;
    Inner in;
    __device__ __forceinline__ void operator()(const f32x4 (&acc)[2][2][4][2], const pg8::Unit& u, int wr, int wc, int fr, int fq) const {
#pragma unroll
        for (int ai = 0; ai < 2; ++ai)
#pragma unroll
            for (int m = 0; m < 4; ++m) {
                const int r = u.pm * 256 + ai * 128 + wr * 64 + m * 16 + fr;
                const int c0 = u.pn * 256 + wc * 32 + 8 * fq;
                const int cols[4] = {c0, c0 + 4, c0 + 128, c0 + 132};
                const f32x4 vv[4] = {acc[ai][0][m][0], acc[ai][0][m][1], acc[ai][1][m][0], acc[ai][1][m][1]};
                in.template row<4, true>(r, cols, vv, fq, 1.f);
            }
    }
};
struct EpiResB {
    const float* srcf; bf16_t* xb; float* dstf; float* ss;
    template <int NQ, bool PAIRED> __device__ __forceinline__ void row(int r, const int (&c)[NQ], const f32x4 (&v)[NQ], int fq, float rscale) const {
        static_assert(PAIRED && NQ % 2 == 0, "EpiResB: paired quads only");
        float a2 = 0.f;
#pragma unroll
        for (int q = 0; q < NQ; q += 2) {
            f32x4 s0, s1;
            if (srcf) { s0 = __builtin_nontemporal_load((const f32x4*)(srcf + (size_t)r * D + c[q])); s1 = __builtin_nontemporal_load((const f32x4*)(srcf + (size_t)r * D + c[q] + 4)); }
            else { const u32x4 xr = *(const u32x4*)(xb + (size_t)r * D + c[q]); s0 = (f32x4){bflo(xr.x), bfhi(xr.x), bflo(xr.y), bfhi(xr.y)}; s1 = (f32x4){bflo(xr.z), bfhi(xr.z), bflo(xr.w), bfhi(xr.w)}; }
            const f32x4 o0 = s0 + v[q], o1 = s1 + v[q + 1];
            if (dstf) { __builtin_nontemporal_store(o0, (f32x4*)(dstf + (size_t)r * D + c[q])); __builtin_nontemporal_store(o1, (f32x4*)(dstf + (size_t)r * D + c[q] + 4)); }
            else {
                u32x4 w; w.x = cvt_pk_bf16(o0.x, o0.y); w.y = cvt_pk_bf16(o0.z, o0.w); w.z = cvt_pk_bf16(o1.x, o1.y); w.w = cvt_pk_bf16(o1.z, o1.w);
                *(u32x4*)(xb + (size_t)r * D + c[q]) = w;
                a2 += (o0.x * o0.x + o0.y * o0.y) + (o0.z * o0.z + o0.w * o0.w) + (o1.x * o1.x + o1.y * o1.y) + (o1.z * o1.z + o1.w * o1.w);
            }
        }
        if (ss) { a2 += __shfl_xor(a2, 16); a2 += __shfl_xor(a2, 32); if (fq == 0) atomicAdd(ss + r, a2); }
    }
};
struct EpiAddF32 {
    float* dst;
    template <int NQ, bool PAIRED> __device__ __forceinline__ void row(int r, const int (&c)[NQ], const f32x4 (&v)[NQ], int fq, float rscale) const {
#pragma unroll
        for (int q = 0; q < NQ; ++q) { f32x4* d = (f32x4*)(dst + (size_t)r * D + c[q]); *d = *d + v[q]; }
    }
};
struct EpiAtomic {
    float* dst;
    template <int NQ, bool PAIRED> __device__ __forceinline__ void row(int r, const int (&c)[NQ], const f32x4 (&v)[NQ], int fq, float rscale) const {
#pragma unroll
        for (int q = 0; q < NQ; ++q) { float* d = dst + (size_t)r * D + c[q]; atomicAdd(d, v[q].x); atomicAdd(d + 1, v[q].y); atomicAdd(d + 2, v[q].z); atomicAdd(d + 3, v[q].w); }
    }
};

template <int AF32, class Epi>
__device__ __forceinline__ void sgemm64(unsigned char* lds, const void* Av, int lda, const bf16_t* __restrict__ Bt, int row0, int nrows, int N, int K, int ksplit,
                                        const Epi& E, int bid, int G) {
    const int tid = threadIdx.x, lane = tid & 63, wid = tid >> 6, wr = wid >> 2, wc = wid & 3, fr = lane & 15, fq = lane >> 4;
    const int nN = N / 128, nT = (nrows / 64) * nN, nU = nT * ksplit, Ksl = K / ksplit, nk = Ksl / 128;
    constexpr int LS = 136;
    bf16_t* As = (bf16_t*)lds;
    bf16_t* Bs = As + 2 * 64 * LS;
    float* rs = (float*)(Bs + 2 * 128 * LS);
    const int arow = tid >> 3, ak = (tid & 7) * 8;
    for (int u = bid; u < nU; u += G) {
        const int ks = u / nT, t = u % nT, pm = t / nN, pn = t % nN, k0 = ks * Ksl;
        const bf16_t* Ab = (const bf16_t*)Av + (size_t)(row0 + pm * 64 + arow) * lda + k0 + ak;
        const float* Af = (const float*)Av + (size_t)(row0 + pm * 64 + arow) * lda + k0 + ak;
        const bf16_t* Bg = Bt + (size_t)(pn * 128 + arow) * K + k0 + ak;
        f32x4 acc[2][2];
#pragma unroll
        for (int m = 0; m < 2; ++m)
#pragma unroll
            for (int n = 0; n < 2; ++n) acc[m][n] = (f32x4){0.f, 0.f, 0.f, 0.f};
        float ssq = 0.f;
        u32x4 ra[2], rb[2][2];
        auto loadAB = [&](int kt) {
#pragma unroll
            for (int h = 0; h < 2; ++h) {
                if (AF32) { const f32x4 a = *(const f32x4*)(Af + kt * 128 + 64 * h), b = *(const f32x4*)(Af + kt * 128 + 64 * h + 4);
                    ssq += (a.x * a.x + a.y * a.y) + (a.z * a.z + a.w * a.w) + (b.x * b.x + b.y * b.y) + (b.z * b.z + b.w * b.w);
                    ra[h].x = cvt_pk_bf16(a.x, a.y); ra[h].y = cvt_pk_bf16(a.z, a.w); ra[h].z = cvt_pk_bf16(b.x, b.y); ra[h].w = cvt_pk_bf16(b.z, b.w); }
                else ra[h] = *(const u32x4*)(Ab + kt * 128 + 64 * h);
#pragma unroll
                for (int i = 0; i < 2; ++i) rb[i][h] = *(const u32x4*)(Bg + (size_t)(64 * i) * K + kt * 128 + 64 * h);
            }
        };
        auto storeAB = [&](int buf) {
#pragma unroll
            for (int h = 0; h < 2; ++h) {
                *(u32x4*)(As + buf * 64 * LS + arow * LS + ak + 64 * h) = ra[h];
#pragma unroll
                for (int i = 0; i < 2; ++i) *(u32x4*)(Bs + buf * 128 * LS + (arow + 64 * i) * LS + ak + 64 * h) = rb[i][h];
            }
        };
        loadAB(0);
        storeAB(0);
        __syncthreads();
        for (int kt = 0; kt < nk; ++kt) {
            const int buf = kt & 1;
            if (kt + 1 < nk) loadAB(kt + 1);
            const bf16_t* as = As + buf * 64 * LS; const bf16_t* bs = Bs + buf * 128 * LS;
#pragma unroll
            for (int kk = 0; kk < 4; ++kk) {
                bf16x8 af[2], bfr[2];
#pragma unroll
                for (int m = 0; m < 2; ++m) af[m] = *(const bf16x8*)(as + (32 * wr + 16 * m + fr) * LS + 32 * kk + 8 * fq);
#pragma unroll
                for (int n = 0; n < 2; ++n) bfr[n] = *(const bf16x8*)(bs + (32 * wc + 16 * n + fr) * LS + 32 * kk + 8 * fq);
#pragma unroll
                for (int m = 0; m < 2; ++m)
#pragma unroll
                    for (int n = 0; n < 2; ++n) acc[m][n] = MFMA32(bfr[n], af[m], acc[m][n]);
            }
            if (kt + 1 < nk) storeAB(buf ^ 1);
            __syncthreads();
        }
        if (AF32) {
            ssq += __shfl_xor(ssq, 1); ssq += __shfl_xor(ssq, 2); ssq += __shfl_xor(ssq, 4);
            if ((tid & 7) == 0) rs[arow] = rsqrtf(ssq * (1.f / 1024.f) + EPS);
            __syncthreads();
        }
#pragma unroll
        for (int m = 0; m < 2; ++m) {
            const int lr = 32 * wr + 16 * m + fr, r = row0 + pm * 64 + lr;
            const int cols[2] = {pn * 128 + 32 * wc + 4 * fq, pn * 128 + 32 * wc + 16 + 4 * fq};
            const f32x4 vv[2] = {acc[m][0], acc[m][1]};
            E.template row<2, false>(r, cols, vv, fq, AF32 ? rs[lr] : 1.f);
        }
    }
}

template <class Epi>
__device__ __forceinline__ void sgemm_phase(unsigned char* lds, const bf16_t* __restrict__ A, const bf16_t* __restrict__ Bt, int row0, int nrows, int N, int K,
                                            const Epi& E, int bid, int G) {
    const int tid = threadIdx.x, lane = tid & 63, wid = tid >> 6, wr = wid >> 2, wc = wid & 3, fr = lane & 15, fq = lane >> 4;
    const int nN = N / 128, nU = (nrows / 128) * nN, nk = K / 64;
    bf16_t* As = (bf16_t*)lds;
    bf16_t* Bs = As + 2 * 128 * 72;
    const int ldrow = tid >> 3, ldk = (tid & 7) * 8;
    for (int u = bid; u < nU; u += G) {
        const int pm = u / nN, pn = u % nN;
        const bf16_t* Ag = A + (size_t)(row0 + pm * 128 + ldrow) * K + ldk;
        const bf16_t* Bg = Bt + (size_t)(pn * 128 + ldrow) * K + ldk;
        f32x4 acc[4][2];
#pragma unroll
        for (int m = 0; m < 4; ++m)
#pragma unroll
            for (int n = 0; n < 2; ++n) acc[m][n] = (f32x4){0.f, 0.f, 0.f, 0.f};
        u32x4 ra[2], rb[2];
#pragma unroll
        for (int i = 0; i < 2; ++i) { ra[i] = *(const u32x4*)(Ag + (size_t)(64 * i) * K); rb[i] = *(const u32x4*)(Bg + (size_t)(64 * i) * K); }
#pragma unroll
        for (int i = 0; i < 2; ++i) { *(u32x4*)(As + (ldrow + 64 * i) * 72 + ldk) = ra[i]; *(u32x4*)(Bs + (ldrow + 64 * i) * 72 + ldk) = rb[i]; }
        __syncthreads();
        for (int kt = 0; kt < nk; ++kt) {
            const int buf = kt & 1;
            if (kt + 1 < nk) {
#pragma unroll
                for (int i = 0; i < 2; ++i) { ra[i] = *(const u32x4*)(Ag + (size_t)(64 * i) * K + (kt + 1) * 64); rb[i] = *(const u32x4*)(Bg + (size_t)(64 * i) * K + (kt + 1) * 64); }
            }
            const bf16_t* as = As + buf * 128 * 72; const bf16_t* bs = Bs + buf * 128 * 72;
#pragma unroll
            for (int kk = 0; kk < 2; ++kk) {
                bf16x8 af[4], bfr[2];
#pragma unroll
                for (int m = 0; m < 4; ++m) af[m] = *(const bf16x8*)(as + (64 * wr + 16 * m + fr) * 72 + 32 * kk + 8 * fq);
#pragma unroll
                for (int n = 0; n < 2; ++n) bfr[n] = *(const bf16x8*)(bs + (32 * wc + 16 * n + fr) * 72 + 32 * kk + 8 * fq);
#pragma unroll
                for (int m = 0; m < 4; ++m)
#pragma unroll
                    for (int n = 0; n < 2; ++n) acc[m][n] = MFMA32(bfr[n], af[m], acc[m][n]);
            }
            if (kt + 1 < nk) {
                bf16_t* an = As + (buf ^ 1) * 128 * 72; bf16_t* bn = Bs + (buf ^ 1) * 128 * 72;
#pragma unroll
                for (int i = 0; i < 2; ++i) { *(u32x4*)(an + (ldrow + 64 * i) * 72 + ldk) = ra[i]; *(u32x4*)(bn + (ldrow + 64 * i) * 72 + ldk) = rb[i]; }
            }
            __syncthreads();
        }
#pragma unroll
        for (int m = 0; m < 4; ++m) {
            const int r = row0 + pm * 128 + 64 * wr + 16 * m + fr;
            const int cols[2] = {pn * 128 + 32 * wc + 4 * fq, pn * 128 + 32 * wc + 16 + 4 * fq};
            const f32x4 vv[2] = {acc[m][0], acc[m][1]};
            E.template row<2, false>(r, cols, vv, fq, 1.f);
        }
    }
}

__device__ __forceinline__ void mlstm_local_unit(const Params& p, unsigned char* lds, int u) {
    const int tid = threadIdx.x, lane = tid & 63, wid = tid >> 6, fr = lane & 15, fq = lane >> 4;
    const int bh = u >> 6, c = u & 63, b = bh >> 2, h = bh & 3, base = b * 4096 + c * 64;
    unsigned char* ws = p.ws;
    const bf16_t* P = (const bf16_t*)(ws + WS_P); const float* gates = (const float*)(ws + WS_GATES);
    bf16_t* GS = (bf16_t*)p.out;
    bf16_t* kT = (bf16_t*)lds;
    bf16_t* vT = kT + 128 * 72;
    float* wk = (float*)(vT + 256 * 72);
    if (wid == 0) {
        const float lf = gates[(size_t)(base + lane) * 8 + 4 + h], li = gates[(size_t)(base + lane) * 8 + h];
        const float bc = scan_sum(lf, lane);
        const float B = __shfl(bc, 63);
        const float val = B - bc + li;
        const float ml = wave_max(val);
        wk[lane] = __expf(val - ml);
        if (lane == 0) { ((float*)(ws + WS_CHB))[u] = B; ((float*)(ws + WS_CHM))[u] = ml; }
    }
    __syncthreads();
    {
        const bf16_t* Pk = P + (size_t)(base + lane) * NIN + 512 + h * 128;
#pragma unroll
        for (int i = 0; i < 2; ++i) {
            const int dch = wid * 2 + i; const u32x4 r = *(const u32x4*)(Pk + dch * 8);
            bf16_t* dst = kT + (dch * 8) * 72 + lane;
            dst[0 * 72] = (bf16_t)(r.x & 0xffff); dst[1 * 72] = (bf16_t)(r.x >> 16); dst[2 * 72] = (bf16_t)(r.y & 0xffff); dst[3 * 72] = (bf16_t)(r.y >> 16);
            dst[4 * 72] = (bf16_t)(r.z & 0xffff); dst[5 * 72] = (bf16_t)(r.z >> 16); dst[6 * 72] = (bf16_t)(r.w & 0xffff); dst[7 * 72] = (bf16_t)(r.w >> 16);
        }
        const bf16_t* Pv = P + (size_t)(base + lane) * NIN + 1024 + h * 256;
        const float w = wk[lane];
#pragma unroll
        for (int i = 0; i < 4; ++i) {
            const int vch = wid * 4 + i; const u32x4 r = *(const u32x4*)(Pv + vch * 8);
            bf16_t* dst = vT + (vch * 8) * 72 + lane;
            dst[0 * 72] = f2bf(bflo(r.x) * w); dst[1 * 72] = f2bf(bfhi(r.x) * w); dst[2 * 72] = f2bf(bflo(r.y) * w); dst[3 * 72] = f2bf(bfhi(r.y) * w);
            dst[4 * 72] = f2bf(bflo(r.z) * w); dst[5 * 72] = f2bf(bfhi(r.z) * w); dst[6 * 72] = f2bf(bflo(r.w) * w); dst[7 * 72] = f2bf(bfhi(r.w) * w);
        }
    }
    __syncthreads();
    {
        f32x4 acc[2][8];
#pragma unroll
        for (int a = 0; a < 2; ++a)
#pragma unroll
            for (int d = 0; d < 8; ++d) acc[a][d] = (f32x4){0.f, 0.f, 0.f, 0.f};
#pragma unroll
        for (int ks = 0; ks < 2; ++ks) {
            bf16x8 yf[2];
#pragma unroll
            for (int vt = 0; vt < 2; ++vt) yf[vt] = *(const bf16x8*)(vT + (32 * wid + 16 * vt + fr) * 72 + 32 * ks + 8 * fq);
#pragma unroll
            for (int dt = 0; dt < 8; ++dt) {
                const bf16x8 xf = *(const bf16x8*)(kT + (16 * dt + fr) * 72 + 32 * ks + 8 * fq);
#pragma unroll
                for (int vt = 0; vt < 2; ++vt) acc[vt][dt] = MFMA32(xf, yf[vt], acc[vt][dt]);
            }
        }
        bf16_t* G = GS + (size_t)u * 32768;
#pragma unroll
        for (int vt = 0; vt < 2; ++vt)
#pragma unroll
            for (int dt = 0; dt < 8; ++dt) {
                u32x2 w; w.x = cvt_pk_bf16(acc[vt][dt].x, acc[vt][dt].y); w.y = cvt_pk_bf16(acc[vt][dt].z, acc[vt][dt].w);
                *(u32x2*)(G + (32 * wid + 16 * vt + fr) * 128 + 16 * dt + 4 * fq) = w;
            }
    }
    if (tid < 128) {
        float s = 0.f;
#pragma unroll 8
        for (int ss = 0; ss < 64; ++ss) s += bf2f(kT[tid * 72 + ss]) * wk[ss];
        ((float*)(ws + WS_GN))[(size_t)u * 128 + tid] = s;
    }
    __syncthreads();
}

__device__ __forceinline__ void mlstm_sample_unit(const Params& p, unsigned char* lds, int u) {
    const int tid = threadIdx.x, lane = tid & 63, wid = tid >> 6;
    const int b = u >> 2, h = u & 3, base = TP + b * 4;
    unsigned char* ws = p.ws;
    const bf16_t* P = (const bf16_t*)(ws + WS_P); const float* gates = (const float*)(ws + WS_GATES);
    float* q = (float*)lds;
    float* k = q + 512;
    float* v = k + 512;
    float* n0 = v + 1024;
    float* sc = n0 + 128;
    float* red = sc + 64;
    const float* C0 = p.st_C + (size_t)u * 32768;
    float* Cout = p.out + O_SC + (size_t)u * 32768;
    {
        const int t = tid >> 7, d = tid & 127;
        q[tid] = bf2f(P[(size_t)(base + t) * NIN + h * 128 + d]);
        k[tid] = bf2f(P[(size_t)(base + t) * NIN + 512 + h * 128 + d]);
        const int t2 = tid >> 8, vv = tid & 255;
        v[tid] = bf2f(P[(size_t)(base + t2) * NIN + 1024 + h * 256 + vv]);
        v[512 + tid] = bf2f(P[(size_t)(base + 2 + t2) * NIN + 1024 + h * 256 + vv]);
        if (tid < 128) n0[tid] = p.st_n[(size_t)u * 128 + tid];
    }
    if (tid == 0) {
        float li[4], bc[4]; float run = 0.f;
#pragma unroll
        for (int t = 0; t < 4; ++t) { li[t] = gates[(size_t)(base + t) * 8 + h]; run += gates[(size_t)(base + t) * 8 + 4 + h]; bc[t] = run; }
        const float m0 = p.st_m[u]; float mt[4];
#pragma unroll
        for (int t = 0; t < 4; ++t) {
            const float inter = bc[t] + m0; float mx = inter;
#pragma unroll
            for (int s = 0; s < 4; ++s) if (s <= t) mx = fmaxf(mx, bc[t] - bc[s] + li[s]);
            mt[t] = mx; sc[16 + t] = __expf(inter - mx); sc[28 + t] = __expf(-mx);
#pragma unroll
            for (int s = 0; s < 4; ++s) sc[t * 4 + s] = (s <= t) ? __expf(bc[t] - bc[s] + li[s] - mx) : 0.f;
        }
        const float mn = mt[3];
        sc[24] = __expf(bc[3] + m0 - mn);
#pragma unroll
        for (int s = 0; s < 4; ++s) sc[20 + s] = __expf(bc[3] - bc[s] + li[s] - mn);
        p.out[O_SM + u] = mn;
    }
    __syncthreads();
#pragma unroll
    for (int i = 0; i < 2; ++i) {
        const int pr = wid * 2 + i, t = pr >> 2, s = pr & 3;
        float a = q[t * 128 + lane] * k[s * 128 + lane] + q[t * 128 + 64 + lane] * k[s * 128 + 64 + lane];
        a = wave_sum(a);
        if (lane == 0) sc[32 + pr] = a * sc[pr];
    }
    if (wid < 4) { float a = q[wid * 128 + lane] * n0[lane] + q[wid * 128 + 64 + lane] * n0[64 + lane]; a = wave_sum(a); if (lane == 0) sc[48 + wid] = a; }
    if (tid < 8) sc[52 + tid] = 0.f;
    {
        const int vq = lane, dg = wid;
        f32x4 qc[4];
#pragma unroll
        for (int t = 0; t < 4; ++t) qc[t] = (f32x4){0.f, 0.f, 0.f, 0.f};
        const float decay = sc[24];
        f32x4 vs[4];
#pragma unroll
        for (int s = 0; s < 4; ++s) vs[s] = *(const f32x4*)(v + s * 256 + 4 * vq) * sc[20 + s];
#pragma unroll 4
        for (int dd = 0; dd < 16; ++dd) {
            const int d = dg * 16 + dd;
            const f32x4 c0 = __builtin_nontemporal_load((const f32x4*)(C0 + (size_t)d * 256 + 4 * vq));
            f32x4 cn = c0 * decay;
#pragma unroll
            for (int s = 0; s < 4; ++s) cn += vs[s] * k[s * 128 + d];
            __builtin_nontemporal_store(cn, (f32x4*)(Cout + (size_t)d * 256 + 4 * vq));
#pragma unroll
            for (int t = 0; t < 4; ++t) qc[t] += c0 * q[t * 128 + d];
        }
#pragma unroll
        for (int t = 0; t < 4; ++t) *(f32x4*)(red + (dg * 4 + t) * 256 + 4 * vq) = qc[t];
    }
    if (tid < 128) {
        float nn = sc[24] * n0[tid];
#pragma unroll
        for (int s = 0; s < 4; ++s) nn += sc[20 + s] * k[s * 128 + tid];
        p.out[O_SN + (size_t)u * 128 + tid] = nn;
    }
    __syncthreads();
    {
        const int t = tid >> 7, v0 = (tid & 127) * 2;
        float den = sc[16 + t] * sc[48 + t];
#pragma unroll
        for (int s = 0; s < 4; ++s) den += sc[32 + t * 4 + s];
        const float inv = 1.f / fmaxf(fabsf(den), sc[28 + t]);
        float hv[2]; float ssq = 0.f;
#pragma unroll
        for (int j = 0; j < 2; ++j) {
            float qC = 0.f;
#pragma unroll
            for (int g = 0; g < 8; ++g) qC += red[(g * 4 + t) * 256 + v0 + j];
            float num = sc[16 + t] * qC;
#pragma unroll
            for (int s = 0; s < 4; ++s) num += sc[32 + t * 4 + s] * v[s * 256 + v0 + j];
            hv[j] = num * inv; ssq += hv[j] * hv[j];
        }
        ssq = wave_sum(ssq);
        if (lane == 0) sc[52 + wid] = ssq;
        __syncthreads();
        const float tot = sc[52 + 2 * t] + sc[52 + 2 * t + 1];
        const float rstd = rsqrtf(tot * (1.f / 256.f) + EPS);
        const unsigned ob = *(const unsigned*)(P + (size_t)(base + t) * NIN + 2048 + h * 256 + v0);
        const float o0 = sigmoidf_(bflo(ob)), o1 = sigmoidf_(bfhi(ob));
        const float g0 = p.ml_head_g[h * 256 + v0], g1 = p.ml_head_g[h * 256 + v0 + 1];
        bf16_t* HG = (bf16_t*)(ws + WS_HG);
        *(unsigned*)(HG + (size_t)(base + t) * D + h * 256 + v0) = cvt_pk_bf16(hv[0] * rstd * g0 * o0, hv[1] * rstd * g1 * o1);
    }
    __syncthreads();
}

__device__ __forceinline__ void mlstm_scan(const Params& p, unsigned char* lds, int bid, int G) {
    unsigned char* ws = p.ws;
    bf16_t* GS = (bf16_t*)p.out;
    const float* CHB = (const float*)(ws + WS_CHB); const float* CHM = (const float*)(ws + WS_CHM);
    float* MPREV = (float*)(ws + WS_MPREV); float* GN = (float*)(ws + WS_GN);
    const int tid = threadIdx.x;
    float* decs = (float*)lds;
    float* scls = decs + 64;
    float* tile = scls + 64;
    for (int blk = bid; blk < 256; blk += G) {
        const int bh = blk >> 4;
        if (tid < 64) {
            const float B = CHB[bh * 64 + tid], ml = CHM[bh * 64 + tid];
            float a = B, b2 = ml;
#pragma unroll
            for (int o = 1; o < 64; o <<= 1) { const float ya = __shfl_up(a, o), yb = __shfl_up(b2, o); if (tid >= o) { b2 = fmaxf(yb + a, b2); a = ya + a; } }
            const float m = fmaxf(a, b2);
            float mp = __shfl_up(m, 1); if (tid == 0) mp = 0.f;
            decs[tid] = __expf(B + mp - m); scls[tid] = __expf(ml - m);
            if ((blk & 15) == 0) { MPREV[bh * 64 + tid] = mp; if (tid == 63) p.out[O_PM + bh] = m; }
        }
        float gnv[64]; float* gp = GN + (size_t)(bh * 64) * 128 + (blk & 15) * 8 + (tid & 7);
        if (tid < 8) {
#pragma unroll
            for (int c = 0; c < 64; ++c) gnv[c] = gp[(size_t)c * 128];
        }
        __syncthreads();
        const int e4 = blk * NTHREADS + tid;
        const int off = (e4 & 8191) * 4;
        bf16_t* ptr = GS + (size_t)bh * 64 * 32768 + off;
        float c0 = 0.f, c1 = 0.f, c2 = 0.f, c3 = 0.f;
#pragma unroll 1
        for (int cb = 0; cb < 64; cb += 16) {
            u32x2 g[16];
#pragma unroll
            for (int j = 0; j < 16; ++j) g[j] = __builtin_nontemporal_load((const u32x2*)(ptr + (size_t)(cb + j) * 32768));
#pragma unroll
            for (int j = 0; j < 16; ++j) {
                const float dec = decs[cb + j], s = scls[cb + j];
                u32x2 w; w.x = cvt_pk_bf16(c0, c1); w.y = cvt_pk_bf16(c2, c3);
                *(u32x2*)(ptr + (size_t)(cb + j) * 32768) = w;
                c0 = dec * c0 + s * bflo(g[j].x); c1 = dec * c1 + s * bfhi(g[j].x); c2 = dec * c2 + s * bflo(g[j].y); c3 = dec * c3 + s * bfhi(g[j].y);
            }
        }
        {
            const int vl = (off >> 7) & 15, d = off & 127;
            tile[(d + 0) * 20 + vl] = c0; tile[(d + 1) * 20 + vl] = c1; tile[(d + 2) * 20 + vl] = c2; tile[(d + 3) * 20 + vl] = c3;
            __syncthreads();
            const int dd = tid >> 2, vq = tid & 3, v0 = (blk & 15) * 16;
            const f32x4 o = (f32x4){tile[dd * 20 + 4 * vq], tile[dd * 20 + 4 * vq + 1], tile[dd * 20 + 4 * vq + 2], tile[dd * 20 + 4 * vq + 3]};
            __builtin_nontemporal_store(o, (f32x4*)(p.out + O_PC + (size_t)bh * 32768 + (size_t)dd * 256 + v0 + 4 * vq));
        }
        if (tid < 8) {
            float n = 0.f;
#pragma unroll
            for (int c = 0; c < 64; ++c) { gp[(size_t)c * 128] = n; n = decs[c] * n + scls[c] * gnv[c]; }
            p.out[O_PN + bh * 128 + (blk & 15) * 8 + tid] = n;
        }
        __syncthreads();
    }
}

__device__ __forceinline__ void mlstm_out_unit(const Params& p, unsigned char* lds, int u) {
    const int tid = threadIdx.x, lane = tid & 63, wid = tid >> 6, fr = lane & 15, fq = lane >> 4;
    const int bh = u >> 6, c = u & 63, b = bh >> 2, h = bh & 3, base = b * 4096 + c * 64;
    unsigned char* ws = p.ws;
    const bf16_t* P = (const bf16_t*)(ws + WS_P); const float* gates = (const float*)(ws + WS_GATES);
    const bf16_t* CT = (const bf16_t*)p.out + (size_t)u * 32768;
    bf16_t* Qs = (bf16_t*)lds;
    bf16_t* Ks = Qs + 64 * 136;
    bf16_t* Ac = Ks + 64 * 136;
    bf16_t* VT = Ac + 64 * 200;
    float* sm = (float*)(VT + 256 * 72);
    float *bt = sm, *lmb = sm + 64, *mt = sm + 128, *at = sm + 192, *den = sm + 256, *hss = sm + 320, *npv = sm + 384;
    bf16x8 cf[2][4];
#pragma unroll
    for (int vt = 0; vt < 2; ++vt)
#pragma unroll
        for (int kd = 0; kd < 4; ++kd) cf[vt][kd] = *(const bf16x8*)(CT + (32 * wid + 16 * vt + fr) * 128 + 32 * kd + 8 * fq);
    if (wid == 0) {
        const float lf = gates[(size_t)(base + lane) * 8 + 4 + h], li = gates[(size_t)(base + lane) * 8 + h];
        const float bc = scan_sum(lf, lane);
        const float lm = li - bc;
        const float pm = scan_max(lm, lane);
        const float mprev = ((const float*)(ws + WS_MPREV))[u];
        const float inter = bc + mprev;
        const float m_t = fmaxf(inter, bc + pm);
        bt[lane] = bc; lmb[lane] = lm; mt[lane] = m_t; at[lane] = __expf(inter - m_t); den[lane] = 0.f; hss[lane] = 0.f;
    }
    if (wid == 1) { const float* NP = (const float*)(ws + WS_GN) + (size_t)u * 128; npv[lane] = NP[lane]; npv[64 + lane] = NP[64 + lane]; }
    __syncthreads();
#pragma unroll
    for (int i = 0; i < 2; ++i) {
        const int ci = tid + 512 * i, t = ci >> 4, dch = ci & 15;
        const u32x4 qv = *(const u32x4*)(P + (size_t)(base + t) * NIN + h * 128 + dch * 8);
        const u32x4 kv = *(const u32x4*)(P + (size_t)(base + t) * NIN + 512 + h * 128 + dch * 8);
        *(u32x4*)(Qs + t * 136 + dch * 8) = qv;
        *(u32x4*)(Ks + t * 136 + dch * 8) = kv;
        const float a = at[t];
        u32x4 sq; sq.x = cvt_pk_bf16(bflo(qv.x) * a, bfhi(qv.x) * a); sq.y = cvt_pk_bf16(bflo(qv.y) * a, bfhi(qv.y) * a);
        sq.z = cvt_pk_bf16(bflo(qv.z) * a, bfhi(qv.z) * a); sq.w = cvt_pk_bf16(bflo(qv.w) * a, bfhi(qv.w) * a);
        *(u32x4*)(Ac + t * 200 + 64 + dch * 8) = sq;
    }
    {
        const bf16_t* Pv = P + (size_t)(base + lane) * NIN + 1024 + h * 256;
#pragma unroll
        for (int i = 0; i < 4; ++i) {
            const int vch = wid * 4 + i; const u32x4 r = *(const u32x4*)(Pv + vch * 8);
            bf16_t* dst = VT + (vch * 8) * 72 + lane;
            dst[0 * 72] = (bf16_t)(r.x & 0xffff); dst[1 * 72] = (bf16_t)(r.x >> 16); dst[2 * 72] = (bf16_t)(r.y & 0xffff); dst[3 * 72] = (bf16_t)(r.y >> 16);
            dst[4 * 72] = (bf16_t)(r.z & 0xffff); dst[5 * 72] = (bf16_t)(r.z >> 16); dst[6 * 72] = (bf16_t)(r.w & 0xffff); dst[7 * 72] = (bf16_t)(r.w >> 16);
        }
    }
    __syncthreads();
    {
        const int tt = wid >> 1;
#pragma unroll
        for (int j = 0; j < 2; ++j) {
            const int st = 2 * (wid & 1) + j;
            const int t = 16 * tt + fr, s0 = 16 * st + 4 * fq;
            u32x2 w; w.x = 0u; w.y = 0u;
            if (st <= tt) {
                f32x4 a = (f32x4){0.f, 0.f, 0.f, 0.f};
#pragma unroll
                for (int kd = 0; kd < 4; ++kd) {
                    const bf16x8 x = *(const bf16x8*)(Ks + (16 * st + fr) * 136 + 32 * kd + 8 * fq);
                    const bf16x8 y = *(const bf16x8*)(Qs + (16 * tt + fr) * 136 + 32 * kd + 8 * fq);
                    a = MFMA32(x, y, a);
                }
                const float e0 = bt[t] - mt[t];
                float vals[4];
#pragma unroll
                for (int i = 0; i < 4; ++i) { const int s = s0 + i; vals[i] = (s <= t) ? a[i] * __expf(e0 + lmb[s]) : 0.f; }
                float rs = (vals[0] + vals[1]) + (vals[2] + vals[3]);
                rs += __shfl_xor(rs, 16); rs += __shfl_xor(rs, 32);
                if (fq == 0) atomicAdd(&den[t], rs);
                w.x = cvt_pk_bf16(vals[0], vals[1]); w.y = cvt_pk_bf16(vals[2], vals[3]);
            }
            *(u32x2*)(Ac + t * 200 + s0) = w;
        }
#pragma unroll
        for (int i = 0; i < 8; ++i) {
            const int t = 8 * wid + i;
            float a = bf2f(Qs[t * 136 + lane]) * npv[lane] + bf2f(Qs[t * 136 + 64 + lane]) * npv[64 + lane];
            a = wave_sum(a);
            if (lane == 0) atomicAdd(&den[t], at[t] * a);
        }
    }
    __syncthreads();
    f32x4 acc[4][2];
#pragma unroll
    for (int a = 0; a < 4; ++a)
#pragma unroll
        for (int d = 0; d < 2; ++d) acc[a][d] = (f32x4){0.f, 0.f, 0.f, 0.f};
#pragma unroll
    for (int kk = 0; kk < 6; ++kk) {
        bf16x8 x[2];
#pragma unroll
        for (int vt = 0; vt < 2; ++vt) x[vt] = (kk < 2) ? *(const bf16x8*)(VT + (32 * wid + 16 * vt + fr) * 72 + 32 * kk + 8 * fq) : cf[vt][kk >= 2 ? kk - 2 : 0];
#pragma unroll
        for (int tt = 0; tt < 4; ++tt) {
            const bf16x8 y = *(const bf16x8*)(Ac + (16 * tt + fr) * 200 + 32 * kk + 8 * fq);
#pragma unroll
            for (int vt = 0; vt < 2; ++vt) acc[tt][vt] = MFMA32(x[vt], y, acc[tt][vt]);
        }
    }
#pragma unroll
    for (int tt = 0; tt < 4; ++tt) {
        const int t = 16 * tt + fr;
        const float inv = 1.f / fmaxf(fabsf(den[t]), __expf(-mt[t]));
        float ssq = 0.f;
#pragma unroll
        for (int vt = 0; vt < 2; ++vt) { acc[tt][vt] = acc[tt][vt] * inv; const f32x4 a = acc[tt][vt]; ssq += (a.x * a.x + a.y * a.y) + (a.z * a.z + a.w * a.w); }
        ssq += __shfl_xor(ssq, 16); ssq += __shfl_xor(ssq, 32);
        if (fq == 0) atomicAdd(&hss[t], ssq);
    }
    __syncthreads();
    {
        bf16_t* HG = (bf16_t*)(ws + WS_HG);
#pragma unroll
        for (int tt = 0; tt < 4; ++tt) {
            const int t = 16 * tt + fr;
            const float rstd = rsqrtf(hss[t] * (1.f / 256.f) + EPS);
#pragma unroll
            for (int vt = 0; vt < 2; ++vt) {
                const int v0 = 32 * wid + 16 * vt + 4 * fq;
                const u32x2 ob = *(const u32x2*)(P + (size_t)(base + t) * NIN + 2048 + h * 256 + v0);
                const f32x4 g = *(const f32x4*)(p.ml_head_g + h * 256 + v0);
                const f32x4 a = acc[tt][vt];
                u32x2 w;
                w.x = cvt_pk_bf16(a.x * rstd * g.x * sigmoidf_(bflo(ob.x)), a.y * rstd * g.y * sigmoidf_(bfhi(ob.x)));
                w.y = cvt_pk_bf16(a.z * rstd * g.z * sigmoidf_(bflo(ob.y)), a.w * rstd * g.w * sigmoidf_(bfhi(ob.y)));
                *(u32x2*)(HG + (size_t)(base + t) * D + h * 256 + v0) = w;
            }
        }
    }
    __syncthreads();
}

__device__ __forceinline__ void norm_frag(const u32x4 r0, const u32x4 r1, const float* __restrict__ g, float extra, int fq, bf16x8& o0, bf16x8& o1) {
    float f[16];
    f[0] = bflo(r0.x); f[1] = bfhi(r0.x); f[2] = bflo(r0.y); f[3] = bfhi(r0.y); f[4] = bflo(r0.z); f[5] = bfhi(r0.z); f[6] = bflo(r0.w); f[7] = bfhi(r0.w);
    f[8] = bflo(r1.x); f[9] = bfhi(r1.x); f[10] = bflo(r1.y); f[11] = bfhi(r1.y); f[12] = bflo(r1.z); f[13] = bfhi(r1.z); f[14] = bflo(r1.w); f[15] = bfhi(r1.w);
    float s = 0.f;
#pragma unroll
    for (int i = 0; i < 16; ++i) s += f[i] * f[i];
    s += __shfl_xor(s, 16); s += __shfl_xor(s, 32);
    const float rs = rsqrtf(s * (1.f / 64.f) + EPS) * extra;
    const f32x4 ga = *(const f32x4*)(g + 8 * fq), gb = *(const f32x4*)(g + 8 * fq + 4), gc = *(const f32x4*)(g + 32 + 8 * fq), gd = *(const f32x4*)(g + 32 + 8 * fq + 4);
    u32x4 a, b2;
    a.x = cvt_pk_bf16(f[0] * rs * ga.x, f[1] * rs * ga.y); a.y = cvt_pk_bf16(f[2] * rs * ga.z, f[3] * rs * ga.w);
    a.z = cvt_pk_bf16(f[4] * rs * gb.x, f[5] * rs * gb.y); a.w = cvt_pk_bf16(f[6] * rs * gb.z, f[7] * rs * gb.w);
    b2.x = cvt_pk_bf16(f[8] * rs * gc.x, f[9] * rs * gc.y); b2.y = cvt_pk_bf16(f[10] * rs * gc.z, f[11] * rs * gc.w);
    b2.z = cvt_pk_bf16(f[12] * rs * gd.x, f[13] * rs * gd.y); b2.w = cvt_pk_bf16(f[14] * rs * gd.z, f[15] * rs * gd.w);
    o0 = __builtin_bit_cast(bf16x8, a); o1 = __builtin_bit_cast(bf16x8, b2);
}

__device__ __forceinline__ void attn_prompt_unit(const Params& p, unsigned char* lds, int u) {
    const int tid = threadIdx.x, lane = tid & 63, wid = tid >> 6, fr = lane & 15, fq = lane >> 4;
    const int qb = u & 31, kvh = (u >> 5) & 3, b = u >> 7;
    unsigned char* ws = p.ws;
    const bf16_t* KVQ = (const bf16_t*)(ws + WS_KVQ);
    bf16_t* AO = (bf16_t*)(ws + WS_ATT);
    bf16_t* Ks = (bf16_t*)lds;
    bf16_t* VT = Ks + 256 * 72;
    const int pos0 = qb * 128 - 128;
    u32x4 qr[4][2];
    {
        const int g_ = wid >> 1, half_ = wid & 1, head_ = kvh * 4 + g_;
#pragma unroll
        for (int m = 0; m < 4; ++m) {
            const bf16_t* qp = KVQ + ((size_t)b * 4096 + qb * 128 + 64 * half_ + 16 * m + fr) * NKVQ + 512 + head_ * 64;
            qr[m][0] = __builtin_nontemporal_load((const u32x4*)(qp + 8 * fq)); qr[m][1] = __builtin_nontemporal_load((const u32x4*)(qp + 32 + 8 * fq));
        }
    }
#pragma unroll
    for (int i = 0; i < 4; ++i) {
        const int ci = tid + 512 * i, j = ci >> 3, ch = ci & 7, pos = pos0 + j;
        u32x4 r = (u32x4){0u, 0u, 0u, 0u};
        if (pos >= 0) r = *(const u32x4*)(KVQ + (size_t)(b * 4096 + pos) * NKVQ + kvh * 64 + ch * 8);
        float f[8] = {bflo(r.x), bfhi(r.x), bflo(r.y), bfhi(r.y), bflo(r.z), bfhi(r.z), bflo(r.w), bfhi(r.w)};
        float s = 0.f;
#pragma unroll
        for (int e = 0; e < 8; ++e) s += f[e] * f[e];
        s += __shfl_xor(s, 1); s += __shfl_xor(s, 2); s += __shfl_xor(s, 4);
        const float rs = rsqrtf(s * (1.f / 64.f) + EPS);
        const f32x4 g0 = *(const f32x4*)(p.k_norm_g + ch * 8), g1 = *(const f32x4*)(p.k_norm_g + ch * 8 + 4);
        f[0] *= rs * g0.x; f[1] *= rs * g0.y; f[2] *= rs * g0.z; f[3] *= rs * g0.w; f[4] *= rs * g1.x; f[5] *= rs * g1.y; f[6] *= rs * g1.z; f[7] *= rs * g1.w;
        u32x4 w; w.x = cvt_pk_bf16(f[0], f[1]); w.y = cvt_pk_bf16(f[2], f[3]); w.z = cvt_pk_bf16(f[4], f[5]); w.w = cvt_pk_bf16(f[6], f[7]);
        *(u32x4*)(Ks + j * 72 + ch * 8) = w;
        if (qb == 31 && j >= 128) {
            float* o = p.out + O_PWK + ((size_t)(b * 128 + (j - 128)) * 4 + kvh) * 64 + ch * 8;
            *(f32x4*)o = (f32x4){f[0], f[1], f[2], f[3]}; *(f32x4*)(o + 4) = (f32x4){f[4], f[5], f[6], f[7]};
        }
    }
#pragma unroll
    for (int i = 0; i < 4; ++i) {
        const int ci = tid + 512 * i, j = ci & 255, ch = ci >> 8, pos = pos0 + j;
        u32x4 r = (u32x4){0u, 0u, 0u, 0u};
        if (pos >= 0) r = *(const u32x4*)(KVQ + (size_t)(b * 4096 + pos) * NKVQ + 256 + kvh * 64 + ch * 8);
        bf16_t* dst = VT + (ch * 8) * 264 + j;
        dst[0 * 264] = (bf16_t)(r.x & 0xffff); dst[1 * 264] = (bf16_t)(r.x >> 16); dst[2 * 264] = (bf16_t)(r.y & 0xffff); dst[3 * 264] = (bf16_t)(r.y >> 16);
        dst[4 * 264] = (bf16_t)(r.z & 0xffff); dst[5 * 264] = (bf16_t)(r.z >> 16); dst[6 * 264] = (bf16_t)(r.w & 0xffff); dst[7 * 264] = (bf16_t)(r.w >> 16);
        if (qb == 31 && j >= 128) {
            float* o = p.out + O_PWV + ((size_t)(b * 128 + (j - 128)) * 4 + kvh) * 64 + ch * 8;
            *(f32x4*)o = (f32x4){bflo(r.x), bfhi(r.x), bflo(r.y), bfhi(r.y)}; *(f32x4*)(o + 4) = (f32x4){bflo(r.z), bfhi(r.z), bflo(r.w), bfhi(r.w)};
        }
    }
    __syncthreads();
    const int g = wid >> 1, half = wid & 1, head = kvh * 4 + g;
    const float sink = p.att_sinks[head];
    const float* qg = p.q_norm_g;
#pragma unroll
    for (int m = 0; m < 4; ++m) {
        const int j0 = 64 * half + 16 * m;
        const size_t R = (size_t)b * 4096 + qb * 128 + j0 + fr;
        bf16x8 q0, q1; norm_frag(qr[m][0], qr[m][1], qg, 0.125f, fq, q0, q1);
        f32x4 s[9];
#pragma unroll
        for (int i = 0; i < 9; ++i) {
            s[i] = (f32x4){0.f, 0.f, 0.f, 0.f};
            const bf16_t* kr = Ks + (j0 + 16 * i + fr) * 72 + 8 * fq;
            s[i] = MFMA32(*(const bf16x8*)kr, q0, s[i]);
            s[i] = MFMA32(*(const bf16x8*)(kr + 32), q1, s[i]);
        }
        float mx = sink;
#pragma unroll
        for (int e = 0; e < 4; ++e) {
            s[0][e] = (4 * fq + e >= fr) ? s[0][e] : -INFINITY;
            s[8][e] = (4 * fq + e <= fr) ? s[8][e] : -INFINITY;
        }
        if (pos0 < 0) {
#pragma unroll
            for (int i = 0; i < 9; ++i)
#pragma unroll
                for (int e = 0; e < 4; ++e) s[i][e] = (pos0 + j0 + 16 * i + 4 * fq + e >= 0) ? s[i][e] : -INFINITY;
        }
#pragma unroll
        for (int i = 0; i < 9; ++i)
#pragma unroll
            for (int e = 0; e < 4; ++e) mx = fmaxf(mx, s[i][e]);
        mx = fmaxf(mx, __shfl_xor(mx, 16)); mx = fmaxf(mx, __shfl_xor(mx, 32));
        float l = 0.f;
        bf16x4 pf[9];
#pragma unroll
        for (int i = 0; i < 9; ++i) {
            float e0 = __expf(s[i][0] - mx), e1 = __expf(s[i][1] - mx), e2 = __expf(s[i][2] - mx), e3 = __expf(s[i][3] - mx);
            l += (e0 + e1) + (e2 + e3);
            u32x2 w; w.x = cvt_pk_bf16(e0, e1); w.y = cvt_pk_bf16(e2, e3);
            pf[i] = __builtin_bit_cast(bf16x4, w);
        }
        l += __shfl_xor(l, 16); l += __shfl_xor(l, 32);
        l += __expf(sink - mx);
        const float inv = 1.f / l;
        f32x4 o[4];
#pragma unroll
        for (int dt = 0; dt < 4; ++dt) {
            o[dt] = (f32x4){0.f, 0.f, 0.f, 0.f};
#pragma unroll
            for (int i = 0; i < 9; ++i) {
                const bf16x4 vf = *(const bf16x4*)(VT + (16 * dt + fr) * 264 + j0 + 16 * i + 4 * fq);
                o[dt] = MFMA16(vf, pf[i], o[dt]);
            }
        }
#pragma unroll
        for (int dt = 0; dt < 4; ++dt) {
            u32x2 w; w.x = cvt_pk_bf16(o[dt].x * inv, o[dt].y * inv); w.y = cvt_pk_bf16(o[dt].z * inv, o[dt].w * inv);
            *(u32x2*)(AO + R * D + head * 64 + 16 * dt + 4 * fq) = w;
        }
    }
    __syncthreads();
}

__device__ __forceinline__ void attn_sample_unit(const Params& p, int u, int lane) {
    const int fr = lane & 15, fq = lane >> 4;
    const int b = u >> 2, kvh = u & 3;
    unsigned char* ws = p.ws;
    const bf16_t* KVQ = (const bf16_t*)(ws + WS_KVQ);
    bf16_t* AO = (bf16_t*)(ws + WS_ATT);
    const float* ck = p.cache_k + (size_t)b * 128 * 256 + kvh * 64;
    const float* cv = p.cache_v + (size_t)b * 128 * 256 + kvh * 64;
    float* owk = p.out + O_SWK + (size_t)b * 128 * 256 + kvh * 64;
    float* owv = p.out + O_SWV + (size_t)b * 128 * 256 + kvh * 64;
    const size_t rbase = (size_t)TP + b * 4;
    for (int i = lane; i < 124 * 16; i += 64) {
        const int j = i >> 4, d4 = (i & 15) * 4;
        *(f32x4*)(owk + (size_t)j * 256 + d4) = *(const f32x4*)(ck + (size_t)(j + 4) * 256 + d4);
        *(f32x4*)(owv + (size_t)j * 256 + d4) = *(const f32x4*)(cv + (size_t)(j + 4) * 256 + d4);
    }
    {
        const int t = lane >> 4, d4 = (lane & 15) * 4;
        const u32x2 kr = *(const u32x2*)(KVQ + (rbase + t) * NKVQ + kvh * 64 + d4);
        const u32x2 vr = *(const u32x2*)(KVQ + (rbase + t) * NKVQ + 256 + kvh * 64 + d4);
        float f0 = bflo(kr.x), f1 = bfhi(kr.x), f2 = bflo(kr.y), f3 = bfhi(kr.y);
        float s = (f0 * f0 + f1 * f1) + (f2 * f2 + f3 * f3);
        s += __shfl_xor(s, 1); s += __shfl_xor(s, 2); s += __shfl_xor(s, 4); s += __shfl_xor(s, 8);
        const float rs = rsqrtf(s * (1.f / 64.f) + EPS);
        const f32x4 g = *(const f32x4*)(p.k_norm_g + d4);
        *(f32x4*)(owk + (size_t)(124 + t) * 256 + d4) = (f32x4){f0 * rs * g.x, f1 * rs * g.y, f2 * rs * g.z, f3 * rs * g.w};
        *(f32x4*)(owv + (size_t)(124 + t) * 256 + d4) = (f32x4){bflo(vr.x), bfhi(vr.x), bflo(vr.y), bfhi(vr.y)};
    }
    const int g = fr >> 2, t = fr & 3, head = kvh * 4 + g;
    const bf16_t* qp = KVQ + (rbase + t) * NKVQ + 512 + head * 64;
    const u32x4 r0 = *(const u32x4*)(qp + 8 * fq), r1 = *(const u32x4*)(qp + 32 + 8 * fq);
    bf16x8 q0, q1; norm_frag(r0, r1, p.q_norm_g, 0.125f, fq, q0, q1);
    const float sink = p.att_sinks[head];
    bf16x8 nk0, nk1;
    {
        const bf16_t* kp = KVQ + (rbase + (fr & 3)) * NKVQ + kvh * 64;
        const u32x4 a0 = *(const u32x4*)(kp + 8 * fq), a1 = *(const u32x4*)(kp + 32 + 8 * fq);
        norm_frag(a0, a1, p.k_norm_g, 1.f, fq, nk0, nk1);
        if (fr >= 4) { nk0 = (bf16x8){0, 0, 0, 0, 0, 0, 0, 0}; nk1 = nk0; }
    }
    f32x4 s[9];
#pragma unroll
    for (int i = 0; i < 8; ++i) {
        const float* kr = ck + (size_t)(16 * i + fr) * 256 + 8 * fq;
        const f32x4 a = *(const f32x4*)kr, b2 = *(const f32x4*)(kr + 4), c = *(const f32x4*)(kr + 32), d = *(const f32x4*)(kr + 36);
        u32x4 x0, x1;
        x0.x = cvt_pk_bf16(a.x, a.y); x0.y = cvt_pk_bf16(a.z, a.w); x0.z = cvt_pk_bf16(b2.x, b2.y); x0.w = cvt_pk_bf16(b2.z, b2.w);
        x1.x = cvt_pk_bf16(c.x, c.y); x1.y = cvt_pk_bf16(c.z, c.w); x1.z = cvt_pk_bf16(d.x, d.y); x1.w = cvt_pk_bf16(d.z, d.w);
        s[i] = (f32x4){0.f, 0.f, 0.f, 0.f};
        s[i] = MFMA32(__builtin_bit_cast(bf16x8, x0), q0, s[i]);
        s[i] = MFMA32(__builtin_bit_cast(bf16x8, x1), q1, s[i]);
    }
    s[8] = (f32x4){0.f, 0.f, 0.f, 0.f};
    s[8] = MFMA32(nk0, q0, s[8]); s[8] = MFMA32(nk1, q1, s[8]);
    float mx = sink;
#pragma unroll
    for (int i = 0; i < 9; ++i)
#pragma unroll
        for (int e = 0; e < 4; ++e) {
            const int j = 16 * i + 4 * fq + e;
            const bool ok = (j >= t) && (j <= t + 128);
            s[i][e] = ok ? s[i][e] : -INFINITY;
            mx = fmaxf(mx, s[i][e]);
        }
    mx = fmaxf(mx, __shfl_xor(mx, 16)); mx = fmaxf(mx, __shfl_xor(mx, 32));
    float l = 0.f; bf16x4 pf[9];
#pragma unroll
    for (int i = 0; i < 9; ++i) {
        float e0 = __expf(s[i][0] - mx), e1 = __expf(s[i][1] - mx), e2 = __expf(s[i][2] - mx), e3 = __expf(s[i][3] - mx);
        l += (e0 + e1) + (e2 + e3);
        u32x2 w; w.x = cvt_pk_bf16(e0, e1); w.y = cvt_pk_bf16(e2, e3);
        pf[i] = __builtin_bit_cast(bf16x4, w);
    }
    l += __shfl_xor(l, 16); l += __shfl_xor(l, 32);
    l += __expf(sink - mx);
    const float inv = 1.f / l;
#pragma unroll
    for (int dt = 0; dt < 4; ++dt) {
        f32x4 o = (f32x4){0.f, 0.f, 0.f, 0.f};
#pragma unroll
        for (int i = 0; i < 8; ++i) {
            const float* vr = cv + (size_t)(16 * i + 4 * fq) * 256 + 16 * dt + fr;
            u32x2 w; w.x = cvt_pk_bf16(vr[0], vr[256]); w.y = cvt_pk_bf16(vr[512], vr[768]);
            o = MFMA16(__builtin_bit_cast(bf16x4, w), pf[i], o);
        }
        {
            u32x2 w; w.x = 0u; w.y = 0u;
            const bf16_t* vp = KVQ + rbase * NKVQ + 256 + kvh * 64 + 16 * dt + fr;
            const unsigned v0 = vp[0], v1 = vp[NKVQ], v2 = vp[2 * NKVQ], v3 = vp[3 * NKVQ];
            if (fq == 0) { w.x = v0 | (v1 << 16); w.y = v2 | (v3 << 16); }
            o = MFMA16(__builtin_bit_cast(bf16x4, w), pf[8], o);
        }
        u32x2 w; w.x = cvt_pk_bf16(o.x * inv, o.y * inv); w.y = cvt_pk_bf16(o.z * inv, o.w * inv);
        *(u32x2*)(AO + (rbase + t) * D + head * 64 + 16 * dt + 4 * fq) = w;
    }
}


__device__ __forceinline__ void attn_sample_block(const Params& p, unsigned char* lds, int u) {
    const int tid = threadIdx.x, lane = tid & 63, wid = tid >> 6, fr = lane & 15, fq = lane >> 4;
    const int b = u >> 2, kvh = u & 3;
    unsigned char* ws = p.ws;
    const bf16_t* KVQ = (const bf16_t*)(ws + WS_KVQ);
    bf16_t* AO = (bf16_t*)(ws + WS_ATT);
    const float* ck = p.cache_k + (size_t)b * 128 * 256 + kvh * 64;
    const float* cv = p.cache_v + (size_t)b * 128 * 256 + kvh * 64;
    float* owk = p.out + O_SWK + (size_t)b * 128 * 256 + kvh * 64;
    float* owv = p.out + O_SWV + (size_t)b * 128 * 256 + kvh * 64;
    const size_t rbase = (size_t)TP + b * 4;
    bf16_t* Ks = (bf16_t*)lds;
    bf16_t* VT = Ks + 144 * 72;
    f32x4 kf[4], vf[4];
#pragma unroll
    for (int i = 0; i < 4; ++i) { const int idx = tid + 512 * i, j = idx >> 4, c4 = (idx & 15) * 4; kf[i] = __builtin_nontemporal_load((const f32x4*)(ck + (size_t)j * 256 + c4)); vf[i] = __builtin_nontemporal_load((const f32x4*)(cv + (size_t)j * 256 + c4)); }
#pragma unroll
    for (int i = 0; i < 4; ++i) {
        const int idx = tid + 512 * i, j = idx >> 4, c4 = (idx & 15) * 4;
        if (j >= 4) { __builtin_nontemporal_store(kf[i], (f32x4*)(owk + (size_t)(j - 4) * 256 + c4)); __builtin_nontemporal_store(vf[i], (f32x4*)(owv + (size_t)(j - 4) * 256 + c4)); }
        u32x2 w; w.x = cvt_pk_bf16(kf[i].x, kf[i].y); w.y = cvt_pk_bf16(kf[i].z, kf[i].w);
        *(u32x2*)(Ks + j * 72 + c4) = w;
        VT[(c4 + 0) * 152 + j] = f2bf(vf[i].x); VT[(c4 + 1) * 152 + j] = f2bf(vf[i].y); VT[(c4 + 2) * 152 + j] = f2bf(vf[i].z); VT[(c4 + 3) * 152 + j] = f2bf(vf[i].w);
    }
    if (tid < 64) {
        const int t = tid >> 4, d4 = (tid & 15) * 4;
        const u32x2 kr = *(const u32x2*)(KVQ + (rbase + t) * NKVQ + kvh * 64 + d4);
        const u32x2 vr = *(const u32x2*)(KVQ + (rbase + t) * NKVQ + 256 + kvh * 64 + d4);
        float f0 = bflo(kr.x), f1 = bfhi(kr.x), f2 = bflo(kr.y), f3 = bfhi(kr.y);
        float s = (f0 * f0 + f1 * f1) + (f2 * f2 + f3 * f3);
        s += __shfl_xor(s, 1); s += __shfl_xor(s, 2); s += __shfl_xor(s, 4); s += __shfl_xor(s, 8);
        const float rs = rsqrtf(s * (1.f / 64.f) + EPS);
        const f32x4 g = *(const f32x4*)(p.k_norm_g + d4);
        f0 *= rs * g.x; f1 *= rs * g.y; f2 *= rs * g.z; f3 *= rs * g.w;
        *(f32x4*)(owk + (size_t)(124 + t) * 256 + d4) = (f32x4){f0, f1, f2, f3};
        *(f32x4*)(owv + (size_t)(124 + t) * 256 + d4) = (f32x4){bflo(vr.x), bfhi(vr.x), bflo(vr.y), bfhi(vr.y)};
        u32x2 w; w.x = cvt_pk_bf16(f0, f1); w.y = cvt_pk_bf16(f2, f3);
        *(u32x2*)(Ks + (128 + t) * 72 + d4) = w;
        VT[(d4 + 0) * 152 + 128 + t] = (bf16_t)(vr.x & 0xffff); VT[(d4 + 1) * 152 + 128 + t] = (bf16_t)(vr.x >> 16);
        VT[(d4 + 2) * 152 + 128 + t] = (bf16_t)(vr.y & 0xffff); VT[(d4 + 3) * 152 + 128 + t] = (bf16_t)(vr.y >> 16);
    } else if (tid < 64 + 192) {
        const int i = tid - 64;
        if (i < 96) { const int r = 132 + (i >> 3), c8 = (i & 7) * 8; *(u32x4*)(Ks + r * 72 + c8) = (u32x4){0u, 0u, 0u, 0u}; }
        else { const int d = i - 96; if (d < 64) { bf16_t* z = VT + d * 152 + 132; for (int e = 0; e < 12; ++e) z[e] = 0; } }
    }
    __syncthreads();
    if (wid < 4) {
        const int dt = wid;
        const int g = fr >> 2, t = fr & 3, head = kvh * 4 + g;
        const bf16_t* qp = KVQ + (rbase + t) * NKVQ + 512 + head * 64;
        const u32x4 r0 = *(const u32x4*)(qp + 8 * fq), r1 = *(const u32x4*)(qp + 32 + 8 * fq);
        bf16x8 q0, q1; norm_frag(r0, r1, p.q_norm_g, 0.125f, fq, q0, q1);
        const float sink = p.att_sinks[head];
        f32x4 s[9];
#pragma unroll
        for (int i = 0; i < 9; ++i) {
            s[i] = (f32x4){0.f, 0.f, 0.f, 0.f};
            const bf16_t* kr = Ks + (16 * i + fr) * 72 + 8 * fq;
            s[i] = MFMA32(*(const bf16x8*)kr, q0, s[i]);
            s[i] = MFMA32(*(const bf16x8*)(kr + 32), q1, s[i]);
        }
        float mx = sink;
#pragma unroll
        for (int i = 0; i < 9; ++i)
#pragma unroll
            for (int e = 0; e < 4; ++e) {
                const int j = 16 * i + 4 * fq + e;
                const bool ok = (j >= t) && (j <= t + 128);
                s[i][e] = ok ? s[i][e] : -INFINITY;
                mx = fmaxf(mx, s[i][e]);
            }
        mx = fmaxf(mx, __shfl_xor(mx, 16)); mx = fmaxf(mx, __shfl_xor(mx, 32));
        float l = 0.f;
        f32x4 o = (f32x4){0.f, 0.f, 0.f, 0.f};
#pragma unroll
        for (int i = 0; i < 9; ++i) {
            const float e0 = __expf(s[i][0] - mx), e1 = __expf(s[i][1] - mx), e2 = __expf(s[i][2] - mx), e3 = __expf(s[i][3] - mx);
            l += (e0 + e1) + (e2 + e3);
            u32x2 w; w.x = cvt_pk_bf16(e0, e1); w.y = cvt_pk_bf16(e2, e3);
            const bf16x4 vfr = *(const bf16x4*)(VT + (16 * dt + fr) * 152 + 16 * i + 4 * fq);
            o = MFMA16(vfr, __builtin_bit_cast(bf16x4, w), o);
        }
        l += __shfl_xor(l, 16); l += __shfl_xor(l, 32);
        l += __expf(sink - mx);
        const float inv = 1.f / l;
        u32x2 w; w.x = cvt_pk_bf16(o.x * inv, o.y * inv); w.y = cvt_pk_bf16(o.z * inv, o.w * inv);
        *(u32x2*)(AO + (rbase + t) * D + head * 64 + 16 * dt + 4 * fq) = w;
    }
    __syncthreads();
}

#define LAS __attribute__((address_space(3)))
#define XB_TMO      128
#define XB_XCNT(j)  (256  + 64 * (j))
#define XB_XSUB(j)  (1280 + 64 * (j))
#define XB_XGEN(j)  (2304 + 64 * (j))
#define XB_TOP      3328
#define XB_TOPGEN   3392
#define XCD_BAR_WORDS 3456
#define XB_SPIN_CAP (1u << 18)

__device__ __forceinline__ unsigned xb_ld(unsigned* p)              { return __hip_atomic_load(p, __ATOMIC_RELAXED, __HIP_MEMORY_SCOPE_AGENT); }
__device__ __forceinline__ unsigned xb_add(unsigned* p, unsigned v) { return __hip_atomic_fetch_add(p, v, __ATOMIC_RELAXED, __HIP_MEMORY_SCOPE_AGENT); }
__device__ __forceinline__ unsigned xb_xcc_id() { return (unsigned)__builtin_amdgcn_s_getreg((3 << 11) | 20) & 0xFu; }
#define XB_SPIN(cond, bar) do { unsigned _sp = 0; while (cond) { __builtin_amdgcn_s_sleep(1); \
    if ((++_sp & 255u) == 0u) { if (xb_ld(&(bar)[XB_TMO])) break; if (_sp > XB_SPIN_CAP) { atomicAdd(&(bar)[XB_TMO], 1u); break; } } } } while (0)

struct XcdBarrier {
    unsigned* bar; unsigned x;
    volatile LAS unsigned* st;
};

__device__ __forceinline__ XcdBarrier xcd_barrier_post(unsigned* bar, volatile LAS unsigned* st) {
    XcdBarrier b; b.bar = bar; b.x = xb_xcc_id(); b.st = st;
    if (threadIdx.x == 0) (void)xb_add(&bar[XB_XCNT(b.x)], 1u);
    return b;
}
__device__ __forceinline__ void xcd_barrier_complete(unsigned* bar, unsigned x, unsigned& nloc, unsigned& nx) {
    const unsigned G = gridDim.x * gridDim.y * gridDim.z;
    unsigned sum, cnt, mine, sp = 0u;
    for (;;) {
        sum = 0u; cnt = 0u; mine = 0u;
#pragma unroll
        for (unsigned j = 0; j < 16; ++j) { const unsigned c = xb_ld(&bar[XB_XCNT(j)]); sum += c; cnt += (c > 0u) ? 1u : 0u; mine = (j == x) ? c : mine; }
        if (sum == G) break;
        __builtin_amdgcn_s_sleep(1);
        if ((++sp & 255u) == 0u) { if (xb_ld(&bar[XB_TMO])) break; if (sp > XB_SPIN_CAP) { atomicAdd(&bar[XB_TMO], 1u); break; } }
    }
    nloc = mine > 0u ? mine : 1u; nx = cnt > 0u ? cnt : 1u;
}

__device__ __forceinline__ void xcd_barrier(const XcdBarrier& b) {
    asm volatile("s_waitcnt vmcnt(0)" ::: "memory");
    __syncthreads();
    if (threadIdx.x == 0) {
        unsigned* bar = b.bar;
        __builtin_amdgcn_s_waitcnt(0);
        unsigned nloc = b.st[0], nx = b.st[1];
        if (nloc == 0u) { xcd_barrier_complete(bar, b.x, nloc, nx); b.st[0] = nloc; b.st[1] = nx; }
        const unsigned old = xb_add(&bar[XB_XSUB(b.x)], 1u);
        const unsigned gen = old / nloc;
        if (old + 1u == (gen + 1u) * nloc) {
            __builtin_amdgcn_fence(__ATOMIC_RELEASE, "agent");
            asm volatile("s_waitcnt vmcnt(0)" ::: "memory");
            const unsigned og = xb_add(&bar[XB_TOP], 1u);
            const unsigned tg = og / nx;
            if (og + 1u == (tg + 1u) * nx) xb_add(&bar[XB_TOPGEN], 1u);
            else XB_SPIN(xb_ld(&bar[XB_TOPGEN]) == tg, bar);
            __builtin_amdgcn_fence(__ATOMIC_ACQUIRE, "agent");
            xb_add(&bar[XB_XGEN(b.x)], 1u);
            asm volatile("s_waitcnt vmcnt(0)" ::: "memory");
        } else {
            XB_SPIN(xb_ld(&bar[XB_XGEN(b.x)]) == gen, bar);
            __builtin_amdgcn_fence(__ATOMIC_ACQUIRE, "agent");
            asm volatile("s_waitcnt vmcnt(0)" ::: "memory");
        }
    }
    __syncthreads();
}

__global__ void __launch_bounds__(NTHREADS) yoco_fwd(Params p) {
    extern __shared__ __attribute__((aligned(16))) unsigned char lds[];
    const int bid = blockIdx.x, G = gridDim.x;
    unsigned char* ws = p.ws;
    float* SS = (float*)(ws + WS_SS);
    float* Y = p.out + O_Y;
    bf16_t* XB = (bf16_t*)(ws + WS_XB);

#define IN(k) (p.ph_lo <= (k) && (k) < p.ph_hi)
    volatile LAS unsigned* bst = (volatile LAS unsigned*)((LAS unsigned char*)lds + 131072 + 64);
    XcdBarrier xbar; xbar.bar = (unsigned*)(ws + WS_BAR); xbar.x = 0; xbar.st = bst;
    int cv = bid;
    if (p.ph_hi - p.ph_lo > 1) {
        if (threadIdx.x < 8) bst[threadIdx.x] = 0u;
        __syncthreads();
        xbar.x = xb_xcc_id();
        if (threadIdx.x == 0) bst[2] = xb_add(&xbar.bar[XB_XCNT(xbar.x)], 1u);
    }
#define SEAM(k) do { if (IN(k) && IN((k) + 1)) xcd_barrier(xbar); } while (0)
    if (IN(0)) { for (int rep = 0; rep < REP_P0; ++rep) p0_prologue(p, lds, bid, G); }
    SEAM(0);
    if (p.ph_hi - p.ph_lo > 1 && IN(0) && IN(1)) {
        if (threadIdx.x == 0) {
            bool ok = (G % 8 == 0) && xbar.x < 8u;
            for (unsigned j = 0; j < 8; ++j) ok = ok && (xb_ld(&xbar.bar[XB_XCNT(j)]) == (unsigned)(G / 8));
            const unsigned rank = bst[2];
            bst[3] = (ok && rank < (unsigned)(G / 8)) ? (xbar.x + 8u * rank) : (unsigned)bid;
        }
        __syncthreads();
        cv = __builtin_amdgcn_readfirstlane((int)bst[3]);
    }
    PG8_LAS unsigned char* l3 = (PG8_LAS unsigned char*)lds;
    float* YS = Y;
#define PGEMM(Aptr, Bptr, Nn, Kk, EpiT, ...) do { pg8::Gemm g_{(const bf16_t*)(Aptr), (const bf16_t*)(Bptr), TP, (Nn), (Kk), ((Kk) == FF) ? 1 : 0}; pg8::StaticOrder S_; S_.init(TP, (Nn), G, cv); \
        Pg8Epi<EpiT> E_{EpiT{__VA_ARGS__}}; pg8::gemm_phase<Pg8Epi<EpiT>, pg8::StaticOrder, true, true>(l3, g_, S_, E_); } while (0)
    if (IN(1)) {
        for (int rep = 0; rep < REP_PG; ++rep) { PGEMM(XB, ws + WS_WIN, NIN, 1024, EpiBf16, (bf16_t*)(ws + WS_P), NIN, nullptr, 0); }
        { EpiBf16 E{(bf16_t*)(ws + WS_P), NIN, nullptr, 0}; for (int rep = 0; rep < REP_SG; ++rep) sgemm64<0>(lds, XB, 1024, (const bf16_t*)(ws + WS_WIN), TP, TS, NIN, 1024, 1, E, bid, G); }
    }
    SEAM(1);
    if (IN(2)) {
        for (int rep = 0; rep < REP_2AL; ++rep) for (int u = bid; u < 1024; u += G) mlstm_local_unit(p, lds, u);
        for (int rep = 0; rep < REP_2AS; ++rep) for (int u = bid; u < 512; u += G) mlstm_sample_unit(p, lds, u);
    }
    SEAM(2);
    if (IN(3)) mlstm_scan(p, lds, bid, G);
    SEAM(3);
    if (IN(4)) { for (int rep = 0; rep < REP_2C; ++rep) for (int u = bid; u < 1024; u += G) mlstm_out_unit(p, lds, u); }
    SEAM(4);
    if (IN(5)) {
        PGEMM(ws + WS_HG, ws + WS_WOUT, 1024, 1024, EpiResB, p.x_prompt, XB, nullptr, SS);
        { EpiAddF32 E{YS}; sgemm64<0>(lds, ws + WS_HG, 1024, (const bf16_t*)(ws + WS_WOUT), TP, TS, 1024, 1024, 1, E, bid, G); }
    }
    SEAM(5);
    if (IN(6)) {
        for (int rep = 0; rep < REP_PG; ++rep) { PGEMM(XB, ws + WS_W1A, FF, 1024, EpiBf16, (bf16_t*)(ws + WS_HID), FF, SS, 1); }
        { EpiBf16 E{(bf16_t*)(ws + WS_HID), FF, nullptr, 1}; for (int rep = 0; rep < REP_SG; ++rep) sgemm64<1>(lds, Y, 1024, (const bf16_t*)(ws + WS_W1A), TP, TS, FF, 1024, 1, E, bid, G); }
    }
    SEAM(6);
    if (IN(7)) {
        PGEMM(ws + WS_HID, ws + WS_W2A, 1024, FF, EpiResB, nullptr, XB, nullptr, SS + T);
        { EpiAtomic E{YS}; sgemm64<0>(lds, ws + WS_HID, FF, (const bf16_t*)(ws + WS_W2A), TP, TS, 1024, FF, 2, E, bid, G); }
    }
    SEAM(7);
    if (IN(8)) {
        for (int rep = 0; rep < REP_PG; ++rep) { PGEMM(XB, ws + WS_WKVQ, NKVQ, 1024, EpiBf16, (bf16_t*)(ws + WS_KVQ), NKVQ, SS + T, 0); }
        { EpiBf16 E{(bf16_t*)(ws + WS_KVQ), NKVQ, nullptr, 0}; for (int rep = 0; rep < REP_SG; ++rep) sgemm64<1>(lds, Y, 1024, (const bf16_t*)(ws + WS_WKVQ), TP, TS, NKVQ, 1024, 1, E, (cv + G / 2) % G, G); }
        __syncthreads();
        if (cv >= G / 2) late_weights(p, lds, cv - G / 2, G - G / 2);
    }
    SEAM(8);
    if (IN(9)) {
        { const int vb = (G % 8 == 0) ? (cv % 8) * (G / 8) + cv / 8 : cv;
          for (int rep = 0; rep < REP_7P; ++rep) for (int u = vb; u < 512; u += G) attn_prompt_unit(p, lds, u); }
        for (int rep = 0; rep < REP_7S; ++rep) for (int u = bid; u < 512; u += G) attn_sample_block(p, lds, u);
    }
    SEAM(9);
    if (IN(10)) {
        PGEMM(ws + WS_ATT, ws + WS_WO, 1024, 1024, EpiResB, nullptr, XB, nullptr, SS + 2 * T);
        { EpiAddF32 E{YS}; sgemm64<0>(lds, ws + WS_ATT, 1024, (const bf16_t*)(ws + WS_WO), TP, TS, 1024, 1024, 1, E, bid, G); }
    }
    SEAM(10);
    if (IN(11)) {
        for (int rep = 0; rep < REP_PG; ++rep) { PGEMM(XB, ws + WS_W1B, FF, 1024, EpiBf16, (bf16_t*)(ws + WS_HID), FF, SS + 2 * T, 1); }
        { EpiBf16 E{(bf16_t*)(ws + WS_HID), FF, nullptr, 1}; for (int rep = 0; rep < REP_SG; ++rep) sgemm64<1>(lds, Y, 1024, (const bf16_t*)(ws + WS_W1B), TP, TS, FF, 1024, 1, E, bid, G); }
    }
    SEAM(11);
    if (IN(12)) {
        PGEMM(ws + WS_HID, ws + WS_W2B, 1024, FF, EpiResB, nullptr, XB, Y, nullptr);
        { EpiAtomic E{YS}; sgemm64<0>(lds, ws + WS_HID, FF, (const bf16_t*)(ws + WS_W2B), TP, TS, 1024, FF, 2, E, bid, G); }
    }
#undef PGEMM
#undef IN
#undef SEAM
}

extern "C" void kernel_launch(void* const* d_in, const int* in_sizes, int n_in, void* d_out, int out_size, void* d_ws, size_t ws_size, hipStream_t stream) {
    static int grid_blocks = 0;
    if (!grid_blocks) {
        if (n_in != 24 || (size_t)out_size != O_END || ws_size < WS_END) { fprintf(stderr, "kernel_launch: unexpected shapes n_in=%d out=%d ws=%zu\n", n_in, out_size, ws_size); grid_blocks = -1; return; }
        int dev = 0, cus = 0, per_cu = 0;
        hipGetDevice(&dev);
        hipDeviceGetAttribute(&cus, hipDeviceAttributeMultiprocessorCount, dev);
        hipFuncSetAttribute((const void*)yoco_fwd, hipFuncAttributeMaxDynamicSharedMemorySize, LDS_BYTES);
        hipOccupancyMaxActiveBlocksPerMultiprocessor(&per_cu, (const void*)yoco_fwd, NTHREADS, LDS_BYTES);
        if (per_cu < 1) per_cu = 1;
        grid_blocks = cus * per_cu;
        (void)hipGetLastError();
    }
    if (grid_blocks < 0) return;
    Params p{};
    const float** pp = (const float**)&p;
    for (int i = 0; i < 24; ++i) pp[i] = (const float*)d_in[i];
    p.out = (float*)d_out; p.ws = (unsigned char*)d_ws;
#if N_LAUNCH_MODE == 1
    p.ph_lo = 0; p.ph_hi = 13;
    (void)hipMemsetAsync((char*)d_ws + WS_BAR, 0, BAR_BYTES, stream);
    void* args[] = {&p};
    hipError_t e = hipLaunchCooperativeKernel((const void*)yoco_fwd, dim3(grid_blocks), dim3(NTHREADS), args, LDS_BYTES, stream);
    if (e != hipSuccess) fprintf(stderr, "cooperative launch failed: %s (grid %d)\n", hipGetErrorString(e), grid_blocks);
#else
    for (int k = 0; k < MAX_PHASE; ++k) { p.ph_lo = k; p.ph_hi = k + 1; hipLaunchKernelGGL(yoco_fwd, dim3(grid_blocks), dim3(NTHREADS), LDS_BYTES, stream, p); }
#endif
}
```
